# Optimizing an MI355X kernel written in HIP

```python
import jax
import jax.numpy as jnp
from jax import lax
import numpy as np

D_MODEL = 2048
BATCH = 4
SEQ = 4096
DEPTH = 4

N_MIXERS = 4
DEEPNORM_ALPHA = (2.0 * DEPTH) ** 0.25
DEEPNORM_BETA = (8.0 * DEPTH) ** -0.25
LN_EPS = 1e-5
D_FF = 4 * D_MODEL
NEG_INF = -1e30

LRU_WIDTH = D_MODEL
LRU_BLOCKS = 8
LRU_BLOCK_W = LRU_WIDTH // LRU_BLOCKS
CONV_WIDTH = 4
LRU_C = 8.0

ATTN_HEAD_DIM = 128
ATTN_HEADS = D_MODEL // ATTN_HEAD_DIM
MOBA_BLOCK = 256
MOBA_TOPK = 3
MOBA_Q_CHUNK = 16
ROPE_THETA = 500000.0
ROPE_DIM = ATTN_HEAD_DIM // 4

RWKV_HEAD_DIM = 64
RWKV_HEADS = D_MODEL // RWKV_HEAD_DIM
RWKV_DECAY_LORA = 96
RWKV_AAA_LORA = 96
RWKV_GATE_LORA = 256
RWKV_LNX_EPS = 64e-5

POOL_WINDOWS = (2, 4, 8, 16)
POOL_GROUPS = len(POOL_WINDOWS)
POOL_GROUP_W = D_MODEL // POOL_GROUPS

kernel_name = "hybrid_rglru_moba_rwkv7_pool_deepnorm"


def _layers_of(mixer):
    return len(range(mixer, DEPTH, N_MIXERS))


def _layer_norm(x, g, b):
    x32 = x.astype(jnp.float32)
    mean = jnp.mean(x32, axis=-1, keepdims=True)
    var = jnp.mean(jnp.square(x32 - mean), axis=-1, keepdims=True)
    return ((x32 - mean) * lax.rsqrt(var + LN_EPS) * g + b).astype(x.dtype)


def _sqrelu_mlp(x, w1, w2):
    h = jax.nn.relu(x @ w1)
    return (h * h) @ w2


def _linear_recurrence_combine(left, right):
    a_l, b_l = left
    a_r, b_r = right
    return a_l * a_r, a_r * b_l + b_r


def _rglru_mixer(x, w_in, conv_w, conv_b, gate_a_w, gate_a_b, gate_x_w, gate_x_b, lam, w_out):
    bsz, seqlen, _ = x.shape
    gate, u = jnp.split(x @ w_in, 2, axis=-1)
    u = lax.conv_general_dilated(
        u, conv_w[:, None, :], window_strides=(1,), padding=[(CONV_WIDTH - 1, 0)],
        dimension_numbers=("NWC", "WIO", "NWC"), feature_group_count=LRU_WIDTH) + conv_b
    ub = u.reshape(bsz, seqlen, LRU_BLOCKS, LRU_BLOCK_W)
    r = jax.nn.sigmoid((jnp.einsum("bsnw,nwv->bsnv", ub, gate_a_w) + gate_a_b).astype(jnp.float32))
    i = jax.nn.sigmoid((jnp.einsum("bsnw,nwv->bsnv", ub, gate_x_w) + gate_x_b).astype(jnp.float32))
    log_a = -LRU_C * r * jax.nn.softplus(-lam.astype(jnp.float32)).reshape(LRU_BLOCKS, LRU_BLOCK_W)
    a = jnp.exp(log_a)
    b = ub.astype(jnp.float32) * i * jnp.sqrt(-jnp.expm1(2.0 * log_a))
    _, h = lax.associative_scan(_linear_recurrence_combine, (a, b), axis=1)
    h = h.reshape(bsz, seqlen, LRU_WIDTH).astype(x.dtype)
    return (jax.nn.gelu(gate) * h) @ w_out


def _partial_rope(t, cos, sin):
    half = ROPE_DIM // 2
    t32 = t.astype(jnp.float32)
    t1, t2 = t32[..., :half], t32[..., half:ROPE_DIM]
    c, s = cos[None, :, None, :], sin[None, :, None, :]
    return jnp.concatenate([t1 * c - t2 * s, t2 * c + t1 * s, t32[..., ROPE_DIM:]], axis=-1).astype(t.dtype)


def _moba_mixer(x, w_qkv, w_out):
    bsz, seqlen, _ = x.shape
    n_blk = -(-seqlen // MOBA_BLOCK)
    pad = n_blk * MOBA_BLOCK - seqlen
    top_k = min(MOBA_TOPK, n_blk)
    qkv = (x @ w_qkv).reshape(bsz, seqlen, 3, ATTN_HEADS, ATTN_HEAD_DIM)
    q, k, v = qkv[:, :, 0], qkv[:, :, 1], qkv[:, :, 2]
    pos = jnp.arange(seqlen, dtype=jnp.float32)
    inv_freq = ROPE_THETA ** (-jnp.arange(0, ROPE_DIM, 2, dtype=jnp.float32) / ROPE_DIM)
    ang = pos[:, None] * inv_freq[None, :]
    cos, sin = jnp.cos(ang), jnp.sin(ang)
    q = (_partial_rope(q, cos, sin) * (ATTN_HEAD_DIM ** -0.5)).transpose(0, 2, 1, 3)
    k = _partial_rope(k, cos, sin).transpose(0, 2, 1, 3)
    v = v.transpose(0, 2, 1, 3)
    blk_shape = (bsz, ATTN_HEADS, n_blk, MOBA_BLOCK, ATTN_HEAD_DIM)
    k_blk = jnp.pad(k, ((0, 0), (0, 0), (0, pad), (0, 0))).reshape(blk_shape)
    v_blk = jnp.pad(v, ((0, 0), (0, 0), (0, pad), (0, 0))).reshape(blk_shape)
    k_mean = jnp.mean(k_blk.astype(jnp.float32), axis=3)
    gate = jnp.einsum("bhsd,bhnd->bhsn", q.astype(jnp.float32), k_mean)
    q_blk = jnp.arange(seqlen) // MOBA_BLOCK
    past = jnp.arange(n_blk)[None, :] < q_blk[:, None]
    gate = jnp.where(past, gate, NEG_INF)
    _, sel = lax.top_k(gate, top_k)
    sel_valid = sel < q_blk[:, None]
    b_idx = jnp.arange(bsz)[:, None, None, None]
    h_idx = jnp.arange(ATTN_HEADS)[None, :, None, None]
    key_off = jnp.arange(MOBA_BLOCK)
    n_sel = top_k * MOBA_BLOCK

    def chunk(c):
        start = c * MOBA_Q_CHUNK
        q_c = lax.dynamic_slice_in_dim(q, start, MOBA_Q_CHUNK, axis=2)
        sel_c = lax.dynamic_slice_in_dim(sel, start, MOBA_Q_CHUNK, axis=2)
        valid_c = lax.dynamic_slice_in_dim(sel_valid, start, MOBA_Q_CHUNK, axis=2)
        own = start // MOBA_BLOCK
        k_own = lax.dynamic_index_in_dim(k_blk, own, axis=2, keepdims=False)
        v_own = lax.dynamic_index_in_dim(v_blk, own, axis=2, keepdims=False)
        k_sel = k_blk[b_idx, h_idx, sel_c]
        v_sel = v_blk[b_idx, h_idx, sel_c]
        s_sel = jnp.einsum("bhcd,bhcjpd->bhcjp", q_c, k_sel, preferred_element_type=jnp.float32)
        s_sel = jnp.where(valid_c[..., None], s_sel, NEG_INF)
        s_own = jnp.einsum("bhcd,bhpd->bhcp", q_c, k_own, preferred_element_type=jnp.float32)
        q_pos = start + jnp.arange(MOBA_Q_CHUNK)
        k_pos = own * MOBA_BLOCK + key_off
        s_own = jnp.where(k_pos[None, :] <= q_pos[:, None], s_own, NEG_INF)
        s = jnp.concatenate([s_sel.reshape(bsz, ATTN_HEADS, MOBA_Q_CHUNK, n_sel), s_own], axis=-1)
        p = jax.nn.softmax(s, axis=-1).astype(v.dtype)
        p_sel = p[..., :n_sel].reshape(bsz, ATTN_HEADS, MOBA_Q_CHUNK, top_k, MOBA_BLOCK)
        p_own = p[..., n_sel:]
        return (jnp.einsum("bhcjp,bhcjpd->bhcd", p_sel, v_sel)
                + jnp.einsum("bhcp,bhpd->bhcd", p_own, v_own))

    o = lax.map(chunk, jnp.arange(seqlen // MOBA_Q_CHUNK))
    o = o.transpose(1, 0, 3, 2, 4).reshape(bsz, seqlen, ATTN_HEADS * ATTN_HEAD_DIM)
    return o @ w_out


def _token_shift(x):
    return jnp.pad(x, ((0, 0), (1, 0), (0, 0)))[:, :-1]


def _rwkv7_step(state, inp):
    r_t, w_t, k_t, v_t, kk_t, b_t = inp
    sa = jnp.einsum("bhvk,bhk->bhv", state, -kk_t)
    state = (state * w_t[:, :, None, :]
             + jnp.einsum("bhv,bhk->bhvk", sa, b_t)
             + jnp.einsum("bhv,bhk->bhvk", v_t, k_t))
    return state, jnp.einsum("bhvk,bhk->bhv", state, r_t)


def _rwkv7_mixer(x, mu, w_rkv, w0, w_w1, w_w2, a0, a_w1, a_w2, g_w1, g_w2,
                 k_k, k_a, r_k, lnx_g, lnx_b, w_out):
    f32 = jnp.float32
    bsz, seqlen, _ = x.shape
    hs = (bsz, seqlen, RWKV_HEADS, RWKV_HEAD_DIM)
    xx = _token_shift(x) - x
    x_rkv = x[:, :, None, :] + xx[:, :, None, :] * mu[:3]
    rkv = jnp.einsum("bsgd,gde->bsge", x_rkv, w_rkv)
    r, k, v = rkv[:, :, 0], rkv[:, :, 1], rkv[:, :, 2]
    xw = x + xx * mu[3]
    xa = x + xx * mu[4]
    xg = x + xx * mu[5]
    w_log = -jax.nn.softplus(-(w0 + jnp.tanh(xw @ w_w1) @ w_w2).astype(f32)) - 0.5
    decay = jnp.exp(-jnp.exp(w_log)).reshape(hs)
    a = jax.nn.sigmoid((a0 + (xa @ a_w1) @ a_w2).astype(f32))
    g = jax.nn.sigmoid(xg @ g_w1) @ g_w2
    kk = (k * k_k).astype(f32).reshape(hs)
    kk = kk / jnp.maximum(jnp.sqrt(jnp.sum(kk * kk, axis=-1, keepdims=True)), 1e-12)
    k32 = (k.astype(f32) * (1.0 + (a - 1.0) * k_a)).reshape(hs)
    r32 = r.astype(f32).reshape(hs)
    v32 = v.astype(f32).reshape(hs)
    b = kk * a.reshape(hs)
    xs = tuple(jnp.moveaxis(t, 1, 0) for t in (r32, decay, k32, v32, kk, b))
    state0 = jnp.zeros((bsz, RWKV_HEADS, RWKV_HEAD_DIM, RWKV_HEAD_DIM), f32)
    _, y = lax.scan(_rwkv7_step, state0, xs)
    y = jnp.moveaxis(y, 0, 1)
    mean = jnp.mean(y, axis=-1, keepdims=True)
    var = jnp.mean(jnp.square(y - mean), axis=-1, keepdims=True)
    y = ((y - mean) * lax.rsqrt(var + RWKV_LNX_EPS)).reshape(bsz, seqlen, D_MODEL) * lnx_g + lnx_b
    bonus = jnp.sum(r32 * k32 * r_k, axis=-1, keepdims=True) * v32
    y = y + bonus.reshape(bsz, seqlen, D_MODEL)
    return (y.astype(x.dtype) * g) @ w_out


def _pool_mixer(x, w_pool, pool_scale):
    bsz, seqlen, _ = x.shape
    x32 = x.astype(jnp.float32)
    csum = jnp.pad(jnp.cumsum(x32, axis=1), ((0, 0), (1, 0), (0, 0)))
    t = jnp.arange(seqlen)
    groups = []
    for gi, w in enumerate(POOL_WINDOWS):
        sl = slice(gi * POOL_GROUP_W, (gi + 1) * POOL_GROUP_W)
        upper = csum[:, 1:, sl]
        lower = jnp.pad(csum[:, :seqlen - w + 1, sl], ((0, 0), (w - 1, 0), (0, 0)))
        count = jnp.minimum(t + 1, w).astype(jnp.float32)[None, :, None]
        groups.append((upper - lower) / count - x32[:, :, sl])
    pooled = jnp.stack(groups, axis=2).astype(x.dtype)
    y = jnp.einsum("bsgc,gce->bsge", pooled, w_pool).reshape(bsz, seqlen, D_MODEL)
    return y * pool_scale


def setup_inputs(seed: int = 0) -> dict:
    key = jax.random.key(seed)
    keys = list(jax.random.split(key, 48))
    f32 = jnp.float32

    def nrm(shape, scale):
        return jax.random.normal(keys.pop(), shape, f32) * scale

    def uni(shape, lo, hi):
        return jax.random.uniform(keys.pop(), shape, f32, lo, hi)

    n_a, n_b, n_c, n_d = (_layers_of(m) for m in range(N_MIXERS))
    D, R = D_MODEL, LRU_WIDTH
    beta = DEEPNORM_BETA
    u = uni((n_a, R), 0.9, 0.999)
    a_base = u ** (1.0 / LRU_C)
    return {
        "x": nrm((BATCH, SEQ, D), 1.0),
        "ln_g": 1.0 + nrm((DEPTH, 2, D), 0.05),
        "ln_b": nrm((DEPTH, 2, D), 0.01),
        "mlp_w1": nrm((DEPTH, D, D_FF), D ** -0.5),
        "mlp_w2": nrm((DEPTH, D_FF, D), D_FF ** -0.5 * beta),
        "rg_w_in": nrm((n_a, D, 2 * R), D ** -0.5),
        "rg_conv_w": nrm((n_a, CONV_WIDTH, R), CONV_WIDTH ** -0.5),
        "rg_conv_b": nrm((n_a, R), 0.01),
        "rg_gate_a_w": nrm((n_a, LRU_BLOCKS, LRU_BLOCK_W, LRU_BLOCK_W), LRU_BLOCK_W ** -0.5),
        "rg_gate_a_b": nrm((n_a, LRU_BLOCKS, LRU_BLOCK_W), 0.01),
        "rg_gate_x_w": nrm((n_a, LRU_BLOCKS, LRU_BLOCK_W, LRU_BLOCK_W), LRU_BLOCK_W ** -0.5),
        "rg_gate_x_b": nrm((n_a, LRU_BLOCKS, LRU_BLOCK_W), 0.01),
        "rg_lambda": jnp.log(a_base) - jnp.log1p(-a_base),
        "rg_w_out": nrm((n_a, R, D), R ** -0.5 * beta),
        "moba_w_qkv": nrm((n_b, D, 3 * D), D ** -0.5),
        "moba_w_out": nrm((n_b, D, D), D ** -0.5 * beta),
        "rwkv_mu": uni((n_c, 6, D), 0.0, 1.0),
        "rwkv_w_rkv": nrm((n_c, 3, D, D), D ** -0.5),
        "rwkv_w0": uni((n_c, D), -5.0, -1.0),
        "rwkv_w_w1": nrm((n_c, D, RWKV_DECAY_LORA), D ** -0.5),
        "rwkv_w_w2": nrm((n_c, RWKV_DECAY_LORA, D), 0.5 * RWKV_DECAY_LORA ** -0.5),
        "rwkv_a0": nrm((n_c, D), 0.3),
        "rwkv_a_w1": nrm((n_c, D, RWKV_AAA_LORA), D ** -0.5),
        "rwkv_a_w2": nrm((n_c, RWKV_AAA_LORA, D), 0.5 * RWKV_AAA_LORA ** -0.5),
        "rwkv_g_w1": nrm((n_c, D, RWKV_GATE_LORA), D ** -0.5),
        "rwkv_g_w2": nrm((n_c, RWKV_GATE_LORA, D), RWKV_GATE_LORA ** -0.5),
        "rwkv_k_k": 0.85 + nrm((n_c, D), 0.05),
        "rwkv_k_a": 1.0 + nrm((n_c, D), 0.05),
        "rwkv_r_k": nrm((n_c, RWKV_HEADS, RWKV_HEAD_DIM), 0.1),
        "rwkv_lnx_g": 1.0 + nrm((n_c, D), 0.05),
        "rwkv_lnx_b": nrm((n_c, D), 0.01),
        "rwkv_w_out": nrm((n_c, D, D), D ** -0.5 * beta),
        "pool_w": nrm((n_d, POOL_GROUPS, POOL_GROUP_W, POOL_GROUP_W), POOL_GROUP_W ** -0.5 * beta),
        "pool_scale": 1.0 + nrm((n_d, D), 0.05),
    }


def reference(x, ln_g, ln_b, mlp_w1, mlp_w2,
              rg_w_in, rg_conv_w, rg_conv_b, rg_gate_a_w, rg_gate_a_b, rg_gate_x_w, rg_gate_x_b,
              rg_lambda, rg_w_out,
              moba_w_qkv, moba_w_out,
              rwkv_mu, rwkv_w_rkv, rwkv_w0, rwkv_w_w1, rwkv_w_w2, rwkv_a0, rwkv_a_w1, rwkv_a_w2,
              rwkv_g_w1, rwkv_g_w2, rwkv_k_k, rwkv_k_a, rwkv_r_k, rwkv_lnx_g, rwkv_lnx_b, rwkv_w_out,
              pool_w, pool_scale):
    counts = [0] * N_MIXERS
    for layer in range(DEPTH):
        m = layer % N_MIXERS
        j = counts[m]
        counts[m] += 1
        if m == 0:
            y = _rglru_mixer(x, rg_w_in[j], rg_conv_w[j], rg_conv_b[j], rg_gate_a_w[j], rg_gate_a_b[j],
                             rg_gate_x_w[j], rg_gate_x_b[j], rg_lambda[j], rg_w_out[j])
        elif m == 1:
            y = _moba_mixer(x, moba_w_qkv[j], moba_w_out[j])
        elif m == 2:
            y = _rwkv7_mixer(x, rwkv_mu[j], rwkv_w_rkv[j], rwkv_w0[j], rwkv_w_w1[j], rwkv_w_w2[j],
                             rwkv_a0[j], rwkv_a_w1[j], rwkv_a_w2[j], rwkv_g_w1[j], rwkv_g_w2[j],
                             rwkv_k_k[j], rwkv_k_a[j], rwkv_r_k[j], rwkv_lnx_g[j], rwkv_lnx_b[j],
                             rwkv_w_out[j])
        else:
            y = _pool_mixer(x, pool_w[j], pool_scale[j])
        x = _layer_norm(DEEPNORM_ALPHA * x + y, ln_g[layer, 0], ln_b[layer, 0])
        x = _layer_norm(DEEPNORM_ALPHA * x + _sqrelu_mlp(x, mlp_w1[layer], mlp_w2[layer]),
                        ln_g[layer, 1], ln_b[layer, 1])
    return x
```

```cpp
#include <hip/hip_runtime.h>
#include <hip/hip_cooperative_groups.h>
#include <cstdio>
namespace cg = cooperative_groups;

#define LAS __attribute__((address_space(3)))
typedef unsigned short bf16_t;
typedef short bf16x8 __attribute__((ext_vector_type(8)));
typedef float f32x4 __attribute__((ext_vector_type(4)));
typedef float f32x2 __attribute__((ext_vector_type(2)));
typedef unsigned u32x4 __attribute__((ext_vector_type(4)));
typedef unsigned u32x2 __attribute__((ext_vector_type(2)));
typedef __bf16 bfv2 __attribute__((ext_vector_type(2)));
#define DI __device__ __forceinline__

constexpr int T = 16384, D = 2048, SEQ = 4096, DFF = 8192;
constexpr float ALPHA = 1.6817928305074290f;
constexpr float LN_EPS = 1e-5f;

constexpr size_t SZ_DD = (size_t)D * D * 2;
constexpr size_t O_W1T = 0;
constexpr size_t O_W2T = O_W1T + 4 * (size_t)DFF * D * 2;
constexpr size_t O_WIN = O_W2T + 4 * (size_t)DFF * D * 2;
constexpr size_t O_GATES = O_WIN + (size_t)4096 * D * 2;
constexpr size_t O_RGOUT = O_GATES + (size_t)8 * 512 * 256 * 2;
constexpr size_t O_QKV = O_RGOUT + SZ_DD;
constexpr size_t O_MOUT = O_QKV + 3 * SZ_DD;
constexpr size_t O_RKV = O_MOUT + SZ_DD;
constexpr size_t O_L1 = O_RKV + 3 * SZ_DD;
constexpr size_t O_L2 = O_L1 + (size_t)3 * 256 * D * 2;
constexpr size_t O_ROUT = O_L2 + (size_t)3 * D * 256 * 2;
constexpr size_t O_POOL = O_ROUT + SZ_DD;
constexpr size_t O_SLOT = O_POOL + (size_t)4 * 512 * 512 * 2;
constexpr size_t SLOT = (size_t)T * D * 2;
constexpr size_t O_L1O = O_SLOT + 9 * SLOT;
constexpr size_t O_ROPE = O_L1O + (size_t)3 * T * 256 * 2;
constexpr size_t O_KMEAN = O_ROPE + (size_t)2 * SEQ * 16 * 4;
constexpr size_t O_AGG = O_KMEAN + (size_t)64 * 16 * 128 * 4;
constexpr size_t O_SCAL = O_AGG + (size_t)4 * 128 * D * 2 * 4;
constexpr size_t O_BAR = O_SCAL + (size_t)3 * T * 32 * 4;
constexpr size_t BAR_BYTES = 16384;
constexpr size_t WS_END = O_BAR + BAR_BYTES;

constexpr int LDS_BYTES = 131072 + 16;

struct TJob { const float* src; bf16_t* dst; int Ks, Ns, Kd, Nd, tile0, pad; };
constexpr int NTJ = 42;
struct Params {
    const float* in[34];
    float* out;
    unsigned char* ws;
    int lo, hi, ntiles, pad;
    TJob tj[NTJ];
};

DI unsigned pk_bf16(float a, float b) { f32x2 v = {a, b}; bfv2 r = __builtin_convertvector(v, bfv2); return __builtin_bit_cast(unsigned, r); }
DI bf16_t f2bf(float a) { return (bf16_t)(pk_bf16(a, 0.f) & 0xffffu); }
DI float bf2f(bf16_t b) { return __uint_as_float(((unsigned)b) << 16); }
DI float bflo(unsigned u) { return __uint_as_float(u << 16); }
DI float bfhi(unsigned u) { return __uint_as_float(u & 0xffff0000u); }
DI float wave_sum(float v) {
    v += __int_as_float(__builtin_amdgcn_update_dpp(0, __float_as_int(v), 0xB1, 0xF, 0xF, false));
    v += __int_as_float(__builtin_amdgcn_update_dpp(0, __float_as_int(v), 0x4E, 0xF, 0xF, false));
    v += __int_as_float(__builtin_amdgcn_update_dpp(0, __float_as_int(v), 0x141, 0xF, 0xF, false));
    v += __int_as_float(__builtin_amdgcn_update_dpp(0, __float_as_int(v), 0x140, 0xF, 0xF, false));
    const int iv = __float_as_int(v);
    return __int_as_float(__builtin_amdgcn_readlane(iv, 0)) + __int_as_float(__builtin_amdgcn_readlane(iv, 16)) +
           __int_as_float(__builtin_amdgcn_readlane(iv, 32)) + __int_as_float(__builtin_amdgcn_readlane(iv, 48));
}
DI void lds_barrier() { asm volatile("s_waitcnt lgkmcnt(0)" ::: "memory"); __builtin_amdgcn_s_barrier(); asm volatile("" ::: "memory"); }
DI float sigmoidf_(float x) { return __builtin_amdgcn_rcpf(1.f + __expf(-x)); }
DI float tanhf_(float x) { return 1.f - 2.f * __builtin_amdgcn_rcpf(1.f + __expf(2.f * x)); }
DI float gelu_tanh(float x) { const float u = 0.7978845608028654f * (x + 0.044715f * x * x * x); return 0.5f * x * (1.f + tanhf_(u)); }

namespace pg8 {
constexpr int BM = 256, BK = 64, HALF = 128, HTB = HALF * BK * 2, NXCD = 8, WGM = 4;
DI int lds_byte(int r, int c) { const int st = (r >> 4) * 2 + (c >> 5), rr = r & 15, cc = c & 31, ob = rr * 64 + cc * 2; return st * 1024 + (ob ^ (((ob >> 9) & 1) << 5)); }
DI void stage_rc(int b, int& R, int& C) { const int st = b / 1024, sb = b % 1024, swz = sb ^ (((sb >> 9) & 1) << 5); R = (st >> 1) * 16 + swz / 64; C = (st & 1) * 32 + (swz % 64) / 2; }
DI int perm32(int rho) { const int n = rho >> 4, i = rho & 15; return 8 * (i >> 2) + 4 * n + (i & 3); }

struct Unit { int g, pm, pn; };
struct Gemm { const bf16_t* A; const bf16_t* Bt; long sA, sB; int lda, ldb, K, nM, nN, G; };

struct Order {
    int nM, nN, nwg, tot, Gd, c;
    DI void init(const Gemm& g, int Gd_, int c_) { nM = g.nM; nN = g.nN; nwg = nM * nN; tot = nwg * g.G; Gd = Gd_; c = c_; }
    DI bool next(int i, Unit& u) const {
        const long L = (long)i * Gd + c; if (L >= tot) return false;
        const int grp = (int)(L / nwg); int wgid = (int)(L - (long)grp * nwg);
        { const int q = nwg / NXCD, r = nwg % NXCD, xcd = wgid % NXCD, off = wgid / NXCD; wgid = (xcd < r ? xcd * (q + 1) : r * (q + 1) + (xcd - r) * q) + off; }
        const int nig = WGM * nN, gid = wgid / nig, fm = gid * WGM, gsz = (nM - fm) < WGM ? (nM - fm) : WGM;
        u.g = grp; u.pm = fm + ((wgid % nig) % gsz); u.pn = (wgid % nig) / gsz; return true;
    }
};

struct EpiAct {
    static constexpr bool PERM = true;
    bf16_t* C; long sC; int ldc; unsigned acts;
    DI void operator()(const f32x4 (&acc)[2][2][4][2], const Unit& u, int wr, int wc, int fr, int fq) const {
        bf16_t* base = C + (size_t)u.g * sC;
        const int act = (int)((acts >> (4 * u.g)) & 15u);
        const int row0 = u.pm * BM + wr * 64 + fr, col0 = u.pn * BM + wc * 32 + 8 * fq;
#pragma unroll
        for (int ai = 0; ai < 2; ++ai)
#pragma unroll
            for (int m = 0; m < 4; ++m) {
                bf16_t* rowp = base + (size_t)(row0 + ai * HALF + m * 16) * ldc + col0;
#pragma unroll
                for (int bj = 0; bj < 2; ++bj) {
                    float v[8];
#pragma unroll
                    for (int e = 0; e < 4; ++e) { v[e] = acc[ai][bj][m][0][e]; v[4 + e] = acc[ai][bj][m][1][e]; }
                    if (act == 1) {
#pragma unroll
                        for (int e = 0; e < 8; ++e) { const float t = fmaxf(v[e], 0.f); v[e] = t * t; }
                    } else if (act == 2) {
#pragma unroll
                        for (int e = 0; e < 8; ++e) v[e] = tanhf_(v[e]);
                    } else if (act == 3) {
#pragma unroll
                        for (int e = 0; e < 8; ++e) v[e] = sigmoidf_(v[e]);
                    }
                    u32x4 o = {pk_bf16(v[0], v[1]), pk_bf16(v[2], v[3]), pk_bf16(v[4], v[5]), pk_bf16(v[6], v[7])};
                    *(u32x4*)(rowp + bj * HALF) = o;
                }
            }
    }
};
struct EpiRes {
    static constexpr bool PERM = false;
    float* out; const float* res; const float* cscale; float alpha; long sC; int ldc;
    DI void operator()(const f32x4 (&acc)[2][2][4][2], const Unit& u, int wr, int wc, int fr, int fq) const {
        const int row0 = u.pm * BM + wr * 64 + fr, col0 = (int)(u.g * sC) + u.pn * BM + wc * 32 + 4 * fq;
        f32x4 r[2][2][2][2];
        auto ldq = [&](int q, int buf) {
            const int ai = q >> 1, m0 = (q & 1) * 2;
#pragma unroll
            for (int mm = 0; mm < 2; ++mm) {
                const size_t ro = (size_t)(row0 + ai * HALF + (m0 + mm) * 16) * ldc + col0;
#pragma unroll
                for (int bj = 0; bj < 2; ++bj)
#pragma unroll
                    for (int n = 0; n < 2; ++n) r[buf][mm][bj][n] = *(const f32x4*)(res + ro + bj * HALF + n * 16);
            }
        };
        auto stq = [&](int q, int buf) {
            const int ai = q >> 1, m0 = (q & 1) * 2;
#pragma unroll
            for (int mm = 0; mm < 2; ++mm) {
                const size_t ro = (size_t)(row0 + ai * HALF + (m0 + mm) * 16) * ldc + col0;
#pragma unroll
                for (int bj = 0; bj < 2; ++bj)
#pragma unroll
                    for (int n = 0; n < 2; ++n) {
                        f32x4 a = acc[ai][bj][m0 + mm][n];
                        if (cscale) a *= *(const f32x4*)(cscale + col0 + bj * HALF + n * 16);
                        *(f32x4*)(out + ro + bj * HALF + n * 16) = alpha * r[buf][mm][bj][n] + a;
                    }
            }
        };
        ldq(0, 0); ldq(1, 1);
        __builtin_amdgcn_sched_barrier(0);
        stq(0, 0); ldq(2, 0);
        __builtin_amdgcn_sched_barrier(0);
        stq(1, 1); ldq(3, 1);
        __builtin_amdgcn_sched_barrier(0);
        stq(2, 0); stq(3, 1);
    }
};
template <class Epi>
DI void gemm_phase(int tid_, int bid_, LAS unsigned char* lds, const Gemm g, const Epi& E) {
    const int tid = tid_, wid = __builtin_amdgcn_readfirstlane(tid >> 6), lane = tid & 63, wr = wid >> 2, wc = wid & 3, fr = lane & 15, fq = lane >> 4;
    const int K = g.K, nt = K / BK;
    Order S; S.init(g, (int)gridDim.x, (int)bid_);
    unsigned voffA[2], voffB[2];
#pragma unroll
    for (int i = 0; i < 2; ++i) { int R, C; stage_rc(tid * 16 + i * 8192, R, C); const int Rb = Epi::PERM ? ((R & ~31) + perm32(R & 31)) : R;
        voffA[i] = (unsigned)(R * g.lda + C) * 2u; voffB[i] = (unsigned)(Rb * g.ldb + C) * 2u; }
    const size_t kstep = (size_t)(BK * 2);
    const size_t hA = (size_t)HALF * g.lda * 2, hB = (size_t)HALF * g.ldb * 2;
    const unsigned ldsw = (unsigned)wid * 1024u;
    const int aoff = lds_byte(wr * 64 + fr, fq * 8), boff = lds_byte(wc * 32 + fr, fq * 8);
#define PG8_SA(b, h) (((b) * 2 + (h)) * HTB)
#define PG8_SB(b, h) ((4 + (b) * 2 + (h)) * HTB)
#define PG8_STAGE(bufoff, gbase, voff) do { _Pragma("unroll") for (int _i = 0; _i < 2; ++_i) \
        __builtin_amdgcn_global_load_lds((const unsigned*)((const char*)(gbase) + (voff)[_i]), (LAS unsigned*)(lds + (bufoff) + ldsw + _i * 8192), 16, 0, 0); } while (0)
#define PG8_LDA(dst, b, h) do { _Pragma("unroll") for (int m = 0; m < 4; ++m) _Pragma("unroll") for (int k = 0; k < 2; ++k) dst[m][k] = *(const LAS bf16x8*)(lds + PG8_SA(b, h) + aoff + m * 2048 + k * 1024); } while (0)
#define PG8_LDB(dst, b, h) do { _Pragma("unroll") for (int n = 0; n < 2; ++n) _Pragma("unroll") for (int k = 0; k < 2; ++k) dst[n][k] = *(const LAS bf16x8*)(lds + PG8_SB(b, h) + boff + n * 2048 + k * 1024); } while (0)
#define PG8_MMA(ai, bj, At, Bt) do { __builtin_amdgcn_s_setprio(1); _Pragma("unroll") for (int m = 0; m < 4; ++m) _Pragma("unroll") for (int n = 0; n < 2; ++n) _Pragma("unroll") for (int k = 0; k < 2; ++k) \
        acc[ai][bj][m][n] = __builtin_amdgcn_mfma_f32_16x16x32_bf16(Bt[n][k], At[m][k], acc[ai][bj][m][n], 0, 0, 0); __builtin_amdgcn_s_setprio(0); } while (0)
#define PG8_WAIT_V(n) asm volatile("s_waitcnt vmcnt(" #n ")" ::: "memory")
#define PG8_WAIT_L(n) asm volatile("s_waitcnt lgkmcnt(" #n ")" ::: "memory")
#define PG8_BAR __builtin_amdgcn_s_barrier()
#define PG8_SCHED __builtin_amdgcn_sched_barrier(0)
    Unit cur, nxt; int ui = 0;
    if (!S.next(0, cur)) return;
    f32x4 acc[2][2][4][2];
#pragma unroll
    for (int a = 0; a < 2; ++a)
#pragma unroll
        for (int b = 0; b < 2; ++b)
#pragma unroll
            for (int m = 0; m < 4; ++m)
#pragma unroll
                for (int n = 0; n < 2; ++n) acc[a][b][m][n] = (f32x4){0.f, 0.f, 0.f, 0.f};
    bf16x8 At[4][2], B0[2][2], B1[2][2];
    const char* cA = (const char*)g.A + ((size_t)cur.g * g.sA + (size_t)cur.pm * BM * g.lda) * 2;
    const char* cB = (const char*)g.Bt + ((size_t)cur.g * g.sB + (size_t)cur.pn * BM * g.ldb) * 2;
    PG8_STAGE(PG8_SB(0, 0), cB, voffB); PG8_STAGE(PG8_SA(0, 0), cA, voffA); PG8_STAGE(PG8_SB(0, 1), cB + hB, voffB); PG8_STAGE(PG8_SA(0, 1), cA + hA, voffA);
    if (wr == 1) PG8_BAR;
    PG8_WAIT_V(4); PG8_BAR;
    PG8_STAGE(PG8_SB(1, 0), cB + kstep, voffB); PG8_STAGE(PG8_SA(1, 0), cA + kstep, voffA); PG8_STAGE(PG8_SB(1, 1), cB + hB + kstep, voffB);
    PG8_WAIT_V(6); PG8_BAR;
    for (;;) {
        const bool has_next = S.next(ui + 1, nxt);
        const char* nA = has_next ? (const char*)g.A + ((size_t)nxt.g * g.sA + (size_t)nxt.pm * BM * g.lda) * 2 : cA;
        const char* nB = has_next ? (const char*)g.Bt + ((size_t)nxt.g * g.sB + (size_t)nxt.pn * BM * g.ldb) * 2 : cB;
        for (int t = 0; t < nt; t += 2) {
            const bool last = (t == nt - 2);
            const char* a1 = cA + (size_t)(t + 1) * kstep;
            const char* a2 = last ? nA : cA + (size_t)(t + 2) * kstep; const char* b2 = last ? nB : cB + (size_t)(t + 2) * kstep;
            const char* a3 = a2 + kstep; const char* b3 = b2 + kstep;
            PG8_LDB(B0, 0, 0); PG8_SCHED; PG8_LDA(At, 0, 0); PG8_STAGE(PG8_SA(1, 1), a1 + hA, voffA);
            PG8_WAIT_L(8); PG8_BAR; PG8_WAIT_L(0); PG8_MMA(0, 0, At, B0); PG8_BAR; PG8_SCHED;
            PG8_LDB(B1, 0, 1); PG8_STAGE(PG8_SB(0, 0), b2, voffB);
            PG8_BAR; PG8_WAIT_L(0); PG8_MMA(0, 1, At, B1); PG8_BAR;
            PG8_LDA(At, 0, 1); PG8_STAGE(PG8_SA(0, 0), a2, voffA);
            PG8_BAR; PG8_WAIT_L(0); PG8_MMA(1, 0, At, B0); PG8_BAR; PG8_SCHED;
            PG8_STAGE(PG8_SB(0, 1), b2 + hB, voffB);
            PG8_WAIT_V(6); PG8_BAR; PG8_MMA(1, 1, At, B1); PG8_BAR;
            PG8_LDB(B0, 1, 0); PG8_SCHED; PG8_LDA(At, 1, 0); PG8_STAGE(PG8_SA(0, 1), a2 + hA, voffA);
            PG8_WAIT_L(8); PG8_BAR; PG8_WAIT_L(0); PG8_MMA(0, 0, At, B0); PG8_BAR; PG8_SCHED;
            PG8_LDB(B1, 1, 1); PG8_STAGE(PG8_SB(1, 0), b3, voffB);
            PG8_BAR; PG8_WAIT_L(0); PG8_MMA(0, 1, At, B1); PG8_BAR;
            PG8_LDA(At, 1, 1); PG8_STAGE(PG8_SA(1, 0), a3, voffA);
            PG8_BAR; PG8_WAIT_L(0); PG8_MMA(1, 0, At, B0); PG8_BAR; PG8_SCHED;
            PG8_STAGE(PG8_SB(1, 1), b3 + hB, voffB);
            PG8_WAIT_V(6); PG8_BAR; PG8_MMA(1, 1, At, B1); PG8_BAR;
        }
        E(acc, cur, wr, wc, fr, fq);
        if (!has_next) break;
#pragma unroll
        for (int a = 0; a < 2; ++a)
#pragma unroll
            for (int b = 0; b < 2; ++b)
#pragma unroll
                for (int m = 0; m < 4; ++m)
#pragma unroll
                    for (int n = 0; n < 2; ++n) acc[a][b][m][n] = (f32x4){0.f, 0.f, 0.f, 0.f};
        cur = nxt; cA = nA; cB = nB; ++ui;
    }
    PG8_WAIT_V(0);
    if (wr == 0) PG8_BAR;
    PG8_BAR;
#undef PG8_SA
#undef PG8_SB
#undef PG8_STAGE
#undef PG8_LDA
#undef PG8_LDB
#undef PG8_MMA
#undef PG8_WAIT_V
#undef PG8_WAIT_L
#undef PG8_BAR
#undef PG8_SCHED
}
}

DI pg8::Gemm mk_gemm(const bf16_t* A, const bf16_t* Bt, long sA, long sB, int lda, int ldb, int K, int nM, int nN, int G) {
    pg8::Gemm g; g.A = A; g.Bt = Bt; g.sA = sA; g.sB = sB; g.lda = lda; g.ldb = ldb; g.K = K; g.nM = nM; g.nN = nN; g.G = G; return g;
}

DI void prep_phase(int tid_, int bid_, const Params& p, unsigned char* smem) {
    TJob* jobs = (TJob*)smem;
    float* tile = (float*)(smem + 4096);
    const int tid = tid_;
    if (tid < NTJ) jobs[tid] = p.tj[tid];
    __syncthreads();
    const int ntiles = p.ntiles;
    for (int tix = bid_; tix < ntiles; tix += gridDim.x) {
        int j = 0;
        for (int q = 1; q < NTJ; ++q) if (jobs[q].tile0 <= tix) j = q;
        const TJob jb = jobs[j];
        const int lt = tix - jb.tile0, ntk = jb.Kd / 128, k0 = (lt % ntk) * 128, n0 = (lt / ntk) * 128;
        f32x4 v[8];
#pragma unroll
        for (int i = 0; i < 8; ++i) {
            const int idx = tid + i * 512, kk = idx >> 5, n4 = idx & 31;
            const int k = k0 + kk, n = n0 + n4 * 4;
            v[i] = (k < jb.Ks && n < jb.Ns) ? *(const f32x4*)(jb.src + (size_t)k * jb.Ns + n) : (f32x4){0.f, 0.f, 0.f, 0.f};
        }
#pragma unroll
        for (int i = 0; i < 8; ++i) {
            const int idx = tid + i * 512, kk = idx >> 5, n4 = idx & 31;
#pragma unroll
            for (int e = 0; e < 4; ++e) tile[kk * 129 + n4 * 4 + e] = v[i][e];
        }
        __syncthreads();
#pragma unroll
        for (int i = 0; i < 4; ++i) {
            const int idx = tid + i * 512, n = idx >> 4, kc = idx & 15;
            float f[8];
#pragma unroll
            for (int e = 0; e < 8; ++e) f[e] = tile[(kc * 8 + e) * 129 + n];
            u32x4 o = {pk_bf16(f[0], f[1]), pk_bf16(f[2], f[3]), pk_bf16(f[4], f[5]), pk_bf16(f[6], f[7])};
            *(u32x4*)(jb.dst + (size_t)(n0 + n) * jb.Kd + k0 + kc * 8) = o;
        }
        __syncthreads();
    }
    {
        const float* x = p.in[0]; bf16_t* xb = (bf16_t*)(p.ws + O_SLOT + 8 * SLOT);
        const size_t n8 = (size_t)T * D / 8;
        for (size_t i = (size_t)bid_ * 512 + tid; i < n8; i += (size_t)gridDim.x * 512) {
            const f32x4 a = *(const f32x4*)(x + i * 8), b = *(const f32x4*)(x + i * 8 + 4);
            u32x4 o = {pk_bf16(a[0], a[1]), pk_bf16(a[2], a[3]), pk_bf16(b[0], b[1]), pk_bf16(b[2], b[3])};
            *(u32x4*)(xb + i * 8) = o;
        }
    }
    {
        float* ct = (float*)(p.ws + O_ROPE); float* st = ct + SEQ * 16;
        for (int i = bid_ * 512 + tid; i < SEQ * 16; i += gridDim.x * 512) {
            const int pos = i >> 4, f = i & 15;
            const float inv = powf(500000.0f, -(float)(2 * f) / 32.0f);
            const float ang = (float)pos * inv;
            ct[i] = cosf(ang); st[i] = sinf(ang);
        }
    }
}

DI void ln_phase(int tid_, int bid_, const float* zin, float* xout, bf16_t* xb, const float* gam, const float* bet) {
    const int lane = tid_ & 63, wid = tid_ >> 6;
    const int rstride = gridDim.x * 8;
    constexpr int NR = 4;
    for (int row0 = bid_ * 8 + wid; row0 < T; row0 += NR * rstride) {
        f32x4 v[NR][8];
#pragma unroll
        for (int r = 0; r < NR; ++r)
#pragma unroll
            for (int i = 0; i < 8; ++i)
                v[r][i] = (row0 + r * rstride < T) ? *(const f32x4*)(zin + (size_t)(row0 + r * rstride) * D + (i * 64 + lane) * 4) : (f32x4){0.f, 0.f, 0.f, 0.f};
#pragma unroll
        for (int r = 0; r < NR; ++r) {
            const int row = row0 + r * rstride;
            if (row >= T) break;
            float s = 0.f;
#pragma unroll
            for (int i = 0; i < 8; ++i) s += v[r][i][0] + v[r][i][1] + v[r][i][2] + v[r][i][3];
            const float mean = wave_sum(s) * (1.f / D);
            float q = 0.f;
#pragma unroll
            for (int i = 0; i < 8; ++i) { v[r][i] -= mean; q += v[r][i][0] * v[r][i][0] + v[r][i][1] * v[r][i][1] + v[r][i][2] * v[r][i][2] + v[r][i][3] * v[r][i][3]; }
            const float rstd = rsqrtf(wave_sum(q) * (1.f / D) + LN_EPS);
#pragma unroll
            for (int i = 0; i < 8; ++i) {
                const int c = (i * 64 + lane) * 4;
                const f32x4 g = *(const f32x4*)(gam + c), b = *(const f32x4*)(bet + c);
                const f32x4 o = v[r][i] * rstd * g + b;
                *(f32x4*)(xout + (size_t)row * D + c) = o;
                if (xb) { u32x2 w = {pk_bf16(o[0], o[1]), pk_bf16(o[2], o[3])}; *(u32x2*)(xb + (size_t)row * D + c) = w; }
            }
        }
    }
}

DI void rg_conv_phase(int tid_, int bid_, const bf16_t* gu, bf16_t* uc, const float* cw, const float* cb) {
    const size_t n8 = (size_t)T * D / 8;
    const size_t stride = (size_t)gridDim.x * 512;
    constexpr int U = 4;
    for (size_t ib = (size_t)bid_ * 512 + tid_; ib < n8; ib += stride * U) {
        u32x4 uu[U][4];
#pragma unroll
        for (int u = 0; u < U; ++u) {
            const size_t i = ib + u * stride;
            const int t = (int)(i >> 8), c = (int)(i & 255) * 8, s = t & (SEQ - 1);
#pragma unroll
            for (int j = 0; j < 4; ++j)
                uu[u][j] = (i < n8 && s - 3 + j >= 0) ? *(const u32x4*)(gu + (size_t)(t - 3 + j) * 4096 + 2048 + c) : (u32x4){0u, 0u, 0u, 0u};
        }
#pragma unroll
        for (int u = 0; u < U; ++u) {
            const size_t i = ib + u * stride;
            if (i >= n8) break;
            const int c = (int)(i & 255) * 8;
            float a[8];
            { const f32x4 b0 = *(const f32x4*)(cb + c), b1 = *(const f32x4*)(cb + c + 4);
#pragma unroll
              for (int e = 0; e < 4; ++e) { a[e] = b0[e]; a[4 + e] = b1[e]; } }
#pragma unroll
            for (int j = 0; j < 4; ++j) {
                const u32x4 q = uu[u][j];
                const f32x4 w0 = *(const f32x4*)(cw + j * D + c), w1 = *(const f32x4*)(cw + j * D + c + 4);
                a[0] += w0[0] * bflo(q[0]); a[1] += w0[1] * bfhi(q[0]); a[2] += w0[2] * bflo(q[1]); a[3] += w0[3] * bfhi(q[1]);
                a[4] += w1[0] * bflo(q[2]); a[5] += w1[1] * bfhi(q[2]); a[6] += w1[2] * bflo(q[3]); a[7] += w1[3] * bfhi(q[3]);
            }
            u32x4 o = {pk_bf16(a[0], a[1]), pk_bf16(a[2], a[3]), pk_bf16(a[4], a[5]), pk_bf16(a[6], a[7])};
            *(u32x4*)(uc + i * 8) = o;
        }
    }
}
DI void rg_ab(float rpre, float ipre, float u, float ba, float bx, float sp8, float& a, float& b) {
    const float r = sigmoidf_(rpre + ba), ii = sigmoidf_(ipre + bx);
    const float la = -sp8 * r;
    a = __expf(la);
    const float x2 = 2.f * la;
    const float om = (x2 > -0.05f) ? -x2 * (1.f + x2 * (0.5f + x2 * (0.16666667f + x2 * 0.041666668f))) : 1.f - a * a;
    b = u * ii * __builtin_amdgcn_sqrtf(om);
}
template <int MODE>
DI void rg_scan_phase(int tid_, int bid_, const Params& p, const bf16_t* gates, const bf16_t* uc, const bf16_t* gu, float* agg, bf16_t* outg) {
    constexpr int CH = 32;
    const float* gab = p.in[9]; const float* gxb = p.in[11]; const float* lam = p.in[12];
    for (int item = bid_; item < 4 * 128 * 2; item += gridDim.x) {
        const int cg2 = item & 1, chunk = (item >> 1) & 127, b = item >> 8;
        const int ch = cg2 * 1024 + tid_ * 2;
        const int n = ch >> 8, v = ch & 255;
        const f32x2 ba = *(const f32x2*)(gab + ch), bx = *(const f32x2*)(gxb + ch), lm = *(const f32x2*)(lam + ch);
        const float sp0 = 8.f * log1pf(expf(-lm[0])), sp1 = 8.f * log1pf(expf(-lm[1]));
        float h0 = 0.f, h1 = 0.f, P0 = 1.f, P1 = 1.f;
        if (MODE == 1) {
            for (int c0 = 0; c0 < chunk; c0 += 16) {
                f32x4 gv[16];
#pragma unroll
                for (int j = 0; j < 16; ++j) gv[j] = (c0 + j < chunk) ? *(const f32x4*)(agg + (((size_t)b * 128 + c0 + j) * D + ch) * 2) : (f32x4){1.f, 0.f, 1.f, 0.f};
#pragma unroll
                for (int j = 0; j < 16; ++j) { h0 = gv[j][0] * h0 + gv[j][1]; h1 = gv[j][2] * h1 + gv[j][3]; }
            }
        }
        const size_t t0 = (size_t)b * SEQ + (size_t)chunk * CH;
        constexpr int UB = 32;
        for (int tb = 0; tb < CH; tb += UB) {
            unsigned rpv[UB], ipv[UB], uuv[UB], ggv[UB];
#pragma unroll
            for (int j = 0; j < UB; ++j) {
                const size_t t = t0 + tb + j;
                rpv[j] = *(const unsigned*)(gates + t * 4096 + n * 512 + v);
                ipv[j] = *(const unsigned*)(gates + t * 4096 + n * 512 + 256 + v);
                uuv[j] = *(const unsigned*)(uc + t * D + ch);
                if (MODE == 1) ggv[j] = *(const unsigned*)(gu + t * 4096 + ch);
            }
#pragma unroll
            for (int j = 0; j < UB; ++j) {
                const size_t t = t0 + tb + j;
                float a0, b0, a1, b1;
                rg_ab(bflo(rpv[j]), bflo(ipv[j]), bflo(uuv[j]), ba[0], bx[0], sp0, a0, b0);
                rg_ab(bfhi(rpv[j]), bfhi(ipv[j]), bfhi(uuv[j]), ba[1], bx[1], sp1, a1, b1);
                h0 = a0 * h0 + b0; h1 = a1 * h1 + b1;
                if (MODE == 0) { P0 *= a0; P1 *= a1; }
                else *(unsigned*)(outg + t * D + ch) = pk_bf16(gelu_tanh(bflo(ggv[j])) * h0, gelu_tanh(bfhi(ggv[j])) * h1);
            }
        }
        if (MODE == 0) { f32x4 o = {P0, h0, P1, h1}; *(f32x4*)(agg + (((size_t)b * 128 + chunk) * D + ch) * 2) = o; }
    }
}

DI void kmean_phase(int tid_, int bid_, bf16_t* Qx, bf16_t* Kx, float* kmean, const float* ctab, const float* stab, unsigned char* smem) {
    float* redA = (float*)smem;
    float* redB = redA + 1024;
    const int tid = tid_;
    for (int item = bid_; item < 1024; item += gridDim.x) {
        const int blk = item & 15, h = (item >> 4) & 15, b = item >> 8;
        {
            const int i = tid & 15, rg = tid >> 4;
            float s1 = 0.f, s2 = 0.f;
            bf16_t k1v[8], k2v[8], q1v[8], q2v[8]; float cv[8], sv[8];
#pragma unroll
            for (int r = 0; r < 8; ++r) {
                const int pos = blk * 256 + rg * 8 + r;
                const size_t o = ((size_t)b * SEQ + pos) * D + h * 128 + i;
                cv[r] = ctab[pos * 16 + i]; sv[r] = stab[pos * 16 + i];
                k1v[r] = Kx[o]; k2v[r] = Kx[o + 16]; q1v[r] = Qx[o]; q2v[r] = Qx[o + 16];
            }
#pragma unroll
            for (int r = 0; r < 8; ++r) {
                const int pos = blk * 256 + rg * 8 + r;
                const size_t o = ((size_t)b * SEQ + pos) * D + h * 128 + i;
                const float c = cv[r], sn = sv[r];
                const float k1 = bf2f(k1v[r]), k2 = bf2f(k2v[r]);
                const bf16_t k1r = f2bf(k1 * c - k2 * sn), k2r = f2bf(k2 * c + k1 * sn);
                Kx[o] = k1r; Kx[o + 16] = k2r; s1 += bf2f(k1r); s2 += bf2f(k2r);
                const float q1 = bf2f(q1v[r]), q2 = bf2f(q2v[r]);
                Qx[o] = f2bf(q1 * c - q2 * sn); Qx[o + 16] = f2bf(q2 * c + q1 * sn);
            }
            redA[rg * 32 + i] = s1; redA[rg * 32 + 16 + i] = s2;
        }
        {
            const int dp = tid & 63, rg = tid >> 6;
            if (dp >= 16) {
                const bf16_t* base = Kx + ((size_t)b * SEQ + blk * 256 + rg * 32) * D + h * 128 + dp * 2;
                float s0 = 0.f, s1 = 0.f;
                unsigned uv[32];
#pragma unroll
                for (int r = 0; r < 32; ++r) uv[r] = *(const unsigned*)(base + (size_t)r * D);
#pragma unroll
                for (int r = 0; r < 32; ++r) { s0 += bflo(uv[r]); s1 += bfhi(uv[r]); }
                redB[rg * 128 + dp * 2] = s0; redB[rg * 128 + dp * 2 + 1] = s1;
            }
        }
        __syncthreads();
        if (tid < 128) {
            float s = 0.f;
            if (tid < 32) { for (int r = 0; r < 32; ++r) s += redA[r * 32 + tid]; }
            else { for (int r = 0; r < 8; ++r) s += redB[r * 128 + tid]; }
            kmean[(size_t)item * 128 + tid] = s * (1.f / 256.f);
        }
        __syncthreads();
    }
}

DI void attn_phase(int tid_, int bid_, const bf16_t* Q, const bf16_t* Kx, const bf16_t* VT, bf16_t* O, const float* kmean, unsigned char* smem) {
    constexpr int KB_STRIDE = 272, VB_STRIDE = 144;
    constexpr int KBUF = 64 * KB_STRIDE, VBUF = 128 * VB_STRIDE;
    constexpr float QC = 0.08838834764831845f * 1.4426950408889634f;
#define KBUFP(bi) (smem + (bi) * KBUF)
#define VBUFP(bi) (smem + 2 * KBUF + (bi) * VBUF)
    float* km = (float*)(smem + 2 * KBUF + 2 * VBUF);
    const int tid = tid_, wid = tid >> 6, lane = tid & 63, fr = lane & 15, fq = lane >> 4;
    for (int idx = bid_; idx < 2048; idx += gridDim.x) {
        const int bh = idx & 63, jj = idx >> 6, sub = jj & 3, rnd = jj >> 2;
        const int r2 = rnd >> 1, half = rnd & 1;
        const int qb = (r2 == 0) ? sub : (r2 == 1) ? (7 - sub) : (r2 == 2) ? (8 + sub) : (15 - sub);
        const int b = bh >> 4, h = bh & 15;
        const size_t tok0 = (size_t)b * SEQ;
        const int qloc = half * 128 + wid * 16 + fr;
        { const f32x4 kv = *(const f32x4*)(kmean + (size_t)bh * 2048 + tid * 4); *(f32x4*)(km + tid * 4) = kv; }
        bf16x8 qf[4];
#pragma unroll
        for (int dc = 0; dc < 4; ++dc) qf[dc] = *(const bf16x8*)(Q + (tok0 + qb * 256 + qloc) * D + h * 128 + dc * 32 + fq * 8);
        __syncthreads();
        const int ntile = qb * 4 + (half ? 4 : 2);
        const int kr0 = tid >> 4, kc0 = tid & 15;
        const int vr0 = tid >> 3, vc0 = tid & 7;
        u32x4 kreg0[2], vreg0[2], kreg1[2], vreg1[2];
        auto gload = [&](int tt, u32x4 (&kreg)[2], u32x4 (&vreg)[2]) {
            const int key0 = tt * 64;
#pragma unroll
            for (int i = 0; i < 2; ++i) {
                kreg[i] = *(const u32x4*)(Kx + (tok0 + key0 + kr0 + i * 32) * D + h * 128 + kc0 * 8);
                vreg[i] = *(const u32x4*)(VT + (size_t)(h * 128 + vr0 + i * 64) * T + tok0 + key0 + vc0 * 8);
            }
        };
        auto lstore = [&](int bi, const u32x4 (&kreg)[2], const u32x4 (&vreg)[2]) {
#pragma unroll
            for (int i = 0; i < 2; ++i) {
                *(u32x4*)(KBUFP(bi) + (kr0 + i * 32) * KB_STRIDE + kc0 * 16) = kreg[i];
                *(u32x4*)(VBUFP(bi) + (vr0 + i * 64) * VB_STRIDE + vc0 * 16) = vreg[i];
            }
        };
        gload(0, kreg0, vreg0);
        if (1 < ntile) gload(1, kreg1, vreg1);
        unsigned mask = 0u;
        {
            float v0 = -3e38f, v1 = -3e38f, v2 = -3e38f; int i0 = -1, i1 = -1, i2 = -1;
            for (int j = 0; j < qb; ++j) {
                float g = 0.f;
#pragma unroll
                for (int dc = 0; dc < 4; ++dc) {
                    const f32x4 ka = *(const f32x4*)(km + j * 128 + dc * 32 + fq * 8), kb2 = *(const f32x4*)(km + j * 128 + dc * 32 + fq * 8 + 4);
#pragma unroll
                    for (int e = 0; e < 4; ++e) { g += bf2f((bf16_t)qf[dc][e]) * ka[e]; g += bf2f((bf16_t)qf[dc][4 + e]) * kb2[e]; }
                }
                g += __shfl_xor(g, 16); g += __shfl_xor(g, 32);
                if (g > v0) { v2 = v1; i2 = i1; v1 = v0; i1 = i0; v0 = g; i0 = j; }
                else if (g > v1) { v2 = v1; i2 = i1; v1 = g; i1 = j; }
                else if (g > v2) { v2 = g; i2 = j; }
            }
            if (i0 >= 0) mask |= 1u << i0;
            if (i1 >= 0) mask |= 1u << i1;
            if (i2 >= 0) mask |= 1u << i2;
        }
        float mrun = -1e30f, lrun = 0.f;
        f32x4 oacc[8];
#pragma unroll
        for (int dt = 0; dt < 8; ++dt) oacc[dt] = (f32x4){0.f, 0.f, 0.f, 0.f};
        auto compute = [&](int tt, int bi) {
            const int kb = tt >> 2, kt64 = tt & 3;
            const bool own = (kb == qb);
            const bool actq = own ? true : (((mask >> kb) & 1u) != 0u);
            const bool doit = own ? (kt64 * 64 <= half * 128 + wid * 16 + 15) : (__any((int)actq) != 0);
            if (doit) {
                f32x4 sacc[4];
#pragma unroll
                for (int kt = 0; kt < 4; ++kt) sacc[kt] = (f32x4){0.f, 0.f, 0.f, 0.f};
#pragma unroll
                for (int dc = 0; dc < 4; ++dc)
#pragma unroll
                    for (int kt = 0; kt < 4; ++kt) {
                        const bf16x8 kf = *(const bf16x8*)(KBUFP(bi) + (kt * 16 + fr) * KB_STRIDE + dc * 64 + fq * 16);
                        sacc[kt] = __builtin_amdgcn_mfma_f32_16x16x32_bf16(kf, qf[dc], sacc[kt], 0, 0, 0);
                    }
                const int lim = own ? (qloc - kt64 * 64 - fq * 4) : (actq ? 1000 : -1000);
                float mx = -1e30f;
#pragma unroll
                for (int kt = 0; kt < 4; ++kt)
#pragma unroll
                    for (int r = 0; r < 4; ++r) {
                        const float sv = (kt * 16 + r <= lim) ? sacc[kt][r] : -__builtin_inff();
                        sacc[kt][r] = sv; mx = fmaxf(mx, sv);
                    }
                mx = fmaxf(mx, __shfl_xor(mx, 16)); mx = fmaxf(mx, __shfl_xor(mx, 32));
                const float mnew = fmaxf(mrun, mx);
                const float alpha = __builtin_amdgcn_exp2f((mrun - mnew) * QC);
                mrun = mnew;
                const float mneg = -mnew * QC;
                float ps = 0.f;
#pragma unroll
                for (int kt = 0; kt < 4; ++kt)
#pragma unroll
                    for (int r = 0; r < 4; ++r) { const float pe = __builtin_amdgcn_exp2f(__builtin_fmaf(sacc[kt][r], QC, mneg)); sacc[kt][r] = pe; ps += pe; }
                lrun = lrun * alpha + ps;
                if (__any((int)(alpha != 1.f))) {
#pragma unroll
                    for (int dt = 0; dt < 8; ++dt) oacc[dt] *= alpha;
                }
                bf16x8 pf[2];
#pragma unroll
                for (int ks = 0; ks < 2; ++ks) {
                    u32x4 w = {pk_bf16(sacc[2 * ks][0], sacc[2 * ks][1]), pk_bf16(sacc[2 * ks][2], sacc[2 * ks][3]),
                               pk_bf16(sacc[2 * ks + 1][0], sacc[2 * ks + 1][1]), pk_bf16(sacc[2 * ks + 1][2], sacc[2 * ks + 1][3])};
                    pf[ks] = __builtin_bit_cast(bf16x8, w);
                }
#pragma unroll
                for (int ks = 0; ks < 2; ++ks)
#pragma unroll
                    for (int dt = 0; dt < 8; ++dt) {
                        const u32x2 va = *(const u32x2*)(VBUFP(bi) + (dt * 16 + fr) * VB_STRIDE + ks * 64 + fq * 8);
                        const u32x2 vb2 = *(const u32x2*)(VBUFP(bi) + (dt * 16 + fr) * VB_STRIDE + ks * 64 + 32 + fq * 8);
                        u32x4 w = {va[0], va[1], vb2[0], vb2[1]};
                        oacc[dt] = __builtin_amdgcn_mfma_f32_16x16x32_bf16(__builtin_bit_cast(bf16x8, w), pf[ks], oacc[dt], 0, 0, 0);
                    }
            }
        };
        lstore(0, kreg0, vreg0);
        __syncthreads();
        for (int tt = 0; tt < ntile; tt += 2) {
            if (tt + 2 < ntile) gload(tt + 2, kreg0, vreg0);
            compute(tt, 0);
            if (tt + 1 < ntile) lstore(1, kreg1, vreg1);
            lds_barrier();
            if (tt + 1 < ntile) {
                if (tt + 3 < ntile) gload(tt + 3, kreg1, vreg1);
                compute(tt + 1, 1);
                if (tt + 2 < ntile) lstore(0, kreg0, vreg0);
                lds_barrier();
            }
        }
        __syncthreads();
        {
            float lt = lrun; lt += __shfl_xor(lt, 16); lt += __shfl_xor(lt, 32);
            const float inv = 1.f / lt;
            bf16_t* orow = O + (tok0 + qb * 256 + qloc) * D + h * 128 + fq * 4;
#pragma unroll
            for (int dt = 0; dt < 8; ++dt) {
                const f32x4 o = oacc[dt] * inv;
                u32x2 w = {pk_bf16(o[0], o[1]), pk_bf16(o[2], o[3])};
                *(u32x2*)(orow + dt * 16) = w;
            }
        }
    }
#undef KBUFP
#undef VBUFP
}

DI void rwkv_mix_phase(int tid_, int bid_, const float* x, const float* mu, bf16_t* slots) {
    const size_t n4 = (size_t)T * D / 4;
    const size_t stride = (size_t)gridDim.x * 512;
    constexpr int U = 8;
    for (size_t ib = (size_t)bid_ * 512 + tid_; ib < n4; ib += stride * U) {
        f32x4 xv[U], xp[U];
#pragma unroll
        for (int u = 0; u < U; ++u) {
            const size_t i = ib + u * stride;
            const int t = (int)(i >> 9), s_ = t & (SEQ - 1);
            xv[u] = (i < n4) ? *(const f32x4*)(x + i * 4) : (f32x4){0.f, 0.f, 0.f, 0.f};
            xp[u] = (i < n4 && s_ > 0) ? *(const f32x4*)(x + i * 4 - D) : (f32x4){0.f, 0.f, 0.f, 0.f};
        }
#pragma unroll
        for (int u = 0; u < U; ++u) {
            const size_t i = ib + u * stride;
            if (i >= n4) break;
            const int c = (int)(i & 511) * 4;
            const f32x4 xx = xp[u] - xv[u];
#pragma unroll
            for (int k = 0; k < 6; ++k) {
                const f32x4 m = *(const f32x4*)(mu + k * D + c);
                const f32x4 o = xv[u] + xx * m;
                u32x2 w = {pk_bf16(o[0], o[1]), pk_bf16(o[2], o[3])};
                *(u32x2*)((unsigned char*)slots + k * SLOT + i * 8) = w;
            }
        }
    }
}
DI float softplusf_(float y) { return fmaxf(y, 0.f) + __logf(1.f + __expf(-fabsf(y))); }
DI void rwkv_prep_phase(int tid_, int bid_, const Params& p, unsigned char* sl, float* scal) {
    bf16_t* R = (bf16_t*)(sl + 6 * SLOT); bf16_t* Kk = (bf16_t*)(sl + 7 * SLOT);
    const bf16_t* WP = (const bf16_t*)(sl + 0 * SLOT); bf16_t* AP = (bf16_t*)(sl + 1 * SLOT);
    bf16_t* KX = (bf16_t*)(sl + 3 * SLOT); float* WD = (float*)(sl + 4 * SLOT);
    const float* w0 = p.in[18]; const float* a0 = p.in[21]; const float* k_k = p.in[26]; const float* k_a = p.in[27]; const float* r_k = p.in[28];
    float* BR = scal; float* KR = scal + (size_t)T * 32; float* BO = scal + (size_t)2 * T * 32;
    const int lane = tid_ & 63, wid = tid_ >> 6;
    constexpr int U = 16;
    for (int grp = bid_ * 8 + wid; grp < T * 32 / U; grp += gridDim.x * 8) {
        const int item0 = grp * U;
        const int h0 = item0 & 31; const size_t t = (size_t)(item0 >> 5);
        const size_t o0 = t * D + h0 * 64 + lane;
        bf16_t rr[U], kr_[U], wpr[U], apr[U];
#pragma unroll
        for (int u = 0; u < U; ++u) { rr[u] = R[o0 + u * 64]; kr_[u] = Kk[o0 + u * 64]; wpr[u] = WP[o0 + u * 64]; apr[u] = AP[o0 + u * 64]; }
#pragma unroll
        for (int u = 0; u < U; ++u) {
            const int c = (h0 + u) * 64 + lane; const size_t o = o0 + u * 64;
            const float r = bf2f(rr[u]), k = bf2f(kr_[u]), wp = bf2f(wpr[u]), ap = bf2f(apr[u]);
            const float wlog = -softplusf_(-(w0[c] + wp)) - 0.5f;
            const float dec = __expf(-__expf(wlog));
            const float a = __builtin_amdgcn_rcpf(1.f + __expf(-(a0[c] + ap)));
            float kk = k * k_k[c];
            kk = kk * fminf(__builtin_amdgcn_rsqf(wave_sum(kk * kk)), 1e12f);
            const float kx = k * (1.f + (a - 1.f) * k_a[c]);
            const float bb = kk * a;
            const float br = wave_sum(bb * r), kr = wave_sum(kx * r), bo = wave_sum(r * kx * r_k[c]);
            R[o] = f2bf(dec * r); Kk[o] = f2bf(-kk); AP[o] = f2bf(bb); KX[o] = f2bf(kx); WD[o] = dec;
            if (lane == 0) { BR[item0 + u] = br; KR[item0 + u] = kr; BO[item0 + u] = bo; }
        }
    }
}
DI float dpp_sum8(float v) {
    v += __int_as_float(__builtin_amdgcn_update_dpp(0, __float_as_int(v), 0xB1, 0xF, 0xF, false));
    v += __int_as_float(__builtin_amdgcn_update_dpp(0, __float_as_int(v), 0x4E, 0xF, 0xF, false));
    v += __int_as_float(__builtin_amdgcn_update_dpp(0, __float_as_int(v), 0x141, 0xF, 0xF, false));
    return v;
}
DI void rwkv_scan_phase(int tid_, int bid_, unsigned char* sl, const float* scal, unsigned char* smem) {
    constexpr int TC = 32;
    constexpr int OFF_BB = TC * 128, OFF_KX = OFF_BB + TC * 64, OFF_W = OFF_KX + TC * 64, OFF_V = OFF_W + TC * 64, OFF_SC = OFF_V + TC * 32, BUF_F = OFF_SC + TC * 2;
    constexpr int NCH = SEQ / TC;
#define SBUF(i) ((float*)smem + (i) * BUF_F)
    const bf16_t* NKK = (const bf16_t*)(sl + 7 * SLOT); const bf16_t* WR = (const bf16_t*)(sl + 6 * SLOT);
    const bf16_t* BB = (const bf16_t*)(sl + 1 * SLOT); const bf16_t* KX = (const bf16_t*)(sl + 3 * SLOT);
    const float* WD = (const float*)(sl + 4 * SLOT); const bf16_t* V = (const bf16_t*)(sl + 8 * SLOT);
    bf16_t* Y = (bf16_t*)(sl + 0 * SLOT);
    const float* BR = scal; const float* KR = scal + (size_t)T * 32;
    const int tid = tid_, wid = tid >> 6, lane = tid & 63;
    for (int item = bid_; item < 256; item += gridDim.x) {
        const int half = item & 1, h = (item >> 1) & 31, b = item >> 6;
        const size_t tok0 = (size_t)b * SEQ;
        if (wid >= 4) {
            const int lt = tid - 256, lt_t = lt >> 3, lt_c = lt & 7;
            u32x4 r_nk, r_wr, r_bb, r_kx, r_v = {0u, 0u, 0u, 0u}; f32x4 r_w0, r_w1; float r_s = 0.f;
            auto gload = [&](int c) {
                const size_t tb = tok0 + (size_t)c * TC;
                const size_t o = (tb + lt_t) * D + h * 64 + lt_c * 8;
                r_nk = *(const u32x4*)(NKK + o); r_wr = *(const u32x4*)(WR + o); r_bb = *(const u32x4*)(BB + o); r_kx = *(const u32x4*)(KX + o);
                r_w0 = *(const f32x4*)(WD + (tb + (lt >> 4)) * D + h * 64 + (lt & 15) * 4);
                r_w1 = *(const f32x4*)(WD + (tb + 16 + (lt >> 4)) * D + h * 64 + (lt & 15) * 4);
                if (lt < 128) r_v = *(const u32x4*)(V + (tb + (lt >> 2)) * D + h * 64 + half * 32 + (lt & 3) * 8);
                else if (lt < 192) { const int i = lt - 128; r_s = ((i & 1) ? KR : BR)[(tb + (i >> 1)) * 32 + h]; }
            };
            auto lstore = [&](float* F) {
                float* pp = F + lt_t * 128 + lt_c * 16;
#pragma unroll
                for (int j = 0; j < 4; ++j) { f32x4 q = {bflo(r_nk[j]), bflo(r_wr[j]), bfhi(r_nk[j]), bfhi(r_wr[j])}; *(f32x4*)(pp + j * 4) = q; }
                { float* d = F + OFF_BB + lt_t * 64 + lt_c * 8;
                  f32x4 lo = {bflo(r_bb[0]), bfhi(r_bb[0]), bflo(r_bb[1]), bfhi(r_bb[1])}, hi = {bflo(r_bb[2]), bfhi(r_bb[2]), bflo(r_bb[3]), bfhi(r_bb[3])};
                  *(f32x4*)d = lo; *(f32x4*)(d + 4) = hi; }
                { float* d = F + OFF_KX + lt_t * 64 + lt_c * 8;
                  f32x4 lo = {bflo(r_kx[0]), bfhi(r_kx[0]), bflo(r_kx[1]), bfhi(r_kx[1])}, hi = {bflo(r_kx[2]), bfhi(r_kx[2]), bflo(r_kx[3]), bfhi(r_kx[3])};
                  *(f32x4*)d = lo; *(f32x4*)(d + 4) = hi; }
                *(f32x4*)(F + OFF_W + (lt >> 4) * 64 + (lt & 15) * 4) = r_w0;
                *(f32x4*)(F + OFF_W + (16 + (lt >> 4)) * 64 + (lt & 15) * 4) = r_w1;
                if (lt < 128) { float* d = F + OFF_V + (lt >> 2) * 32 + (lt & 3) * 8;
                  f32x4 lo = {bflo(r_v[0]), bfhi(r_v[0]), bflo(r_v[1]), bfhi(r_v[1])}, hi = {bflo(r_v[2]), bfhi(r_v[2]), bflo(r_v[3]), bfhi(r_v[3])};
                  *(f32x4*)d = lo; *(f32x4*)(d + 4) = hi; }
                else if (lt < 192) F[OFF_SC + (lt - 128)] = r_s;
            };
            gload(0); lstore(SBUF(0)); gload(1);
            __syncthreads();
            for (int c = 0; c < NCH; ++c) {
                if (c + 1 < NCH) lstore(SBUF((c + 1) & 1));
                if (c + 2 < NCH) gload(c + 2);
                lds_barrier();
            }
        } else {
            const int kq = lane & 7, rl = wid * 8 + (lane >> 3);
            f32x2 st[4];
#pragma unroll
            for (int j = 0; j < 4; ++j) st[j] = (f32x2){0.f, 0.f};
            bf16_t* yp = Y + (tok0 + kq) * D + h * 64 + half * 32 + rl;
            __syncthreads();
            struct Ops { f32x4 pq[4], b0, b1, k0, k1, w0, w1; float vv; f32x2 sc; };
            for (int c = 0; c < NCH; ++c) {
                const float* F = SBUF(c & 1);
                const float* fp = F + kq * 16;
                const float* fb = F + OFF_BB + kq * 8;
                auto ld = [&](Ops& o, int t) {
#pragma unroll
                    for (int j = 0; j < 4; ++j) o.pq[j] = *(const f32x4*)(fp + t * 128 + j * 4);
                    o.b0 = *(const f32x4*)(fb + t * 64); o.b1 = *(const f32x4*)(fb + t * 64 + 4);
                    o.k0 = *(const f32x4*)(fb + (OFF_KX - OFF_BB) + t * 64); o.k1 = *(const f32x4*)(fb + (OFF_KX - OFF_BB) + t * 64 + 4);
                    o.w0 = *(const f32x4*)(fb + (OFF_W - OFF_BB) + t * 64); o.w1 = *(const f32x4*)(fb + (OFF_W - OFF_BB) + t * 64 + 4);
                    o.vv = F[OFF_V + t * 32 + rl]; o.sc = *(const f32x2*)(F + OFF_SC + t * 2);
                };
                auto dots = [&](const Ops& o) -> f32x2 {
                    f32x2 acc = {0.f, 0.f}, acc2 = {0.f, 0.f};
#pragma unroll
                    for (int j = 0; j < 4; ++j) {
                        acc += st[j][0] * (f32x2){o.pq[j][0], o.pq[j][1]};
                        acc2 += st[j][1] * (f32x2){o.pq[j][2], o.pq[j][3]};
                    }
                    return acc + acc2;
                };
                auto update = [&](const Ops& o, f32x2 acc) -> float {
                    const float d1 = dpp_sum8(acc[0]), d2 = dpp_sum8(acc[1]);
                    st[0] = st[0] * (f32x2){o.w0[0], o.w0[1]} + d1 * (f32x2){o.b0[0], o.b0[1]} + o.vv * (f32x2){o.k0[0], o.k0[1]};
                    st[1] = st[1] * (f32x2){o.w0[2], o.w0[3]} + d1 * (f32x2){o.b0[2], o.b0[3]} + o.vv * (f32x2){o.k0[2], o.k0[3]};
                    st[2] = st[2] * (f32x2){o.w1[0], o.w1[1]} + d1 * (f32x2){o.b1[0], o.b1[1]} + o.vv * (f32x2){o.k1[0], o.k1[1]};
                    st[3] = st[3] * (f32x2){o.w1[2], o.w1[3]} + d1 * (f32x2){o.b1[2], o.b1[3]} + o.vv * (f32x2){o.k1[2], o.k1[3]};
                    return d2 + d1 * o.sc[0] + o.vv * o.sc[1];
                };
                Ops os[3];
                ld(os[0], 0); ld(os[1], 1);
                float yv = 0.f;
#pragma unroll
                for (int t = 0; t < TC; ++t) {
                    const f32x2 da = dots(os[t % 3]);
                    __builtin_amdgcn_sched_barrier(0);
                    if (t + 2 < TC) ld(os[(t + 2) % 3], t + 2);
                    __builtin_amdgcn_sched_barrier(0);
                    const float ya = update(os[t % 3], da);
                    yv = (kq == (t & 7)) ? ya : yv;
                    if ((t & 7) == 7) yp[(size_t)(c * TC + (t & ~7)) * D] = f2bf(yv);
                }
                lds_barrier();
            }
        }
        __syncthreads();
    }
#undef SBUF
}
DI void rwkv_post_phase(int tid_, int bid_, const Params& p, unsigned char* sl, const float* scal) {
    const bf16_t* Y = (const bf16_t*)(sl + 0 * SLOT); const bf16_t* V = (const bf16_t*)(sl + 8 * SLOT); const bf16_t* G = (const bf16_t*)(sl + 2 * SLOT);
    bf16_t* OUT = (bf16_t*)(sl + 3 * SLOT);
    const float* lg = p.in[29]; const float* lb = p.in[30]; const float* BO = scal + (size_t)2 * T * 32;
    const int lane = tid_ & 63, wid = tid_ >> 6;
    constexpr int U = 16;
    for (int grp = bid_ * 8 + wid; grp < T * 32 / U; grp += gridDim.x * 8) {
        const int item0 = grp * U;
        const int h0 = item0 & 31; const size_t t = (size_t)(item0 >> 5);
        const size_t o0 = t * D + h0 * 64 + lane;
        bf16_t yr[U], vr[U], gr[U]; float bor[U];
#pragma unroll
        for (int u = 0; u < U; ++u) { yr[u] = Y[o0 + u * 64]; vr[u] = V[o0 + u * 64]; gr[u] = G[o0 + u * 64]; bor[u] = BO[item0 + u]; }
#pragma unroll
        for (int u = 0; u < U; ++u) {
            const int c = (h0 + u) * 64 + lane;
            const float y = bf2f(yr[u]);
            const float mean = wave_sum(y) * (1.f / 64.f);
            const float dlt = y - mean;
            const float var = wave_sum(dlt * dlt) * (1.f / 64.f);
            float r = dlt * rsqrtf(var + 64e-5f) * lg[c] + lb[c];
            r += bor[u] * bf2f(vr[u]);
            OUT[o0 + u * 64] = f2bf(r * bf2f(gr[u]));
        }
    }
}

DI void pool_phase(int tid_, int bid_, const float* x, bf16_t* outp) {
    constexpr int CH = 32;
    const int tid = tid_, c = tid * 4, w = 2 << (c >> 9);
    for (int item = bid_; item < T / CH; item += gridDim.x) {
        const int t0 = item * CH, s0 = t0 & (SEQ - 1);
        f32x4 sum = {0.f, 0.f, 0.f, 0.f};
#pragma unroll
        for (int j = 1; j <= 16; ++j) if (j <= w && s0 - j >= 0) sum += *(const f32x4*)(x + (size_t)(t0 - j) * D + c);
#pragma unroll 16
        for (int tt = 0; tt < CH; ++tt) {
            const int t = t0 + tt, s = s0 + tt;
            const f32x4 xv = *(const f32x4*)(x + (size_t)t * D + c);
            sum += xv;
            if (s - w >= 0) sum -= *(const f32x4*)(x + (size_t)(t - w) * D + c);
            const float rc = __builtin_amdgcn_rcpf((float)((s + 1 < w) ? (s + 1) : w));
            const f32x4 o = sum * rc - xv;
            u32x2 wv = {pk_bf16(o[0], o[1]), pk_bf16(o[2], o[3])};
            *(u32x2*)(outp + (size_t)t * D + c) = wv;
        }
    }
}

#define XB_TMO      128
#define XB_XCNT(j)  (256  + 64 * (j))
#define XB_XSUB(j)  (1280 + 64 * (j))
#define XB_XGEN(j)  (2304 + 64 * (j))
#define XB_TOP      3328
#define XB_TOPGEN   3392
#define XCD_BAR_WORDS 3456
#define XB_SPIN_CAP (1u << 18)
DI unsigned xb_ld(unsigned* p) { return __hip_atomic_load(p, __ATOMIC_RELAXED, __HIP_MEMORY_SCOPE_AGENT); }
DI unsigned xb_add(unsigned* p, unsigned v) { return __hip_atomic_fetch_add(p, v, __ATOMIC_RELAXED, __HIP_MEMORY_SCOPE_AGENT); }
DI unsigned xb_xcc_id() { return (unsigned)__builtin_amdgcn_s_getreg((3 << 11) | 20) & 0xFu; }
#define XB_SPIN(cond, bar) do { unsigned _sp = 0; while (cond) { __builtin_amdgcn_s_sleep(1); \
    if ((++_sp & 255u) == 0u) { if (xb_ld(&(bar)[XB_TMO])) break; if (_sp > XB_SPIN_CAP) { atomicAdd(&(bar)[XB_TMO], 1u); break; } } } } while (0)
struct XcdBarrier { unsigned* bar; unsigned x; volatile LAS unsigned* st; };
DI XcdBarrier xcd_barrier_post(int tid, unsigned* bar, volatile LAS unsigned* st) {
    XcdBarrier b; b.bar = bar; b.x = xb_xcc_id(); b.st = st;
    if (tid == 0) (void)xb_add(&bar[XB_XCNT(b.x)], 1u);
    return b;
}
DI void xcd_barrier_complete(unsigned* bar, unsigned x, unsigned& nloc, unsigned& nx) {
    const unsigned G = gridDim.x * gridDim.y * gridDim.z;
    unsigned sum, cnt, mine, sp = 0u;
    for (;;) {
        sum = 0u; cnt = 0u; mine = 0u;
#pragma unroll
        for (unsigned j = 0; j < 16; ++j) { const unsigned c = xb_ld(&bar[XB_XCNT(j)]); sum += c; cnt += (c > 0u) ? 1u : 0u; mine = (j == x) ? c : mine; }
        if (sum == G) break;
        __builtin_amdgcn_s_sleep(1);
        if ((++sp & 255u) == 0u) { if (xb_ld(&bar[XB_TMO])) break; if (sp > XB_SPIN_CAP) { atomicAdd(&bar[XB_TMO], 1u); break; } }
    }
    nloc = mine > 0u ? mine : 1u; nx = cnt > 0u ? cnt : 1u;
}
DI void xcd_barrier(int tid, const XcdBarrier& b) {
    asm volatile("s_waitcnt vmcnt(0)" ::: "memory");
    __syncthreads();
    if (tid == 0) {
        unsigned* bar = b.bar;
        __builtin_amdgcn_s_waitcnt(0);
        unsigned nloc = b.st[0], nx = b.st[1];
        if (nloc == 0u) { xcd_barrier_complete(bar, b.x, nloc, nx); b.st[0] = nloc; b.st[1] = nx; }
        const unsigned old = xb_add(&bar[XB_XSUB(b.x)], 1u);
        const unsigned gen = old / nloc;
        if (old + 1u == (gen + 1u) * nloc) {
            __builtin_amdgcn_fence(__ATOMIC_RELEASE, "agent");
            asm volatile("s_waitcnt vmcnt(0)" ::: "memory");
            const unsigned og = xb_add(&bar[XB_TOP], 1u);
            const unsigned tg = og / nx;
            if (og + 1u == (tg + 1u) * nx) xb_add(&bar[XB_TOPGEN], 1u);
            else XB_SPIN(xb_ld(&bar[XB_TOPGEN]) == tg, bar);
            __builtin_amdgcn_fence(__ATOMIC_ACQUIRE, "agent");
            xb_add(&bar[XB_XGEN(b.x)], 1u);
            asm volatile("s_waitcnt vmcnt(0)" ::: "memory");
        } else {
            XB_SPIN(xb_ld(&bar[XB_XGEN(b.x)]) == gen, bar);
            __builtin_amdgcn_fence(__ATOMIC_ACQUIRE, "agent");
            asm volatile("s_waitcnt vmcnt(0)" ::: "memory");
        }
    }
    __syncthreads();
}

enum { K_PREP = 0, K_GACT, K_GRES, K_LN, K_RGCONV, K_RGSCAN0, K_RGSCAN1, K_KMEAN, K_ATTN, K_RMIX, K_RPREP, K_RSCAN, K_RPOST, K_POOL };
constexpr int NSTEPS = 38;
struct Desc {
    int kind;
    pg8::Gemm g;
    bf16_t* C; const float* res; const float* cscale; long sC; int ldc; unsigned acts;
    int lnidx, lnlast;
};
DI bool step_nosync(int st) { return st == 11 || st == 21; }
DI Desc make_desc(int st, const Params& p, unsigned char* ws) {
    unsigned char* sl = ws + O_SLOT;
    auto slot = [&](int i) { return (bf16_t*)(sl + (size_t)i * SLOT); };
    bf16_t* xb = slot(8);
    Desc d; d.kind = K_PREP; d.g = mk_gemm(nullptr, nullptr, 0, 0, 0, 0, 0, 0, 0, 0);
    d.C = nullptr; d.res = nullptr; d.cscale = nullptr; d.sC = 0; d.ldc = D; d.acts = 0u; d.lnidx = 0; d.lnlast = 0;
    int layer = -1, sub = 0;
    if (st >= 7 && st < 11) { layer = 0; sub = st - 7; }
    else if (st >= 16 && st < 20) { layer = 1; sub = st - 16; }
    else if (st >= 28 && st < 32) { layer = 2; sub = st - 28; }
    else if (st >= 34 && st < 38) { layer = 3; sub = st - 34; }
    if (layer >= 0) {
        if (sub == 0) { d.kind = K_LN; d.lnidx = layer * 2; }
        else if (sub == 1) { d.kind = K_GACT; d.C = slot(0); d.ldc = DFF; d.acts = 1u;
            d.g = mk_gemm(xb, (const bf16_t*)(ws + O_W1T + (size_t)layer * DFF * D * 2), 0, 0, D, D, D, T / 256, DFF / 256, 1); }
        else if (sub == 2) { d.kind = K_GRES;
            d.g = mk_gemm(slot(0), (const bf16_t*)(ws + O_W2T + (size_t)layer * DFF * D * 2), 0, 0, DFF, DFF, DFF, T / 256, D / 256, 1); }
        else { d.kind = K_LN; d.lnidx = layer * 2 + 1; d.lnlast = (layer == 3); }
        return d;
    }
    switch (st) {
    case 0: d.kind = K_PREP; break;
    case 1: d.kind = K_GACT; d.C = slot(0); d.ldc = 4096;
            d.g = mk_gemm(xb, (const bf16_t*)(ws + O_WIN), 0, 0, D, D, D, T / 256, 4096 / 256, 1); break;
    case 2: d.kind = K_RGCONV; break;
    case 3: d.kind = K_GACT; d.C = slot(3); d.sC = 512; d.ldc = 4096;
            d.g = mk_gemm(slot(2), (const bf16_t*)(ws + O_GATES), 256, 512 * 256, D, 256, 256, T / 256, 2, 8); break;
    case 4: d.kind = K_RGSCAN0; break;
    case 5: d.kind = K_RGSCAN1; break;
    case 6: d.kind = K_GRES; d.res = p.in[0];
            d.g = mk_gemm(slot(5), (const bf16_t*)(ws + O_RGOUT), 0, 0, D, D, D, T / 256, D / 256, 1); break;
    case 11: d.kind = K_GACT; d.C = slot(0); d.sC = (long)T * D;
             d.g = mk_gemm(xb, (const bf16_t*)(ws + O_QKV), 0, (long)D * D, D, D, D, T / 256, D / 256, 2); break;
    case 12: d.kind = K_GACT; d.C = slot(2); d.ldc = T;
             d.g = mk_gemm((const bf16_t*)(ws + O_QKV + 2 * SZ_DD), xb, 0, 0, D, D, D, D / 256, T / 256, 1); break;
    case 13: d.kind = K_KMEAN; break;
    case 14: d.kind = K_ATTN; break;
    case 15: d.kind = K_GRES;
             d.g = mk_gemm(slot(3), (const bf16_t*)(ws + O_MOUT), 0, 0, D, D, D, T / 256, D / 256, 1); break;
    case 20: d.kind = K_RMIX; break;
    case 21: d.kind = K_GACT; d.C = slot(6); d.sC = (long)T * D;
             d.g = mk_gemm(slot(0), (const bf16_t*)(ws + O_RKV), (long)T * D, (long)D * D, D, D, D, T / 256, D / 256, 3); break;
    case 22: d.kind = K_GACT; d.C = (bf16_t*)(ws + O_L1O); d.sC = (long)T * 256; d.ldc = 256; d.acts = 0x302u;
             d.g = mk_gemm(slot(3), (const bf16_t*)(ws + O_L1), (long)T * D, (long)256 * D, D, D, D, T / 256, 1, 3); break;
    case 23: d.kind = K_GACT; d.C = slot(0); d.sC = (long)T * D;
             d.g = mk_gemm((const bf16_t*)(ws + O_L1O), (const bf16_t*)(ws + O_L2), (long)T * 256, (long)D * 256, 256, 256, 256, T / 256, D / 256, 3); break;
    case 24: d.kind = K_RPREP; break;
    case 25: d.kind = K_RSCAN; break;
    case 26: d.kind = K_RPOST; break;
    case 27: d.kind = K_GRES;
             d.g = mk_gemm(slot(3), (const bf16_t*)(ws + O_ROUT), 0, 0, D, D, D, T / 256, D / 256, 1); break;
    case 32: d.kind = K_POOL; break;
    case 33: d.kind = K_GRES; d.cscale = p.in[33]; d.sC = 512;
             d.g = mk_gemm(slot(0), (const bf16_t*)(ws + O_POOL), 512, 512 * 512, D, 512, 512, T / 256, 2, 4); break;
    default: break;
    }
    return d;
}

__global__ void __launch_bounds__(512, 2) fwd_megakernel(Params p) {
    extern __shared__ __attribute__((aligned(16))) unsigned char smem[];
    cg::grid_group grid = cg::this_grid();
    LAS unsigned char* lds = (LAS unsigned char*)smem;

    const bool multi = (p.hi - p.lo) > 1;
    volatile LAS unsigned* xst = (volatile LAS unsigned*)(lds + 131072);
    if (__builtin_amdgcn_workitem_id_x() == 0) { xst[0] = 0u; xst[1] = 0u; }
    __syncthreads();
    (void)xcd_barrier_post((int)__builtin_amdgcn_workitem_id_x(), (unsigned*)(p.ws + O_BAR), xst);
    for (int st = p.lo; st < p.hi; ++st) {
        int tid_ = (int)__builtin_amdgcn_workitem_id_x(); asm volatile("" : "+v"(tid_));
        int bid_ = (int)__builtin_amdgcn_workgroup_id_x(); asm volatile("" : "+s"(bid_));
        unsigned char* ws = p.ws; asm volatile("" : "+s"(ws));
        float* xcur = p.out; asm volatile("" : "+s"(xcur));
        unsigned char* sl = ws + O_SLOT;
        auto slot = [&](int i) { return (bf16_t*)(sl + (size_t)i * SLOT); };
        const int stu = __builtin_amdgcn_readfirstlane(st);
        const Desc d = make_desc(stu, p, ws);
        switch (__builtin_amdgcn_readfirstlane(d.kind)) {
        case K_PREP: prep_phase(tid_, bid_, p, smem); break;
        case K_GACT: { pg8::EpiAct E; E.C = d.C; E.sC = d.sC; E.ldc = d.ldc; E.acts = d.acts; pg8::gemm_phase(tid_, bid_, lds, d.g, E); } break;
        case K_GRES: { pg8::EpiRes E; E.out = xcur; E.res = d.res ? d.res : xcur; E.cscale = d.cscale; E.alpha = ALPHA; E.sC = d.sC; E.ldc = D; pg8::gemm_phase(tid_, bid_, lds, d.g, E); } break;
        case K_LN: ln_phase(tid_, bid_, xcur, xcur, d.lnlast ? nullptr : slot(8), p.in[1] + (size_t)d.lnidx * D, p.in[2] + (size_t)d.lnidx * D); break;
        case K_RGCONV: rg_conv_phase(tid_, bid_, slot(0), slot(2), p.in[6], p.in[7]); break;
        case K_RGSCAN0: rg_scan_phase<0>(tid_, bid_, p, slot(3), slot(2), slot(0), (float*)(ws + O_AGG), slot(5)); break;
        case K_RGSCAN1: rg_scan_phase<1>(tid_, bid_, p, slot(3), slot(2), slot(0), (float*)(ws + O_AGG), slot(5)); break;
        case K_KMEAN: kmean_phase(tid_, bid_, slot(0), slot(1), (float*)(ws + O_KMEAN), (const float*)(ws + O_ROPE), (const float*)(ws + O_ROPE) + SEQ * 16, smem); break;
        case K_ATTN: attn_phase(tid_, bid_, slot(0), slot(1), slot(2), slot(3), (const float*)(ws + O_KMEAN), smem); break;
        case K_RMIX: rwkv_mix_phase(tid_, bid_, xcur, p.in[16], slot(0)); break;
        case K_RPREP: rwkv_prep_phase(tid_, bid_, p, sl, (float*)(ws + O_SCAL)); break;
        case K_RSCAN: rwkv_scan_phase(tid_, bid_, sl, (const float*)(ws + O_SCAL), smem); break;
        case K_RPOST: rwkv_post_phase(tid_, bid_, p, sl, (const float*)(ws + O_SCAL)); break;
        case K_POOL: pool_phase(tid_, bid_, xcur, slot(0)); break;
        default: break;
        }
        if (multi && !step_nosync(st) && st + 1 < p.hi) { if (st == p.lo) grid.sync(); else { XcdBarrier xb; xb.bar = (unsigned*)(ws + O_BAR); xb.x = xb_xcc_id(); xb.st = (volatile LAS unsigned*)(lds + 131072); xcd_barrier(tid_, xb); } }
    }
}

extern "C" void kernel_launch(void* const* d_in, const int* in_sizes, int n_in, void* d_out, int out_size, void* d_ws, size_t ws_size, hipStream_t stream) {
    static int grid = 0;
    if (grid == 0) {
        if (n_in != 34 || out_size != T * D || ws_size < WS_END) { fprintf(stderr, "kernel_launch: unexpected shapes (n_in %d out %d ws %zu need %zu)\n", n_in, out_size, ws_size, (size_t)WS_END); grid = -1; return; }
        int dev = 0, cus = 0, per_cu = 0;
        hipGetDevice(&dev);
        hipDeviceGetAttribute(&cus, hipDeviceAttributeMultiprocessorCount, dev);
        if (hipFuncSetAttribute((const void*)fwd_megakernel, hipFuncAttributeMaxDynamicSharedMemorySize, LDS_BYTES) != hipSuccess) { fprintf(stderr, "kernel_launch: hipFuncSetAttribute failed\n"); grid = -1; return; }
        hipOccupancyMaxActiveBlocksPerMultiprocessor(&per_cu, (const void*)fwd_megakernel, 512, LDS_BYTES);
        if (per_cu < 1) { fprintf(stderr, "kernel_launch: occupancy query says %d blocks/CU\n", per_cu); per_cu = 1; }
        (void)hipGetLastError();
        grid = cus;
    }
    if (grid < 0) return;
    Params p{};
    for (int i = 0; i < 34; ++i) p.in[i] = (const float*)d_in[i];
    {
        unsigned char* ws = (unsigned char*)d_ws; int nj = 0, t0 = 0;
        auto add = [&](const float* src, size_t dstoff, int Ks, int Ns, int Kd, int Nd) {
            TJob& j = p.tj[nj]; j.src = src; j.dst = (bf16_t*)(ws + dstoff); j.Ks = Ks; j.Ns = Ns; j.Kd = Kd; j.Nd = Nd; j.tile0 = t0; j.pad = 0;
            t0 += (Kd / 128) * (Nd / 128); ++nj; };
        for (int l = 0; l < 4; ++l) add(p.in[3] + (size_t)l * D * DFF, O_W1T + (size_t)l * DFF * D * 2, D, DFF, D, DFF);
        for (int l = 0; l < 4; ++l) add(p.in[4] + (size_t)l * D * DFF, O_W2T + (size_t)l * DFF * D * 2, DFF, D, DFF, D);
        add(p.in[5], O_WIN, D, 4096, D, 4096);
        for (int n = 0; n < 8; ++n) { add(p.in[8] + (size_t)n * 65536, O_GATES + (size_t)n * 512 * 256 * 2, 256, 256, 256, 256);
                                      add(p.in[10] + (size_t)n * 65536, O_GATES + ((size_t)n * 512 + 256) * 256 * 2, 256, 256, 256, 256); }
        add(p.in[13], O_RGOUT, D, D, D, D);
        add(p.in[14], O_QKV, D, 3 * D, D, 3 * D);
        add(p.in[15], O_MOUT, D, D, D, D);
        for (int g = 0; g < 3; ++g) add(p.in[17] + (size_t)g * D * D, O_RKV + g * SZ_DD, D, D, D, D);
        add(p.in[19], O_L1 + 0 * (size_t)256 * D * 2, D, 96, D, 256);
        add(p.in[22], O_L1 + 1 * (size_t)256 * D * 2, D, 96, D, 256);
        add(p.in[24], O_L1 + 2 * (size_t)256 * D * 2, D, 256, D, 256);
        add(p.in[20], O_L2 + 0 * (size_t)D * 256 * 2, 96, D, 256, D);
        add(p.in[23], O_L2 + 1 * (size_t)D * 256 * 2, 96, D, 256, D);
        add(p.in[25], O_L2 + 2 * (size_t)D * 256 * 2, 256, D, 256, D);
        add(p.in[31], O_ROUT, D, D, D, D);
        for (int g = 0; g < 4; ++g) add(p.in[32] + (size_t)g * 512 * 512, O_POOL + (size_t)g * 512 * 512 * 2, 512, 512, 512, 512);
        p.ntiles = t0;
        if (nj != NTJ) fprintf(stderr, "kernel_launch: job table size %d != %d\n", nj, NTJ);
    }
    p.out = (float*)d_out; p.ws = (unsigned char*)d_ws; p.lo = 0; p.hi = NSTEPS;
    if (hipMemsetAsync((unsigned char*)d_ws + O_BAR, 0, BAR_BYTES, stream) != hipSuccess) { fprintf(stderr, "kernel_launch: memset of barrier words failed\n"); return; }
    void* args[] = {&p};
    hipError_t e = hipLaunchCooperativeKernel((const void*)fwd_megakernel, dim3(grid), dim3(512), args, LDS_BYTES, stream);
    if (e != hipSuccess) fprintf(stderr, "cooperative launch failed: %s (grid %d)\n", hipGetErrorString(e), grid);
}
```

```cpp
#include <hip/hip_runtime.h>
#include <hip/hip_cooperative_groups.h>
#include <cstdio>
namespace cg = cooperative_groups;

#define LAS __attribute__((address_space(3)))
typedef unsigned short bf16_t;
typedef short bf16x8 __attribute__((ext_vector_type(8)));
typedef float f32x4 __attribute__((ext_vector_type(4)));
typedef float f32x2 __attribute__((ext_vector_type(2)));
typedef unsigned u32x4 __attribute__((ext_vector_type(4)));
typedef unsigned u32x2 __attribute__((ext_vector_type(2)));
typedef __bf16 bfv2 __attribute__((ext_vector_type(2)));
#define DI __device__ __forceinline__

constexpr int T = 16384, D = 2048, SEQ = 4096, DFF = 8192;
constexpr float ALPHA = 1.6817928305074290f;
constexpr float LN_EPS = 1e-5f;

constexpr size_t SZ_DD = (size_t)D * D * 2;
constexpr size_t O_W1T = 0;
constexpr size_t O_W2T = O_W1T + 4 * (size_t)DFF * D * 2;
constexpr size_t O_WIN = O_W2T + 4 * (size_t)DFF * D * 2;
constexpr size_t O_GATES = O_WIN + (size_t)4096 * D * 2;
constexpr size_t O_RGOUT = O_GATES + (size_t)8 * 512 * 256 * 2;
constexpr size_t O_QKV = O_RGOUT + SZ_DD;
constexpr size_t O_MOUT = O_QKV + 3 * SZ_DD;
constexpr size_t O_RKV = O_MOUT + SZ_DD;
constexpr size_t O_L1 = O_RKV + 3 * SZ_DD;
constexpr size_t O_L2 = O_L1 + (size_t)3 * 256 * D * 2;
constexpr size_t O_ROUT = O_L2 + (size_t)3 * D * 256 * 2;
constexpr size_t O_POOL = O_ROUT + SZ_DD;
constexpr size_t O_SLOT = O_POOL + (size_t)4 * 512 * 512 * 2;
constexpr size_t SLOT = (size_t)T * D * 2;
constexpr size_t O_L1O = O_SLOT + 9 * SLOT;
constexpr size_t O_ROPE = O_L1O + (size_t)3 * T * 256 * 2;
constexpr size_t O_KMEAN = O_ROPE + (size_t)2 * SEQ * 16 * 4;
constexpr size_t O_AGG = O_KMEAN + (size_t)64 * 16 * 128 * 4;
constexpr size_t O_SCAL = O_AGG + (size_t)4 * 128 * D * 2 * 4;
constexpr size_t O_BAR = O_SCAL + (size_t)3 * T * 32 * 4;
constexpr size_t BAR_BYTES = 16384;
constexpr size_t WS_END = O_BAR + BAR_BYTES;

constexpr int LDS_BYTES = 131072 + 16;

struct TJob { const float* src; bf16_t* dst; int Ks, Ns, Kd, Nd, tile0, pad; };
constexpr int NTJ = 42;
struct Params {
    const float* in[34];
    float* out;
    unsigned char* ws;
    int lo, hi, ntiles, pad;
    TJob tj[NTJ];
};

DI unsigned pk_bf16(float a, float b) { f32x2 v = {a, b}; bfv2 r = __builtin_convertvector(v, bfv2); return __builtin_bit_cast(unsigned, r); }
DI bf16_t f2bf(float a) { return (bf16_t)(pk_bf16(a, 0.f) & 0xffffu); }
DI float bf2f(bf16_t b) { return __uint_as_float(((unsigned)b) << 16); }
DI float bflo(unsigned u) { return __uint_as_float(u << 16); }
DI float bfhi(unsigned u) { return __uint_as_float(u & 0xffff0000u); }
DI float wave_sum(float v) {
    v += __int_as_float(__builtin_amdgcn_update_dpp(0, __float_as_int(v), 0xB1, 0xF, 0xF, false));
    v += __int_as_float(__builtin_amdgcn_update_dpp(0, __float_as_int(v), 0x4E, 0xF, 0xF, false));
    v += __int_as_float(__builtin_amdgcn_update_dpp(0, __float_as_int(v), 0x141, 0xF, 0xF, false));
    v += __int_as_float(__builtin_amdgcn_update_dpp(0, __float_as_int(v), 0x140, 0xF, 0xF, false));
    const int iv = __float_as_int(v);
    return __int_as_float(__builtin_amdgcn_readlane(iv, 0)) + __int_as_float(__builtin_amdgcn_readlane(iv, 16)) +
           __int_as_float(__builtin_amdgcn_readlane(iv, 32)) + __int_as_float(__builtin_amdgcn_readlane(iv, 48));
}
DI void lds_barrier() { asm volatile("s_waitcnt lgkmcnt(0)" ::: "memory"); __builtin_amdgcn_s_barrier(); asm volatile("" ::: "memory"); }
DI float sigmoidf_(float x) { return __builtin_amdgcn_rcpf(1.f + __expf(-x)); }
DI float tanhf_(float x) { return 1.f - 2.f * __builtin_amdgcn_rcpf(1.f + __expf(2.f * x)); }
DI float gelu_tanh(float x) { const float u = 0.7978845608028654f * (x + 0.044715f * x * x * x); return 0.5f * x * (1.f + tanhf_(u)); }

namespace pg8 {
constexpr int BM = 256, BK = 64, HALF = 128, HTB = HALF * BK * 2, NXCD = 8, WGM = 4;
DI int lds_byte(int r, int c) { const int st = (r >> 4) * 2 + (c >> 5), rr = r & 15, cc = c & 31, ob = rr * 64 + cc * 2; return st * 1024 + (ob ^ (((ob >> 9) & 1) << 5)); }
DI void stage_rc(int b, int& R, int& C) { const int st = b / 1024, sb = b % 1024, swz = sb ^ (((sb >> 9) & 1) << 5); R = (st >> 1) * 16 + swz / 64; C = (st & 1) * 32 + (swz % 64) / 2; }
DI int perm32(int rho) { const int n = rho >> 4, i = rho & 15; return 8 * (i >> 2) + 4 * n + (i & 3); }

struct Unit { int g, pm, pn; };
struct Gemm { const bf16_t* A; const bf16_t* Bt; long sA, sB; int lda, ldb, K, nM, nN, G; };

struct Order {
    int nM, nN, nwg, tot, Gd, c;
    DI void init(const Gemm& g, int Gd_, int c_) { nM = g.nM; nN = g.nN; nwg = nM * nN; tot = nwg * g.G; Gd = Gd_; c = c_; }
    DI bool next(int i, Unit& u) const {
        const long L = (long)i * Gd + c; if (L >= tot) return false;
        const int grp = (int)(L / nwg); int wgid = (int)(L - (long)grp * nwg);
        { const int q = nwg / NXCD, r = nwg % NXCD, xcd = wgid % NXCD, off = wgid / NXCD; wgid = (xcd < r ? xcd * (q + 1) : r * (q + 1) + (xcd - r) * q) + off; }
        const int nig = WGM * nN, gid = wgid / nig, fm = gid * WGM, gsz = (nM - fm) < WGM ? (nM - fm) : WGM;
        u.g = grp; u.pm = fm + ((wgid % nig) % gsz); u.pn = (wgid % nig) / gsz; return true;
    }
};

struct EpiAct {
    static constexpr bool PERM = true;
    bf16_t* C; long sC; int ldc; unsigned acts;
    DI void operator()(const f32x4 (&acc)[2][2][4][2], const Unit& u, int wr, int wc, int fr, int fq) const {
        bf16_t* base = C + (size_t)u.g * sC;
        const int act = (int)((acts >> (4 * u.g)) & 15u);
        const int row0 = u.pm * BM + wr * 64 + fr, col0 = u.pn * BM + wc * 32 + 8 * fq;
#pragma unroll
        for (int ai = 0; ai < 2; ++ai)
#pragma unroll
            for (int m = 0; m < 4; ++m) {
                bf16_t* rowp = base + (size_t)(row0 + ai * HALF + m * 16) * ldc + col0;
#pragma unroll
                for (int bj = 0; bj < 2; ++bj) {
                    float v[8];
#pragma unroll
                    for (int e = 0; e < 4; ++e) { v[e] = acc[ai][bj][m][0][e]; v[4 + e] = acc[ai][bj][m][1][e]; }
                    if (act == 1) {
#pragma unroll
                        for (int e = 0; e < 8; ++e) { const float t = fmaxf(v[e], 0.f); v[e] = t * t; }
                    } else if (act == 2) {
#pragma unroll
                        for (int e = 0; e < 8; ++e) v[e] = tanhf_(v[e]);
                    } else if (act == 3) {
#pragma unroll
                        for (int e = 0; e < 8; ++e) v[e] = sigmoidf_(v[e]);
                    }
                    u32x4 o = {pk_bf16(v[0], v[1]), pk_bf16(v[2], v[3]), pk_bf16(v[4], v[5]), pk_bf16(v[6], v[7])};
                    *(u32x4*)(rowp + bj * HALF) = o;
                }
            }
    }
};
struct EpiRes {
    static constexpr bool PERM = false;
    float* out; const float* res; const float* cscale; float alpha; long sC; int ldc;
    DI void operator()(const f32x4 (&acc)[2][2][4][2], const Unit& u, int wr, int wc, int fr, int fq) const {
        const int row0 = u.pm * BM + wr * 64 + fr, col0 = (int)(u.g * sC) + u.pn * BM + wc * 32 + 4 * fq;
        f32x4 r[2][2][2][2];
        auto ldq = [&](int q, int buf) {
            const int ai = q >> 1, m0 = (q & 1) * 2;
#pragma unroll
            for (int mm = 0; mm < 2; ++mm) {
                const size_t ro = (size_t)(row0 + ai * HALF + (m0 + mm) * 16) * ldc + col0;
#pragma unroll
                for (int bj = 0; bj < 2; ++bj)
#pragma unroll
                    for (int n = 0; n < 2; ++n) r[buf][mm][bj][n] = *(const f32x4*)(res + ro + bj * HALF + n * 16);
            }
        };
        auto stq = [&](int q, int buf) {
            const int ai = q >> 1, m0 = (q & 1) * 2;
#pragma unroll
            for (int mm = 0; mm < 2; ++mm) {
                const size_t ro = (size_t)(row0 + ai * HALF + (m0 + mm) * 16) * ldc + col0;
#pragma unroll
                for (int bj = 0; bj < 2; ++bj)
#pragma unroll
                    for (int n = 0; n < 2; ++n) {
                        f32x4 a = acc[ai][bj][m0 + mm][n];
                        if (cscale) a *= *(const f32x4*)(cscale + col0 + bj * HALF + n * 16);
                        *(f32x4*)(out + ro + bj * HALF + n * 16) = alpha * r[buf][mm][bj][n] + a;
                    }
            }
        };
        ldq(0, 0); ldq(1, 1);
        __builtin_amdgcn_sched_barrier(0);
        stq(0, 0); ldq(2, 0);
        __builtin_amdgcn_sched_barrier(0);
        stq(1, 1); ldq(3, 1);
        __builtin_amdgcn_sched_barrier(0);
        stq(2, 0); stq(3, 1);
    }
};
template <class Epi>
DI void gemm_phase(int tid_, int bid_, LAS unsigned char* lds, const Gemm g, const Epi& E) {
    const int tid = tid_, wid = __builtin_amdgcn_readfirstlane(tid >> 6), lane = tid & 63, wr = wid >> 2, wc = wid & 3, fr = lane & 15, fq = lane >> 4;
    const int K = g.K, nt = K / BK;
    Order S; S.init(g, (int)gridDim.x, (int)bid_);
    unsigned voffA[2], voffB[2];
#pragma unroll
    for (int i = 0; i < 2; ++i) { int R, C; stage_rc(tid * 16 + i * 8192, R, C); const int Rb = Epi::PERM ? ((R & ~31) + perm32(R & 31)) : R;
        voffA[i] = (unsigned)(R * g.lda + C) * 2u; voffB[i] = (unsigned)(Rb * g.ldb + C) * 2u; }
    const size_t kstep = (size_t)(BK * 2);
    const size_t hA = (size_t)HALF * g.lda * 2, hB = (size_t)HALF * g.ldb * 2;
    const unsigned ldsw = (unsigned)wid * 1024u;
    const int aoff = lds_byte(wr * 64 + fr, fq * 8), boff = lds_byte(wc * 32 + fr, fq * 8);
#define PG8_SA(b, h) (((b) * 2 + (h)) * HTB)
#define PG8_SB(b, h) ((4 + (b) * 2 + (h)) * HTB)
#define PG8_STAGE(bufoff, gbase, voff) do { _Pragma("unroll") for (int _i = 0; _i < 2; ++_i) \
        __builtin_amdgcn_global_load_lds((const unsigned*)((const char*)(gbase) + (voff)[_i]), (LAS unsigned*)(lds + (bufoff) + ldsw + _i * 8192), 16, 0, 0); } while (0)
#define PG8_LDA(dst, b, h) do { _Pragma("unroll") for (int m = 0; m < 4; ++m) _Pragma("unroll") for (int k = 0; k < 2; ++k) dst[m][k] = *(const LAS bf16x8*)(lds + PG8_SA(b, h) + aoff + m * 2048 + k * 1024); } while (0)
#define PG8_LDB(dst, b, h) do { _Pragma("unroll") for (int n = 0; n < 2; ++n) _Pragma("unroll") for (int k = 0; k < 2; ++k) dst[n][k] = *(const LAS bf16x8*)(lds + PG8_SB(b, h) + boff + n * 2048 + k * 1024); } while (0)
#define PG8_MMA(ai, bj, At, Bt) do { __builtin_amdgcn_s_setprio(1); _Pragma("unroll") for (int m = 0; m < 4; ++m) _Pragma("unroll") for (int n = 0; n < 2; ++n) _Pragma("unroll") for (int k = 0; k < 2; ++k) \
        acc[ai][bj][m][n] = __builtin_amdgcn_mfma_f32_16x16x32_bf16(Bt[n][k], At[m][k], acc[ai][bj][m][n], 0, 0, 0); __builtin_amdgcn_s_setprio(0); } while (0)
#define PG8_WAIT_V(n) asm volatile("s_waitcnt vmcnt(" #n ")" ::: "memory")
#define PG8_WAIT_L(n) asm volatile("s_waitcnt lgkmcnt(" #n ")" ::: "memory")
#define PG8_BAR __builtin_amdgcn_s_barrier()
#define PG8_SCHED __builtin_amdgcn_sched_barrier(0)
    Unit cur, nxt; int ui = 0;
    if (!S.next(0, cur)) return;
    f32x4 acc[2][2][4][2];
#pragma unroll
    for (int a = 0; a < 2; ++a)
#pragma unroll
        for (int b = 0; b < 2; ++b)
#pragma unroll
            for (int m = 0; m < 4; ++m)
#pragma unroll
                for (int n = 0; n < 2; ++n) acc[a][b][m][n] = (f32x4){0.f, 0.f, 0.f, 0.f};
    bf16x8 At[4][2], B0[2][2], B1[2][2];
    const char* cA = (const char*)g.A + ((size_t)cur.g * g.sA + (size_t)cur.pm * BM * g.lda) * 2;
    const char* cB = (const char*)g.Bt + ((size_t)cur.g * g.sB + (size_t)cur.pn * BM * g.ldb) * 2;
    PG8_STAGE(PG8_SB(0, 0), cB, voffB); PG8_STAGE(PG8_SA(0, 0), cA, voffA); PG8_STAGE(PG8_SB(0, 1), cB + hB, voffB); PG8_STAGE(PG8_SA(0, 1), cA + hA, voffA);
    if (wr == 1) PG8_BAR;
    PG8_WAIT_V(4); PG8_BAR;
    PG8_STAGE(PG8_SB(1, 0), cB + kstep, voffB); PG8_STAGE(PG8_SA(1, 0), cA + kstep, voffA); PG8_STAGE(PG8_SB(1, 1), cB + hB + kstep, voffB);
    PG8_WAIT_V(6); PG8_BAR;
    for (;;) {
        const bool has_next = S.next(ui + 1, nxt);
        const char* nA = has_next ? (const char*)g.A + ((size_t)nxt.g * g.sA + (size_t)nxt.pm * BM * g.lda) * 2 : cA;
        const char* nB = has_next ? (const char*)g.Bt + ((size_t)nxt.g * g.sB + (size_t)nxt.pn * BM * g.ldb) * 2 : cB;
        for (int t = 0; t < nt; t += 2) {
            const bool last = (t == nt - 2);
            const char* a1 = cA + (size_t)(t + 1) * kstep;
            const char* a2 = last ? nA : cA + (size_t)(t + 2) * kstep; const char* b2 = last ? nB : cB + (size_t)(t + 2) * kstep;
            const char* a3 = a2 + kstep; const char* b3 = b2 + kstep;
            PG8_LDB(B0, 0, 0); PG8_SCHED; PG8_LDA(At, 0, 0); PG8_STAGE(PG8_SA(1, 1), a1 + hA, voffA);
            PG8_WAIT_L(8); PG8_BAR; PG8_WAIT_L(0); PG8_MMA(0, 0, At, B0); PG8_BAR; PG8_SCHED;
            PG8_LDB(B1, 0, 1); PG8_STAGE(PG8_SB(0, 0), b2, voffB);
            PG8_BAR; PG8_WAIT_L(0); PG8_MMA(0, 1, At, B1); PG8_BAR;
            PG8_LDA(At, 0, 1); PG8_STAGE(PG8_SA(0, 0), a2, voffA);
            PG8_BAR; PG8_WAIT_L(0); PG8_MMA(1, 0, At, B0); PG8_BAR; PG8_SCHED;
            PG8_STAGE(PG8_SB(0, 1), b2 + hB, voffB);
            PG8_WAIT_V(6); PG8_BAR; PG8_MMA(1, 1, At, B1); PG8_BAR;
            PG8_LDB(B0, 1, 0); PG8_SCHED; PG8_LDA(At, 1, 0); PG8_STAGE(PG8_SA(0, 1), a2 + hA, voffA);
            PG8_WAIT_L(8); PG8_BAR; PG8_WAIT_L(0); PG8_MMA(0, 0, At, B0); PG8_BAR; PG8_SCHED;
            PG8_LDB(B1, 1, 1); PG8_STAGE(PG8_SB(1, 0), b3, voffB);
            PG8_BAR; PG8_WAIT_L(0); PG8_MMA(0, 1, At, B1); PG8_BAR;
            PG8_LDA(At, 1, 1); PG8_STAGE(PG8_SA(1, 0), a3, voffA);
            PG8_BAR; PG8_WAIT_L(0); PG8_MMA(1, 0, At, B0); PG8_BAR; PG8_SCHED;
            PG8_STAGE(PG8_SB(1, 1), b3 + hB, voffB);
            PG8_WAIT_V(6); PG8_BAR; PG8_MMA(1, 1, At, B1); PG8_BAR;
        }
        E(acc, cur, wr, wc, fr, fq);
        if (!has_next) break;
#pragma unroll
        for (int a = 0; a < 2; ++a)
#pragma unroll
            for (int b = 0; b < 2; ++b)
#pragma unroll
                for (int m = 0; m < 4; ++m)
#pragma unroll
                    for (int n = 0; n < 2; ++n) acc[a][b][m][n] = (f32x4){0.f, 0.f, 0.f, 0.f};
        cur = nxt; cA = nA; cB = nB; ++ui;
    }
    PG8_WAIT_V(0);
    if (wr == 0) PG8_BAR;
    PG8_BAR;
#undef PG8_SA
#undef PG8_SB
#undef PG8_STAGE
#undef PG8_LDA
#undef PG8_LDB
#undef PG8_MMA
#undef PG8_WAIT_V
#undef PG8_WAIT_L
#undef PG8_BAR
#undef PG8_SCHED
}
}

DI pg8::Gemm mk_gemm(const bf16_t* A, const bf16_t* Bt, long sA, long sB, int lda, int ldb, int K, int nM, int nN, int G) {
    pg8::Gemm g; g.A = A; g.Bt = Bt; g.sA = sA; g.sB = sB; g.lda = lda; g.ldb = ldb; g.K = K; g.nM = nM; g.nN = nN; g.G = G; return g;
}

DI void prep_phase(int tid_, int bid_, const Params& p, unsigned char* smem) {
    TJob* jobs = (TJob*)smem;
    float* tile = (float*)(smem + 4096);
    const int tid = tid_;
    if (tid < NTJ) jobs[tid] = p.tj[tid];
    __syncthreads();
    const int ntiles = p.ntiles;
    for (int tix = bid_; tix < ntiles; tix += gridDim.x) {
        int j = 0;
        for (int q = 1; q < NTJ; ++q) if (jobs[q].tile0 <= tix) j = q;
        const TJob jb = jobs[j];
        const int lt = tix - jb.tile0, ntk = jb.Kd / 128, k0 = (lt % ntk) * 128, n0 = (lt / ntk) * 128;
        f32x4 v[8];
#pragma unroll
        for (int i = 0; i < 8; ++i) {
            const int idx = tid + i * 512, kk = idx >> 5, n4 = idx & 31;
            const int k = k0 + kk, n = n0 + n4 * 4;
            v[i] = (k < jb.Ks && n < jb.Ns) ? *(const f32x4*)(jb.src + (size_t)k * jb.Ns + n) : (f32x4){0.f, 0.f, 0.f, 0.f};
        }
#pragma unroll
        for (int i = 0; i < 8; ++i) {
            const int idx = tid + i * 512, kk = idx >> 5, n4 = idx & 31;
#pragma unroll
            for (int e = 0; e < 4; ++e) tile[kk * 129 + n4 * 4 + e] = v[i][e];
        }
        __syncthreads();
#pragma unroll
        for (int i = 0; i < 4; ++i) {
            const int idx = tid + i * 512, n = idx >> 4, kc = idx & 15;
            float f[8];
#pragma unroll
            for (int e = 0; e < 8; ++e) f[e] = tile[(kc * 8 + e) * 129 + n];
            u32x4 o = {pk_bf16(f[0], f[1]), pk_bf16(f[2], f[3]), pk_bf16(f[4], f[5]), pk_bf16(f[6], f[7])};
            *(u32x4*)(jb.dst + (size_t)(n0 + n) * jb.Kd + k0 + kc * 8) = o;
        }
        __syncthreads();
    }
    {
        const float* x = p.in[0]; bf16_t* xb = (bf16_t*)(p.ws + O_SLOT + 8 * SLOT);
        const size_t n8 = (size_t)T * D / 8;
        for (size_t i = (size_t)bid_ * 512 + tid; i < n8; i += (size_t)gridDim.x * 512) {
            const f32x4 a = *(const f32x4*)(x + i * 8), b = *(const f32x4*)(x + i * 8 + 4);
            u32x4 o = {pk_bf16(a[0], a[1]), pk_bf16(a[2], a[3]), pk_bf16(b[0], b[1]), pk_bf16(b[2], b[3])};
            *(u32x4*)(xb + i * 8) = o;
        }
    }
    {
        float* ct = (float*)(p.ws + O_ROPE); float* st = ct + SEQ * 16;
        for (int i = bid_ * 512 + tid; i < SEQ * 16; i += gridDim.x * 512) {
            const int pos = i >> 4, f = i & 15;
            const float inv = powf(500000.0f, -(float)(2 * f) / 32.0f);
            const float ang = (float)pos * inv;
            ct[i] = cosf(ang); st[i] = sinf(ang);
        }
    }
}

DI void ln_phase(int tid_, int bid_, const float* zin, float* xout, bf16_t* xb, const float* gam, const float* bet) {
    const int lane = tid_ & 63, wid = tid_ >> 6;
    const int rstride = gridDim.x * 8;
    constexpr int NR = 4;
    for (int row0 = bid_ * 8 + wid; row0 < T; row0 += NR * rstride) {
        f32x4 v[NR][8];
#pragma unroll
        for (int r = 0; r < NR; ++r)
#pragma unroll
            for (int i = 0; i < 8; ++i)
                v[r][i] = (row0 + r * rstride < T) ? *(const f32x4*)(zin + (size_t)(row0 + r * rstride) * D + (i * 64 + lane) * 4) : (f32x4){0.f, 0.f, 0.f, 0.f};
#pragma unroll
        for (int r = 0; r < NR; ++r) {
            const int row = row0 + r * rstride;
            if (row >= T) break;
            float s = 0.f;
#pragma unroll
            for (int i = 0; i < 8; ++i) s += v[r][i][0] + v[r][i][1] + v[r][i][2] + v[r][i][3];
            const float mean = wave_sum(s) * (1.f / D);
            float q = 0.f;
#pragma unroll
            for (int i = 0; i < 8; ++i) { v[r][i] -= mean; q += v[r][i][0] * v[r][i][0] + v[r][i][1] * v[r][i][1] + v[r][i][2] * v[r][i][2] + v[r][i][3] * v[r][i][3]; }
            const float rstd = rsqrtf(wave_sum(q) * (1.f / D) + LN_EPS);
#pragma unroll
            for (int i = 0; i < 8; ++i) {
                const int c = (i * 64 + lane) * 4;
                const f32x4 g = *(const f32x4*)(gam + c), b = *(const f32x4*)(bet + c);
                const f32x4 o = v[r][i] * rstd * g + b;
                *(f32x4*)(xout + (size_t)row * D + c) = o;
                if (xb) { u32x2 w = {pk_bf16(o[0], o[1]), pk_bf16(o[2], o[3])}; *(u32x2*)(xb + (size_t)row * D + c) = w; }
            }
        }
    }
}

DI void rg_conv_phase(int tid_, int bid_, const bf16_t* gu, bf16_t* uc, const float* cw, const float* cb) {
    const size_t n8 = (size_t)T * D / 8;
    const size_t stride = (size_t)gridDim.x * 512;
    constexpr int U = 4;
    for (size_t ib = (size_t)bid_ * 512 + tid_; ib < n8; ib += stride * U) {
        u32x4 uu[U][4];
#pragma unroll
        for (int u = 0; u < U; ++u) {
            const size_t i = ib + u * stride;
            const int t = (int)(i >> 8), c = (int)(i & 255) * 8, s = t & (SEQ - 1);
#pragma unroll
            for (int j = 0; j < 4; ++j)
                uu[u][j] = (i < n8 && s - 3 + j >= 0) ? *(const u32x4*)(gu + (size_t)(t - 3 + j) * 4096 + 2048 + c) : (u32x4){0u, 0u, 0u, 0u};
        }
#pragma unroll
        for (int u = 0; u < U; ++u) {
            const size_t i = ib + u * stride;
            if (i >= n8) break;
            const int c = (int)(i & 255) * 8;
            float a[8];
            { const f32x4 b0 = *(const f32x4*)(cb + c), b1 = *(const f32x4*)(cb + c + 4);
#pragma unroll
              for (int e = 0; e < 4; ++e) { a[e] = b0[e]; a[4 + e] = b1[e]; } }
#pragma unroll
            for (int j = 0; j < 4; ++j) {
                const u32x4 q = uu[u][j];
                const f32x4 w0 = *(const f32x4*)(cw + j * D + c), w1 = *(const f32x4*)(cw + j * D + c + 4);
                a[0] += w0[0] * bflo(q[0]); a[1] += w0[1] * bfhi(q[0]); a[2] += w0[2] * bflo(q[1]); a[3] += w0[3] * bfhi(q[1]);
                a[4] += w1[0] * bflo(q[2]); a[5] += w1[1] * bfhi(q[2]); a[6] += w1[2] * bflo(q[3]); a[7] += w1[3] * bfhi(q[3]);
            }
            u32x4 o = {pk_bf16(a[0], a[1]), pk_bf16(a[2], a[3]), pk_bf16(a[4], a[5]), pk_bf16(a[6], a[7])};
            *(u32x4*)(uc + i * 8) = o;
        }
    }
}
DI void rg_ab(float rpre, float ipre, float u, float ba, float bx, float sp8, float& a, float& b) {
    const float r = sigmoidf_(rpre + ba), ii = sigmoidf_(ipre + bx);
    const float la = -sp8 * r;
    a = __expf(la);
    const float x2 = 2.f * la;
    const float om = (x2 > -0.05f) ? -x2 * (1.f + x2 * (0.5f + x2 * (0.16666667f + x2 * 0.041666668f))) : 1.f - a * a;
    b = u * ii * __builtin_amdgcn_sqrtf(om);
}
template <int MODE>
DI void rg_scan_phase(int tid_, int bid_, const Params& p, const bf16_t* gates, const bf16_t* uc, const bf16_t* gu, float* agg, bf16_t* outg) {
    constexpr int CH = 32;
    const float* gab = p.in[9]; const float* gxb = p.in[11]; const float* lam = p.in[12];
    for (int item = bid_; item < 4 * 128 * 2; item += gridDim.x) {
        const int cg2 = item & 1, chunk = (item >> 1) & 127, b = item >> 8;
        const int ch = cg2 * 1024 + tid_ * 2;
        const int n = ch >> 8, v = ch & 255;
        const f32x2 ba = *(const f32x2*)(gab + ch), bx = *(const f32x2*)(gxb + ch), lm = *(const f32x2*)(lam + ch);
        const float sp0 = 8.f * log1pf(expf(-lm[0])), sp1 = 8.f * log1pf(expf(-lm[1]));
        float h0 = 0.f, h1 = 0.f, P0 = 1.f, P1 = 1.f;
        if (MODE == 1) {
            for (int c0 = 0; c0 < chunk; c0 += 16) {
                f32x4 gv[16];
#pragma unroll
                for (int j = 0; j < 16; ++j) gv[j] = (c0 + j < chunk) ? *(const f32x4*)(agg + (((size_t)b * 128 + c0 + j) * D + ch) * 2) : (f32x4){1.f, 0.f, 1.f, 0.f};
#pragma unroll
                for (int j = 0; j < 16; ++j) { h0 = gv[j][0] * h0 + gv[j][1]; h1 = gv[j][2] * h1 + gv[j][3]; }
            }
        }
        const size_t t0 = (size_t)b * SEQ + (size_t)chunk * CH;
        constexpr int UB = 32;
        for (int tb = 0; tb < CH; tb += UB) {
            unsigned rpv[UB], ipv[UB], uuv[UB], ggv[UB];
#pragma unroll
            for (int j = 0; j < UB; ++j) {
                const size_t t = t0 + tb + j;
                rpv[j] = *(const unsigned*)(gates + t * 4096 + n * 512 + v);
                ipv[j] = *(const unsigned*)(gates + t * 4096 + n * 512 + 256 + v);
                uuv[j] = *(const unsigned*)(uc + t * D + ch);
                if (MODE == 1) ggv[j] = *(const unsigned*)(gu + t * 4096 + ch);
            }
#pragma unroll
            for (int j = 0; j < UB; ++j) {
                const size_t t = t0 + tb + j;
                float a0, b0, a1, b1;
                rg_ab(bflo(rpv[j]), bflo(ipv[j]), bflo(uuv[j]), ba[0], bx[0], sp0, a0, b0);
                rg_ab(bfhi(rpv[j]), bfhi(ipv[j]), bfhi(uuv[j]), ba[1], bx[1], sp1, a1, b1);
                h0 = a0 * h0 + b0; h1 = a1 * h1 + b1;
                if (MODE == 0) { P0 *= a0; P1 *= a1; }
                else *(unsigned*)(outg + t * D + ch) = pk_bf16(gelu_tanh(bflo(ggv[j])) * h0, gelu_tanh(bfhi(ggv[j])) * h1);
            }
        }
        if (MODE == 0) { f32x4 o = {P0, h0, P1, h1}; *(f32x4*)(agg + (((size_t)b * 128 + chunk) * D + ch) * 2) = o; }
    }
}

DI void kmean_phase(int tid_, int bid_, bf16_t* Qx, bf16_t* Kx, float* kmean, const float* ctab, const float* stab, unsigned char* smem) {
    float* redA = (float*)smem;
    float* redB = redA + 1024;
    const int tid = tid_;
    for (int item = bid_; item < 1024; item += gridDim.x) {
        const int blk = item & 15, h = (item >> 4) & 15, b = item >> 8;
        {
            const int i = tid & 15, rg = tid >> 4;
            float s1 = 0.f, s2 = 0.f;
            bf16_t k1v[8], k2v[8], q1v[8], q2v[8]; float cv[8], sv[8];
#pragma unroll
            for (int r = 0; r < 8; ++r) {
                const int pos = blk * 256 + rg * 8 + r;
                const size_t o = ((size_t)b * SEQ + pos) * D + h * 128 + i;
                cv[r] = ctab[pos * 16 + i]; sv[r] = stab[pos * 16 + i];
                k1v[r] = Kx[o]; k2v[r] = Kx[o + 16]; q1v[r] = Qx[o]; q2v[r] = Qx[o + 16];
            }
#pragma unroll
            for (int r = 0; r < 8; ++r) {
                const int pos = blk * 256 + rg * 8 + r;
                const size_t o = ((size_t)b * SEQ + pos) * D + h * 128 + i;
                const float c = cv[r], sn = sv[r];
                const float k1 = bf2f(k1v[r]), k2 = bf2f(k2v[r]);
                const bf16_t k1r = f2bf(k1 * c - k2 * sn), k2r = f2bf(k2 * c + k1 * sn);
                Kx[o] = k1r; Kx[o + 16] = k2r; s1 += bf2f(k1r); s2 += bf2f(k2r);
                const float q1 = bf2f(q1v[r]), q2 = bf2f(q2v[r]);
                Qx[o] = f2bf(q1 * c - q2 * sn); Qx[o + 16] = f2bf(q2 * c + q1 * sn);
            }
            redA[rg * 32 + i] = s1; redA[rg * 32 + 16 + i] = s2;
        }
        {
            const int dp = tid & 63, rg = tid >> 6;
            if (dp >= 16) {
                const bf16_t* base = Kx + ((size_t)b * SEQ + blk * 256 + rg * 32) * D + h * 128 + dp * 2;
                float s0 = 0.f, s1 = 0.f;
                unsigned uv[32];
#pragma unroll
                for (int r = 0; r < 32; ++r) uv[r] = *(const unsigned*)(base + (size_t)r * D);
#pragma unroll
                for (int r = 0; r < 32; ++r) { s0 += bflo(uv[r]); s1 += bfhi(uv[r]); }
                redB[rg * 128 + dp * 2] = s0; redB[rg * 128 + dp * 2 + 1] = s1;
            }
        }
        __syncthreads();
        if (tid < 128) {
            float s = 0.f;
            if (tid < 32) { for (int r = 0; r < 32; ++r) s += redA[r * 32 + tid]; }
            else { for (int r = 0; r < 8; ++r) s += redB[r * 128 + tid]; }
            kmean[(size_t)item * 128 + tid] = s * (1.f / 256.f);
        }
        __syncthreads();
    }
}

DI void attn_phase(int tid_, int bid_, const bf16_t* Q, const bf16_t* Kx, const bf16_t* VT, bf16_t* O, const float* kmean, unsigned char* smem) {
    constexpr int KB_STRIDE = 288, VB_STRIDE = 144;
    constexpr int KBUF = 64 * KB_STRIDE, VBUF = 128 * VB_STRIDE;
    constexpr float QC = 0.08838834764831845f * 1.4426950408889634f;
#define KBUFP(bi) (smem + (bi) * KBUF)
#define VBUFP(bi) (smem + 2 * KBUF + (bi) * VBUF)
    float* km = (float*)(smem + 2 * KBUF + 2 * VBUF);
    const int tid = tid_, wid = tid >> 6, lane = tid & 63, fr = lane & 15, fq = lane >> 4;
    for (int idx = bid_; idx < 2048; idx += gridDim.x) {
        const int bh = idx & 63, jj = idx >> 6, sub = jj & 3, rnd = jj >> 2;
        const int r2 = rnd >> 1, half = rnd & 1;
        const int qb = (r2 == 0) ? sub : (r2 == 1) ? (7 - sub) : (r2 == 2) ? (8 + sub) : (15 - sub);
        const int b = bh >> 4, h = bh & 15;
        const size_t tok0 = (size_t)b * SEQ;
        const int qloc = half * 128 + wid * 16 + fr;
        { const f32x4 kv = *(const f32x4*)(kmean + (size_t)bh * 2048 + tid * 4); *(f32x4*)(km + tid * 4) = kv; }
        bf16x8 qf[4];
#pragma unroll
        for (int dc = 0; dc < 4; ++dc) qf[dc] = *(const bf16x8*)(Q + (tok0 + qb * 256 + qloc) * D + h * 128 + dc * 32 + fq * 8);
        __syncthreads();
        const int ntile = qb * 4 + (half ? 4 : 2);
        const int kr0 = tid >> 4, kc0 = tid & 15;
        const int vr0 = tid >> 3, vc0 = tid & 7;
        u32x4 kreg0[2], vreg0[2], kreg1[2], vreg1[2];
        auto gload = [&](int tt, u32x4 (&kreg)[2], u32x4 (&vreg)[2]) {
            const int key0 = tt * 64;
#pragma unroll
            for (int i = 0; i < 2; ++i) {
                kreg[i] = *(const u32x4*)(Kx + (tok0 + key0 + kr0 + i * 32) * D + h * 128 + kc0 * 8);
                vreg[i] = *(const u32x4*)(VT + (size_t)(h * 128 + vr0 + i * 64) * T + tok0 + key0 + vc0 * 8);
            }
        };
        auto lstore = [&](int bi, const u32x4 (&kreg)[2], const u32x4 (&vreg)[2]) {
#pragma unroll
            for (int i = 0; i < 2; ++i) {
                *(u32x4*)(KBUFP(bi) + (kr0 + i * 32) * KB_STRIDE + kc0 * 16) = kreg[i];
                *(u32x4*)(VBUFP(bi) + (vr0 + i * 64) * VB_STRIDE + vc0 * 16) = vreg[i];
            }
        };
        gload(0, kreg0, vreg0);
        if (1 < ntile) gload(1, kreg1, vreg1);
        unsigned mask = 0u;
        {
            float v0 = -3e38f, v1 = -3e38f, v2 = -3e38f; int i0 = -1, i1 = -1, i2 = -1;
            for (int j = 0; j < qb; ++j) {
                float g = 0.f;
#pragma unroll
                for (int dc = 0; dc < 4; ++dc) {
                    const f32x4 ka = *(const f32x4*)(km + j * 128 + dc * 32 + fq * 8), kb2 = *(const f32x4*)(km + j * 128 + dc * 32 + fq * 8 + 4);
#pragma unroll
                    for (int e = 0; e < 4; ++e) { g += bf2f((bf16_t)qf[dc][e]) * ka[e]; g += bf2f((bf16_t)qf[dc][4 + e]) * kb2[e]; }
                }
                g += __shfl_xor(g, 16); g += __shfl_xor(g, 32);
                if (g > v0) { v2 = v1; i2 = i1; v1 = v0; i1 = i0; v0 = g; i0 = j; }
                else if (g > v1) { v2 = v1; i2 = i1; v1 = g; i1 = j; }
                else if (g > v2) { v2 = g; i2 = j; }
            }
            if (i0 >= 0) mask |= 1u << i0;
            if (i1 >= 0) mask |= 1u << i1;
            if (i2 >= 0) mask |= 1u << i2;
        }
        float mrun = -1e30f, lrun = 0.f;
        f32x4 oacc[8];
#pragma unroll
        for (int dt = 0; dt < 8; ++dt) oacc[dt] = (f32x4){0.f, 0.f, 0.f, 0.f};
        auto compute = [&](int tt, int bi) {
            const int kb = tt >> 2, kt64 = tt & 3;
            const bool own = (kb == qb);
            const bool actq = own ? true : (((mask >> kb) & 1u) != 0u);
            const bool doit = own ? (kt64 * 64 <= half * 128 + wid * 16 + 15) : (__any((int)actq) != 0);
            if (doit) {
                f32x4 sacc[4];
#pragma unroll
                for (int kt = 0; kt < 4; ++kt) sacc[kt] = (f32x4){0.f, 0.f, 0.f, 0.f};
#pragma unroll
                for (int dc = 0; dc < 4; ++dc)
#pragma unroll
                    for (int kt = 0; kt < 4; ++kt) {
                        const bf16x8 kf = *(const bf16x8*)(KBUFP(bi) + (kt * 16 + fr) * KB_STRIDE + dc * 64 + fq * 16);
                        sacc[kt] = __builtin_amdgcn_mfma_f32_16x16x32_bf16(kf, qf[dc], sacc[kt], 0, 0, 0);
                    }
                const int lim = own ? (qloc - kt64 * 64 - fq * 4) : (actq ? 1000 : -1000);
                float mx = -1e30f;
#pragma unroll
                for (int kt = 0; kt < 4; ++kt)
#pragma unroll
                    for (int r = 0; r < 4; ++r) {
                        const float sv = (kt * 16 + r <= lim) ? sacc[kt][r] : -__builtin_inff();
                        sacc[kt][r] = sv; mx = fmaxf(mx, sv);
                    }
                mx = fmaxf(mx, __shfl_xor(mx, 16)); mx = fmaxf(mx, __shfl_xor(mx, 32));
                const float mnew = fmaxf(mrun, mx);
                const float alpha = __builtin_amdgcn_exp2f((mrun - mnew) * QC);
                mrun = mnew;
                const float mneg = -mnew * QC;
                float ps = 0.f;
#pragma unroll
                for (int kt = 0; kt < 4; ++kt)
#pragma unroll
                    for (int r = 0; r < 4; ++r) { const float pe = __builtin_amdgcn_exp2f(__builtin_fmaf(sacc[kt][r], QC, mneg)); sacc[kt][r] = pe; ps += pe; }
                lrun = lrun * alpha + ps;
                if (__any((int)(alpha != 1.f))) {
#pragma unroll
                    for (int dt = 0; dt < 8; ++dt) oacc[dt] *= alpha;
                }
                bf16x8 pf[2];
#pragma unroll
                for (int ks = 0; ks < 2; ++ks) {
                    u32x4 w = {pk_bf16(sacc[2 * ks][0], sacc[2 * ks][1]), pk_bf16(sacc[2 * ks][2], sacc[2 * ks][3]),
                               pk_bf16(sacc[2 * ks + 1][0], sacc[2 * ks + 1][1]), pk_bf16(sacc[2 * ks + 1][2], sacc[2 * ks + 1][3])};
                    pf[ks] = __builtin_bit_cast(bf16x8, w);
                }
#pragma unroll
                for (int ks = 0; ks < 2; ++ks)
#pragma unroll
                    for (int dt = 0; dt < 8; ++dt) {
                        const u32x2 va = *(const u32x2*)(VBUFP(bi) + (dt * 16 + fr) * VB_STRIDE + ks * 64 + fq * 8);
                        const u32x2 vb2 = *(const u32x2*)(VBUFP(bi) + (dt * 16 + fr) * VB_STRIDE + ks * 64 + 32 + fq * 8);
                        u32x4 w = {va[0], va[1], vb2[0], vb2[1]};
                        oacc[dt] = __builtin_amdgcn_mfma_f32_16x16x32_bf16(__builtin_bit_cast(bf16x8, w), pf[ks], oacc[dt], 0, 0, 0);
                    }
            }
        };
        lstore(0, kreg0, vreg0);
        __syncthreads();
        for (int tt = 0; tt < ntile; tt += 2) {
            if (tt + 2 < ntile) gload(tt + 2, kreg0, vreg0);
            compute(tt, 0);
            if (tt + 1 < ntile) lstore(1, kreg1, vreg1);
            lds_barrier();
            if (tt + 1 < ntile) {
                if (tt + 3 < ntile) gload(tt + 3, kreg1, vreg1);
                compute(tt + 1, 1);
                if (tt + 2 < ntile) lstore(0, kreg0, vreg0);
                lds_barrier();
            }
        }
        __syncthreads();
        {
            float lt = lrun; lt += __shfl_xor(lt, 16); lt += __shfl_xor(lt, 32);
            const float inv = 1.f / lt;
            bf16_t* orow = O + (tok0 + qb * 256 + qloc) * D + h * 128 + fq * 4;
#pragma unroll
            for (int dt = 0; dt < 8; ++dt) {
                const f32x4 o = oacc[dt] * inv;
                u32x2 w = {pk_bf16(o[0], o[1]), pk_bf16(o[2], o[3])};
                *(u32x2*)(orow + dt * 16) = w;
            }
        }
    }
#undef KBUFP
#undef VBUFP
}

DI void rwkv_mix_phase(int tid_, int bid_, const float* x, const float* mu, bf16_t* slots) {
    const size_t n4 = (size_t)T * D / 4;
    const size_t stride = (size_t)gridDim.x * 512;
    constexpr int U = 8;
    for (size_t ib = (size_t)bid_ * 512 + tid_; ib < n4; ib += stride * U) {
        f32x4 xv[U], xp[U];
#pragma unroll
        for (int u = 0; u < U; ++u) {
            const size_t i = ib + u * stride;
            const int t = (int)(i >> 9), s_ = t & (SEQ - 1);
            xv[u] = (i < n4) ? *(const f32x4*)(x + i * 4) : (f32x4){0.f, 0.f, 0.f, 0.f};
            xp[u] = (i < n4 && s_ > 0) ? *(const f32x4*)(x + i * 4 - D) : (f32x4){0.f, 0.f, 0.f, 0.f};
        }
#pragma unroll
        for (int u = 0; u < U; ++u) {
            const size_t i = ib + u * stride;
            if (i >= n4) break;
            const int c = (int)(i & 511) * 4;
            const f32x4 xx = xp[u] - xv[u];
#pragma unroll
            for (int k = 0; k < 6; ++k) {
                const f32x4 m = *(const f32x4*)(mu + k * D + c);
                const f32x4 o = xv[u] + xx * m;
                u32x2 w = {pk_bf16(o[0], o[1]), pk_bf16(o[2], o[3])};
                *(u32x2*)((unsigned char*)slots + k * SLOT + i * 8) = w;
            }
        }
    }
}
DI float softplusf_(float y) { return fmaxf(y, 0.f) + __logf(1.f + __expf(-fabsf(y))); }
DI void rwkv_prep_phase(int tid_, int bid_, const Params& p, unsigned char* sl, float* scal) {
    bf16_t* R = (bf16_t*)(sl + 6 * SLOT); bf16_t* Kk = (bf16_t*)(sl + 7 * SLOT);
    const bf16_t* WP = (const bf16_t*)(sl + 0 * SLOT); bf16_t* AP = (bf16_t*)(sl + 1 * SLOT);
    bf16_t* KX = (bf16_t*)(sl + 3 * SLOT); float* WD = (float*)(sl + 4 * SLOT);
    const float* w0 = p.in[18]; const float* a0 = p.in[21]; const float* k_k = p.in[26]; const float* k_a = p.in[27]; const float* r_k = p.in[28];
    float* BR = scal; float* KR = scal + (size_t)T * 32; float* BO = scal + (size_t)2 * T * 32;
    const int lane = tid_ & 63, wid = tid_ >> 6;
    constexpr int U = 16;
    for (int grp = bid_ * 8 + wid; grp < T * 32 / U; grp += gridDim.x * 8) {
        const int item0 = grp * U;
        const int h0 = item0 & 31; const size_t t = (size_t)(item0 >> 5);
        const size_t o0 = t * D + h0 * 64 + lane;
        bf16_t rr[U], kr_[U], wpr[U], apr[U];
#pragma unroll
        for (int u = 0; u < U; ++u) { rr[u] = R[o0 + u * 64]; kr_[u] = Kk[o0 + u * 64]; wpr[u] = WP[o0 + u * 64]; apr[u] = AP[o0 + u * 64]; }
#pragma unroll
        for (int u = 0; u < U; ++u) {
            const int c = (h0 + u) * 64 + lane; const size_t o = o0 + u * 64;
            const float r = bf2f(rr[u]), k = bf2f(kr_[u]), wp = bf2f(wpr[u]), ap = bf2f(apr[u]);
            const float wlog = -softplusf_(-(w0[c] + wp)) - 0.5f;
            const float dec = __expf(-__expf(wlog));
            const float a = __builtin_amdgcn_rcpf(1.f + __expf(-(a0[c] + ap)));
            float kk = k * k_k[c];
            kk = kk * fminf(__builtin_amdgcn_rsqf(wave_sum(kk * kk)), 1e12f);
            const float kx = k * (1.f + (a - 1.f) * k_a[c]);
            const float bb = kk * a;
            const float br = wave_sum(bb * r), kr = wave_sum(kx * r), bo = wave_sum(r * kx * r_k[c]);
            R[o] = f2bf(dec * r); Kk[o] = f2bf(-kk); AP[o] = f2bf(bb); KX[o] = f2bf(kx); WD[o] = dec;
            if (lane == 0) { BR[item0 + u] = br; KR[item0 + u] = kr; BO[item0 + u] = bo; }
        }
    }
}
DI float dpp_sum8(float v) {
    v += __int_as_float(__builtin_amdgcn_update_dpp(0, __float_as_int(v), 0xB1, 0xF, 0xF, false));
    v += __int_as_float(__builtin_amdgcn_update_dpp(0, __float_as_int(v), 0x4E, 0xF, 0xF, false));
    v += __int_as_float(__builtin_amdgcn_update_dpp(0, __float_as_int(v), 0x141, 0xF, 0xF, false));
    return v;
}
DI void rwkv_scan_phase(int tid_, int bid_, unsigned char* sl, const float* scal, unsigned char* smem) {
    constexpr int TC = 32;
    constexpr int OFF_BB = TC * 128, OFF_KX = OFF_BB + TC * 64, OFF_W = OFF_KX + TC * 64, OFF_V = OFF_W + TC * 64, OFF_SC = OFF_V + TC * 32, BUF_F = OFF_SC + TC * 2;
    constexpr int NCH = SEQ / TC;
#define SBUF(i) ((float*)smem + (i) * BUF_F)
    const bf16_t* NKK = (const bf16_t*)(sl + 7 * SLOT); const bf16_t* WR = (const bf16_t*)(sl + 6 * SLOT);
    const bf16_t* BB = (const bf16_t*)(sl + 1 * SLOT); const bf16_t* KX = (const bf16_t*)(sl + 3 * SLOT);
    const float* WD = (const float*)(sl + 4 * SLOT); const bf16_t* V = (const bf16_t*)(sl + 8 * SLOT);
    bf16_t* Y = (bf16_t*)(sl + 0 * SLOT);
    const float* BR = scal; const float* KR = scal + (size_t)T * 32;
    const int tid = tid_, wid = tid >> 6, lane = tid & 63;
    for (int item = bid_; item < 256; item += gridDim.x) {
        const int half = item & 1, h = (item >> 1) & 31, b = item >> 6;
        const size_t tok0 = (size_t)b * SEQ;
        if (wid >= 4) {
            const int lt = tid - 256, lt_t = lt >> 3, lt_c = lt & 7;
            u32x4 r_nk, r_wr, r_bb, r_kx, r_v = {0u, 0u, 0u, 0u}; f32x4 r_w0, r_w1; float r_s = 0.f;
            auto gload = [&](int c) {
                const size_t tb = tok0 + (size_t)c * TC;
                const size_t o = (tb + lt_t) * D + h * 64 + lt_c * 8;
                r_nk = *(const u32x4*)(NKK + o); r_wr = *(const u32x4*)(WR + o); r_bb = *(const u32x4*)(BB + o); r_kx = *(const u32x4*)(KX + o);
                r_w0 = *(const f32x4*)(WD + (tb + (lt >> 4)) * D + h * 64 + (lt & 15) * 4);
                r_w1 = *(const f32x4*)(WD + (tb + 16 + (lt >> 4)) * D + h * 64 + (lt & 15) * 4);
                if (lt < 128) r_v = *(const u32x4*)(V + (tb + (lt >> 2)) * D + h * 64 + half * 32 + (lt & 3) * 8);
                else if (lt < 192) { const int i = lt - 128; r_s = ((i & 1) ? KR : BR)[(tb + (i >> 1)) * 32 + h]; }
            };
            auto lstore = [&](float* F) {
                float* pp = F + lt_t * 128 + lt_c * 16;
#pragma unroll
                for (int j = 0; j < 4; ++j) { f32x4 q = {bflo(r_nk[j]), bflo(r_wr[j]), bfhi(r_nk[j]), bfhi(r_wr[j])}; *(f32x4*)(pp + j * 4) = q; }
                { float* d = F + OFF_BB + lt_t * 64 + lt_c * 8;
                  f32x4 lo = {bflo(r_bb[0]), bfhi(r_bb[0]), bflo(r_bb[1]), bfhi(r_bb[1])}, hi = {bflo(r_bb[2]), bfhi(r_bb[2]), bflo(r_bb[3]), bfhi(r_bb[3])};
                  *(f32x4*)d = lo; *(f32x4*)(d + 4) = hi; }
                { float* d = F + OFF_KX + lt_t * 64 + lt_c * 8;
                  f32x4 lo = {bflo(r_kx[0]), bfhi(r_kx[0]), bflo(r_kx[1]), bfhi(r_kx[1])}, hi = {bflo(r_kx[2]), bfhi(r_kx[2]), bflo(r_kx[3]), bfhi(r_kx[3])};
                  *(f32x4*)d = lo; *(f32x4*)(d + 4) = hi; }
                *(f32x4*)(F + OFF_W + (lt >> 4) * 64 + (lt & 15) * 4) = r_w0;
                *(f32x4*)(F + OFF_W + (16 + (lt >> 4)) * 64 + (lt & 15) * 4) = r_w1;
                if (lt < 128) { float* d = F + OFF_V + (lt >> 2) * 32 + (lt & 3) * 8;
                  f32x4 lo = {bflo(r_v[0]), bfhi(r_v[0]), bflo(r_v[1]), bfhi(r_v[1])}, hi = {bflo(r_v[2]), bfhi(r_v[2]), bflo(r_v[3]), bfhi(r_v[3])};
                  *(f32x4*)d = lo; *(f32x4*)(d + 4) = hi; }
                else if (lt < 192) F[OFF_SC + (lt - 128)] = r_s;
            };
            gload(0); lstore(SBUF(0)); gload(1);
            __syncthreads();
            for (int c = 0; c < NCH; ++c) {
                if (c + 1 < NCH) lstore(SBUF((c + 1) & 1));
                if (c + 2 < NCH) gload(c + 2);
                lds_barrier();
            }
        } else {
            const int kq = lane & 7, rl = wid * 8 + (lane >> 3);
            f32x2 st[4];
#pragma unroll
            for (int j = 0; j < 4; ++j) st[j] = (f32x2){0.f, 0.f};
            bf16_t* yp = Y + (tok0 + kq) * D + h * 64 + half * 32 + rl;
            __syncthreads();
            struct Ops { f32x4 pq[4], b0, b1, k0, k1, w0, w1; float vv; f32x2 sc; };
            for (int c = 0; c < NCH; ++c) {
                const float* F = SBUF(c & 1);
                const float* fp = F + kq * 16;
                const float* fb = F + OFF_BB + kq * 8;
                auto ld = [&](Ops& o, int t) {
#pragma unroll
                    for (int j = 0; j < 4; ++j) o.pq[j] = *(const f32x4*)(fp + t * 128 + j * 4);
                    o.b0 = *(const f32x4*)(fb + t * 64); o.b1 = *(const f32x4*)(fb + t * 64 + 4);
                    o.k0 = *(const f32x4*)(fb + (OFF_KX - OFF_BB) + t * 64); o.k1 = *(const f32x4*)(fb + (OFF_KX - OFF_BB) + t * 64 + 4);
                    o.w0 = *(const f32x4*)(fb + (OFF_W - OFF_BB) + t * 64); o.w1 = *(const f32x4*)(fb + (OFF_W - OFF_BB) + t * 64 + 4);
                    o.vv = F[OFF_V + t * 32 + rl]; o.sc = *(const f32x2*)(F + OFF_SC + t * 2);
                };
                auto dots = [&](const Ops& o) -> f32x2 {
                    f32x2 acc = {0.f, 0.f}, acc2 = {0.f, 0.f};
#pragma unroll
                    for (int j = 0; j < 4; ++j) {
                        acc += st[j][0] * (f32x2){o.pq[j][0], o.pq[j][1]};
                        acc2 += st[j][1] * (f32x2){o.pq[j][2], o.pq[j][3]};
                    }
                    return acc + acc2;
                };
                auto update = [&](const Ops& o, f32x2 acc) -> float {
                    const float d1 = dpp_sum8(acc[0]), d2 = dpp_sum8(acc[1]);
                    st[0] = st[0] * (f32x2){o.w0[0], o.w0[1]} + d1 * (f32x2){o.b0[0], o.b0[1]} + o.vv * (f32x2){o.k0[0], o.k0[1]};
                    st[1] = st[1] * (f32x2){o.w0[2], o.w0[3]} + d1 * (f32x2){o.b0[2], o.b0[3]} + o.vv * (f32x2){o.k0[2], o.k0[3]};
                    st[2] = st[2] * (f32x2){o.w1[0], o.w1[1]} + d1 * (f32x2){o.b1[0], o.b1[1]} + o.vv * (f32x2){o.k1[0], o.k1[1]};
                    st[3] = st[3] * (f32x2){o.w1[2], o.w1[3]} + d1 * (f32x2){o.b1[2], o.b1[3]} + o.vv * (f32x2){o.k1[2], o.k1[3]};
                    return d2 + d1 * o.sc[0] + o.vv * o.sc[1];
                };
                Ops os[3];
                ld(os[0], 0); ld(os[1], 1);
                float yv = 0.f;
#pragma unroll
                for (int t = 0; t < TC; ++t) {
                    const f32x2 da = dots(os[t % 3]);
                    __builtin_amdgcn_sched_barrier(0);
                    if (t + 2 < TC) ld(os[(t + 2) % 3], t + 2);
                    __builtin_amdgcn_sched_barrier(0);
                    const float ya = update(os[t % 3], da);
                    yv = (kq == (t & 7)) ? ya : yv;
                    if ((t & 7) == 7) yp[(size_t)(c * TC + (t & ~7)) * D] = f2bf(yv);
                }
                lds_barrier();
            }
        }
        __syncthreads();
    }
#undef SBUF
}
DI void rwkv_post_phase(int tid_, int bid_, const Params& p, unsigned char* sl, const float* scal) {
    const bf16_t* Y = (const bf16_t*)(sl + 0 * SLOT); const bf16_t* V = (const bf16_t*)(sl + 8 * SLOT); const bf16_t* G = (const bf16_t*)(sl + 2 * SLOT);
    bf16_t* OUT = (bf16_t*)(sl + 3 * SLOT);
    const float* lg = p.in[29]; const float* lb = p.in[30]; const float* BO = scal + (size_t)2 * T * 32;
    const int lane = tid_ & 63, wid = tid_ >> 6;
    constexpr int U = 16;
    for (int grp = bid_ * 8 + wid; grp < T * 32 / U; grp += gridDim.x * 8) {
        const int item0 = grp * U;
        const int h0 = item0 & 31; const size_t t = (size_t)(item0 >> 5);
        const size_t o0 = t * D + h0 * 64 + lane;
        bf16_t yr[U], vr[U], gr[U]; float bor[U];
#pragma unroll
        for (int u = 0; u < U; ++u) { yr[u] = Y[o0 + u * 64]; vr[u] = V[o0 + u * 64]; gr[u] = G[o0 + u * 64]; bor[u] = BO[item0 + u]; }
#pragma unroll
        for (int u = 0; u < U; ++u) {
            const int c = (h0 + u) * 64 + lane;
            const float y = bf2f(yr[u]);
            const float mean = wave_sum(y) * (1.f / 64.f);
            const float dlt = y - mean;
            const float var = wave_sum(dlt * dlt) * (1.f / 64.f);
            float r = dlt * rsqrtf(var + 64e-5f) * lg[c] + lb[c];
            r += bor[u] * bf2f(vr[u]);
            OUT[o0 + u * 64] = f2bf(r * bf2f(gr[u]));
        }
    }
}

DI void pool_phase(int tid_, int bid_, const float* x, bf16_t* outp) {
    constexpr int CH = 32;
    const int tid = tid_, c = tid * 4, w = 2 << (c >> 9);
    for (int item = bid_; item < T / CH; item += gridDim.x) {
        const int t0 = item * CH, s0 = t0 & (SEQ - 1);
        f32x4 sum = {0.f, 0.f, 0.f, 0.f};
#pragma unroll
        for (int j = 1; j <= 16; ++j) if (j <= w && s0 - j >= 0) sum += *(const f32x4*)(x + (size_t)(t0 - j) * D + c);
#pragma unroll 16
        for (int tt = 0; tt < CH; ++tt) {
            const int t = t0 + tt, s = s0 + tt;
            const f32x4 xv = *(const f32x4*)(x + (size_t)t * D + c);
            sum += xv;
            if (s - w >= 0) sum -= *(const f32x4*)(x + (size_t)(t - w) * D + c);
            const float rc = __builtin_amdgcn_rcpf((float)((s + 1 < w) ? (s + 1) : w));
            const f32x4 o = sum * rc - xv;
            u32x2 wv = {pk_bf16(o[0], o[1]), pk_bf16(o[2], o[3])};
            *(u32x2*)(outp + (size_t)t * D + c) = wv;
        }
    }
}

#define XB_TMO      128
#define XB_XCNT(j)  (256  + 64 * (j))
#define XB_XSUB(j)  (1280 + 64 * (j))
#define XB_XGEN(j)  (2304 + 64 * (j))
#define XB_TOP      3328
#define XB_TOPGEN   3392
#define XCD_BAR_WORDS 3456
#define XB_SPIN_CAP (1u << 18)
DI unsigned xb_ld(unsigned* p) { return __hip_atomic_load(p, __ATOMIC_RELAXED, __HIP_MEMORY_SCOPE_AGENT); }
DI unsigned xb_add(unsigned* p, unsigned v) { return __hip_atomic_fetch_add(p, v, __ATOMIC_RELAXED, __HIP_MEMORY_SCOPE_AGENT); }
DI unsigned xb_xcc_id() { return (unsigned)__builtin_amdgcn_s_getreg((3 << 11) | 20) & 0xFu; }
#define XB_SPIN(cond, bar) do { unsigned _sp = 0; while (cond) { __builtin_amdgcn_s_sleep(1); \
    if ((++_sp & 255u) == 0u) { if (xb_ld(&(bar)[XB_TMO])) break; if (_sp > XB_SPIN_CAP) { atomicAdd(&(bar)[XB_TMO], 1u); break; } } } } while (0)
struct XcdBarrier { unsigned* bar; unsigned x; volatile LAS unsigned* st; };
DI XcdBarrier xcd_barrier_post(int tid, unsigned* bar, volatile LAS unsigned* st) {
    XcdBarrier b; b.bar = bar; b.x = xb_xcc_id(); b.st = st;
    if (tid == 0) (void)xb_add(&bar[XB_XCNT(b.x)], 1u);
    return b;
}
DI void xcd_barrier_complete(unsigned* bar, unsigned x, unsigned& nloc, unsigned& nx) {
    const unsigned G = gridDim.x * gridDim.y * gridDim.z;
    unsigned sum, cnt, mine, sp = 0u;
    for (;;) {
        sum = 0u; cnt = 0u; mine = 0u;
#pragma unroll
        for (unsigned j = 0; j < 16; ++j) { const unsigned c = xb_ld(&bar[XB_XCNT(j)]); sum += c; cnt += (c > 0u) ? 1u : 0u; mine = (j == x) ? c : mine; }
        if (sum == G) break;
        __builtin_amdgcn_s_sleep(1);
        if ((++sp & 255u) == 0u) { if (xb_ld(&bar[XB_TMO])) break; if (sp > XB_SPIN_CAP) { atomicAdd(&bar[XB_TMO], 1u); break; } }
    }
    nloc = mine > 0u ? mine : 1u; nx = cnt > 0u ? cnt : 1u;
}
DI void xcd_barrier(int tid, const XcdBarrier& b) {
    asm volatile("s_waitcnt vmcnt(0)" ::: "memory");
    __syncthreads();
    if (tid == 0) {
        unsigned* bar = b.bar;
        __builtin_amdgcn_s_waitcnt(0);
        unsigned nloc = b.st[0], nx = b.st[1];
        if (nloc == 0u) { xcd_barrier_complete(bar, b.x, nloc, nx); b.st[0] = nloc; b.st[1] = nx; }
        const unsigned old = xb_add(&bar[XB_XSUB(b.x)], 1u);
        const unsigned gen = old / nloc;
        if (old + 1u == (gen + 1u) * nloc) {
            __builtin_amdgcn_fence(__ATOMIC_RELEASE, "agent");
            asm volatile("s_waitcnt vmcnt(0)" ::: "memory");
            const unsigned og = xb_add(&bar[XB_TOP], 1u);
            const unsigned tg = og / nx;
            if (og + 1u == (tg + 1u) * nx) xb_add(&bar[XB_TOPGEN], 1u);
            else XB_SPIN(xb_ld(&bar[XB_TOPGEN]) == tg, bar);
            __builtin_amdgcn_fence(__ATOMIC_ACQUIRE, "agent");
            xb_add(&bar[XB_XGEN(b.x)], 1u);
            asm volatile("s_waitcnt vmcnt(0)" ::: "memory");
        } else {
            XB_SPIN(xb_ld(&bar[XB_XGEN(b.x)]) == gen, bar);
            __builtin_amdgcn_fence(__ATOMIC_ACQUIRE, "agent");
            asm volatile("s_waitcnt vmcnt(0)" ::: "memory");
        }
    }
    __syncthreads();
}

enum { K_PREP = 0, K_GACT, K_GRES, K_LN, K_RGCONV, K_RGSCAN0, K_RGSCAN1, K_KMEAN, K_ATTN, K_RMIX, K_RPREP, K_RSCAN, K_RPOST, K_POOL };
constexpr int NSTEPS = 38;
struct Desc {
    int kind;
    pg8::Gemm g;
    bf16_t* C; const float* res; const float* cscale; long sC; int ldc; unsigned acts;
    int lnidx, lnlast;
};
DI bool step_nosync(int st) { return st == 11 || st == 21; }
DI Desc make_desc(int st, const Params& p, unsigned char* ws) {
    unsigned char* sl = ws + O_SLOT;
    auto slot = [&](int i) { return (bf16_t*)(sl + (size_t)i * SLOT); };
    bf16_t* xb = slot(8);
    Desc d; d.kind = K_PREP; d.g = mk_gemm(nullptr, nullptr, 0, 0, 0, 0, 0, 0, 0, 0);
    d.C = nullptr; d.res = nullptr; d.cscale = nullptr; d.sC = 0; d.ldc = D; d.acts = 0u; d.lnidx = 0; d.lnlast = 0;
    int layer = -1, sub = 0;
    if (st >= 7 && st < 11) { layer = 0; sub = st - 7; }
    else if (st >= 16 && st < 20) { layer = 1; sub = st - 16; }
    else if (st >= 28 && st < 32) { layer = 2; sub = st - 28; }
    else if (st >= 34 && st < 38) { layer = 3; sub = st - 34; }
    if (layer >= 0) {
        if (sub == 0) { d.kind = K_LN; d.lnidx = layer * 2; }
        else if (sub == 1) { d.kind = K_GACT; d.C = slot(0); d.ldc = DFF; d.acts = 1u;
            d.g = mk_gemm(xb, (const bf16_t*)(ws + O_W1T + (size_t)layer * DFF * D * 2), 0, 0, D, D, D, T / 256, DFF / 256, 1); }
        else if (sub == 2) { d.kind = K_GRES;
            d.g = mk_gemm(slot(0), (const bf16_t*)(ws + O_W2T + (size_t)layer * DFF * D * 2), 0, 0, DFF, DFF, DFF, T / 256, D / 256, 1); }
        else { d.kind = K_LN; d.lnidx = layer * 2 + 1; d.lnlast = (layer == 3); }
        return d;
    }
    switch (st) {
    case 0: d.kind = K_PREP; break;
    case 1: d.kind = K_GACT; d.C = slot(0); d.ldc = 4096;
            d.g = mk_gemm(xb, (const bf16_t*)(ws + O_WIN), 0, 0, D, D, D, T / 256, 4096 / 256, 1); break;
    case 2: d.kind = K_RGCONV; break;
    case 3: d.kind = K_GACT; d.C = slot(3); d.sC = 512; d.ldc = 4096;
            d.g = mk_gemm(slot(2), (const bf16_t*)(ws + O_GATES), 256, 512 * 256, D, 256, 256, T / 256, 2, 8); break;
    case 4: d.kind = K_RGSCAN0; break;
    case 5: d.kind = K_RGSCAN1; break;
    case 6: d.kind = K_GRES; d.res = p.in[0];
            d.g = mk_gemm(slot(5), (const bf16_t*)(ws + O_RGOUT), 0, 0, D, D, D, T / 256, D / 256, 1); break;
    case 11: d.kind = K_GACT; d.C = slot(0); d.sC = (long)T * D;
             d.g = mk_gemm(xb, (const bf16_t*)(ws + O_QKV), 0, (long)D * D, D, D, D, T / 256, D / 256, 2); break;
    case 12: d.kind = K_GACT; d.C = slot(2); d.ldc = T;
             d.g = mk_gemm((const bf16_t*)(ws + O_QKV + 2 * SZ_DD), xb, 0, 0, D, D, D, D / 256, T / 256, 1); break;
    case 13: d.kind = K_KMEAN; break;
    case 14: d.kind = K_ATTN; break;
    case 15: d.kind = K_GRES;
             d.g = mk_gemm(slot(3), (const bf16_t*)(ws + O_MOUT), 0, 0, D, D, D, T / 256, D / 256, 1); break;
    case 20: d.kind = K_RMIX; break;
    case 21: d.kind = K_GACT; d.C = slot(6); d.sC = (long)T * D;
             d.g = mk_gemm(slot(0), (const bf16_t*)(ws + O_RKV), (long)T * D, (long)D * D, D, D, D, T / 256, D / 256, 3); break;
    case 22: d.kind = K_GACT; d.C = (bf16_t*)(ws + O_L1O); d.sC = (long)T * 256; d.ldc = 256; d.acts = 0x302u;
             d.g = mk_gemm(slot(3), (const bf16_t*)(ws + O_L1), (long)T * D, (long)256 * D, D, D, D, T / 256, 1, 3); break;
    case 23: d.kind = K_GACT; d.C = slot(0); d.sC = (long)T * D;
             d.g = mk_gemm((const bf16_t*)(ws + O_L1O), (const bf16_t*)(ws + O_L2), (long)T * 256, (long)D * 256, 256, 256, 256, T / 256, D / 256, 3); break;
    case 24: d.kind = K_RPREP; break;
    case 25: d.kind = K_RSCAN; break;
    case 26: d.kind = K_RPOST; break;
    case 27: d.kind = K_GRES;
             d.g = mk_gemm(slot(3), (const bf16_t*)(ws + O_ROUT), 0, 0, D, D, D, T / 256, D / 256, 1); break;
    case 32: d.kind = K_POOL; break;
    case 33: d.kind = K_GRES; d.cscale = p.in[33]; d.sC = 512;
             d.g = mk_gemm(slot(0), (const bf16_t*)(ws + O_POOL), 512, 512 * 512, D, 512, 512, T / 256, 2, 4); break;
    default: break;
    }
    return d;
}

__global__ void __launch_bounds__(512, 2) fwd_megakernel(Params p) {
    extern __shared__ __attribute__((aligned(16))) unsigned char smem[];
    cg::grid_group grid = cg::this_grid();
    LAS unsigned char* lds = (LAS unsigned char*)smem;

    const bool multi = (p.hi - p.lo) > 1;
    volatile LAS unsigned* xst = (volatile LAS unsigned*)(lds + 131072);
    if (__builtin_amdgcn_workitem_id_x() == 0) { xst[0] = 0u; xst[1] = 0u; }
    __syncthreads();
    (void)xcd_barrier_post((int)__builtin_amdgcn_workitem_id_x(), (unsigned*)(p.ws + O_BAR), xst);
    for (int st = p.lo; st < p.hi; ++st) {
        int tid_ = (int)__builtin_amdgcn_workitem_id_x(); asm volatile("" : "+v"(tid_));
        int bid_ = (int)__builtin_amdgcn_workgroup_id_x(); asm volatile("" : "+s"(bid_));
        unsigned char* ws = p.ws; asm volatile("" : "+s"(ws));
        float* xcur = p.out; asm volatile("" : "+s"(xcur));
        unsigned char* sl = ws + O_SLOT;
        auto slot = [&](int i) { return (bf16_t*)(sl + (size_t)i * SLOT); };
        const int stu = __builtin_amdgcn_readfirstlane(st);
        const Desc d = make_desc(stu, p, ws);
        switch (__builtin_amdgcn_readfirstlane(d.kind)) {
        case K_PREP: prep_phase(tid_, bid_, p, smem); break;
        case K_GACT: { pg8::EpiAct E; E.C = d.C; E.sC = d.sC; E.ldc = d.ldc; E.acts = d.acts; pg8::gemm_phase(tid_, bid_, lds, d.g, E); } break;
        case K_GRES: { pg8::EpiRes E; E.out = xcur; E.res = d.res ? d.res : xcur; E.cscale = d.cscale; E.alpha = ALPHA; E.sC = d.sC; E.ldc = D; pg8::gemm_phase(tid_, bid_, lds, d.g, E); } break;
        case K_LN: ln_phase(tid_, bid_, xcur, xcur, d.lnlast ? nullptr : slot(8), p.in[1] + (size_t)d.lnidx * D, p.in[2] + (size_t)d.lnidx * D); break;
        case K_RGCONV: rg_conv_phase(tid_, bid_, slot(0), slot(2), p.in[6], p.in[7]); break;
        case K_RGSCAN0: rg_scan_phase<0>(tid_, bid_, p, slot(3), slot(2), slot(0), (float*)(ws + O_AGG), slot(5)); break;
        case K_RGSCAN1: rg_scan_phase<1>(tid_, bid_, p, slot(3), slot(2), slot(0), (float*)(ws + O_AGG), slot(5)); break;
        case K_KMEAN: kmean_phase(tid_, bid_, slot(0), slot(1), (float*)(ws + O_KMEAN), (const float*)(ws + O_ROPE), (const float*)(ws + O_ROPE) + SEQ * 16, smem); break;
        case K_ATTN: attn_phase(tid_, bid_, slot(0), slot(1), slot(2), slot(3), (const float*)(ws + O_KMEAN), smem); break;
        case K_RMIX: rwkv_mix_phase(tid_, bid_, xcur, p.in[16], slot(0)); break;
        case K_RPREP: rwkv_prep_phase(tid_, bid_, p, sl, (float*)(ws + O_SCAL)); break;
        case K_RSCAN: rwkv_scan_phase(tid_, bid_, sl, (const float*)(ws + O_SCAL), smem); break;
        case K_RPOST: rwkv_post_phase(tid_, bid_, p, sl, (const float*)(ws + O_SCAL)); break;
        case K_POOL: pool_phase(tid_, bid_, xcur, slot(0)); break;
        default: break;
        }
        if (multi && !step_nosync(st) && st + 1 < p.hi) { if (st == p.lo) grid.sync(); else { XcdBarrier xb; xb.bar = (unsigned*)(ws + O_BAR); xb.x = xb_xcc_id(); xb.st = (volatile LAS unsigned*)(lds + 131072); xcd_barrier(tid_, xb); } }
    }
}

extern "C" void kernel_launch(void* const* d_in, const int* in_sizes, int n_in, void* d_out, int out_size, void* d_ws, size_t ws_size, hipStream_t stream) {
    static int grid = 0;
    if (grid == 0) {
        if (n_in != 34 || out_size != T * D || ws_size < WS_END) { fprintf(stderr, "kernel_launch: unexpected shapes (n_in %d out %d ws %zu need %zu)\n", n_in, out_size, ws_size, (size_t)WS_END); grid = -1; return; }
        int dev = 0, cus = 0, per_cu = 0;
        hipGetDevice(&dev);
        hipDeviceGetAttribute(&cus, hipDeviceAttributeMultiprocessorCount, dev);
        if (hipFuncSetAttribute((const void*)fwd_megakernel, hipFuncAttributeMaxDynamicSharedMemorySize, LDS_BYTES) != hipSuccess) { fprintf(stderr, "kernel_launch: hipFuncSetAttribute failed\n"); grid = -1; return; }
        hipOccupancyMaxActiveBlocksPerMultiprocessor(&per_cu, (const void*)fwd_megakernel, 512, LDS_BYTES);
        if (per_cu < 1) { fprintf(stderr, "kernel_launch: occupancy query says %d blocks/CU\n", per_cu); per_cu = 1; }
        (void)hipGetLastError();
        grid = cus;
    }
    if (grid < 0) return;
    Params p{};
    for (int i = 0; i < 34; ++i) p.in[i] = (const float*)d_in[i];
    {
        unsigned char* ws = (unsigned char*)d_ws; int nj = 0, t0 = 0;
        auto add = [&](const float* src, size_t dstoff, int Ks, int Ns, int Kd, int Nd) {
            TJob& j = p.tj[nj]; j.src = src; j.dst = (bf16_t*)(ws + dstoff); j.Ks = Ks; j.Ns = Ns; j.Kd = Kd; j.Nd = Nd; j.tile0 = t0; j.pad = 0;
            t0 += (Kd / 128) * (Nd / 128); ++nj; };
        for (int l = 0; l < 4; ++l) add(p.in[3] + (size_t)l * D * DFF, O_W1T + (size_t)l * DFF * D * 2, D, DFF, D, DFF);
        for (int l = 0; l < 4; ++l) add(p.in[4] + (size_t)l * D * DFF, O_W2T + (size_t)l * DFF * D * 2, DFF, D, DFF, D);
        add(p.in[5], O_WIN, D, 4096, D, 4096);
        for (int n = 0; n < 8; ++n) { add(p.in[8] + (size_t)n * 65536, O_GATES + (size_t)n * 512 * 256 * 2, 256, 256, 256, 256);
                                      add(p.in[10] + (size_t)n * 65536, O_GATES + ((size_t)n * 512 + 256) * 256 * 2, 256, 256, 256, 256); }
        add(p.in[13], O_RGOUT, D, D, D, D);
        add(p.in[14], O_QKV, D, 3 * D, D, 3 * D);
        add(p.in[15], O_MOUT, D, D, D, D);
        for (int g = 0; g < 3; ++g) add(p.in[17] + (size_t)g * D * D, O_RKV + g * SZ_DD, D, D, D, D);
        add(p.in[19], O_L1 + 0 * (size_t)256 * D * 2, D, 96, D, 256);
        add(p.in[22], O_L1 + 1 * (size_t)256 * D * 2, D, 96, D, 256);
        add(p.in[24], O_L1 + 2 * (size_t)256 * D * 2, D, 256, D, 256);
        add(p.in[20], O_L2 + 0 * (size_t)D * 256 * 2, 96, D, 256, D);
        add(p.in[23], O_L2 + 1 * (size_t)D * 256 * 2, 96, D, 256, D);
        add(p.in[25], O_L2 + 2 * (size_t)D * 256 * 2, 256, D, 256, D);
        add(p.in[31], O_ROUT, D, D, D, D);
        for (int g = 0; g < 4; ++g) add(p.in[32] + (size_t)g * 512 * 512, O_POOL + (size_t)g * 512 * 512 * 2, 512, 512, 512, 512);
        p.ntiles = t0;
        if (nj != NTJ) fprintf(stderr, "kernel_launch: job table size %d != %d\n", nj, NTJ);
    }
    p.out = (float*)d_out; p.ws = (unsigned char*)d_ws; p.lo = 0; p.hi = NSTEPS;
    if (hipMemsetAsync((unsigned char*)d_ws + O_BAR, 0, BAR_BYTES, stream) != hipSuccess) { fprintf(stderr, "kernel_launch: memset of barrier words failed\n"); return; }
    void* args[] = {&p};
    hipError_t e = hipLaunchCooperativeKernel((const void*)fwd_megakernel, dim3(grid), dim3(512), args, LDS_BYTES, stream);
    if (e != hipSuccess) fprintf(stderr, "cooperative launch failed: %s (grid %d)\n", hipGetErrorString(e), grid);
}
```

```cpp
#include <hip/hip_runtime.h>
#include <hip/hip_cooperative_groups.h>
#include <cstdio>
namespace cg = cooperative_groups;

#define LAS __attribute__((address_space(3)))
typedef unsigned short bf16_t;
typedef short bf16x8 __attribute__((ext_vector_type(8)));
typedef float f32x4 __attribute__((ext_vector_type(4)));
typedef float f32x2 __attribute__((ext_vector_type(2)));
typedef unsigned u32x4 __attribute__((ext_vector_type(4)));
typedef unsigned u32x2 __attribute__((ext_vector_type(2)));
typedef __bf16 bfv2 __attribute__((ext_vector_type(2)));
#define DI __device__ __forceinline__

constexpr int T = 16384, D = 2048, SEQ = 4096, DFF = 8192;
constexpr float ALPHA = 1.6817928305074290f;
constexpr float LN_EPS = 1e-5f;

constexpr size_t SZ_DD = (size_t)D * D * 2;
constexpr size_t O_W1T = 0;
constexpr size_t O_W2T = O_W1T + 4 * (size_t)DFF * D * 2;
constexpr size_t O_WIN = O_W2T + 4 * (size_t)DFF * D * 2;
constexpr size_t O_GATES = O_WIN + (size_t)4096 * D * 2;
constexpr size_t O_RGOUT = O_GATES + (size_t)8 * 512 * 256 * 2;
constexpr size_t O_QKV = O_RGOUT + SZ_DD;
constexpr size_t O_MOUT = O_QKV + 3 * SZ_DD;
constexpr size_t O_RKV = O_MOUT + SZ_DD;
constexpr size_t O_L1 = O_RKV + 3 * SZ_DD;
constexpr size_t O_L2 = O_L1 + (size_t)3 * 256 * D * 2;
constexpr size_t O_ROUT = O_L2 + (size_t)3 * D * 256 * 2;
constexpr size_t O_POOL = O_ROUT + SZ_DD;
constexpr size_t O_SLOT = O_POOL + (size_t)4 * 512 * 512 * 2;
constexpr size_t SLOT = (size_t)T * D * 2;
constexpr size_t O_L1O = O_SLOT + 9 * SLOT;
constexpr size_t O_ROPE = O_L1O + (size_t)3 * T * 256 * 2;
constexpr size_t O_KMEAN = O_ROPE + (size_t)2 * SEQ * 16 * 4;
constexpr size_t O_AGG = O_KMEAN + (size_t)64 * 16 * 128 * 4;
constexpr size_t O_SCAL = O_AGG + (size_t)4 * 128 * D * 2 * 4;
constexpr size_t O_BAR = O_SCAL + (size_t)3 * T * 32 * 4;
constexpr size_t BAR_BYTES = 16384;
constexpr size_t WS_END = O_BAR + BAR_BYTES;

constexpr int LDS_BYTES = 131072 + 16;

struct TJob { const float* src; bf16_t* dst; int Ks, Ns, Kd, Nd, tile0, pad; };
constexpr int NTJ = 42;
struct Params {
    const float* in[34];
    float* out;
    unsigned char* ws;
    int lo, hi, ntiles, pad;
    TJob tj[NTJ];
};

DI unsigned pk_bf16(float a, float b) { f32x2 v = {a, b}; bfv2 r = __builtin_convertvector(v, bfv2); return __builtin_bit_cast(unsigned, r); }
DI bf16_t f2bf(float a) { return (bf16_t)(pk_bf16(a, 0.f) & 0xffffu); }
DI float bf2f(bf16_t b) { return __uint_as_float(((unsigned)b) << 16); }
DI float bflo(unsigned u) { return __uint_as_float(u << 16); }
DI float bfhi(unsigned u) { return __uint_as_float(u & 0xffff0000u); }
DI float wave_sum(float v) {
    v += __int_as_float(__builtin_amdgcn_update_dpp(0, __float_as_int(v), 0xB1, 0xF, 0xF, false));
    v += __int_as_float(__builtin_amdgcn_update_dpp(0, __float_as_int(v), 0x4E, 0xF, 0xF, false));
    v += __int_as_float(__builtin_amdgcn_update_dpp(0, __float_as_int(v), 0x141, 0xF, 0xF, false));
    v += __int_as_float(__builtin_amdgcn_update_dpp(0, __float_as_int(v), 0x140, 0xF, 0xF, false));
    const int iv = __float_as_int(v);
    return __int_as_float(__builtin_amdgcn_readlane(iv, 0)) + __int_as_float(__builtin_amdgcn_readlane(iv, 16)) +
           __int_as_float(__builtin_amdgcn_readlane(iv, 32)) + __int_as_float(__builtin_amdgcn_readlane(iv, 48));
}
DI float xmax_fq(float v) {
    const auto a = __builtin_amdgcn_permlane32_swap(__float_as_uint(v), __float_as_uint(v), false, false);
    v = fmaxf(__uint_as_float(a[0]), __uint_as_float(a[1]));
    const auto b = __builtin_amdgcn_permlane16_swap(__float_as_uint(v), __float_as_uint(v), false, false);
    return fmaxf(__uint_as_float(b[0]), __uint_as_float(b[1]));
}
DI float xsum_fq(float v) {
    const auto a = __builtin_amdgcn_permlane32_swap(__float_as_uint(v), __float_as_uint(v), false, false);
    v = __uint_as_float(a[0]) + __uint_as_float(a[1]);
    const auto b = __builtin_amdgcn_permlane16_swap(__float_as_uint(v), __float_as_uint(v), false, false);
    return __uint_as_float(b[0]) + __uint_as_float(b[1]);
}
DI void lds_barrier() { asm volatile("s_waitcnt lgkmcnt(0)" ::: "memory"); __builtin_amdgcn_s_barrier(); asm volatile("" ::: "memory"); }
DI float sigmoidf_(float x) { return __builtin_amdgcn_rcpf(1.f + __expf(-x)); }
DI float tanhf_(float x) { return 1.f - 2.f * __builtin_amdgcn_rcpf(1.f + __expf(2.f * x)); }
DI float gelu_tanh(float x) { const float u = 0.7978845608028654f * (x + 0.044715f * x * x * x); return 0.5f * x * (1.f + tanhf_(u)); }

namespace pg8 {
constexpr int BM = 256, BK = 64, HALF = 128, HTB = HALF * BK * 2, NXCD = 8, WGM = 4;
DI int lds_byte(int r, int c) { const int st = (r >> 4) * 2 + (c >> 5), rr = r & 15, cc = c & 31, ob = rr * 64 + cc * 2; return st * 1024 + (ob ^ (((ob >> 9) & 1) << 5)); }
DI void stage_rc(int b, int& R, int& C) { const int st = b / 1024, sb = b % 1024, swz = sb ^ (((sb >> 9) & 1) << 5); R = (st >> 1) * 16 + swz / 64; C = (st & 1) * 32 + (swz % 64) / 2; }
DI int perm32(int rho) { const int n = rho >> 4, i = rho & 15; return 8 * (i >> 2) + 4 * n + (i & 3); }

struct Unit { int g, pm, pn; };
struct Gemm { const bf16_t* A; const bf16_t* Bt; long sA, sB; int lda, ldb, K, nM, nN, G; };

struct Order {
    int nM, nN, nwg, tot, Gd, c;
    DI void init(const Gemm& g, int Gd_, int c_) { nM = g.nM; nN = g.nN; nwg = nM * nN; tot = nwg * g.G; Gd = Gd_; c = c_; }
    DI bool next(int i, Unit& u) const {
        const long L = (long)i * Gd + c; if (L >= tot) return false;
        const int grp = (int)(L / nwg); int wgid = (int)(L - (long)grp * nwg);
        { const int q = nwg / NXCD, r = nwg % NXCD, xcd = wgid % NXCD, off = wgid / NXCD; wgid = (xcd < r ? xcd * (q + 1) : r * (q + 1) + (xcd - r) * q) + off; }
        const int nig = WGM * nN, gid = wgid / nig, fm = gid * WGM, gsz = (nM - fm) < WGM ? (nM - fm) : WGM;
        u.g = grp; u.pm = fm + ((wgid % nig) % gsz); u.pn = (wgid % nig) / gsz; return true;
    }
};

struct EpiAct {
    static constexpr bool PERM = true;
    bf16_t* C; long sC; int ldc; unsigned acts;
    DI void operator()(const f32x4 (&acc)[2][2][4][2], const Unit& u, int wr, int wc, int fr, int fq) const {
        bf16_t* base = C + (size_t)u.g * sC;
        const int act = (int)((acts >> (4 * u.g)) & 15u);
        const int row0 = u.pm * BM + wr * 64 + fr, col0 = u.pn * BM + wc * 32 + 8 * fq;
#pragma unroll
        for (int ai = 0; ai < 2; ++ai)
#pragma unroll
            for (int m = 0; m < 4; ++m) {
                bf16_t* rowp = base + (size_t)(row0 + ai * HALF + m * 16) * ldc + col0;
#pragma unroll
                for (int bj = 0; bj < 2; ++bj) {
                    float v[8];
#pragma unroll
                    for (int e = 0; e < 4; ++e) { v[e] = acc[ai][bj][m][0][e]; v[4 + e] = acc[ai][bj][m][1][e]; }
                    if (act == 1) {
#pragma unroll
                        for (int e = 0; e < 8; ++e) { const float t = fmaxf(v[e], 0.f); v[e] = t * t; }
                    } else if (act == 2) {
#pragma unroll
                        for (int e = 0; e < 8; ++e) v[e] = tanhf_(v[e]);
                    } else if (act == 3) {
#pragma unroll
                        for (int e = 0; e < 8; ++e) v[e] = sigmoidf_(v[e]);
                    }
                    u32x4 o = {pk_bf16(v[0], v[1]), pk_bf16(v[2], v[3]), pk_bf16(v[4], v[5]), pk_bf16(v[6], v[7])};
                    *(u32x4*)(rowp + bj * HALF) = o;
                }
            }
    }
};
struct EpiRes {
    static constexpr bool PERM = false;
    float* out; const float* res; const float* cscale; float alpha; long sC; int ldc;
    DI void operator()(const f32x4 (&acc)[2][2][4][2], const Unit& u, int wr, int wc, int fr, int fq) const {
        const int row0 = u.pm * BM + wr * 64 + fr, col0 = (int)(u.g * sC) + u.pn * BM + wc * 32 + 4 * fq;
        f32x4 r[2][2][2][2];
        auto ldq = [&](int q, int buf) {
            const int ai = q >> 1, m0 = (q & 1) * 2;
#pragma unroll
            for (int mm = 0; mm < 2; ++mm) {
                const size_t ro = (size_t)(row0 + ai * HALF + (m0 + mm) * 16) * ldc + col0;
#pragma unroll
                for (int bj = 0; bj < 2; ++bj)
#pragma unroll
                    for (int n = 0; n < 2; ++n) r[buf][mm][bj][n] = *(const f32x4*)(res + ro + bj * HALF + n * 16);
            }
        };
        auto stq = [&](int q, int buf) {
            const int ai = q >> 1, m0 = (q & 1) * 2;
#pragma unroll
            for (int mm = 0; mm < 2; ++mm) {
                const size_t ro = (size_t)(row0 + ai * HALF + (m0 + mm) * 16) * ldc + col0;
#pragma unroll
                for (int bj = 0; bj < 2; ++bj)
#pragma unroll
                    for (int n = 0; n < 2; ++n) {
                        f32x4 a = acc[ai][bj][m0 + mm][n];
                        if (cscale) a *= *(const f32x4*)(cscale + col0 + bj * HALF + n * 16);
                        *(f32x4*)(out + ro + bj * HALF + n * 16) = alpha * r[buf][mm][bj][n] + a;
                    }
            }
        };
        ldq(0, 0); ldq(1, 1);
        __builtin_amdgcn_sched_barrier(0);
        stq(0, 0); ldq(2, 0);
        __builtin_amdgcn_sched_barrier(0);
        stq(1, 1); ldq(3, 1);
        __builtin_amdgcn_sched_barrier(0);
        stq(2, 0); stq(3, 1);
    }
};
template <class Epi>
DI void gemm_phase(int tid_, int bid_, LAS unsigned char* lds, const Gemm g, const Epi& E) {
    const int tid = tid_, wid = __builtin_amdgcn_readfirstlane(tid >> 6), lane = tid & 63, wr = wid >> 2, wc = wid & 3, fr = lane & 15, fq = lane >> 4;
    const int K = g.K, nt = K / BK;
    Order S; S.init(g, (int)gridDim.x, (int)bid_);
    unsigned voffA[2], voffB[2];
#pragma unroll
    for (int i = 0; i < 2; ++i) { int R, C; stage_rc(tid * 16 + i * 8192, R, C); const int Rb = Epi::PERM ? ((R & ~31) + perm32(R & 31)) : R;
        voffA[i] = (unsigned)(R * g.lda + C) * 2u; voffB[i] = (unsigned)(Rb * g.ldb + C) * 2u; }
    const size_t kstep = (size_t)(BK * 2);
    const size_t hA = (size_t)HALF * g.lda * 2, hB = (size_t)HALF * g.ldb * 2;
    const unsigned ldsw = (unsigned)wid * 1024u;
    const int aoff = lds_byte(wr * 64 + fr, fq * 8), boff = lds_byte(wc * 32 + fr, fq * 8);
#define PG8_SA(b, h) (((b) * 2 + (h)) * HTB)
#define PG8_SB(b, h) ((4 + (b) * 2 + (h)) * HTB)
#define PG8_STAGE(bufoff, gbase, voff) do { _Pragma("unroll") for (int _i = 0; _i < 2; ++_i) \
        __builtin_amdgcn_global_load_lds((const unsigned*)((const char*)(gbase) + (voff)[_i]), (LAS unsigned*)(lds + (bufoff) + ldsw + _i * 8192), 16, 0, 0); } while (0)
#define PG8_LDA(dst, b, h) do { _Pragma("unroll") for (int m = 0; m < 4; ++m) _Pragma("unroll") for (int k = 0; k < 2; ++k) dst[m][k] = *(const LAS bf16x8*)(lds + PG8_SA(b, h) + aoff + m * 2048 + k * 1024); } while (0)
#define PG8_LDB(dst, b, h) do { _Pragma("unroll") for (int n = 0; n < 2; ++n) _Pragma("unroll") for (int k = 0; k < 2; ++k) dst[n][k] = *(const LAS bf16x8*)(lds + PG8_SB(b, h) + boff + n * 2048 + k * 1024); } while (0)
#define PG8_MMA(ai, bj, At, Bt) do { __builtin_amdgcn_s_setprio(1); _Pragma("unroll") for (int m = 0; m < 4; ++m) _Pragma("unroll") for (int n = 0; n < 2; ++n) _Pragma("unroll") for (int k = 0; k < 2; ++k) \
        acc[ai][bj][m][n] = __builtin_amdgcn_mfma_f32_16x16x32_bf16(Bt[n][k], At[m][k], acc[ai][bj][m][n], 0, 0, 0); __builtin_amdgcn_s_setprio(0); } while (0)
#define PG8_WAIT_V(n) asm volatile("s_waitcnt vmcnt(" #n ")" ::: "memory")
#define PG8_WAIT_L(n) asm volatile("s_waitcnt lgkmcnt(" #n ")" ::: "memory")
#define PG8_BAR __builtin_amdgcn_s_barrier()
#define PG8_SCHED __builtin_amdgcn_sched_barrier(0)
    Unit cur, nxt; int ui = 0;
    if (!S.next(0, cur)) return;
    f32x4 acc[2][2][4][2];
#pragma unroll
    for (int a = 0; a < 2; ++a)
#pragma unroll
        for (int b = 0; b < 2; ++b)
#pragma unroll
            for (int m = 0; m < 4; ++m)
#pragma unroll
                for (int n = 0; n < 2; ++n) acc[a][b][m][n] = (f32x4){0.f, 0.f, 0.f, 0.f};
    bf16x8 At[4][2], B0[2][2], B1[2][2];
    const char* cA = (const char*)g.A + ((size_t)cur.g * g.sA + (size_t)cur.pm * BM * g.lda) * 2;
    const char* cB = (const char*)g.Bt + ((size_t)cur.g * g.sB + (size_t)cur.pn * BM * g.ldb) * 2;
    PG8_STAGE(PG8_SB(0, 0), cB, voffB); PG8_STAGE(PG8_SA(0, 0), cA, voffA); PG8_STAGE(PG8_SB(0, 1), cB + hB, voffB); PG8_STAGE(PG8_SA(0, 1), cA + hA, voffA);
    if (wr == 1) PG8_BAR;
    PG8_WAIT_V(4); PG8_BAR;
    PG8_STAGE(PG8_SB(1, 0), cB + kstep, voffB); PG8_STAGE(PG8_SA(1, 0), cA + kstep, voffA); PG8_STAGE(PG8_SB(1, 1), cB + hB + kstep, voffB);
    PG8_WAIT_V(6); PG8_BAR;
    for (;;) {
        const bool has_next = S.next(ui + 1, nxt);
        const char* nA = has_next ? (const char*)g.A + ((size_t)nxt.g * g.sA + (size_t)nxt.pm * BM * g.lda) * 2 : cA;
        const char* nB = has_next ? (const char*)g.Bt + ((size_t)nxt.g * g.sB + (size_t)nxt.pn * BM * g.ldb) * 2 : cB;
        for (int t = 0; t < nt; t += 2) {
            const bool last = (t == nt - 2);
            const char* a1 = cA + (size_t)(t + 1) * kstep;
            const char* a2 = last ? nA : cA + (size_t)(t + 2) * kstep; const char* b2 = last ? nB : cB + (size_t)(t + 2) * kstep;
            const char* a3 = a2 + kstep; const char* b3 = b2 + kstep;
            PG8_LDB(B0, 0, 0); PG8_SCHED; PG8_LDA(At, 0, 0); PG8_STAGE(PG8_SA(1, 1), a1 + hA, voffA);
            PG8_WAIT_L(8); PG8_BAR; PG8_WAIT_L(0); PG8_MMA(0, 0, At, B0); PG8_BAR; PG8_SCHED;
            PG8_LDB(B1, 0, 1); PG8_STAGE(PG8_SB(0, 0), b2, voffB);
            PG8_BAR; PG8_WAIT_L(0); PG8_MMA(0, 1, At, B1); PG8_BAR;
            PG8_LDA(At, 0, 1); PG8_STAGE(PG8_SA(0, 0), a2, voffA);
            PG8_BAR; PG8_WAIT_L(0); PG8_MMA(1, 0, At, B0); PG8_BAR; PG8_SCHED;
            PG8_STAGE(PG8_SB(0, 1), b2 + hB, voffB);
            PG8_WAIT_V(6); PG8_BAR; PG8_MMA(1, 1, At, B1); PG8_BAR;
            PG8_LDB(B0, 1, 0); PG8_SCHED; PG8_LDA(At, 1, 0); PG8_STAGE(PG8_SA(0, 1), a2 + hA, voffA);
            PG8_WAIT_L(8); PG8_BAR; PG8_WAIT_L(0); PG8_MMA(0, 0, At, B0); PG8_BAR; PG8_SCHED;
            PG8_LDB(B1, 1, 1); PG8_STAGE(PG8_SB(1, 0), b3, voffB);
            PG8_BAR; PG8_WAIT_L(0); PG8_MMA(0, 1, At, B1); PG8_BAR;
            PG8_LDA(At, 1, 1); PG8_STAGE(PG8_SA(1, 0), a3, voffA);
            PG8_BAR; PG8_WAIT_L(0); PG8_MMA(1, 0, At, B0); PG8_BAR; PG8_SCHED;
            PG8_STAGE(PG8_SB(1, 1), b3 + hB, voffB);
            PG8_WAIT_V(6); PG8_BAR; PG8_MMA(1, 1, At, B1); PG8_BAR;
        }
        E(acc, cur, wr, wc, fr, fq);
        if (!has_next) break;
#pragma unroll
        for (int a = 0; a < 2; ++a)
#pragma unroll
            for (int b = 0; b < 2; ++b)
#pragma unroll
                for (int m = 0; m < 4; ++m)
#pragma unroll
                    for (int n = 0; n < 2; ++n) acc[a][b][m][n] = (f32x4){0.f, 0.f, 0.f, 0.f};
        cur = nxt; cA = nA; cB = nB; ++ui;
    }
    PG8_WAIT_V(0);
    if (wr == 0) PG8_BAR;
    PG8_BAR;
#undef PG8_SA
#undef PG8_SB
#undef PG8_STAGE
#undef PG8_LDA
#undef PG8_LDB
#undef PG8_MMA
#undef PG8_WAIT_V
#undef PG8_WAIT_L
#undef PG8_BAR
#undef PG8_SCHED
}
}

DI pg8::Gemm mk_gemm(const bf16_t* A, const bf16_t* Bt, long sA, long sB, int lda, int ldb, int K, int nM, int nN, int G) {
    pg8::Gemm g; g.A = A; g.Bt = Bt; g.sA = sA; g.sB = sB; g.lda = lda; g.ldb = ldb; g.K = K; g.nM = nM; g.nN = nN; g.G = G; return g;
}

DI void prep_phase(int tid_, int bid_, const Params& p, unsigned char* smem) {
    TJob* jobs = (TJob*)smem;
    float* tile = (float*)(smem + 4096);
    const int tid = tid_;
    if (tid < NTJ) jobs[tid] = p.tj[tid];
    __syncthreads();
    const int ntiles = p.ntiles;
    for (int tix = bid_; tix < ntiles; tix += gridDim.x) {
        int j = 0;
        for (int q = 1; q < NTJ; ++q) if (jobs[q].tile0 <= tix) j = q;
        const TJob jb = jobs[j];
        const int lt = tix - jb.tile0, ntk = jb.Kd / 128, k0 = (lt % ntk) * 128, n0 = (lt / ntk) * 128;
        f32x4 v[8];
#pragma unroll
        for (int i = 0; i < 8; ++i) {
            const int idx = tid + i * 512, kk = idx >> 5, n4 = idx & 31;
            const int k = k0 + kk, n = n0 + n4 * 4;
            v[i] = (k < jb.Ks && n < jb.Ns) ? *(const f32x4*)(jb.src + (size_t)k * jb.Ns + n) : (f32x4){0.f, 0.f, 0.f, 0.f};
        }
#pragma unroll
        for (int i = 0; i < 8; ++i) {
            const int idx = tid + i * 512, kk = idx >> 5, n4 = idx & 31;
#pragma unroll
            for (int e = 0; e < 4; ++e) tile[kk * 129 + n4 * 4 + e] = v[i][e];
        }
        __syncthreads();
#pragma unroll
        for (int i = 0; i < 4; ++i) {
            const int idx = tid + i * 512, n = idx >> 4, kc = idx & 15;
            float f[8];
#pragma unroll
            for (int e = 0; e < 8; ++e) f[e] = tile[(kc * 8 + e) * 129 + n];
            u32x4 o = {pk_bf16(f[0], f[1]), pk_bf16(f[2], f[3]), pk_bf16(f[4], f[5]), pk_bf16(f[6], f[7])};
            *(u32x4*)(jb.dst + (size_t)(n0 + n) * jb.Kd + k0 + kc * 8) = o;
        }
        __syncthreads();
    }
    {
        const float* x = p.in[0]; bf16_t* xb = (bf16_t*)(p.ws + O_SLOT + 8 * SLOT);
        const size_t n8 = (size_t)T * D / 8;
        for (size_t i = (size_t)bid_ * 512 + tid; i < n8; i += (size_t)gridDim.x * 512) {
            const f32x4 a = *(const f32x4*)(x + i * 8), b = *(const f32x4*)(x + i * 8 + 4);
            u32x4 o = {pk_bf16(a[0], a[1]), pk_bf16(a[2], a[3]), pk_bf16(b[0], b[1]), pk_bf16(b[2], b[3])};
            *(u32x4*)(xb + i * 8) = o;
        }
    }
    {
        float* ct = (float*)(p.ws + O_ROPE); float* st = ct + SEQ * 16;
        for (int i = bid_ * 512 + tid; i < SEQ * 16; i += gridDim.x * 512) {
            const int pos = i >> 4, f = i & 15;
            const float inv = powf(500000.0f, -(float)(2 * f) / 32.0f);
            const float ang = (float)pos * inv;
            ct[i] = cosf(ang); st[i] = sinf(ang);
        }
    }
}

DI void ln_phase(int tid_, int bid_, const float* zin, float* xout, bf16_t* xb, const float* gam, const float* bet) {
    const int lane = tid_ & 63, wid = tid_ >> 6;
    const int rstride = gridDim.x * 8;
    constexpr int NR = 4;
    for (int row0 = bid_ * 8 + wid; row0 < T; row0 += NR * rstride) {
        f32x4 v[NR][8];
#pragma unroll
        for (int r = 0; r < NR; ++r)
#pragma unroll
            for (int i = 0; i < 8; ++i)
                v[r][i] = (row0 + r * rstride < T) ? *(const f32x4*)(zin + (size_t)(row0 + r * rstride) * D + (i * 64 + lane) * 4) : (f32x4){0.f, 0.f, 0.f, 0.f};
#pragma unroll
        for (int r = 0; r < NR; ++r) {
            const int row = row0 + r * rstride;
            if (row >= T) break;
            float s = 0.f;
#pragma unroll
            for (int i = 0; i < 8; ++i) s += v[r][i][0] + v[r][i][1] + v[r][i][2] + v[r][i][3];
            const float mean = wave_sum(s) * (1.f / D);
            float q = 0.f;
#pragma unroll
            for (int i = 0; i < 8; ++i) { v[r][i] -= mean; q += v[r][i][0] * v[r][i][0] + v[r][i][1] * v[r][i][1] + v[r][i][2] * v[r][i][2] + v[r][i][3] * v[r][i][3]; }
            const float rstd = rsqrtf(wave_sum(q) * (1.f / D) + LN_EPS);
#pragma unroll
            for (int i = 0; i < 8; ++i) {
                const int c = (i * 64 + lane) * 4;
                const f32x4 g = *(const f32x4*)(gam + c), b = *(const f32x4*)(bet + c);
                const f32x4 o = v[r][i] * rstd * g + b;
                *(f32x4*)(xout + (size_t)row * D + c) = o;
                if (xb) { u32x2 w = {pk_bf16(o[0], o[1]), pk_bf16(o[2], o[3])}; *(u32x2*)(xb + (size_t)row * D + c) = w; }
            }
        }
    }
}

DI void rg_conv_phase(int tid_, int bid_, const bf16_t* gu, bf16_t* uc, const float* cw, const float* cb) {
    const size_t n8 = (size_t)T * D / 8;
    const size_t stride = (size_t)gridDim.x * 512;
    constexpr int U = 4;
    for (size_t ib = (size_t)bid_ * 512 + tid_; ib < n8; ib += stride * U) {
        u32x4 uu[U][4];
#pragma unroll
        for (int u = 0; u < U; ++u) {
            const size_t i = ib + u * stride;
            const int t = (int)(i >> 8), c = (int)(i & 255) * 8, s = t & (SEQ - 1);
#pragma unroll
            for (int j = 0; j < 4; ++j)
                uu[u][j] = (i < n8 && s - 3 + j >= 0) ? *(const u32x4*)(gu + (size_t)(t - 3 + j) * 4096 + 2048 + c) : (u32x4){0u, 0u, 0u, 0u};
        }
#pragma unroll
        for (int u = 0; u < U; ++u) {
            const size_t i = ib + u * stride;
            if (i >= n8) break;
            const int c = (int)(i & 255) * 8;
            float a[8];
            { const f32x4 b0 = *(const f32x4*)(cb + c), b1 = *(const f32x4*)(cb + c + 4);
#pragma unroll
              for (int e = 0; e < 4; ++e) { a[e] = b0[e]; a[4 + e] = b1[e]; } }
#pragma unroll
            for (int j = 0; j < 4; ++j) {
                const u32x4 q = uu[u][j];
                const f32x4 w0 = *(const f32x4*)(cw + j * D + c), w1 = *(const f32x4*)(cw + j * D + c + 4);
                a[0] += w0[0] * bflo(q[0]); a[1] += w0[1] * bfhi(q[0]); a[2] += w0[2] * bflo(q[1]); a[3] += w0[3] * bfhi(q[1]);
                a[4] += w1[0] * bflo(q[2]); a[5] += w1[1] * bfhi(q[2]); a[6] += w1[2] * bflo(q[3]); a[7] += w1[3] * bfhi(q[3]);
            }
            u32x4 o = {pk_bf16(a[0], a[1]), pk_bf16(a[2], a[3]), pk_bf16(a[4], a[5]), pk_bf16(a[6], a[7])};
            *(u32x4*)(uc + i * 8) = o;
        }
    }
}
DI void rg_ab(float rpre, float ipre, float u, float ba, float bx, float sp8, float& a, float& b) {
    const float r = sigmoidf_(rpre + ba), ii = sigmoidf_(ipre + bx);
    const float la = -sp8 * r;
    a = __expf(la);
    const float x2 = 2.f * la;
    const float om = (x2 > -0.05f) ? -x2 * (1.f + x2 * (0.5f + x2 * (0.16666667f + x2 * 0.041666668f))) : 1.f - a * a;
    b = u * ii * __builtin_amdgcn_sqrtf(om);
}
template <int MODE>
DI void rg_scan_phase(int tid_, int bid_, const Params& p, const bf16_t* gates, const bf16_t* uc, const bf16_t* gu, float* agg, bf16_t* outg) {
    constexpr int CH = 32;
    const float* gab = p.in[9]; const float* gxb = p.in[11]; const float* lam = p.in[12];
    for (int item = bid_; item < 4 * 128 * 2; item += gridDim.x) {
        const int cg2 = item & 1, chunk = (item >> 1) & 127, b = item >> 8;
        const int ch = cg2 * 1024 + tid_ * 2;
        const int n = ch >> 8, v = ch & 255;
        const f32x2 ba = *(const f32x2*)(gab + ch), bx = *(const f32x2*)(gxb + ch), lm = *(const f32x2*)(lam + ch);
        const float sp0 = 8.f * log1pf(expf(-lm[0])), sp1 = 8.f * log1pf(expf(-lm[1]));
        float h0 = 0.f, h1 = 0.f, P0 = 1.f, P1 = 1.f;
        if (MODE == 1) {
            for (int c0 = 0; c0 < chunk; c0 += 16) {
                f32x4 gv[16];
#pragma unroll
                for (int j = 0; j < 16; ++j) gv[j] = (c0 + j < chunk) ? *(const f32x4*)(agg + (((size_t)b * 128 + c0 + j) * D + ch) * 2) : (f32x4){1.f, 0.f, 1.f, 0.f};
#pragma unroll
                for (int j = 0; j < 16; ++j) { h0 = gv[j][0] * h0 + gv[j][1]; h1 = gv[j][2] * h1 + gv[j][3]; }
            }
        }
        const size_t t0 = (size_t)b * SEQ + (size_t)chunk * CH;
        constexpr int UB = 32;
        for (int tb = 0; tb < CH; tb += UB) {
            unsigned rpv[UB], ipv[UB], uuv[UB], ggv[UB];
#pragma unroll
            for (int j = 0; j < UB; ++j) {
                const size_t t = t0 + tb + j;
                rpv[j] = *(const unsigned*)(gates + t * 4096 + n * 512 + v);
                ipv[j] = *(const unsigned*)(gates + t * 4096 + n * 512 + 256 + v);
                uuv[j] = *(const unsigned*)(uc + t * D + ch);
                if (MODE == 1) ggv[j] = *(const unsigned*)(gu + t * 4096 + ch);
            }
#pragma unroll
            for (int j = 0; j < UB; ++j) {
                const size_t t = t0 + tb + j;
                float a0, b0, a1, b1;
                rg_ab(bflo(rpv[j]), bflo(ipv[j]), bflo(uuv[j]), ba[0], bx[0], sp0, a0, b0);
                rg_ab(bfhi(rpv[j]), bfhi(ipv[j]), bfhi(uuv[j]), ba[1], bx[1], sp1, a1, b1);
                h0 = a0 * h0 + b0; h1 = a1 * h1 + b1;
                if (MODE == 0) { P0 *= a0; P1 *= a1; }
                else *(unsigned*)(outg + t * D + ch) = pk_bf16(gelu_tanh(bflo(ggv[j])) * h0, gelu_tanh(bfhi(ggv[j])) * h1);
            }
        }
        if (MODE == 0) { f32x4 o = {P0, h0, P1, h1}; *(f32x4*)(agg + (((size_t)b * 128 + chunk) * D + ch) * 2) = o; }
    }
}

DI void kmean_phase(int tid_, int bid_, bf16_t* Qx, bf16_t* Kx, float* kmean, const float* ctab, const float* stab, unsigned char* smem) {
    float* redA = (float*)smem;
    float* redB = redA + 1024;
    const int tid = tid_;
    for (int item = bid_; item < 1024; item += gridDim.x) {
        const int blk = item & 15, h = (item >> 4) & 15, b = item >> 8;
        {
            const int i = tid & 15, rg = tid >> 4;
            float s1 = 0.f, s2 = 0.f;
            bf16_t k1v[8], k2v[8], q1v[8], q2v[8]; float cv[8], sv[8];
#pragma unroll
            for (int r = 0; r < 8; ++r) {
                const int pos = blk * 256 + rg * 8 + r;
                const size_t o = ((size_t)b * SEQ + pos) * D + h * 128 + i;
                cv[r] = ctab[pos * 16 + i]; sv[r] = stab[pos * 16 + i];
                k1v[r] = Kx[o]; k2v[r] = Kx[o + 16]; q1v[r] = Qx[o]; q2v[r] = Qx[o + 16];
            }
#pragma unroll
            for (int r = 0; r < 8; ++r) {
                const int pos = blk * 256 + rg * 8 + r;
                const size_t o = ((size_t)b * SEQ + pos) * D + h * 128 + i;
                const float c = cv[r], sn = sv[r];
                const float k1 = bf2f(k1v[r]), k2 = bf2f(k2v[r]);
                const bf16_t k1r = f2bf(k1 * c - k2 * sn), k2r = f2bf(k2 * c + k1 * sn);
                Kx[o] = k1r; Kx[o + 16] = k2r; s1 += bf2f(k1r); s2 += bf2f(k2r);
                const float q1 = bf2f(q1v[r]), q2 = bf2f(q2v[r]);
                Qx[o] = f2bf(q1 * c - q2 * sn); Qx[o + 16] = f2bf(q2 * c + q1 * sn);
            }
            redA[rg * 32 + i] = s1; redA[rg * 32 + 16 + i] = s2;
        }
        {
            const int dp = tid & 63, rg = tid >> 6;
            if (dp >= 16) {
                const bf16_t* base = Kx + ((size_t)b * SEQ + blk * 256 + rg * 32) * D + h * 128 + dp * 2;
                float s0 = 0.f, s1 = 0.f;
                unsigned uv[32];
#pragma unroll
                for (int r = 0; r < 32; ++r) uv[r] = *(const unsigned*)(base + (size_t)r * D);
#pragma unroll
                for (int r = 0; r < 32; ++r) { s0 += bflo(uv[r]); s1 += bfhi(uv[r]); }
                redB[rg * 128 + dp * 2] = s0; redB[rg * 128 + dp * 2 + 1] = s1;
            }
        }
        __syncthreads();
        if (tid < 128) {
            float s = 0.f;
            if (tid < 32) { for (int r = 0; r < 32; ++r) s += redA[r * 32 + tid]; }
            else { for (int r = 0; r < 8; ++r) s += redB[r * 128 + tid]; }
            kmean[(size_t)item * 128 + tid] = s * (1.f / 256.f);
        }
        __syncthreads();
    }
}

DI void attn_phase(int tid_, int bid_, const bf16_t* Q, const bf16_t* Kx, const bf16_t* VT, bf16_t* O, const float* kmean, unsigned char* smem) {
    constexpr int KB_STRIDE = 288, VB_STRIDE = 144;
    constexpr int KBUF = 64 * KB_STRIDE, VBUF = 128 * VB_STRIDE;
    constexpr float QC = 0.08838834764831845f * 1.4426950408889634f;
    constexpr float THR_RAW = 8.0f / 0.08838834764831845f;
#define KBUFP(bi) (smem + (bi) * KBUF)
#define VBUFP(bi) (smem + 2 * KBUF + (bi) * VBUF)
    float* km = (float*)(smem + 2 * KBUF + 2 * VBUF);
    const int tid = tid_, wid = tid >> 6, lane = tid & 63, fr = lane & 15, fq = lane >> 4;
    for (int idx = bid_; idx < 2048; idx += gridDim.x) {
        const int bh = idx & 63, jj = idx >> 6, sub = jj & 3, rnd = jj >> 2;
        const int r2 = rnd >> 1, half = rnd & 1;
        const int qb = (r2 == 0) ? sub : (r2 == 1) ? (7 - sub) : (r2 == 2) ? (8 + sub) : (15 - sub);
        const int b = bh >> 4, h = bh & 15;
        const size_t tok0 = (size_t)b * SEQ;
        const int qloc = half * 128 + wid * 16 + fr;
        { const f32x4 kv = *(const f32x4*)(kmean + (size_t)bh * 2048 + tid * 4); *(f32x4*)(km + tid * 4) = kv; }
        bf16x8 qf[4];
#pragma unroll
        for (int dc = 0; dc < 4; ++dc) qf[dc] = *(const bf16x8*)(Q + (tok0 + qb * 256 + qloc) * D + h * 128 + dc * 32 + fq * 8);
        __syncthreads();
        const int ntile = qb * 4 + (half ? 4 : 2);
        const int kr0 = tid >> 4, kc0 = tid & 15;
        const int vr0 = tid >> 3, vc0 = tid & 7;
        u32x4 kreg0[2], vreg0[2], kreg1[2], vreg1[2];
        auto gload = [&](int tt, u32x4 (&kreg)[2], u32x4 (&vreg)[2]) {
            const int key0 = tt * 64;
#pragma unroll
            for (int i = 0; i < 2; ++i) {
                kreg[i] = *(const u32x4*)(Kx + (tok0 + key0 + kr0 + i * 32) * D + h * 128 + kc0 * 8);
                vreg[i] = *(const u32x4*)(VT + (size_t)(h * 128 + vr0 + i * 64) * T + tok0 + key0 + vc0 * 8);
            }
        };
        auto lstore = [&](int bi, const u32x4 (&kreg)[2], const u32x4 (&vreg)[2]) {
#pragma unroll
            for (int i = 0; i < 2; ++i) {
                *(u32x4*)(KBUFP(bi) + (kr0 + i * 32) * KB_STRIDE + kc0 * 16) = kreg[i];
                *(u32x4*)(VBUFP(bi) + (vr0 + i * 64) * VB_STRIDE + vc0 * 16) = vreg[i];
            }
        };
        gload(0, kreg0, vreg0);
        if (1 < ntile) gload(1, kreg1, vreg1);
        unsigned mask = 0u;
        {
            float v0 = -3e38f, v1 = -3e38f, v2 = -3e38f; int i0 = -1, i1 = -1, i2 = -1;
            for (int j = 0; j < qb; ++j) {
                float g = 0.f;
#pragma unroll
                for (int dc = 0; dc < 4; ++dc) {
                    const f32x4 ka = *(const f32x4*)(km + j * 128 + dc * 32 + fq * 8), kb2 = *(const f32x4*)(km + j * 128 + dc * 32 + fq * 8 + 4);
#pragma unroll
                    for (int e = 0; e < 4; ++e) { g += bf2f((bf16_t)qf[dc][e]) * ka[e]; g += bf2f((bf16_t)qf[dc][4 + e]) * kb2[e]; }
                }
                g = xsum_fq(g);
                if (g > v0) { v2 = v1; i2 = i1; v1 = v0; i1 = i0; v0 = g; i0 = j; }
                else if (g > v1) { v2 = v1; i2 = i1; v1 = g; i1 = j; }
                else if (g > v2) { v2 = g; i2 = j; }
            }
            if (i0 >= 0) mask |= 1u << i0;
            if (i1 >= 0) mask |= 1u << i1;
            if (i2 >= 0) mask |= 1u << i2;
        }
        float mrun = -1e30f, lrun = 0.f;
        f32x4 oacc[8];
#pragma unroll
        for (int dt = 0; dt < 8; ++dt) oacc[dt] = (f32x4){0.f, 0.f, 0.f, 0.f};
        auto compute = [&](int tt, int bi) {
            const int kb = tt >> 2, kt64 = tt & 3;
            const bool own = (kb == qb);
            const bool actq = own ? true : (((mask >> kb) & 1u) != 0u);
            const bool doit = own ? (kt64 * 64 <= half * 128 + wid * 16 + 15) : (__any((int)actq) != 0);
            if (doit) {
                f32x4 sacc[4];
#pragma unroll
                for (int kt = 0; kt < 4; ++kt) sacc[kt] = (f32x4){0.f, 0.f, 0.f, 0.f};
#pragma unroll
                for (int dc = 0; dc < 4; ++dc)
#pragma unroll
                    for (int kt = 0; kt < 4; ++kt) {
                        const bf16x8 kf = *(const bf16x8*)(KBUFP(bi) + (kt * 16 + fr) * KB_STRIDE + dc * 64 + fq * 16);
                        sacc[kt] = __builtin_amdgcn_mfma_f32_16x16x32_bf16(kf, qf[dc], sacc[kt], 0, 0, 0);
                    }
                const int lim = own ? (qloc - kt64 * 64 - fq * 4) : (actq ? 1000 : -1000);
                float mx = -1e30f;
#pragma unroll
                for (int kt = 0; kt < 4; ++kt)
#pragma unroll
                    for (int r = 0; r < 4; ++r) {
                        const float sv = (kt * 16 + r <= lim) ? sacc[kt][r] : -__builtin_inff();
                        sacc[kt][r] = sv; mx = fmaxf(mx, sv);
                    }
                mx = xmax_fq(mx);
                if (__any((int)(mx > mrun + THR_RAW))) {
                    const float mnew = fmaxf(mrun, mx);
                    const float alpha = __builtin_amdgcn_exp2f((mrun - mnew) * QC);
                    mrun = mnew;
                    lrun *= alpha;
#pragma unroll
                    for (int dt = 0; dt < 8; ++dt) oacc[dt] *= alpha;
                }
                const float mneg = -mrun * QC;
                float ps = 0.f;
#pragma unroll
                for (int kt = 0; kt < 4; ++kt)
#pragma unroll
                    for (int r = 0; r < 4; ++r) { const float pe = __builtin_amdgcn_exp2f(__builtin_fmaf(sacc[kt][r], QC, mneg)); sacc[kt][r] = pe; ps += pe; }
                lrun += ps;
                bf16x8 pf[2];
#pragma unroll
                for (int ks = 0; ks < 2; ++ks) {
                    u32x4 w = {pk_bf16(sacc[2 * ks][0], sacc[2 * ks][1]), pk_bf16(sacc[2 * ks][2], sacc[2 * ks][3]),
                               pk_bf16(sacc[2 * ks + 1][0], sacc[2 * ks + 1][1]), pk_bf16(sacc[2 * ks + 1][2], sacc[2 * ks + 1][3])};
                    pf[ks] = __builtin_bit_cast(bf16x8, w);
                }
#pragma unroll
                for (int ks = 0; ks < 2; ++ks)
#pragma unroll
                    for (int dt = 0; dt < 8; ++dt) {
                        const u32x2 va = *(const u32x2*)(VBUFP(bi) + (dt * 16 + fr) * VB_STRIDE + ks * 64 + fq * 8);
                        const u32x2 vb2 = *(const u32x2*)(VBUFP(bi) + (dt * 16 + fr) * VB_STRIDE + ks * 64 + 32 + fq * 8);
                        u32x4 w = {va[0], va[1], vb2[0], vb2[1]};
                        oacc[dt] = __builtin_amdgcn_mfma_f32_16x16x32_bf16(__builtin_bit_cast(bf16x8, w), pf[ks], oacc[dt], 0, 0, 0);
                    }
            }
        };
        lstore(0, kreg0, vreg0);
        __syncthreads();
        for (int tt = 0; tt < ntile; tt += 2) {
            if (tt + 2 < ntile) gload(tt + 2, kreg0, vreg0);
            compute(tt, 0);
            if (tt + 1 < ntile) lstore(1, kreg1, vreg1);
            lds_barrier();
            if (tt + 1 < ntile) {
                if (tt + 3 < ntile) gload(tt + 3, kreg1, vreg1);
                compute(tt + 1, 1);
                if (tt + 2 < ntile) lstore(0, kreg0, vreg0);
                lds_barrier();
            }
        }
        __syncthreads();
        {
            const float lt = xsum_fq(lrun);
            const float inv = 1.f / lt;
            bf16_t* orow = O + (tok0 + qb * 256 + qloc) * D + h * 128 + fq * 4;
#pragma unroll
            for (int dt = 0; dt < 8; ++dt) {
                const f32x4 o = oacc[dt] * inv;
                u32x2 w = {pk_bf16(o[0], o[1]), pk_bf16(o[2], o[3])};
                *(u32x2*)(orow + dt * 16) = w;
            }
        }
    }
#undef KBUFP
#undef VBUFP
}

DI void rwkv_mix_phase(int tid_, int bid_, const float* x, const float* mu, bf16_t* slots) {
    const size_t n4 = (size_t)T * D / 4;
    const size_t stride = (size_t)gridDim.x * 512;
    constexpr int U = 8;
    for (size_t ib = (size_t)bid_ * 512 + tid_; ib < n4; ib += stride * U) {
        f32x4 xv[U], xp[U];
#pragma unroll
        for (int u = 0; u < U; ++u) {
            const size_t i = ib + u * stride;
            const int t = (int)(i >> 9), s_ = t & (SEQ - 1);
            xv[u] = (i < n4) ? *(const f32x4*)(x + i * 4) : (f32x4){0.f, 0.f, 0.f, 0.f};
            xp[u] = (i < n4 && s_ > 0) ? *(const f32x4*)(x + i * 4 - D) : (f32x4){0.f, 0.f, 0.f, 0.f};
        }
#pragma unroll
        for (int u = 0; u < U; ++u) {
            const size_t i = ib + u * stride;
            if (i >= n4) break;
            const int c = (int)(i & 511) * 4;
            const f32x4 xx = xp[u] - xv[u];
#pragma unroll
            for (int k = 0; k < 6; ++k) {
                const f32x4 m = *(const f32x4*)(mu + k * D + c);
                const f32x4 o = xv[u] + xx * m;
                u32x2 w = {pk_bf16(o[0], o[1]), pk_bf16(o[2], o[3])};
                *(u32x2*)((unsigned char*)slots + k * SLOT + i * 8) = w;
            }
        }
    }
}
DI float softplusf_(float y) { return fmaxf(y, 0.f) + __logf(1.f + __expf(-fabsf(y))); }
DI void rwkv_prep_phase(int tid_, int bid_, const Params& p, unsigned char* sl, float* scal) {
    bf16_t* R = (bf16_t*)(sl + 6 * SLOT); bf16_t* Kk = (bf16_t*)(sl + 7 * SLOT);
    const bf16_t* WP = (const bf16_t*)(sl + 0 * SLOT); bf16_t* AP = (bf16_t*)(sl + 1 * SLOT);
    bf16_t* KX = (bf16_t*)(sl + 3 * SLOT); float* WD = (float*)(sl + 4 * SLOT);
    const float* w0 = p.in[18]; const float* a0 = p.in[21]; const float* k_k = p.in[26]; const float* k_a = p.in[27]; const float* r_k = p.in[28];
    float* BR = scal; float* KR = scal + (size_t)T * 32; float* BO = scal + (size_t)2 * T * 32;
    const int lane = tid_ & 63, wid = tid_ >> 6;
    constexpr int U = 16;
    for (int grp = bid_ * 8 + wid; grp < T * 32 / U; grp += gridDim.x * 8) {
        const int item0 = grp * U;
        const int h0 = item0 & 31; const size_t t = (size_t)(item0 >> 5);
        const size_t o0 = t * D + h0 * 64 + lane;
        bf16_t rr[U], kr_[U], wpr[U], apr[U];
#pragma unroll
        for (int u = 0; u < U; ++u) { rr[u] = R[o0 + u * 64]; kr_[u] = Kk[o0 + u * 64]; wpr[u] = WP[o0 + u * 64]; apr[u] = AP[o0 + u * 64]; }
#pragma unroll
        for (int u = 0; u < U; ++u) {
            const int c = (h0 + u) * 64 + lane; const size_t o = o0 + u * 64;
            const float r = bf2f(rr[u]), k = bf2f(kr_[u]), wp = bf2f(wpr[u]), ap = bf2f(apr[u]);
            const float wlog = -softplusf_(-(w0[c] + wp)) - 0.5f;
            const float dec = __expf(-__expf(wlog));
            const float a = __builtin_amdgcn_rcpf(1.f + __expf(-(a0[c] + ap)));
            float kk = k * k_k[c];
            kk = kk * fminf(__builtin_amdgcn_rsqf(wave_sum(kk * kk)), 1e12f);
            const float kx = k * (1.f + (a - 1.f) * k_a[c]);
            const float bb = kk * a;
            const float br = wave_sum(bb * r), kr = wave_sum(kx * r), bo = wave_sum(r * kx * r_k[c]);
            R[o] = f2bf(dec * r); Kk[o] = f2bf(-kk); AP[o] = f2bf(bb); KX[o] = f2bf(kx); WD[o] = dec;
            if (lane == 0) { BR[item0 + u] = br; KR[item0 + u] = kr; BO[item0 + u] = bo; }
        }
    }
}
DI float dpp_sum8(float v) {
    v += __int_as_float(__builtin_amdgcn_update_dpp(0, __float_as_int(v), 0xB1, 0xF, 0xF, false));
    v += __int_as_float(__builtin_amdgcn_update_dpp(0, __float_as_int(v), 0x4E, 0xF, 0xF, false));
    v += __int_as_float(__builtin_amdgcn_update_dpp(0, __float_as_int(v), 0x141, 0xF, 0xF, false));
    return v;
}
DI void rwkv_scan_phase(int tid_, int bid_, unsigned char* sl, const float* scal, unsigned char* smem) {
    constexpr int TC = 32;
    constexpr int OFF_BB = TC * 128, OFF_KX = OFF_BB + TC * 64, OFF_W = OFF_KX + TC * 64, OFF_V = OFF_W + TC * 64, OFF_SC = OFF_V + TC * 32, BUF_F = OFF_SC + TC * 2;
    constexpr int NCH = SEQ / TC;
#define SBUF(i) ((float*)smem + (i) * BUF_F)
    const bf16_t* NKK = (const bf16_t*)(sl + 7 * SLOT); const bf16_t* WR = (const bf16_t*)(sl + 6 * SLOT);
    const bf16_t* BB = (const bf16_t*)(sl + 1 * SLOT); const bf16_t* KX = (const bf16_t*)(sl + 3 * SLOT);
    const float* WD = (const float*)(sl + 4 * SLOT); const bf16_t* V = (const bf16_t*)(sl + 8 * SLOT);
    bf16_t* Y = (bf16_t*)(sl + 0 * SLOT);
    const float* BR = scal; const float* KR = scal + (size_t)T * 32;
    const int tid = tid_, wid = tid >> 6, lane = tid & 63;
    for (int item = bid_; item < 256; item += gridDim.x) {
        const int half = item & 1, h = (item >> 1) & 31, b = item >> 6;
        const size_t tok0 = (size_t)b * SEQ;
        if (wid >= 4) {
            const int lt = tid - 256, lt_t = lt >> 3, lt_c = lt & 7;
            u32x4 r_nk, r_wr, r_bb, r_kx, r_v = {0u, 0u, 0u, 0u}; f32x4 r_w0, r_w1; float r_s = 0.f;
            auto gload = [&](int c) {
                const size_t tb = tok0 + (size_t)c * TC;
                const size_t o = (tb + lt_t) * D + h * 64 + lt_c * 8;
                r_nk = *(const u32x4*)(NKK + o); r_wr = *(const u32x4*)(WR + o); r_bb = *(const u32x4*)(BB + o); r_kx = *(const u32x4*)(KX + o);
                r_w0 = *(const f32x4*)(WD + (tb + (lt >> 4)) * D + h * 64 + (lt & 15) * 4);
                r_w1 = *(const f32x4*)(WD + (tb + 16 + (lt >> 4)) * D + h * 64 + (lt & 15) * 4);
                if (lt < 128) r_v = *(const u32x4*)(V + (tb + (lt >> 2)) * D + h * 64 + half * 32 + (lt & 3) * 8);
                else if (lt < 192) { const int i = lt - 128; r_s = ((i & 1) ? KR : BR)[(tb + (i >> 1)) * 32 + h]; }
            };
            auto lstore = [&](float* F) {
                float* pp = F + lt_t * 128 + lt_c * 16;
#pragma unroll
                for (int j = 0; j < 4; ++j) { f32x4 q = {bflo(r_nk[j]), bflo(r_wr[j]), bfhi(r_nk[j]), bfhi(r_wr[j])}; *(f32x4*)(pp + j * 4) = q; }
                { float* d = F + OFF_BB + lt_t * 64 + lt_c * 8;
                  f32x4 lo = {bflo(r_bb[0]), bfhi(r_bb[0]), bflo(r_bb[1]), bfhi(r_bb[1])}, hi = {bflo(r_bb[2]), bfhi(r_bb[2]), bflo(r_bb[3]), bfhi(r_bb[3])};
                  *(f32x4*)d = lo; *(f32x4*)(d + 4) = hi; }
                { float* d = F + OFF_KX + lt_t * 64 + lt_c * 8;
                  f32x4 lo = {bflo(r_kx[0]), bfhi(r_kx[0]), bflo(r_kx[1]), bfhi(r_kx[1])}, hi = {bflo(r_kx[2]), bfhi(r_kx[2]), bflo(r_kx[3]), bfhi(r_kx[3])};
                  *(f32x4*)d = lo; *(f32x4*)(d + 4) = hi; }
                *(f32x4*)(F + OFF_W + (lt >> 4) * 64 + (lt & 15) * 4) = r_w0;
                *(f32x4*)(F + OFF_W + (16 + (lt >> 4)) * 64 + (lt & 15) * 4) = r_w1;
                if (lt < 128) { float* d = F + OFF_V + (lt >> 2) * 32 + (lt & 3) * 8;
                  f32x4 lo = {bflo(r_v[0]), bfhi(r_v[0]), bflo(r_v[1]), bfhi(r_v[1])}, hi = {bflo(r_v[2]), bfhi(r_v[2]), bflo(r_v[3]), bfhi(r_v[3])};
                  *(f32x4*)d = lo; *(f32x4*)(d + 4) = hi; }
                else if (lt < 192) F[OFF_SC + (lt - 128)] = r_s;
            };
            gload(0); lstore(SBUF(0)); gload(1);
            __syncthreads();
            for (int c = 0; c < NCH; ++c) {
                if (c + 1 < NCH) lstore(SBUF((c + 1) & 1));
                if (c + 2 < NCH) gload(c + 2);
                lds_barrier();
            }
        } else {
            const int kq = lane & 7, rl = wid * 8 + (lane >> 3);
            f32x2 st[4];
#pragma unroll
            for (int j = 0; j < 4; ++j) st[j] = (f32x2){0.f, 0.f};
            bf16_t* yp = Y + (tok0 + kq) * D + h * 64 + half * 32 + rl;
            __syncthreads();
            struct Ops { f32x4 pq[4], b0, b1, k0, k1, w0, w1; float vv; f32x2 sc; };
            for (int c = 0; c < NCH; ++c) {
                const float* F = SBUF(c & 1);
                const float* fp = F + kq * 16;
                const float* fb = F + OFF_BB + kq * 8;
                auto ld = [&](Ops& o, int t) {
#pragma unroll
                    for (int j = 0; j < 4; ++j) o.pq[j] = *(const f32x4*)(fp + t * 128 + j * 4);
                    o.b0 = *(const f32x4*)(fb + t * 64); o.b1 = *(const f32x4*)(fb + t * 64 + 4);
                    o.k0 = *(const f32x4*)(fb + (OFF_KX - OFF_BB) + t * 64); o.k1 = *(const f32x4*)(fb + (OFF_KX - OFF_BB) + t * 64 + 4);
                    o.w0 = *(const f32x4*)(fb + (OFF_W - OFF_BB) + t * 64); o.w1 = *(const f32x4*)(fb + (OFF_W - OFF_BB) + t * 64 + 4);
                    o.vv = F[OFF_V + t * 32 + rl]; o.sc = *(const f32x2*)(F + OFF_SC + t * 2);
                };
                auto dots = [&](const Ops& o) -> f32x2 {
                    f32x2 acc = {0.f, 0.f}, acc2 = {0.f, 0.f};
#pragma unroll
                    for (int j = 0; j < 4; ++j) {
                        acc += st[j][0] * (f32x2){o.pq[j][0], o.pq[j][1]};
                        acc2 += st[j][1] * (f32x2){o.pq[j][2], o.pq[j][3]};
                    }
                    return acc + acc2;
                };
                auto update = [&](const Ops& o, f32x2 acc) -> float {
                    const float d1 = dpp_sum8(acc[0]), d2 = dpp_sum8(acc[1]);
                    st[0] = st[0] * (f32x2){o.w0[0], o.w0[1]} + d1 * (f32x2){o.b0[0], o.b0[1]} + o.vv * (f32x2){o.k0[0], o.k0[1]};
                    st[1] = st[1] * (f32x2){o.w0[2], o.w0[3]} + d1 * (f32x2){o.b0[2], o.b0[3]} + o.vv * (f32x2){o.k0[2], o.k0[3]};
                    st[2] = st[2] * (f32x2){o.w1[0], o.w1[1]} + d1 * (f32x2){o.b1[0], o.b1[1]} + o.vv * (f32x2){o.k1[0], o.k1[1]};
                    st[3] = st[3] * (f32x2){o.w1[2], o.w1[3]} + d1 * (f32x2){o.b1[2], o.b1[3]} + o.vv * (f32x2){o.k1[2], o.k1[3]};
                    return d2 + d1 * o.sc[0] + o.vv * o.sc[1];
                };
                Ops os[3];
                ld(os[0], 0); ld(os[1], 1);
                float yv = 0.f;
#pragma unroll
                for (int t = 0; t < TC; ++t) {
                    const f32x2 da = dots(os[t % 3]);
                    __builtin_amdgcn_sched_barrier(0);
                    if (t + 2 < TC) ld(os[(t + 2) % 3], t + 2);
                    __builtin_amdgcn_sched_barrier(0);
                    const float ya = update(os[t % 3], da);
                    yv = (kq == (t & 7)) ? ya : yv;
                    if ((t & 7) == 7) yp[(size_t)(c * TC + (t & ~7)) * D] = f2bf(yv);
                }
                lds_barrier();
            }
        }
        __syncthreads();
    }
#undef SBUF
}
DI void rwkv_post_phase(int tid_, int bid_, const Params& p, unsigned char* sl, const float* scal) {
    const bf16_t* Y = (const bf16_t*)(sl + 0 * SLOT); const bf16_t* V = (const bf16_t*)(sl + 8 * SLOT); const bf16_t* G = (const bf16_t*)(sl + 2 * SLOT);
    bf16_t* OUT = (bf16_t*)(sl + 3 * SLOT);
    const float* lg = p.in[29]; const float* lb = p.in[30]; const float* BO = scal + (size_t)2 * T * 32;
    const int lane = tid_ & 63, wid = tid_ >> 6;
    constexpr int U = 16;
    for (int grp = bid_ * 8 + wid; grp < T * 32 / U; grp += gridDim.x * 8) {
        const int item0 = grp * U;
        const int h0 = item0 & 31; const size_t t = (size_t)(item0 >> 5);
        const size_t o0 = t * D + h0 * 64 + lane;
        bf16_t yr[U], vr[U], gr[U]; float bor[U];
#pragma unroll
        for (int u = 0; u < U; ++u) { yr[u] = Y[o0 + u * 64]; vr[u] = V[o0 + u * 64]; gr[u] = G[o0 + u * 64]; bor[u] = BO[item0 + u]; }
#pragma unroll
        for (int u = 0; u < U; ++u) {
            const int c = (h0 + u) * 64 + lane;
            const float y = bf2f(yr[u]);
            const float mean = wave_sum(y) * (1.f / 64.f);
            const float dlt = y - mean;
            const float var = wave_sum(dlt * dlt) * (1.f / 64.f);
            float r = dlt * rsqrtf(var + 64e-5f) * lg[c] + lb[c];
            r += bor[u] * bf2f(vr[u]);
            OUT[o0 + u * 64] = f2bf(r * bf2f(gr[u]));
        }
    }
}

DI void pool_phase(int tid_, int bid_, const float* x, bf16_t* outp) {
    constexpr int CH = 32;
    const int tid = tid_, c = tid * 4, w = 2 << (c >> 9);
    for (int item = bid_; item < T / CH; item += gridDim.x) {
        const int t0 = item * CH, s0 = t0 & (SEQ - 1);
        f32x4 sum = {0.f, 0.f, 0.f, 0.f};
#pragma unroll
        for (int j = 1; j <= 16; ++j) if (j <= w && s0 - j >= 0) sum += *(const f32x4*)(x + (size_t)(t0 - j) * D + c);
#pragma unroll 16
        for (int tt = 0; tt < CH; ++tt) {
            const int t = t0 + tt, s = s0 + tt;
            const f32x4 xv = *(const f32x4*)(x + (size_t)t * D + c);
            sum += xv;
            if (s - w >= 0) sum -= *(const f32x4*)(x + (size_t)(t - w) * D + c);
            const float rc = __builtin_amdgcn_rcpf((float)((s + 1 < w) ? (s + 1) : w));
            const f32x4 o = sum * rc - xv;
            u32x2 wv = {pk_bf16(o[0], o[1]), pk_bf16(o[2], o[3])};
            *(u32x2*)(outp + (size_t)t * D + c) = wv;
        }
    }
}

#define XB_TMO      128
#define XB_XCNT(j)  (256  + 64 * (j))
#define XB_XSUB(j)  (1280 + 64 * (j))
#define XB_XGEN(j)  (2304 + 64 * (j))
#define XB_TOP      3328
#define XB_TOPGEN   3392
#define XCD_BAR_WORDS 3456
#define XB_SPIN_CAP (1u << 18)
DI unsigned xb_ld(unsigned* p) { return __hip_atomic_load(p, __ATOMIC_RELAXED, __HIP_MEMORY_SCOPE_AGENT); }
DI unsigned xb_add(unsigned* p, unsigned v) { return __hip_atomic_fetch_add(p, v, __ATOMIC_RELAXED, __HIP_MEMORY_SCOPE_AGENT); }
DI unsigned xb_xcc_id() { return (unsigned)__builtin_amdgcn_s_getreg((3 << 11) | 20) & 0xFu; }
#define XB_SPIN(cond, bar) do { unsigned _sp = 0; while (cond) { __builtin_amdgcn_s_sleep(1); \
    if ((++_sp & 255u) == 0u) { if (xb_ld(&(bar)[XB_TMO])) break; if (_sp > XB_SPIN_CAP) { atomicAdd(&(bar)[XB_TMO], 1u); break; } } } } while (0)
struct XcdBarrier { unsigned* bar; unsigned x; volatile LAS unsigned* st; };
DI XcdBarrier xcd_barrier_post(int tid, unsigned* bar, volatile LAS unsigned* st) {
    XcdBarrier b; b.bar = bar; b.x = xb_xcc_id(); b.st = st;
    if (tid == 0) (void)xb_add(&bar[XB_XCNT(b.x)], 1u);
    return b;
}
DI void xcd_barrier_complete(unsigned* bar, unsigned x, unsigned& nloc, unsigned& nx) {
    const unsigned G = gridDim.x * gridDim.y * gridDim.z;
    unsigned sum, cnt, mine, sp = 0u;
    for (;;) {
        sum = 0u; cnt = 0u; mine = 0u;
#pragma unroll
        for (unsigned j = 0; j < 16; ++j) { const unsigned c = xb_ld(&bar[XB_XCNT(j)]); sum += c; cnt += (c > 0u) ? 1u : 0u; mine = (j == x) ? c : mine; }
        if (sum == G) break;
        __builtin_amdgcn_s_sleep(1);
        if ((++sp & 255u) == 0u) { if (xb_ld(&bar[XB_TMO])) break; if (sp > XB_SPIN_CAP) { atomicAdd(&bar[XB_TMO], 1u); break; } }
    }
    nloc = mine > 0u ? mine : 1u; nx = cnt > 0u ? cnt : 1u;
}
DI void xcd_barrier(int tid, const XcdBarrier& b) {
    asm volatile("s_waitcnt vmcnt(0)" ::: "memory");
    __syncthreads();
    if (tid == 0) {
        unsigned* bar = b.bar;
        __builtin_amdgcn_s_waitcnt(0);
        unsigned nloc = b.st[0], nx = b.st[1];
        if (nloc == 0u) { xcd_barrier_complete(bar, b.x, nloc, nx); b.st[0] = nloc; b.st[1] = nx; }
        const unsigned old = xb_add(&bar[XB_XSUB(b.x)], 1u);
        const unsigned gen = old / nloc;
        if (old + 1u == (gen + 1u) * nloc) {
            __builtin_amdgcn_fence(__ATOMIC_RELEASE, "agent");
            asm volatile("s_waitcnt vmcnt(0)" ::: "memory");
            const unsigned og = xb_add(&bar[XB_TOP], 1u);
            const unsigned tg = og / nx;
            if (og + 1u == (tg + 1u) * nx) xb_add(&bar[XB_TOPGEN], 1u);
            else XB_SPIN(xb_ld(&bar[XB_TOPGEN]) == tg, bar);
            __builtin_amdgcn_fence(__ATOMIC_ACQUIRE, "agent");
            xb_add(&bar[XB_XGEN(b.x)], 1u);
            asm volatile("s_waitcnt vmcnt(0)" ::: "memory");
        } else {
            XB_SPIN(xb_ld(&bar[XB_XGEN(b.x)]) == gen, bar);
            __builtin_amdgcn_fence(__ATOMIC_ACQUIRE, "agent");
            asm volatile("s_waitcnt vmcnt(0)" ::: "memory");
        }
    }
    __syncthreads();
}

enum { K_PREP = 0, K_GACT, K_GRES, K_LN, K_RGCONV, K_RGSCAN0, K_RGSCAN1, K_KMEAN, K_ATTN, K_RMIX, K_RPREP, K_RSCAN, K_RPOST, K_POOL };
constexpr int NSTEPS = 38;
struct Desc {
    int kind;
    pg8::Gemm g;
    bf16_t* C; const float* res; const float* cscale; long sC; int ldc; unsigned acts;
    int lnidx, lnlast;
};
DI bool step_nosync(int st) { return st == 11 || st == 21; }
DI Desc make_desc(int st, const Params& p, unsigned char* ws) {
    unsigned char* sl = ws + O_SLOT;
    auto slot = [&](int i) { return (bf16_t*)(sl + (size_t)i * SLOT); };
    bf16_t* xb = slot(8);
    Desc d; d.kind = K_PREP; d.g = mk_gemm(nullptr, nullptr, 0, 0, 0, 0, 0, 0, 0, 0);
    d.C = nullptr; d.res = nullptr; d.cscale = nullptr; d.sC = 0; d.ldc = D; d.acts = 0u; d.lnidx = 0; d.lnlast = 0;
    int layer = -1, sub = 0;
    if (st >= 7 && st < 11) { layer = 0; sub = st - 7; }
    else if (st >= 16 && st < 20) { layer = 1; sub = st - 16; }
    else if (st >= 28 && st < 32) { layer = 2; sub = st - 28; }
    else if (st >= 34 && st < 38) { layer = 3; sub = st - 34; }
    if (layer >= 0) {
        if (sub == 0) { d.kind = K_LN; d.lnidx = layer * 2; }
        else if (sub == 1) { d.kind = K_GACT; d.C = slot(0); d.ldc = DFF; d.acts = 1u;
            d.g = mk_gemm(xb, (const bf16_t*)(ws + O_W1T + (size_t)layer * DFF * D * 2), 0, 0, D, D, D, T / 256, DFF / 256, 1); }
        else if (sub == 2) { d.kind = K_GRES;
            d.g = mk_gemm(slot(0), (const bf16_t*)(ws + O_W2T + (size_t)layer * DFF * D * 2), 0, 0, DFF, DFF, DFF, T / 256, D / 256, 1); }
        else { d.kind = K_LN; d.lnidx = layer * 2 + 1; d.lnlast = (layer == 3); }
        return d;
    }
    switch (st) {
    case 0: d.kind = K_PREP; break;
    case 1: d.kind = K_GACT; d.C = slot(0); d.ldc = 4096;
            d.g = mk_gemm(xb, (const bf16_t*)(ws + O_WIN), 0, 0, D, D, D, T / 256, 4096 / 256, 1); break;
    case 2: d.kind = K_RGCONV; break;
    case 3: d.kind = K_GACT; d.C = slot(3); d.sC = 512; d.ldc = 4096;
            d.g = mk_gemm(slot(2), (const bf16_t*)(ws + O_GATES), 256, 512 * 256, D, 256, 256, T / 256, 2, 8); break;
    case 4: d.kind = K_RGSCAN0; break;
    case 5: d.kind = K_RGSCAN1; break;
    case 6: d.kind = K_GRES; d.res = p.in[0];
            d.g = mk_gemm(slot(5), (const bf16_t*)(ws + O_RGOUT), 0, 0, D, D, D, T / 256, D / 256, 1); break;
    case 11: d.kind = K_GACT; d.C = slot(0); d.sC = (long)T * D;
             d.g = mk_gemm(xb, (const bf16_t*)(ws + O_QKV), 0, (long)D * D, D, D, D, T / 256, D / 256, 2); break;
    case 12: d.kind = K_GACT; d.C = slot(2); d.ldc = T;
             d.g = mk_gemm((const bf16_t*)(ws + O_QKV + 2 * SZ_DD), xb, 0, 0, D, D, D, D / 256, T / 256, 1); break;
    case 13: d.kind = K_KMEAN; break;
    case 14: d.kind = K_ATTN; break;
    case 15: d.kind = K_GRES;
             d.g = mk_gemm(slot(3), (const bf16_t*)(ws + O_MOUT), 0, 0, D, D, D, T / 256, D / 256, 1); break;
    case 20: d.kind = K_RMIX; break;
    case 21: d.kind = K_GACT; d.C = slot(6); d.sC = (long)T * D;
             d.g = mk_gemm(slot(0), (const bf16_t*)(ws + O_RKV), (long)T * D, (long)D * D, D, D, D, T / 256, D / 256, 3); break;
    case 22: d.kind = K_GACT; d.C = (bf16_t*)(ws + O_L1O); d.sC = (long)T * 256; d.ldc = 256; d.acts = 0x302u;
             d.g = mk_gemm(slot(3), (const bf16_t*)(ws + O_L1), (long)T * D, (long)256 * D, D, D, D, T / 256, 1, 3); break;
    case 23: d.kind = K_GACT; d.C = slot(0); d.sC = (long)T * D;
             d.g = mk_gemm((const bf16_t*)(ws + O_L1O), (const bf16_t*)(ws + O_L2), (long)T * 256, (long)D * 256, 256, 256, 256, T / 256, D / 256, 3); break;
    case 24: d.kind = K_RPREP; break;
    case 25: d.kind = K_RSCAN; break;
    case 26: d.kind = K_RPOST; break;
    case 27: d.kind = K_GRES;
             d.g = mk_gemm(slot(3), (const bf16_t*)(ws + O_ROUT), 0, 0, D, D, D, T / 256, D / 256, 1); break;
    case 32: d.kind = K_POOL; break;
    case 33: d.kind = K_GRES; d.cscale = p.in[33]; d.sC = 512;
             d.g = mk_gemm(slot(0), (const bf16_t*)(ws + O_POOL), 512, 512 * 512, D, 512, 512, T / 256, 2, 4); break;
    default: break;
    }
    return d;
}

__global__ void __launch_bounds__(512, 2) fwd_megakernel(Params p) {
    extern __shared__ __attribute__((aligned(16))) unsigned char smem[];
    cg::grid_group grid = cg::this_grid();
    LAS unsigned char* lds = (LAS unsigned char*)smem;

    const bool multi = (p.hi - p.lo) > 1;
    volatile LAS unsigned* xst = (volatile LAS unsigned*)(lds + 131072);
    if (__builtin_amdgcn_workitem_id_x() == 0) { xst[0] = 0u; xst[1] = 0u; }
    __syncthreads();
    (void)xcd_barrier_post((int)__builtin_amdgcn_workitem_id_x(), (unsigned*)(p.ws + O_BAR), xst);
    for (int st = p.lo; st < p.hi; ++st) {
        int tid_ = (int)__builtin_amdgcn_workitem_id_x(); asm volatile("" : "+v"(tid_));
        int bid_ = (int)__builtin_amdgcn_workgroup_id_x(); asm volatile("" : "+s"(bid_));
        unsigned char* ws = p.ws; asm volatile("" : "+s"(ws));
        float* xcur = p.out; asm volatile("" : "+s"(xcur));
        unsigned char* sl = ws + O_SLOT;
        auto slot = [&](int i) { return (bf16_t*)(sl + (size_t)i * SLOT); };
        const int stu = __builtin_amdgcn_readfirstlane(st);
        const Desc d = make_desc(stu, p, ws);
        switch (__builtin_amdgcn_readfirstlane(d.kind)) {
        case K_PREP: prep_phase(tid_, bid_, p, smem); break;
        case K_GACT: { pg8::EpiAct E; E.C = d.C; E.sC = d.sC; E.ldc = d.ldc; E.acts = d.acts; pg8::gemm_phase(tid_, bid_, lds, d.g, E); } break;
        case K_GRES: { pg8::EpiRes E; E.out = xcur; E.res = d.res ? d.res : xcur; E.cscale = d.cscale; E.alpha = ALPHA; E.sC = d.sC; E.ldc = D; pg8::gemm_phase(tid_, bid_, lds, d.g, E); } break;
        case K_LN: ln_phase(tid_, bid_, xcur, xcur, d.lnlast ? nullptr : slot(8), p.in[1] + (size_t)d.lnidx * D, p.in[2] + (size_t)d.lnidx * D); break;
        case K_RGCONV: rg_conv_phase(tid_, bid_, slot(0), slot(2), p.in[6], p.in[7]); break;
        case K_RGSCAN0: rg_scan_phase<0>(tid_, bid_, p, slot(3), slot(2), slot(0), (float*)(ws + O_AGG), slot(5)); break;
        case K_RGSCAN1: rg_scan_phase<1>(tid_, bid_, p, slot(3), slot(2), slot(0), (float*)(ws + O_AGG), slot(5)); break;
        case K_KMEAN: kmean_phase(tid_, bid_, slot(0), slot(1), (float*)(ws + O_KMEAN), (const float*)(ws + O_ROPE), (const float*)(ws + O_ROPE) + SEQ * 16, smem); break;
        case K_ATTN: attn_phase(tid_, bid_, slot(0), slot(1), slot(2), slot(3), (const float*)(ws + O_KMEAN), smem); break;
        case K_RMIX: rwkv_mix_phase(tid_, bid_, xcur, p.in[16], slot(0)); break;
        case K_RPREP: rwkv_prep_phase(tid_, bid_, p, sl, (float*)(ws + O_SCAL)); break;
        case K_RSCAN: rwkv_scan_phase(tid_, bid_, sl, (const float*)(ws + O_SCAL), smem); break;
        case K_RPOST: rwkv_post_phase(tid_, bid_, p, sl, (const float*)(ws + O_SCAL)); break;
        case K_POOL: pool_phase(tid_, bid_, xcur, slot(0)); break;
        default: break;
        }
        if (multi && !step_nosync(st) && st + 1 < p.hi) { if (st == p.lo) grid.sync(); else { XcdBarrier xb; xb.bar = (unsigned*)(ws + O_BAR); xb.x = xb_xcc_id(); xb.st = (volatile LAS unsigned*)(lds + 131072); xcd_barrier(tid_, xb); } }
    }
}

extern "C" void kernel_launch(void* const* d_in, const int* in_sizes, int n_in, void* d_out, int out_size, void* d_ws, size_t ws_size, hipStream_t stream) {
    static int grid = 0;
    if (grid == 0) {
        if (n_in != 34 || out_size != T * D || ws_size < WS_END) { fprintf(stderr, "kernel_launch: unexpected shapes (n_in %d out %d ws %zu need %zu)\n", n_in, out_size, ws_size, (size_t)WS_END); grid = -1; return; }
        int dev = 0, cus = 0, per_cu = 0;
        hipGetDevice(&dev);
        hipDeviceGetAttribute(&cus, hipDeviceAttributeMultiprocessorCount, dev);
        if (hipFuncSetAttribute((const void*)fwd_megakernel, hipFuncAttributeMaxDynamicSharedMemorySize, LDS_BYTES) != hipSuccess) { fprintf(stderr, "kernel_launch: hipFuncSetAttribute failed\n"); grid = -1; return; }
        hipOccupancyMaxActiveBlocksPerMultiprocessor(&per_cu, (const void*)fwd_megakernel, 512, LDS_BYTES);
        if (per_cu < 1) { fprintf(stderr, "kernel_launch: occupancy query says %d blocks/CU\n", per_cu); per_cu = 1; }
        (void)hipGetLastError();
        grid = cus;
    }
    if (grid < 0) return;
    Params p{};
    for (int i = 0; i < 34; ++i) p.in[i] = (const float*)d_in[i];
    {
        unsigned char* ws = (unsigned char*)d_ws; int nj = 0, t0 = 0;
        auto add = [&](const float* src, size_t dstoff, int Ks, int Ns, int Kd, int Nd) {
            TJob& j = p.tj[nj]; j.src = src; j.dst = (bf16_t*)(ws + dstoff); j.Ks = Ks; j.Ns = Ns; j.Kd = Kd; j.Nd = Nd; j.tile0 = t0; j.pad = 0;
            t0 += (Kd / 128) * (Nd / 128); ++nj; };
        for (int l = 0; l < 4; ++l) add(p.in[3] + (size_t)l * D * DFF, O_W1T + (size_t)l * DFF * D * 2, D, DFF, D, DFF);
        for (int l = 0; l < 4; ++l) add(p.in[4] + (size_t)l * D * DFF, O_W2T + (size_t)l * DFF * D * 2, DFF, D, DFF, D);
        add(p.in[5], O_WIN, D, 4096, D, 4096);
        for (int n = 0; n < 8; ++n) { add(p.in[8] + (size_t)n * 65536, O_GATES + (size_t)n * 512 * 256 * 2, 256, 256, 256, 256);
                                      add(p.in[10] + (size_t)n * 65536, O_GATES + ((size_t)n * 512 + 256) * 256 * 2, 256, 256, 256, 256); }
        add(p.in[13], O_RGOUT, D, D, D, D);
        add(p.in[14], O_QKV, D, 3 * D, D, 3 * D);
        add(p.in[15], O_MOUT, D, D, D, D);
        for (int g = 0; g < 3; ++g) add(p.in[17] + (size_t)g * D * D, O_RKV + g * SZ_DD, D, D, D, D);
        add(p.in[19], O_L1 + 0 * (size_t)256 * D * 2, D, 96, D, 256);
        add(p.in[22], O_L1 + 1 * (size_t)256 * D * 2, D, 96, D, 256);
        add(p.in[24], O_L1 + 2 * (size_t)256 * D * 2, D, 256, D, 256);
        add(p.in[20], O_L2 + 0 * (size_t)D * 256 * 2, 96, D, 256, D);
        add(p.in[23], O_L2 + 1 * (size_t)D * 256 * 2, 96, D, 256, D);
        add(p.in[25], O_L2 + 2 * (size_t)D * 256 * 2, 256, D, 256, D);
        add(p.in[31], O_ROUT, D, D, D, D);
        for (int g = 0; g < 4; ++g) add(p.in[32] + (size_t)g * 512 * 512, O_POOL + (size_t)g * 512 * 512 * 2, 512, 512, 512, 512);
        p.ntiles = t0;
        if (nj != NTJ) fprintf(stderr, "kernel_launch: job table size %d != %d\n", nj, NTJ);
    }
    p.out = (float*)d_out; p.ws = (unsigned char*)d_ws; p.lo = 0; p.hi = NSTEPS;
    if (hipMemsetAsync((unsigned char*)d_ws + O_BAR, 0, BAR_BYTES, stream) != hipSuccess) { fprintf(stderr, "kernel_launch: memset of barrier words failed\n"); return; }
    void* args[] = {&p};
    hipError_t e = hipLaunchCooperativeKernel((const void*)fwd_megakernel, dim3(grid), dim3(512), args, LDS_BYTES, stream);
    if (e != hipSuccess) fprintf(stderr, "cooperative launch failed: %s (grid %d)\n", hipGetErrorString(e), grid);
}
```

```cpp
#include <hip/hip_runtime.h>
#include <hip/hip_cooperative_groups.h>
#include <cstdio>
namespace cg = cooperative_groups;

#define LAS __attribute__((address_space(3)))
typedef unsigned short bf16_t;
typedef short bf16x8 __attribute__((ext_vector_type(8)));
typedef float f32x4 __attribute__((ext_vector_type(4)));
typedef float f32x2 __attribute__((ext_vector_type(2)));
typedef unsigned u32x4 __attribute__((ext_vector_type(4)));
typedef unsigned u32x2 __attribute__((ext_vector_type(2)));
typedef __bf16 bfv2 __attribute__((ext_vector_type(2)));
#define DI __device__ __forceinline__

constexpr int T = 16384, D = 2048, SEQ = 4096, DFF = 8192;
constexpr float ALPHA = 1.6817928305074290f;
constexpr float LN_EPS = 1e-5f;

constexpr size_t SZ_DD = (size_t)D * D * 2;
constexpr size_t O_W1T = 0;
constexpr size_t O_W2T = O_W1T + 4 * (size_t)DFF * D * 2;
constexpr size_t O_WIN = O_W2T + 4 * (size_t)DFF * D * 2;
constexpr size_t O_GATES = O_WIN + (size_t)4096 * D * 2;
constexpr size_t O_RGOUT = O_GATES + (size_t)8 * 512 * 256 * 2;
constexpr size_t O_QKV = O_RGOUT + SZ_DD;
constexpr size_t O_MOUT = O_QKV + 3 * SZ_DD;
constexpr size_t O_RKV = O_MOUT + SZ_DD;
constexpr size_t O_L1 = O_RKV + 3 * SZ_DD;
constexpr size_t O_L2 = O_L1 + (size_t)3 * 256 * D * 2;
constexpr size_t O_ROUT = O_L2 + (size_t)3 * D * 256 * 2;
constexpr size_t O_POOL = O_ROUT + SZ_DD;
constexpr size_t O_SLOT = O_POOL + (size_t)4 * 512 * 512 * 2;
constexpr size_t SLOT = (size_t)T * D * 2;
constexpr size_t O_L1O = O_SLOT + 9 * SLOT;
constexpr size_t O_ROPE = O_L1O + (size_t)3 * T * 256 * 2;
constexpr size_t O_KMEAN = O_ROPE + (size_t)2 * SEQ * 16 * 4;
constexpr size_t O_AGG = O_KMEAN + (size_t)64 * 16 * 128 * 4;
constexpr size_t O_SCAL = O_AGG + (size_t)4 * 128 * D * 2 * 4;
constexpr size_t O_BAR = O_SCAL + (size_t)3 * T * 32 * 4;
constexpr size_t BAR_BYTES = 16384;
constexpr size_t WS_END = O_BAR + BAR_BYTES;

constexpr int LDS_BYTES = 131072 + 16;

struct TJob { const float* src; bf16_t* dst; int Ks, Ns, Kd, Nd, tile0, pad; };
constexpr int NTJ = 42;
struct Params {
    const float* in[34];
    float* out;
    unsigned char* ws;
    int lo, hi, ntiles, pad;
    TJob tj[NTJ];
};

DI unsigned pk_bf16(float a, float b) { f32x2 v = {a, b}; bfv2 r = __builtin_convertvector(v, bfv2); return __builtin_bit_cast(unsigned, r); }
DI bf16_t f2bf(float a) { return (bf16_t)(pk_bf16(a, 0.f) & 0xffffu); }
DI float bf2f(bf16_t b) { return __uint_as_float(((unsigned)b) << 16); }
DI float bflo(unsigned u) { return __uint_as_float(u << 16); }
DI float bfhi(unsigned u) { return __uint_as_float(u & 0xffff0000u); }
DI float wave_sum(float v) {
    v += __int_as_float(__builtin_amdgcn_update_dpp(0, __float_as_int(v), 0xB1, 0xF, 0xF, false));
    v += __int_as_float(__builtin_amdgcn_update_dpp(0, __float_as_int(v), 0x4E, 0xF, 0xF, false));
    v += __int_as_float(__builtin_amdgcn_update_dpp(0, __float_as_int(v), 0x141, 0xF, 0xF, false));
    v += __int_as_float(__builtin_amdgcn_update_dpp(0, __float_as_int(v), 0x140, 0xF, 0xF, false));
    const int iv = __float_as_int(v);
    return __int_as_float(__builtin_amdgcn_readlane(iv, 0)) + __int_as_float(__builtin_amdgcn_readlane(iv, 16)) +
           __int_as_float(__builtin_amdgcn_readlane(iv, 32)) + __int_as_float(__builtin_amdgcn_readlane(iv, 48));
}
DI float xmax_fq(float v) {
    const auto a = __builtin_amdgcn_permlane32_swap(__float_as_uint(v), __float_as_uint(v), false, false);
    v = fmaxf(__uint_as_float(a[0]), __uint_as_float(a[1]));
    const auto b = __builtin_amdgcn_permlane16_swap(__float_as_uint(v), __float_as_uint(v), false, false);
    return fmaxf(__uint_as_float(b[0]), __uint_as_float(b[1]));
}
DI float xsum_fq(float v) {
    const auto a = __builtin_amdgcn_permlane32_swap(__float_as_uint(v), __float_as_uint(v), false, false);
    v = __uint_as_float(a[0]) + __uint_as_float(a[1]);
    const auto b = __builtin_amdgcn_permlane16_swap(__float_as_uint(v), __float_as_uint(v), false, false);
    return __uint_as_float(b[0]) + __uint_as_float(b[1]);
}
DI void lds_barrier() { asm volatile("s_waitcnt lgkmcnt(0)" ::: "memory"); __builtin_amdgcn_s_barrier(); asm volatile("" ::: "memory"); }
DI float sigmoidf_(float x) { return __builtin_amdgcn_rcpf(1.f + __expf(-x)); }
DI float tanhf_(float x) { return 1.f - 2.f * __builtin_amdgcn_rcpf(1.f + __expf(2.f * x)); }
DI float gelu_tanh(float x) { const float u = 0.7978845608028654f * (x + 0.044715f * x * x * x); return 0.5f * x * (1.f + tanhf_(u)); }

namespace pg8 {
constexpr int BM = 256, BK = 64, HALF = 128, HTB = HALF * BK * 2, NXCD = 8, WGM = 4;
DI int lds_byte(int r, int c) { const int st = (r >> 4) * 2 + (c >> 5), rr = r & 15, cc = c & 31, ob = rr * 64 + cc * 2; return st * 1024 + (ob ^ (((ob >> 9) & 1) << 5)); }
DI void stage_rc(int b, int& R, int& C) { const int st = b / 1024, sb = b % 1024, swz = sb ^ (((sb >> 9) & 1) << 5); R = (st >> 1) * 16 + swz / 64; C = (st & 1) * 32 + (swz % 64) / 2; }
DI int perm32(int rho) { const int n = rho >> 4, i = rho & 15; return 8 * (i >> 2) + 4 * n + (i & 3); }

struct Unit { int g, pm, pn; };
struct Gemm { const bf16_t* A; const bf16_t* Bt; long sA, sB; int lda, ldb, K, nM, nN, G; };

struct Order {
    int nM, nN, nwg, tot, Gd, c;
    DI void init(const Gemm& g, int Gd_, int c_) { nM = g.nM; nN = g.nN; nwg = nM * nN; tot = nwg * g.G; Gd = Gd_; c = c_; }
    DI bool next(int i, Unit& u) const {
        const long L = (long)i * Gd + c; if (L >= tot) return false;
        const int grp = (int)(L / nwg); int wgid = (int)(L - (long)grp * nwg);
        { const int q = nwg / NXCD, r = nwg % NXCD, xcd = wgid % NXCD, off = wgid / NXCD; wgid = (xcd < r ? xcd * (q + 1) : r * (q + 1) + (xcd - r) * q) + off; }
        const int nig = WGM * nN, gid = wgid / nig, fm = gid * WGM, gsz = (nM - fm) < WGM ? (nM - fm) : WGM;
        u.g = grp; u.pm = fm + ((wgid % nig) % gsz); u.pn = (wgid % nig) / gsz; return true;
    }
};

struct EpiAct {
    static constexpr bool PERM = true;
    bf16_t* C; long sC; int ldc; unsigned acts;
    DI void operator()(const f32x4 (&acc)[2][2][4][2], const Unit& u, int wr, int wc, int fr, int fq) const {
        bf16_t* base = C + (size_t)u.g * sC;
        const int act = (int)((acts >> (4 * u.g)) & 15u);
        const int row0 = u.pm * BM + wr * 64 + fr, col0 = u.pn * BM + wc * 32 + 8 * fq;
#pragma unroll
        for (int ai = 0; ai < 2; ++ai)
#pragma unroll
            for (int m = 0; m < 4; ++m) {
                bf16_t* rowp = base + (size_t)(row0 + ai * HALF + m * 16) * ldc + col0;
#pragma unroll
                for (int bj = 0; bj < 2; ++bj) {
                    float v[8];
#pragma unroll
                    for (int e = 0; e < 4; ++e) { v[e] = acc[ai][bj][m][0][e]; v[4 + e] = acc[ai][bj][m][1][e]; }
                    if (act == 1) {
#pragma unroll
                        for (int e = 0; e < 8; ++e) { const float t = fmaxf(v[e], 0.f); v[e] = t * t; }
                    } else if (act == 2) {
#pragma unroll
                        for (int e = 0; e < 8; ++e) v[e] = tanhf_(v[e]);
                    } else if (act == 3) {
#pragma unroll
                        for (int e = 0; e < 8; ++e) v[e] = sigmoidf_(v[e]);
                    }
                    u32x4 o = {pk_bf16(v[0], v[1]), pk_bf16(v[2], v[3]), pk_bf16(v[4], v[5]), pk_bf16(v[6], v[7])};
                    *(u32x4*)(rowp + bj * HALF) = o;
                }
            }
    }
};
struct EpiRes {
    static constexpr bool PERM = false;
    float* out; const float* res; const float* cscale; float alpha; long sC; int ldc;
    DI void operator()(const f32x4 (&acc)[2][2][4][2], const Unit& u, int wr, int wc, int fr, int fq) const {
        const int row0 = u.pm * BM + wr * 64 + fr, col0 = (int)(u.g * sC) + u.pn * BM + wc * 32 + 4 * fq;
        f32x4 r[2][2][2][2];
        auto ldq = [&](int q, int buf) {
            const int ai = q >> 1, m0 = (q & 1) * 2;
#pragma unroll
            for (int mm = 0; mm < 2; ++mm) {
                const size_t ro = (size_t)(row0 + ai * HALF + (m0 + mm) * 16) * ldc + col0;
#pragma unroll
                for (int bj = 0; bj < 2; ++bj)
#pragma unroll
                    for (int n = 0; n < 2; ++n) r[buf][mm][bj][n] = *(const f32x4*)(res + ro + bj * HALF + n * 16);
            }
        };
        auto stq = [&](int q, int buf) {
            const int ai = q >> 1, m0 = (q & 1) * 2;
#pragma unroll
            for (int mm = 0; mm < 2; ++mm) {
                const size_t ro = (size_t)(row0 + ai * HALF + (m0 + mm) * 16) * ldc + col0;
#pragma unroll
                for (int bj = 0; bj < 2; ++bj)
#pragma unroll
                    for (int n = 0; n < 2; ++n) {
                        f32x4 a = acc[ai][bj][m0 + mm][n];
                        if (cscale) a *= *(const f32x4*)(cscale + col0 + bj * HALF + n * 16);
                        *(f32x4*)(out + ro + bj * HALF + n * 16) = alpha * r[buf][mm][bj][n] + a;
                    }
            }
        };
        ldq(0, 0); ldq(1, 1);
        __builtin_amdgcn_sched_barrier(0);
        stq(0, 0); ldq(2, 0);
        __builtin_amdgcn_sched_barrier(0);
        stq(1, 1); ldq(3, 1);
        __builtin_amdgcn_sched_barrier(0);
        stq(2, 0); stq(3, 1);
    }
};
template <class Epi>
DI void gemm_phase(int tid_, int bid_, LAS unsigned char* lds, const Gemm g, const Epi& E) {
    const int tid = tid_, wid = __builtin_amdgcn_readfirstlane(tid >> 6), lane = tid & 63, wr = wid >> 2, wc = wid & 3, fr = lane & 15, fq = lane >> 4;
    const int K = g.K, nt = K / BK;
    Order S; S.init(g, (int)gridDim.x, (int)bid_);
    unsigned voffA[2], voffB[2];
#pragma unroll
    for (int i = 0; i < 2; ++i) { int R, C; stage_rc(tid * 16 + i * 8192, R, C); const int Rb = Epi::PERM ? ((R & ~31) + perm32(R & 31)) : R;
        voffA[i] = (unsigned)(R * g.lda + C) * 2u; voffB[i] = (unsigned)(Rb * g.ldb + C) * 2u; }
    const size_t kstep = (size_t)(BK * 2);
    const size_t hA = (size_t)HALF * g.lda * 2, hB = (size_t)HALF * g.ldb * 2;
    const unsigned ldsw = (unsigned)wid * 1024u;
    const int aoff = lds_byte(wr * 64 + fr, fq * 8), boff = lds_byte(wc * 32 + fr, fq * 8);
#define PG8_SA(b, h) (((b) * 2 + (h)) * HTB)
#define PG8_SB(b, h) ((4 + (b) * 2 + (h)) * HTB)
#define PG8_STAGE(bufoff, gbase, voff) do { _Pragma("unroll") for (int _i = 0; _i < 2; ++_i) \
        __builtin_amdgcn_global_load_lds((const unsigned*)((const char*)(gbase) + (voff)[_i]), (LAS unsigned*)(lds + (bufoff) + ldsw + _i * 8192), 16, 0, 0); } while (0)
#define PG8_LDA(dst, b, h) do { _Pragma("unroll") for (int m = 0; m < 4; ++m) _Pragma("unroll") for (int k = 0; k < 2; ++k) dst[m][k] = *(const LAS bf16x8*)(lds + PG8_SA(b, h) + aoff + m * 2048 + k * 1024); } while (0)
#define PG8_LDB(dst, b, h) do { _Pragma("unroll") for (int n = 0; n < 2; ++n) _Pragma("unroll") for (int k = 0; k < 2; ++k) dst[n][k] = *(const LAS bf16x8*)(lds + PG8_SB(b, h) + boff + n * 2048 + k * 1024); } while (0)
#define PG8_MMA(ai, bj, At, Bt) do { __builtin_amdgcn_s_setprio(1); _Pragma("unroll") for (int m = 0; m < 4; ++m) _Pragma("unroll") for (int n = 0; n < 2; ++n) _Pragma("unroll") for (int k = 0; k < 2; ++k) \
        acc[ai][bj][m][n] = __builtin_amdgcn_mfma_f32_16x16x32_bf16(Bt[n][k], At[m][k], acc[ai][bj][m][n], 0, 0, 0); __builtin_amdgcn_s_setprio(0); } while (0)
#define PG8_WAIT_V(n) asm volatile("s_waitcnt vmcnt(" #n ")" ::: "memory")
#define PG8_WAIT_L(n) asm volatile("s_waitcnt lgkmcnt(" #n ")" ::: "memory")
#define PG8_BAR __builtin_amdgcn_s_barrier()
#define PG8_SCHED __builtin_amdgcn_sched_barrier(0)
    Unit cur, nxt; int ui = 0;
    if (!S.next(0, cur)) return;
    f32x4 acc[2][2][4][2];
#pragma unroll
    for (int a = 0; a < 2; ++a)
#pragma unroll
        for (int b = 0; b < 2; ++b)
#pragma unroll
            for (int m = 0; m < 4; ++m)
#pragma unroll
                for (int n = 0; n < 2; ++n) acc[a][b][m][n] = (f32x4){0.f, 0.f, 0.f, 0.f};
    bf16x8 At[4][2], B0[2][2], B1[2][2];
    const char* cA = (const char*)g.A + ((size_t)cur.g * g.sA + (size_t)cur.pm * BM * g.lda) * 2;
    const char* cB = (const char*)g.Bt + ((size_t)cur.g * g.sB + (size_t)cur.pn * BM * g.ldb) * 2;
    PG8_STAGE(PG8_SB(0, 0), cB, voffB); PG8_STAGE(PG8_SA(0, 0), cA, voffA); PG8_STAGE(PG8_SB(0, 1), cB + hB, voffB); PG8_STAGE(PG8_SA(0, 1), cA + hA, voffA);
    if (wr == 1) PG8_BAR;
    PG8_WAIT_V(4); PG8_BAR;
    PG8_STAGE(PG8_SB(1, 0), cB + kstep, voffB); PG8_STAGE(PG8_SA(1, 0), cA + kstep, voffA); PG8_STAGE(PG8_SB(1, 1), cB + hB + kstep, voffB);
    PG8_WAIT_V(6); PG8_BAR;
    for (;;) {
        const bool has_next = S.next(ui + 1, nxt);
        const char* nA = has_next ? (const char*)g.A + ((size_t)nxt.g * g.sA + (size_t)nxt.pm * BM * g.lda) * 2 : cA;
        const char* nB = has_next ? (const char*)g.Bt + ((size_t)nxt.g * g.sB + (size_t)nxt.pn * BM * g.ldb) * 2 : cB;
        for (int t = 0; t < nt; t += 2) {
            const bool last = (t == nt - 2);
            const char* a1 = cA + (size_t)(t + 1) * kstep;
            const char* a2 = last ? nA : cA + (size_t)(t + 2) * kstep; const char* b2 = last ? nB : cB + (size_t)(t + 2) * kstep;
            const char* a3 = a2 + kstep; const char* b3 = b2 + kstep;
            PG8_LDB(B0, 0, 0); PG8_SCHED; PG8_LDA(At, 0, 0); PG8_STAGE(PG8_SA(1, 1), a1 + hA, voffA);
            PG8_WAIT_L(8); PG8_BAR; PG8_WAIT_L(0); PG8_MMA(0, 0, At, B0); PG8_BAR; PG8_SCHED;
            PG8_LDB(B1, 0, 1); PG8_STAGE(PG8_SB(0, 0), b2, voffB);
            PG8_BAR; PG8_WAIT_L(0); PG8_MMA(0, 1, At, B1); PG8_BAR;
            PG8_LDA(At, 0, 1); PG8_STAGE(PG8_SA(0, 0), a2, voffA);
            PG8_BAR; PG8_WAIT_L(0); PG8_MMA(1, 0, At, B0); PG8_BAR; PG8_SCHED;
            PG8_STAGE(PG8_SB(0, 1), b2 + hB, voffB);
            PG8_WAIT_V(6); PG8_BAR; PG8_MMA(1, 1, At, B1); PG8_BAR;
            PG8_LDB(B0, 1, 0); PG8_SCHED; PG8_LDA(At, 1, 0); PG8_STAGE(PG8_SA(0, 1), a2 + hA, voffA);
            PG8_WAIT_L(8); PG8_BAR; PG8_WAIT_L(0); PG8_MMA(0, 0, At, B0); PG8_BAR; PG8_SCHED;
            PG8_LDB(B1, 1, 1); PG8_STAGE(PG8_SB(1, 0), b3, voffB);
            PG8_BAR; PG8_WAIT_L(0); PG8_MMA(0, 1, At, B1); PG8_BAR;
            PG8_LDA(At, 1, 1); PG8_STAGE(PG8_SA(1, 0), a3, voffA);
            PG8_BAR; PG8_WAIT_L(0); PG8_MMA(1, 0, At, B0); PG8_BAR; PG8_SCHED;
            PG8_STAGE(PG8_SB(1, 1), b3 + hB, voffB);
            PG8_WAIT_V(6); PG8_BAR; PG8_MMA(1, 1, At, B1); PG8_BAR;
        }
        E(acc, cur, wr, wc, fr, fq);
        if (!has_next) break;
#pragma unroll
        for (int a = 0; a < 2; ++a)
#pragma unroll
            for (int b = 0; b < 2; ++b)
#pragma unroll
                for (int m = 0; m < 4; ++m)
#pragma unroll
                    for (int n = 0; n < 2; ++n) acc[a][b][m][n] = (f32x4){0.f, 0.f, 0.f, 0.f};
        cur = nxt; cA = nA; cB = nB; ++ui;
    }
    PG8_WAIT_V(0);
    if (wr == 0) PG8_BAR;
    PG8_BAR;
#undef PG8_SA
#undef PG8_SB
#undef PG8_STAGE
#undef PG8_LDA
#undef PG8_LDB
#undef PG8_MMA
#undef PG8_WAIT_V
#undef PG8_WAIT_L
#undef PG8_BAR
#undef PG8_SCHED
}
}

DI pg8::Gemm mk_gemm(const bf16_t* A, const bf16_t* Bt, long sA, long sB, int lda, int ldb, int K, int nM, int nN, int G) {
    pg8::Gemm g; g.A = A; g.Bt = Bt; g.sA = sA; g.sB = sB; g.lda = lda; g.ldb = ldb; g.K = K; g.nM = nM; g.nN = nN; g.G = G; return g;
}

DI void prep_phase(int tid_, int bid_, const Params& p, unsigned char* smem) {
    TJob* jobs = (TJob*)smem;
    float* tile = (float*)(smem + 4096);
    const int tid = tid_;
    if (tid < NTJ) jobs[tid] = p.tj[tid];
    __syncthreads();
    const int ntiles = p.ntiles;
    for (int tix = bid_; tix < ntiles; tix += gridDim.x) {
        int j = 0;
        for (int q = 1; q < NTJ; ++q) if (jobs[q].tile0 <= tix) j = q;
        const TJob jb = jobs[j];
        const int lt = tix - jb.tile0, ntk = jb.Kd / 128, k0 = (lt % ntk) * 128, n0 = (lt / ntk) * 128;
        f32x4 v[8];
#pragma unroll
        for (int i = 0; i < 8; ++i) {
            const int idx = tid + i * 512, kk = idx >> 5, n4 = idx & 31;
            const int k = k0 + kk, n = n0 + n4 * 4;
            v[i] = (k < jb.Ks && n < jb.Ns) ? *(const f32x4*)(jb.src + (size_t)k * jb.Ns + n) : (f32x4){0.f, 0.f, 0.f, 0.f};
        }
#pragma unroll
        for (int i = 0; i < 8; ++i) {
            const int idx = tid + i * 512, kk = idx >> 5, n4 = idx & 31;
#pragma unroll
            for (int e = 0; e < 4; ++e) tile[kk * 129 + n4 * 4 + e] = v[i][e];
        }
        __syncthreads();
#pragma unroll
        for (int i = 0; i < 4; ++i) {
            const int idx = tid + i * 512, n = idx >> 4, kc = idx & 15;
            float f[8];
#pragma unroll
            for (int e = 0; e < 8; ++e) f[e] = tile[(kc * 8 + e) * 129 + n];
            u32x4 o = {pk_bf16(f[0], f[1]), pk_bf16(f[2], f[3]), pk_bf16(f[4], f[5]), pk_bf16(f[6], f[7])};
            *(u32x4*)(jb.dst + (size_t)(n0 + n) * jb.Kd + k0 + kc * 8) = o;
        }
        __syncthreads();
    }
    {
        const float* x = p.in[0]; bf16_t* xb = (bf16_t*)(p.ws + O_SLOT + 8 * SLOT);
        const size_t n8 = (size_t)T * D / 8;
        for (size_t i = (size_t)bid_ * 512 + tid; i < n8; i += (size_t)gridDim.x * 512) {
            const f32x4 a = *(const f32x4*)(x + i * 8), b = *(const f32x4*)(x + i * 8 + 4);
            u32x4 o = {pk_bf16(a[0], a[1]), pk_bf16(a[2], a[3]), pk_bf16(b[0], b[1]), pk_bf16(b[2], b[3])};
            *(u32x4*)(xb + i * 8) = o;
        }
    }
    {
        float* ct = (float*)(p.ws + O_ROPE); float* st = ct + SEQ * 16;
        for (int i = bid_ * 512 + tid; i < SEQ * 16; i += gridDim.x * 512) {
            const int pos = i >> 4, f = i & 15;
            const float inv = powf(500000.0f, -(float)(2 * f) / 32.0f);
            const float ang = (float)pos * inv;
            ct[i] = cosf(ang); st[i] = sinf(ang);
        }
    }
}

DI void ln_phase(int tid_, int bid_, const float* zin, float* xout, bf16_t* xb, const float* gam, const float* bet) {
    const int lane = tid_ & 63, wid = tid_ >> 6;
    const int rstride = gridDim.x * 8;
    constexpr int NR = 4;
    for (int row0 = bid_ * 8 + wid; row0 < T; row0 += NR * rstride) {
        f32x4 v[NR][8];
#pragma unroll
        for (int r = 0; r < NR; ++r)
#pragma unroll
            for (int i = 0; i < 8; ++i)
                v[r][i] = (row0 + r * rstride < T) ? *(const f32x4*)(zin + (size_t)(row0 + r * rstride) * D + (i * 64 + lane) * 4) : (f32x4){0.f, 0.f, 0.f, 0.f};
#pragma unroll
        for (int r = 0; r < NR; ++r) {
            const int row = row0 + r * rstride;
            if (row >= T) break;
            float s = 0.f;
#pragma unroll
            for (int i = 0; i < 8; ++i) s += v[r][i][0] + v[r][i][1] + v[r][i][2] + v[r][i][3];
            const float mean = wave_sum(s) * (1.f / D);
            float q = 0.f;
#pragma unroll
            for (int i = 0; i < 8; ++i) { v[r][i] -= mean; q += v[r][i][0] * v[r][i][0] + v[r][i][1] * v[r][i][1] + v[r][i][2] * v[r][i][2] + v[r][i][3] * v[r][i][3]; }
            const float rstd = rsqrtf(wave_sum(q) * (1.f / D) + LN_EPS);
#pragma unroll
            for (int i = 0; i < 8; ++i) {
                const int c = (i * 64 + lane) * 4;
                const f32x4 g = *(const f32x4*)(gam + c), b = *(const f32x4*)(bet + c);
                const f32x4 o = v[r][i] * rstd * g + b;
                *(f32x4*)(xout + (size_t)row * D + c) = o;
                if (xb) { u32x2 w = {pk_bf16(o[0], o[1]), pk_bf16(o[2], o[3])}; *(u32x2*)(xb + (size_t)row * D + c) = w; }
            }
        }
    }
}

DI void rg_conv_phase(int tid_, int bid_, const bf16_t* gu, bf16_t* uc, const float* cw, const float* cb) {
    const size_t n8 = (size_t)T * D / 8;
    const size_t stride = (size_t)gridDim.x * 512;
    constexpr int U = 4;
    for (size_t ib = (size_t)bid_ * 512 + tid_; ib < n8; ib += stride * U) {
        u32x4 uu[U][4];
#pragma unroll
        for (int u = 0; u < U; ++u) {
            const size_t i = ib + u * stride;
            const int t = (int)(i >> 8), c = (int)(i & 255) * 8, s = t & (SEQ - 1);
#pragma unroll
            for (int j = 0; j < 4; ++j)
                uu[u][j] = (i < n8 && s - 3 + j >= 0) ? *(const u32x4*)(gu + (size_t)(t - 3 + j) * 4096 + 2048 + c) : (u32x4){0u, 0u, 0u, 0u};
        }
#pragma unroll
        for (int u = 0; u < U; ++u) {
            const size_t i = ib + u * stride;
            if (i >= n8) break;
            const int c = (int)(i & 255) * 8;
            float a[8];
            { const f32x4 b0 = *(const f32x4*)(cb + c), b1 = *(const f32x4*)(cb + c + 4);
#pragma unroll
              for (int e = 0; e < 4; ++e) { a[e] = b0[e]; a[4 + e] = b1[e]; } }
#pragma unroll
            for (int j = 0; j < 4; ++j) {
                const u32x4 q = uu[u][j];
                const f32x4 w0 = *(const f32x4*)(cw + j * D + c), w1 = *(const f32x4*)(cw + j * D + c + 4);
                a[0] += w0[0] * bflo(q[0]); a[1] += w0[1] * bfhi(q[0]); a[2] += w0[2] * bflo(q[1]); a[3] += w0[3] * bfhi(q[1]);
                a[4] += w1[0] * bflo(q[2]); a[5] += w1[1] * bfhi(q[2]); a[6] += w1[2] * bflo(q[3]); a[7] += w1[3] * bfhi(q[3]);
            }
            u32x4 o = {pk_bf16(a[0], a[1]), pk_bf16(a[2], a[3]), pk_bf16(a[4], a[5]), pk_bf16(a[6], a[7])};
            *(u32x4*)(uc + i * 8) = o;
        }
    }
}
DI void rg_ab(float rpre, float ipre, float u, float ba, float bx, float sp8, float& a, float& b) {
    const float r = sigmoidf_(rpre + ba), ii = sigmoidf_(ipre + bx);
    const float la = -sp8 * r;
    a = __expf(la);
    const float x2 = 2.f * la;
    const float om = (x2 > -0.05f) ? -x2 * (1.f + x2 * (0.5f + x2 * (0.16666667f + x2 * 0.041666668f))) : 1.f - a * a;
    b = u * ii * __builtin_amdgcn_sqrtf(om);
}
template <int MODE>
DI void rg_scan_phase(int tid_, int bid_, const Params& p, const bf16_t* gates, const bf16_t* uc, const bf16_t* gu, float* agg, bf16_t* outg) {
    constexpr int CH = 32;
    const float* gab = p.in[9]; const float* gxb = p.in[11]; const float* lam = p.in[12];
    for (int item = bid_; item < 4 * 128 * 2; item += gridDim.x) {
        const int cg2 = item & 1, chunk = (item >> 1) & 127, b = item >> 8;
        const int ch = cg2 * 1024 + tid_ * 2;
        const int n = ch >> 8, v = ch & 255;
        const f32x2 ba = *(const f32x2*)(gab + ch), bx = *(const f32x2*)(gxb + ch), lm = *(const f32x2*)(lam + ch);
        const float sp0 = 8.f * log1pf(expf(-lm[0])), sp1 = 8.f * log1pf(expf(-lm[1]));
        float h0 = 0.f, h1 = 0.f, P0 = 1.f, P1 = 1.f;
        if (MODE == 1) {
            for (int c0 = 0; c0 < chunk; c0 += 16) {
                f32x4 gv[16];
#pragma unroll
                for (int j = 0; j < 16; ++j) gv[j] = (c0 + j < chunk) ? *(const f32x4*)(agg + (((size_t)b * 128 + c0 + j) * D + ch) * 2) : (f32x4){1.f, 0.f, 1.f, 0.f};
#pragma unroll
                for (int j = 0; j < 16; ++j) { h0 = gv[j][0] * h0 + gv[j][1]; h1 = gv[j][2] * h1 + gv[j][3]; }
            }
        }
        const size_t t0 = (size_t)b * SEQ + (size_t)chunk * CH;
        constexpr int UB = 32;
        for (int tb = 0; tb < CH; tb += UB) {
            unsigned rpv[UB], ipv[UB], uuv[UB], ggv[UB];
#pragma unroll
            for (int j = 0; j < UB; ++j) {
                const size_t t = t0 + tb + j;
                rpv[j] = *(const unsigned*)(gates + t * 4096 + n * 512 + v);
                ipv[j] = *(const unsigned*)(gates + t * 4096 + n * 512 + 256 + v);
                uuv[j] = *(const unsigned*)(uc + t * D + ch);
                if (MODE == 1) ggv[j] = *(const unsigned*)(gu + t * 4096 + ch);
            }
#pragma unroll
            for (int j = 0; j < UB; ++j) {
                const size_t t = t0 + tb + j;
                float a0, b0, a1, b1;
                rg_ab(bflo(rpv[j]), bflo(ipv[j]), bflo(uuv[j]), ba[0], bx[0], sp0, a0, b0);
                rg_ab(bfhi(rpv[j]), bfhi(ipv[j]), bfhi(uuv[j]), ba[1], bx[1], sp1, a1, b1);
                h0 = a0 * h0 + b0; h1 = a1 * h1 + b1;
                if (MODE == 0) { P0 *= a0; P1 *= a1; }
                else *(unsigned*)(outg + t * D + ch) = pk_bf16(gelu_tanh(bflo(ggv[j])) * h0, gelu_tanh(bfhi(ggv[j])) * h1);
            }
        }
        if (MODE == 0) { f32x4 o = {P0, h0, P1, h1}; *(f32x4*)(agg + (((size_t)b * 128 + chunk) * D + ch) * 2) = o; }
    }
}

DI void kmean_phase(int tid_, int bid_, bf16_t* Qx, bf16_t* Kx, float* kmean, const float* ctab, const float* stab, unsigned char* smem) {
    float* redA = (float*)smem;
    float* redB = redA + 1024;
    const int tid = tid_;
    for (int item = bid_; item < 1024; item += gridDim.x) {
        const int blk = item & 15, h = (item >> 4) & 15, b = item >> 8;
        {
            const int i = tid & 15, rg = tid >> 4;
            float s1 = 0.f, s2 = 0.f;
            bf16_t k1v[8], k2v[8], q1v[8], q2v[8]; float cv[8], sv[8];
#pragma unroll
            for (int r = 0; r < 8; ++r) {
                const int pos = blk * 256 + rg * 8 + r;
                const size_t o = ((size_t)b * SEQ + pos) * D + h * 128 + i;
                cv[r] = ctab[pos * 16 + i]; sv[r] = stab[pos * 16 + i];
                k1v[r] = Kx[o]; k2v[r] = Kx[o + 16]; q1v[r] = Qx[o]; q2v[r] = Qx[o + 16];
            }
#pragma unroll
            for (int r = 0; r < 8; ++r) {
                const int pos = blk * 256 + rg * 8 + r;
                const size_t o = ((size_t)b * SEQ + pos) * D + h * 128 + i;
                const float c = cv[r], sn = sv[r];
                const float k1 = bf2f(k1v[r]), k2 = bf2f(k2v[r]);
                const bf16_t k1r = f2bf(k1 * c - k2 * sn), k2r = f2bf(k2 * c + k1 * sn);
                Kx[o] = k1r; Kx[o + 16] = k2r; s1 += bf2f(k1r); s2 += bf2f(k2r);
                const float q1 = bf2f(q1v[r]), q2 = bf2f(q2v[r]);
                Qx[o] = f2bf(q1 * c - q2 * sn); Qx[o + 16] = f2bf(q2 * c + q1 * sn);
            }
            redA[rg * 32 + i] = s1; redA[rg * 32 + 16 + i] = s2;
        }
        {
            const int dp = tid & 63, rg = tid >> 6;
            if (dp >= 16) {
                const bf16_t* base = Kx + ((size_t)b * SEQ + blk * 256 + rg * 32) * D + h * 128 + dp * 2;
                float s0 = 0.f, s1 = 0.f;
                unsigned uv[32];
#pragma unroll
                for (int r = 0; r < 32; ++r) uv[r] = *(const unsigned*)(base + (size_t)r * D);
#pragma unroll
                for (int r = 0; r < 32; ++r) { s0 += bflo(uv[r]); s1 += bfhi(uv[r]); }
                redB[rg * 128 + dp * 2] = s0; redB[rg * 128 + dp * 2 + 1] = s1;
            }
        }
        __syncthreads();
        if (tid < 128) {
            float s = 0.f;
            if (tid < 32) { for (int r = 0; r < 32; ++r) s += redA[r * 32 + tid]; }
            else { for (int r = 0; r < 8; ++r) s += redB[r * 128 + tid]; }
            kmean[(size_t)item * 128 + tid] = s * (1.f / 256.f);
        }
        __syncthreads();
    }
}

DI void attn_phase(int tid_, int bid_, const bf16_t* Q, const bf16_t* Kx, const bf16_t* VT, bf16_t* O, const float* kmean, unsigned char* smem) {
    constexpr int KB_STRIDE = 288, VB_STRIDE = 160;
    constexpr int KBUF = 64 * KB_STRIDE, VBUF = 128 * VB_STRIDE;
    constexpr float QC = 0.08838834764831845f * 1.4426950408889634f;
    constexpr float THR_RAW = 8.0f / 0.08838834764831845f;
#define KBUFP(bi) (smem + (bi) * KBUF)
#define VBUFP(bi) (smem + 2 * KBUF + (bi) * VBUF)
    float* km = (float*)(smem + 2 * KBUF + 2 * VBUF);
    const int tid = tid_, wid = tid >> 6, lane = tid & 63, fr = lane & 15, fq = lane >> 4;
    for (int idx = bid_; idx < 2048; idx += gridDim.x) {
        const int bh = idx & 63, jj = idx >> 6, sub = jj & 3, rnd = jj >> 2;
        const int r2 = rnd >> 1, half = rnd & 1;
        const int qb = (r2 == 0) ? sub : (r2 == 1) ? (7 - sub) : (r2 == 2) ? (8 + sub) : (15 - sub);
        const int b = bh >> 4, h = bh & 15;
        const size_t tok0 = (size_t)b * SEQ;
        const int qloc = half * 128 + wid * 16 + fr;
        { const f32x4 kv = *(const f32x4*)(kmean + (size_t)bh * 2048 + tid * 4); *(f32x4*)(km + tid * 4) = kv; }
        bf16x8 qf[4];
#pragma unroll
        for (int dc = 0; dc < 4; ++dc) qf[dc] = *(const bf16x8*)(Q + (tok0 + qb * 256 + qloc) * D + h * 128 + dc * 32 + fq * 8);
        __syncthreads();
        const int ntile = qb * 4 + (half ? 4 : 2);
        const int kr0 = tid >> 4, kc0 = tid & 15;
        const int vr0 = tid >> 3, vc0 = tid & 7;
        u32x4 kreg0[2], vreg0[2], kreg1[2], vreg1[2];
        auto gload = [&](int tt, u32x4 (&kreg)[2], u32x4 (&vreg)[2]) {
            const int key0 = tt * 64;
#pragma unroll
            for (int i = 0; i < 2; ++i) {
                kreg[i] = *(const u32x4*)(Kx + (tok0 + key0 + kr0 + i * 32) * D + h * 128 + kc0 * 8);
                vreg[i] = *(const u32x4*)(VT + (size_t)(h * 128 + vr0 + i * 64) * T + tok0 + key0 + vc0 * 8);
            }
        };
        auto lstore = [&](int bi, const u32x4 (&kreg)[2], const u32x4 (&vreg)[2]) {
#pragma unroll
            for (int i = 0; i < 2; ++i) {
                *(u32x4*)(KBUFP(bi) + (kr0 + i * 32) * KB_STRIDE + kc0 * 16) = kreg[i];
                {
                    unsigned char* vrow = VBUFP(bi) + (vr0 + i * 64) * VB_STRIDE + (vc0 >> 2) * 64;
                    const int c = vc0 & 3, p0 = ((c & 1) * 2) * 16 + (c >> 1) * 8;
                    u32x2 lo = {vreg[i][0], vreg[i][1]}, hi = {vreg[i][2], vreg[i][3]};
                    *(u32x2*)(vrow + p0) = lo; *(u32x2*)(vrow + p0 + 16) = hi;
                }
            }
        };
        gload(0, kreg0, vreg0);
        if (1 < ntile) gload(1, kreg1, vreg1);
        unsigned mask = 0u;
        {
            float v0 = -3e38f, v1 = -3e38f, v2 = -3e38f; int i0 = -1, i1 = -1, i2 = -1;
            for (int j = 0; j < qb; ++j) {
                float g = 0.f;
#pragma unroll
                for (int dc = 0; dc < 4; ++dc) {
                    const f32x4 ka = *(const f32x4*)(km + j * 128 + dc * 32 + fq * 8), kb2 = *(const f32x4*)(km + j * 128 + dc * 32 + fq * 8 + 4);
#pragma unroll
                    for (int e = 0; e < 4; ++e) { g += bf2f((bf16_t)qf[dc][e]) * ka[e]; g += bf2f((bf16_t)qf[dc][4 + e]) * kb2[e]; }
                }
                g = xsum_fq(g);
                if (g > v0) { v2 = v1; i2 = i1; v1 = v0; i1 = i0; v0 = g; i0 = j; }
                else if (g > v1) { v2 = v1; i2 = i1; v1 = g; i1 = j; }
                else if (g > v2) { v2 = g; i2 = j; }
            }
            if (i0 >= 0) mask |= 1u << i0;
            if (i1 >= 0) mask |= 1u << i1;
            if (i2 >= 0) mask |= 1u << i2;
        }
        float mrun = -1e30f, lrun = 0.f;
        f32x4 oacc[8];
#pragma unroll
        for (int dt = 0; dt < 8; ++dt) oacc[dt] = (f32x4){0.f, 0.f, 0.f, 0.f};
        auto compute = [&](int tt, int bi) {
            const int kb = tt >> 2, kt64 = tt & 3;
            const bool own = (kb == qb);
            const bool actq = own ? true : (((mask >> kb) & 1u) != 0u);
            const bool doit = own ? (kt64 * 64 <= half * 128 + wid * 16 + 15) : (__any((int)actq) != 0);
            if (doit) {
                f32x4 sacc[4];
#pragma unroll
                for (int kt = 0; kt < 4; ++kt) sacc[kt] = (f32x4){0.f, 0.f, 0.f, 0.f};
#pragma unroll
                for (int dc = 0; dc < 4; ++dc)
#pragma unroll
                    for (int kt = 0; kt < 4; ++kt) {
                        const bf16x8 kf = *(const bf16x8*)(KBUFP(bi) + (kt * 16 + fr) * KB_STRIDE + dc * 64 + fq * 16);
                        sacc[kt] = __builtin_amdgcn_mfma_f32_16x16x32_bf16(kf, qf[dc], sacc[kt], 0, 0, 0);
                    }
                const int lim = own ? (qloc - kt64 * 64 - fq * 4) : (actq ? 1000 : -1000);
                float mx = -1e30f;
#pragma unroll
                for (int kt = 0; kt < 4; ++kt)
#pragma unroll
                    for (int r = 0; r < 4; ++r) {
                        const float sv = (kt * 16 + r <= lim) ? sacc[kt][r] : -__builtin_inff();
                        sacc[kt][r] = sv; mx = fmaxf(mx, sv);
                    }
                mx = xmax_fq(mx);
                if (__any((int)(mx > mrun + THR_RAW))) {
                    const float mnew = fmaxf(mrun, mx);
                    const float alpha = __builtin_amdgcn_exp2f((mrun - mnew) * QC);
                    mrun = mnew;
                    lrun *= alpha;
#pragma unroll
                    for (int dt = 0; dt < 8; ++dt) oacc[dt] *= alpha;
                }
                const float mneg = -mrun * QC;
                float ps = 0.f;
#pragma unroll
                for (int kt = 0; kt < 4; ++kt)
#pragma unroll
                    for (int r = 0; r < 4; ++r) { const float pe = __builtin_amdgcn_exp2f(__builtin_fmaf(sacc[kt][r], QC, mneg)); sacc[kt][r] = pe; ps += pe; }
                lrun += ps;
                bf16x8 pf[2];
#pragma unroll
                for (int ks = 0; ks < 2; ++ks) {
                    u32x4 w = {pk_bf16(sacc[2 * ks][0], sacc[2 * ks][1]), pk_bf16(sacc[2 * ks][2], sacc[2 * ks][3]),
                               pk_bf16(sacc[2 * ks + 1][0], sacc[2 * ks + 1][1]), pk_bf16(sacc[2 * ks + 1][2], sacc[2 * ks + 1][3])};
                    pf[ks] = __builtin_bit_cast(bf16x8, w);
                }
#pragma unroll
                for (int ks = 0; ks < 2; ++ks)
#pragma unroll
                    for (int dt = 0; dt < 8; ++dt) {
                        const bf16x8 vf = *(const bf16x8*)(VBUFP(bi) + (dt * 16 + fr) * VB_STRIDE + ks * 64 + fq * 16);
                        oacc[dt] = __builtin_amdgcn_mfma_f32_16x16x32_bf16(vf, pf[ks], oacc[dt], 0, 0, 0);
                    }
            }
        };
        lstore(0, kreg0, vreg0);
        __syncthreads();
        for (int tt = 0; tt < ntile; tt += 2) {
            if (tt + 2 < ntile) gload(tt + 2, kreg0, vreg0);
            compute(tt, 0);
            if (tt + 1 < ntile) lstore(1, kreg1, vreg1);
            lds_barrier();
            if (tt + 1 < ntile) {
                if (tt + 3 < ntile) gload(tt + 3, kreg1, vreg1);
                compute(tt + 1, 1);
                if (tt + 2 < ntile) lstore(0, kreg0, vreg0);
                lds_barrier();
            }
        }
        __syncthreads();
        {
            const float lt = xsum_fq(lrun);
            const float inv = 1.f / lt;
            bf16_t* orow = O + (tok0 + qb * 256 + qloc) * D + h * 128 + fq * 4;
#pragma unroll
            for (int dt = 0; dt < 8; ++dt) {
                const f32x4 o = oacc[dt] * inv;
                u32x2 w = {pk_bf16(o[0], o[1]), pk_bf16(o[2], o[3])};
                *(u32x2*)(orow + dt * 16) = w;
            }
        }
    }
#undef KBUFP
#undef VBUFP
}

DI void rwkv_mix_phase(int tid_, int bid_, const float* x, const float* mu, bf16_t* slots) {
    const size_t n4 = (size_t)T * D / 4;
    const size_t stride = (size_t)gridDim.x * 512;
    constexpr int U = 8;
    for (size_t ib = (size_t)bid_ * 512 + tid_; ib < n4; ib += stride * U) {
        f32x4 xv[U], xp[U];
#pragma unroll
        for (int u = 0; u < U; ++u) {
            const size_t i = ib + u * stride;
            const int t = (int)(i >> 9), s_ = t & (SEQ - 1);
            xv[u] = (i < n4) ? *(const f32x4*)(x + i * 4) : (f32x4){0.f, 0.f, 0.f, 0.f};
            xp[u] = (i < n4 && s_ > 0) ? *(const f32x4*)(x + i * 4 - D) : (f32x4){0.f, 0.f, 0.f, 0.f};
        }
#pragma unroll
        for (int u = 0; u < U; ++u) {
            const size_t i = ib + u * stride;
            if (i >= n4) break;
            const int c = (int)(i & 511) * 4;
            const f32x4 xx = xp[u] - xv[u];
#pragma unroll
            for (int k = 0; k < 6; ++k) {
                const f32x4 m = *(const f32x4*)(mu + k * D + c);
                const f32x4 o = xv[u] + xx * m;
                u32x2 w = {pk_bf16(o[0], o[1]), pk_bf16(o[2], o[3])};
                *(u32x2*)((unsigned char*)slots + k * SLOT + i * 8) = w;
            }
        }
    }
}
DI float softplusf_(float y) { return fmaxf(y, 0.f) + __logf(1.f + __expf(-fabsf(y))); }
DI void rwkv_prep_phase(int tid_, int bid_, const Params& p, unsigned char* sl, float* scal) {
    bf16_t* R = (bf16_t*)(sl + 6 * SLOT); bf16_t* Kk = (bf16_t*)(sl + 7 * SLOT);
    const bf16_t* WP = (const bf16_t*)(sl + 0 * SLOT); bf16_t* AP = (bf16_t*)(sl + 1 * SLOT);
    bf16_t* KX = (bf16_t*)(sl + 3 * SLOT); float* WD = (float*)(sl + 4 * SLOT);
    const float* w0 = p.in[18]; const float* a0 = p.in[21]; const float* k_k = p.in[26]; const float* k_a = p.in[27]; const float* r_k = p.in[28];
    float* BR = scal; float* KR = scal + (size_t)T * 32; float* BO = scal + (size_t)2 * T * 32;
    const int lane = tid_ & 63, wid = tid_ >> 6;
    constexpr int U = 16;
    for (int grp = bid_ * 8 + wid; grp < T * 32 / U; grp += gridDim.x * 8) {
        const int item0 = grp * U;
        const int h0 = item0 & 31; const size_t t = (size_t)(item0 >> 5);
        const size_t o0 = t * D + h0 * 64 + lane;
        bf16_t rr[U], kr_[U], wpr[U], apr[U];
#pragma unroll
        for (int u = 0; u < U; ++u) { rr[u] = R[o0 + u * 64]; kr_[u] = Kk[o0 + u * 64]; wpr[u] = WP[o0 + u * 64]; apr[u] = AP[o0 + u * 64]; }
#pragma unroll
        for (int u = 0; u < U; ++u) {
            const int c = (h0 + u) * 64 + lane; const size_t o = o0 + u * 64;
            const float r = bf2f(rr[u]), k = bf2f(kr_[u]), wp = bf2f(wpr[u]), ap = bf2f(apr[u]);
            const float wlog = -softplusf_(-(w0[c] + wp)) - 0.5f;
            const float dec = __expf(-__expf(wlog));
            const float a = __builtin_amdgcn_rcpf(1.f + __expf(-(a0[c] + ap)));
            float kk = k * k_k[c];
            kk = kk * fminf(__builtin_amdgcn_rsqf(wave_sum(kk * kk)), 1e12f);
            const float kx = k * (1.f + (a - 1.f) * k_a[c]);
            const float bb = kk * a;
            const float br = wave_sum(bb * r), kr = wave_sum(kx * r), bo = wave_sum(r * kx * r_k[c]);
            R[o] = f2bf(dec * r); Kk[o] = f2bf(-kk); AP[o] = f2bf(bb); KX[o] = f2bf(kx); WD[o] = dec;
            if (lane == 0) { BR[item0 + u] = br; KR[item0 + u] = kr; BO[item0 + u] = bo; }
        }
    }
}
DI float dpp_sum8(float v) {
    v += __int_as_float(__builtin_amdgcn_update_dpp(0, __float_as_int(v), 0xB1, 0xF, 0xF, false));
    v += __int_as_float(__builtin_amdgcn_update_dpp(0, __float_as_int(v), 0x4E, 0xF, 0xF, false));
    v += __int_as_float(__builtin_amdgcn_update_dpp(0, __float_as_int(v), 0x141, 0xF, 0xF, false));
    return v;
}
DI void rwkv_scan_phase(int tid_, int bid_, unsigned char* sl, const float* scal, unsigned char* smem) {
    constexpr int TC = 32;
    constexpr int OFF_BB = TC * 128, OFF_KX = OFF_BB + TC * 64, OFF_W = OFF_KX + TC * 64, OFF_V = OFF_W + TC * 64, OFF_SC = OFF_V + TC * 32, BUF_F = OFF_SC + TC * 2;
    constexpr int NCH = SEQ / TC;
#define SBUF(i) ((float*)smem + (i) * BUF_F)
    const bf16_t* NKK = (const bf16_t*)(sl + 7 * SLOT); const bf16_t* WR = (const bf16_t*)(sl + 6 * SLOT);
    const bf16_t* BB = (const bf16_t*)(sl + 1 * SLOT); const bf16_t* KX = (const bf16_t*)(sl + 3 * SLOT);
    const float* WD = (const float*)(sl + 4 * SLOT); const bf16_t* V = (const bf16_t*)(sl + 8 * SLOT);
    bf16_t* Y = (bf16_t*)(sl + 0 * SLOT);
    const float* BR = scal; const float* KR = scal + (size_t)T * 32;
    const int tid = tid_, wid = tid >> 6, lane = tid & 63;
    for (int item = bid_; item < 256; item += gridDim.x) {
        const int half = item & 1, h = (item >> 1) & 31, b = item >> 6;
        const size_t tok0 = (size_t)b * SEQ;
        if (wid >= 4) {
            const int lt = tid - 256, lt_t = lt >> 3, lt_c = lt & 7;
            u32x4 r_nk, r_wr, r_bb, r_kx, r_v = {0u, 0u, 0u, 0u}; f32x4 r_w0, r_w1; float r_s = 0.f;
            auto gload = [&](int c) {
                const size_t tb = tok0 + (size_t)c * TC;
                const size_t o = (tb + lt_t) * D + h * 64 + lt_c * 8;
                r_nk = *(const u32x4*)(NKK + o); r_wr = *(const u32x4*)(WR + o); r_bb = *(const u32x4*)(BB + o); r_kx = *(const u32x4*)(KX + o);
                r_w0 = *(const f32x4*)(WD + (tb + (lt >> 4)) * D + h * 64 + (lt & 15) * 4);
                r_w1 = *(const f32x4*)(WD + (tb + 16 + (lt >> 4)) * D + h * 64 + (lt & 15) * 4);
                if (lt < 128) r_v = *(const u32x4*)(V + (tb + (lt >> 2)) * D + h * 64 + half * 32 + (lt & 3) * 8);
                else if (lt < 192) { const int i = lt - 128; r_s = ((i & 1) ? KR : BR)[(tb + (i >> 1)) * 32 + h]; }
            };
            auto lstore = [&](float* F) {
                float* pp = F + lt_t * 128 + lt_c * 16;
#pragma unroll
                for (int j = 0; j < 4; ++j) { f32x4 q = {bflo(r_nk[j]), bflo(r_wr[j]), bfhi(r_nk[j]), bfhi(r_wr[j])}; *(f32x4*)(pp + j * 4) = q; }
                { float* d = F + OFF_BB + lt_t * 64 + lt_c * 8;
                  f32x4 lo = {bflo(r_bb[0]), bfhi(r_bb[0]), bflo(r_bb[1]), bfhi(r_bb[1])}, hi = {bflo(r_bb[2]), bfhi(r_bb[2]), bflo(r_bb[3]), bfhi(r_bb[3])};
                  *(f32x4*)d = lo; *(f32x4*)(d + 4) = hi; }
                { float* d = F + OFF_KX + lt_t * 64 + lt_c * 8;
                  f32x4 lo = {bflo(r_kx[0]), bfhi(r_kx[0]), bflo(r_kx[1]), bfhi(r_kx[1])}, hi = {bflo(r_kx[2]), bfhi(r_kx[2]), bflo(r_kx[3]), bfhi(r_kx[3])};
                  *(f32x4*)d = lo; *(f32x4*)(d + 4) = hi; }
                *(f32x4*)(F + OFF_W + (lt >> 4) * 64 + (lt & 15) * 4) = r_w0;
                *(f32x4*)(F + OFF_W + (16 + (lt >> 4)) * 64 + (lt & 15) * 4) = r_w1;
                if (lt < 128) { float* d = F + OFF_V + (lt >> 2) * 32 + (lt & 3) * 8;
                  f32x4 lo = {bflo(r_v[0]), bfhi(r_v[0]), bflo(r_v[1]), bfhi(r_v[1])}, hi = {bflo(r_v[2]), bfhi(r_v[2]), bflo(r_v[3]), bfhi(r_v[3])};
                  *(f32x4*)d = lo; *(f32x4*)(d + 4) = hi; }
                else if (lt < 192) F[OFF_SC + (lt - 128)] = r_s;
            };
            gload(0); lstore(SBUF(0)); gload(1);
            __syncthreads();
            for (int c = 0; c < NCH; ++c) {
                if (c + 1 < NCH) lstore(SBUF((c + 1) & 1));
                if (c + 2 < NCH) gload(c + 2);
                lds_barrier();
            }
        } else {
            const int kq = lane & 7, rl = wid * 8 + (lane >> 3);
            f32x2 st[4];
#pragma unroll
            for (int j = 0; j < 4; ++j) st[j] = (f32x2){0.f, 0.f};
            bf16_t* yp = Y + (tok0 + kq) * D + h * 64 + half * 32 + rl;
            __syncthreads();
            struct Ops { f32x4 pq[4], b0, b1, k0, k1, w0, w1; float vv; f32x2 sc; };
            for (int c = 0; c < NCH; ++c) {
                const float* F = SBUF(c & 1);
                const float* fp = F + kq * 16;
                const float* fb = F + OFF_BB + kq * 8;
                auto ld = [&](Ops& o, int t) {
#pragma unroll
                    for (int j = 0; j < 4; ++j) o.pq[j] = *(const f32x4*)(fp + t * 128 + j * 4);
                    o.b0 = *(const f32x4*)(fb + t * 64); o.b1 = *(const f32x4*)(fb + t * 64 + 4);
                    o.k0 = *(const f32x4*)(fb + (OFF_KX - OFF_BB) + t * 64); o.k1 = *(const f32x4*)(fb + (OFF_KX - OFF_BB) + t * 64 + 4);
                    o.w0 = *(const f32x4*)(fb + (OFF_W - OFF_BB) + t * 64); o.w1 = *(const f32x4*)(fb + (OFF_W - OFF_BB) + t * 64 + 4);
                    o.vv = F[OFF_V + t * 32 + rl]; o.sc = *(const f32x2*)(F + OFF_SC + t * 2);
                };
                auto dots = [&](const Ops& o) -> f32x2 {
                    f32x2 acc = {0.f, 0.f}, acc2 = {0.f, 0.f};
#pragma unroll
                    for (int j = 0; j < 4; ++j) {
                        acc += st[j][0] * (f32x2){o.pq[j][0], o.pq[j][1]};
                        acc2 += st[j][1] * (f32x2){o.pq[j][2], o.pq[j][3]};
                    }
                    return acc + acc2;
                };
                auto update = [&](const Ops& o, f32x2 acc) -> float {
                    const float d1 = dpp_sum8(acc[0]), d2 = dpp_sum8(acc[1]);
                    st[0] = st[0] * (f32x2){o.w0[0], o.w0[1]} + d1 * (f32x2){o.b0[0], o.b0[1]} + o.vv * (f32x2){o.k0[0], o.k0[1]};
                    st[1] = st[1] * (f32x2){o.w0[2], o.w0[3]} + d1 * (f32x2){o.b0[2], o.b0[3]} + o.vv * (f32x2){o.k0[2], o.k0[3]};
                    st[2] = st[2] * (f32x2){o.w1[0], o.w1[1]} + d1 * (f32x2){o.b1[0], o.b1[1]} + o.vv * (f32x2){o.k1[0], o.k1[1]};
                    st[3] = st[3] * (f32x2){o.w1[2], o.w1[3]} + d1 * (f32x2){o.b1[2], o.b1[3]} + o.vv * (f32x2){o.k1[2], o.k1[3]};
                    return d2 + d1 * o.sc[0] + o.vv * o.sc[1];
                };
                Ops os[3];
                ld(os[0], 0); ld(os[1], 1);
                float yv = 0.f;
#pragma unroll
                for (int t = 0; t < TC; ++t) {
                    const f32x2 da = dots(os[t % 3]);
                    __builtin_amdgcn_sched_barrier(0);
                    if (t + 2 < TC) ld(os[(t + 2) % 3], t + 2);
                    __builtin_amdgcn_sched_barrier(0);
                    const float ya = update(os[t % 3], da);
                    yv = (kq == (t & 7)) ? ya : yv;
                    if ((t & 7) == 7) yp[(size_t)(c * TC + (t & ~7)) * D] = f2bf(yv);
                }
                lds_barrier();
            }
        }
        __syncthreads();
    }
#undef SBUF
}
DI void rwkv_post_phase(int tid_, int bid_, const Params& p, unsigned char* sl, const float* scal) {
    const bf16_t* Y = (const bf16_t*)(sl + 0 * SLOT); const bf16_t* V = (const bf16_t*)(sl + 8 * SLOT); const bf16_t* G = (const bf16_t*)(sl + 2 * SLOT);
    bf16_t* OUT = (bf16_t*)(sl + 3 * SLOT);
    const float* lg = p.in[29]; const float* lb = p.in[30]; const float* BO = scal + (size_t)2 * T * 32;
    const int lane = tid_ & 63, wid = tid_ >> 6;
    constexpr int U = 16;
    for (int grp = bid_ * 8 + wid; grp < T * 32 / U; grp += gridDim.x * 8) {
        const int item0 = grp * U;
        const int h0 = item0 & 31; const size_t t = (size_t)(item0 >> 5);
        const size_t o0 = t * D + h0 * 64 + lane;
        bf16_t yr[U], vr[U], gr[U]; float bor[U];
#pragma unroll
        for (int u = 0; u < U; ++u) { yr[u] = Y[o0 + u * 64]; vr[u] = V[o0 + u * 64]; gr[u] = G[o0 + u * 64]; bor[u] = BO[item0 + u]; }
#pragma unroll
        for (int u = 0; u < U; ++u) {
            const int c = (h0 + u) * 64 + lane;
            const float y = bf2f(yr[u]);
            const float mean = wave_sum(y) * (1.f / 64.f);
            const float dlt = y - mean;
            const float var = wave_sum(dlt * dlt) * (1.f / 64.f);
            float r = dlt * rsqrtf(var + 64e-5f) * lg[c] + lb[c];
            r += bor[u] * bf2f(vr[u]);
            OUT[o0 + u * 64] = f2bf(r * bf2f(gr[u]));
        }
    }
}

DI void pool_phase(int tid_, int bid_, const float* x, bf16_t* outp) {
    constexpr int CH = 32;
    const int tid = tid_, c = tid * 4, w = 2 << (c >> 9);
    for (int item = bid_; item < T / CH; item += gridDim.x) {
        const int t0 = item * CH, s0 = t0 & (SEQ - 1);
        f32x4 sum = {0.f, 0.f, 0.f, 0.f};
#pragma unroll
        for (int j = 1; j <= 16; ++j) if (j <= w && s0 - j >= 0) sum += *(const f32x4*)(x + (size_t)(t0 - j) * D + c);
#pragma unroll 16
        for (int tt = 0; tt < CH; ++tt) {
            const int t = t0 + tt, s = s0 + tt;
            const f32x4 xv = *(const f32x4*)(x + (size_t)t * D + c);
            sum += xv;
            if (s - w >= 0) sum -= *(const f32x4*)(x + (size_t)(t - w) * D + c);
            const float rc = __builtin_amdgcn_rcpf((float)((s + 1 < w) ? (s + 1) : w));
            const f32x4 o = sum * rc - xv;
            u32x2 wv = {pk_bf16(o[0], o[1]), pk_bf16(o[2], o[3])};
            *(u32x2*)(outp + (size_t)t * D + c) = wv;
        }
    }
}

#define XB_TMO      128
#define XB_XCNT(j)  (256  + 64 * (j))
#define XB_XSUB(j)  (1280 + 64 * (j))
#define XB_XGEN(j)  (2304 + 64 * (j))
#define XB_TOP      3328
#define XB_TOPGEN   3392
#define XCD_BAR_WORDS 3456
#define XB_SPIN_CAP (1u << 18)
DI unsigned xb_ld(unsigned* p) { return __hip_atomic_load(p, __ATOMIC_RELAXED, __HIP_MEMORY_SCOPE_AGENT); }
DI unsigned xb_add(unsigned* p, unsigned v) { return __hip_atomic_fetch_add(p, v, __ATOMIC_RELAXED, __HIP_MEMORY_SCOPE_AGENT); }
DI unsigned xb_xcc_id() { return (unsigned)__builtin_amdgcn_s_getreg((3 << 11) | 20) & 0xFu; }
#define XB_SPIN(cond, bar) do { unsigned _sp = 0; while (cond) { __builtin_amdgcn_s_sleep(1); \
    if ((++_sp & 255u) == 0u) { if (xb_ld(&(bar)[XB_TMO])) break; if (_sp > XB_SPIN_CAP) { atomicAdd(&(bar)[XB_TMO], 1u); break; } } } } while (0)
struct XcdBarrier { unsigned* bar; unsigned x; volatile LAS unsigned* st; };
DI XcdBarrier xcd_barrier_post(int tid, unsigned* bar, volatile LAS unsigned* st) {
    XcdBarrier b; b.bar = bar; b.x = xb_xcc_id(); b.st = st;
    if (tid == 0) (void)xb_add(&bar[XB_XCNT(b.x)], 1u);
    return b;
}
DI void xcd_barrier_complete(unsigned* bar, unsigned x, unsigned& nloc, unsigned& nx) {
    const unsigned G = gridDim.x * gridDim.y * gridDim.z;
    unsigned sum, cnt, mine, sp = 0u;
    for (;;) {
        sum = 0u; cnt = 0u; mine = 0u;
#pragma unroll
        for (unsigned j = 0; j < 16; ++j) { const unsigned c = xb_ld(&bar[XB_XCNT(j)]); sum += c; cnt += (c > 0u) ? 1u : 0u; mine = (j == x) ? c : mine; }
        if (sum == G) break;
        __builtin_amdgcn_s_sleep(1);
        if ((++sp & 255u) == 0u) { if (xb_ld(&bar[XB_TMO])) break; if (sp > XB_SPIN_CAP) { atomicAdd(&bar[XB_TMO], 1u); break; } }
    }
    nloc = mine > 0u ? mine : 1u; nx = cnt > 0u ? cnt : 1u;
}
DI void xcd_barrier(int tid, const XcdBarrier& b) {
    asm volatile("s_waitcnt vmcnt(0)" ::: "memory");
    __syncthreads();
    if (tid == 0) {
        unsigned* bar = b.bar;
        __builtin_amdgcn_s_waitcnt(0);
        unsigned nloc = b.st[0], nx = b.st[1];
        if (nloc == 0u) { xcd_barrier_complete(bar, b.x, nloc, nx); b.st[0] = nloc; b.st[1] = nx; }
        const unsigned old = xb_add(&bar[XB_XSUB(b.x)], 1u);
        const unsigned gen = old / nloc;
        if (old + 1u == (gen + 1u) * nloc) {
            __builtin_amdgcn_fence(__ATOMIC_RELEASE, "agent");
            asm volatile("s_waitcnt vmcnt(0)" ::: "memory");
            const unsigned og = xb_add(&bar[XB_TOP], 1u);
            const unsigned tg = og / nx;
            if (og + 1u == (tg + 1u) * nx) xb_add(&bar[XB_TOPGEN], 1u);
            else XB_SPIN(xb_ld(&bar[XB_TOPGEN]) == tg, bar);
            __builtin_amdgcn_fence(__ATOMIC_ACQUIRE, "agent");
            xb_add(&bar[XB_XGEN(b.x)], 1u);
            asm volatile("s_waitcnt vmcnt(0)" ::: "memory");
        } else {
            XB_SPIN(xb_ld(&bar[XB_XGEN(b.x)]) == gen, bar);
            __builtin_amdgcn_fence(__ATOMIC_ACQUIRE, "agent");
            asm volatile("s_waitcnt vmcnt(0)" ::: "memory");
        }
    }
    __syncthreads();
}

enum { K_PREP = 0, K_GACT, K_GRES, K_LN, K_RGCONV, K_RGSCAN0, K_RGSCAN1, K_KMEAN, K_ATTN, K_RMIX, K_RPREP, K_RSCAN, K_RPOST, K_POOL };
constexpr int NSTEPS = 38;
struct Desc {
    int kind;
    pg8::Gemm g;
    bf16_t* C; const float* res; const float* cscale; long sC; int ldc; unsigned acts;
    int lnidx, lnlast;
};
DI bool step_nosync(int st) { return st == 11 || st == 21; }
DI Desc make_desc(int st, const Params& p, unsigned char* ws) {
    unsigned char* sl = ws + O_SLOT;
    auto slot = [&](int i) { return (bf16_t*)(sl + (size_t)i * SLOT); };
    bf16_t* xb = slot(8);
    Desc d; d.kind = K_PREP; d.g = mk_gemm(nullptr, nullptr, 0, 0, 0, 0, 0, 0, 0, 0);
    d.C = nullptr; d.res = nullptr; d.cscale = nullptr; d.sC = 0; d.ldc = D; d.acts = 0u; d.lnidx = 0; d.lnlast = 0;
    int layer = -1, sub = 0;
    if (st >= 7 && st < 11) { layer = 0; sub = st - 7; }
    else if (st >= 16 && st < 20) { layer = 1; sub = st - 16; }
    else if (st >= 28 && st < 32) { layer = 2; sub = st - 28; }
    else if (st >= 34 && st < 38) { layer = 3; sub = st - 34; }
    if (layer >= 0) {
        if (sub == 0) { d.kind = K_LN; d.lnidx = layer * 2; }
        else if (sub == 1) { d.kind = K_GACT; d.C = slot(0); d.ldc = DFF; d.acts = 1u;
            d.g = mk_gemm(xb, (const bf16_t*)(ws + O_W1T + (size_t)layer * DFF * D * 2), 0, 0, D, D, D, T / 256, DFF / 256, 1); }
        else if (sub == 2) { d.kind = K_GRES;
            d.g = mk_gemm(slot(0), (const bf16_t*)(ws + O_W2T + (size_t)layer * DFF * D * 2), 0, 0, DFF, DFF, DFF, T / 256, D / 256, 1); }
        else { d.kind = K_LN; d.lnidx = layer * 2 + 1; d.lnlast = (layer == 3); }
        return d;
    }
    switch (st) {
    case 0: d.kind = K_PREP; break;
    case 1: d.kind = K_GACT; d.C = slot(0); d.ldc = 4096;
            d.g = mk_gemm(xb, (const bf16_t*)(ws + O_WIN), 0, 0, D, D, D, T / 256, 4096 / 256, 1); break;
    case 2: d.kind = K_RGCONV; break;
    case 3: d.kind = K_GACT; d.C = slot(3); d.sC = 512; d.ldc = 4096;
            d.g = mk_gemm(slot(2), (const bf16_t*)(ws + O_GATES), 256, 512 * 256, D, 256, 256, T / 256, 2, 8); break;
    case 4: d.kind = K_RGSCAN0; break;
    case 5: d.kind = K_RGSCAN1; break;
    case 6: d.kind = K_GRES; d.res = p.in[0];
            d.g = mk_gemm(slot(5), (const bf16_t*)(ws + O_RGOUT), 0, 0, D, D, D, T / 256, D / 256, 1); break;
    case 11: d.kind = K_GACT; d.C = slot(0); d.sC = (long)T * D;
             d.g = mk_gemm(xb, (const bf16_t*)(ws + O_QKV), 0, (long)D * D, D, D, D, T / 256, D / 256, 2); break;
    case 12: d.kind = K_GACT; d.C = slot(2); d.ldc = T;
             d.g = mk_gemm((const bf16_t*)(ws + O_QKV + 2 * SZ_DD), xb, 0, 0, D, D, D, D / 256, T / 256, 1); break;
    case 13: d.kind = K_KMEAN; break;
    case 14: d.kind = K_ATTN; break;
    case 15: d.kind = K_GRES;
             d.g = mk_gemm(slot(3), (const bf16_t*)(ws + O_MOUT), 0, 0, D, D, D, T / 256, D / 256, 1); break;
    case 20: d.kind = K_RMIX; break;
    case 21: d.kind = K_GACT; d.C = slot(6); d.sC = (long)T * D;
             d.g = mk_gemm(slot(0), (const bf16_t*)(ws + O_RKV), (long)T * D, (long)D * D, D, D, D, T / 256, D / 256, 3); break;
    case 22: d.kind = K_GACT; d.C = (bf16_t*)(ws + O_L1O); d.sC = (long)T * 256; d.ldc = 256; d.acts = 0x302u;
             d.g = mk_gemm(slot(3), (const bf16_t*)(ws + O_L1), (long)T * D, (long)256 * D, D, D, D, T / 256, 1, 3); break;
    case 23: d.kind = K_GACT; d.C = slot(0); d.sC = (long)T * D;
             d.g = mk_gemm((const bf16_t*)(ws + O_L1O), (const bf16_t*)(ws + O_L2), (long)T * 256, (long)D * 256, 256, 256, 256, T / 256, D / 256, 3); break;
    case 24: d.kind = K_RPREP; break;
    case 25: d.kind = K_RSCAN; break;
    case 26: d.kind = K_RPOST; break;
    case 27: d.kind = K_GRES;
             d.g = mk_gemm(slot(3), (const bf16_t*)(ws + O_ROUT), 0, 0, D, D, D, T / 256, D / 256, 1); break;
    case 32: d.kind = K_POOL; break;
    case 33: d.kind = K_GRES; d.cscale = p.in[33]; d.sC = 512;
             d.g = mk_gemm(slot(0), (const bf16_t*)(ws + O_POOL), 512, 512 * 512, D, 512, 512, T / 256, 2, 4); break;
    default: break;
    }
    return d;
}

__global__ void __launch_bounds__(512, 2) fwd_megakernel(Params p) {
    extern __shared__ __attribute__((aligned(16))) unsigned char smem[];
    cg::grid_group grid = cg::this_grid();
    LAS unsigned char* lds = (LAS unsigned char*)smem;

    const bool multi = (p.hi - p.lo) > 1;
    volatile LAS unsigned* xst = (volatile LAS unsigned*)(lds + 131072);
    if (__builtin_amdgcn_workitem_id_x() == 0) { xst[0] = 0u; xst[1] = 0u; }
    __syncthreads();
    (void)xcd_barrier_post((int)__builtin_amdgcn_workitem_id_x(), (unsigned*)(p.ws + O_BAR), xst);
    for (int st = p.lo; st < p.hi; ++st) {
        int tid_ = (int)__builtin_amdgcn_workitem_id_x(); asm volatile("" : "+v"(tid_));
        int bid_ = (int)__builtin_amdgcn_workgroup_id_x(); asm volatile("" : "+s"(bid_));
        unsigned char* ws = p.ws; asm volatile("" : "+s"(ws));
        float* xcur = p.out; asm volatile("" : "+s"(xcur));
        unsigned char* sl = ws + O_SLOT;
        auto slot = [&](int i) { return (bf16_t*)(sl + (size_t)i * SLOT); };
        const int stu = __builtin_amdgcn_readfirstlane(st);
        const Desc d = make_desc(stu, p, ws);
        switch (__builtin_amdgcn_readfirstlane(d.kind)) {
        case K_PREP: prep_phase(tid_, bid_, p, smem); break;
        case K_GACT: { pg8::EpiAct E; E.C = d.C; E.sC = d.sC; E.ldc = d.ldc; E.acts = d.acts; pg8::gemm_phase(tid_, bid_, lds, d.g, E); } break;
        case K_GRES: { pg8::EpiRes E; E.out = xcur; E.res = d.res ? d.res : xcur; E.cscale = d.cscale; E.alpha = ALPHA; E.sC = d.sC; E.ldc = D; pg8::gemm_phase(tid_, bid_, lds, d.g, E); } break;
        case K_LN: ln_phase(tid_, bid_, xcur, xcur, d.lnlast ? nullptr : slot(8), p.in[1] + (size_t)d.lnidx * D, p.in[2] + (size_t)d.lnidx * D); break;
        case K_RGCONV: rg_conv_phase(tid_, bid_, slot(0), slot(2), p.in[6], p.in[7]); break;
        case K_RGSCAN0: rg_scan_phase<0>(tid_, bid_, p, slot(3), slot(2), slot(0), (float*)(ws + O_AGG), slot(5)); break;
        case K_RGSCAN1: rg_scan_phase<1>(tid_, bid_, p, slot(3), slot(2), slot(0), (float*)(ws + O_AGG), slot(5)); break;
        case K_KMEAN: kmean_phase(tid_, bid_, slot(0), slot(1), (float*)(ws + O_KMEAN), (const float*)(ws + O_ROPE), (const float*)(ws + O_ROPE) + SEQ * 16, smem); break;
        case K_ATTN: attn_phase(tid_, bid_, slot(0), slot(1), slot(2), slot(3), (const float*)(ws + O_KMEAN), smem); break;
        case K_RMIX: rwkv_mix_phase(tid_, bid_, xcur, p.in[16], slot(0)); break;
        case K_RPREP: rwkv_prep_phase(tid_, bid_, p, sl, (float*)(ws + O_SCAL)); break;
        case K_RSCAN: rwkv_scan_phase(tid_, bid_, sl, (const float*)(ws + O_SCAL), smem); break;
        case K_RPOST: rwkv_post_phase(tid_, bid_, p, sl, (const float*)(ws + O_SCAL)); break;
        case K_POOL: pool_phase(tid_, bid_, xcur, slot(0)); break;
        default: break;
        }
        if (multi && !step_nosync(st) && st + 1 < p.hi) { if (st == p.lo) grid.sync(); else { XcdBarrier xb; xb.bar = (unsigned*)(ws + O_BAR); xb.x = xb_xcc_id(); xb.st = (volatile LAS unsigned*)(lds + 131072); xcd_barrier(tid_, xb); } }
    }
}

extern "C" void kernel_launch(void* const* d_in, const int* in_sizes, int n_in, void* d_out, int out_size, void* d_ws, size_t ws_size, hipStream_t stream) {
    static int grid = 0;
    if (grid == 0) {
        if (n_in != 34 || out_size != T * D || ws_size < WS_END) { fprintf(stderr, "kernel_launch: unexpected shapes (n_in %d out %d ws %zu need %zu)\n", n_in, out_size, ws_size, (size_t)WS_END); grid = -1; return; }
        int dev = 0, cus = 0, per_cu = 0;
        hipGetDevice(&dev);
        hipDeviceGetAttribute(&cus, hipDeviceAttributeMultiprocessorCount, dev);
        if (hipFuncSetAttribute((const void*)fwd_megakernel, hipFuncAttributeMaxDynamicSharedMemorySize, LDS_BYTES) != hipSuccess) { fprintf(stderr, "kernel_launch: hipFuncSetAttribute failed\n"); grid = -1; return; }
        hipOccupancyMaxActiveBlocksPerMultiprocessor(&per_cu, (const void*)fwd_megakernel, 512, LDS_BYTES);
        if (per_cu < 1) { fprintf(stderr, "kernel_launch: occupancy query says %d blocks/CU\n", per_cu); per_cu = 1; }
        (void)hipGetLastError();
        grid = cus;
    }
    if (grid < 0) return;
    Params p{};
    for (int i = 0; i < 34; ++i) p.in[i] = (const float*)d_in[i];
    {
        unsigned char* ws = (unsigned char*)d_ws; int nj = 0, t0 = 0;
        auto add = [&](const float* src, size_t dstoff, int Ks, int Ns, int Kd, int Nd) {
            TJob& j = p.tj[nj]; j.src = src; j.dst = (bf16_t*)(ws + dstoff); j.Ks = Ks; j.Ns = Ns; j.Kd = Kd; j.Nd = Nd; j.tile0 = t0; j.pad = 0;
            t0 += (Kd / 128) * (Nd / 128); ++nj; };
        for (int l = 0; l < 4; ++l) add(p.in[3] + (size_t)l * D * DFF, O_W1T + (size_t)l * DFF * D * 2, D, DFF, D, DFF);
        for (int l = 0; l < 4; ++l) add(p.in[4] + (size_t)l * D * DFF, O_W2T + (size_t)l * DFF * D * 2, DFF, D, DFF, D);
        add(p.in[5], O_WIN, D, 4096, D, 4096);
        for (int n = 0; n < 8; ++n) { add(p.in[8] + (size_t)n * 65536, O_GATES + (size_t)n * 512 * 256 * 2, 256, 256, 256, 256);
                                      add(p.in[10] + (size_t)n * 65536, O_GATES + ((size_t)n * 512 + 256) * 256 * 2, 256, 256, 256, 256); }
        add(p.in[13], O_RGOUT, D, D, D, D);
        add(p.in[14], O_QKV, D, 3 * D, D, 3 * D);
        add(p.in[15], O_MOUT, D, D, D, D);
        for (int g = 0; g < 3; ++g) add(p.in[17] + (size_t)g * D * D, O_RKV + g * SZ_DD, D, D, D, D);
        add(p.in[19], O_L1 + 0 * (size_t)256 * D * 2, D, 96, D, 256);
        add(p.in[22], O_L1 + 1 * (size_t)256 * D * 2, D, 96, D, 256);
        add(p.in[24], O_L1 + 2 * (size_t)256 * D * 2, D, 256, D, 256);
        add(p.in[20], O_L2 + 0 * (size_t)D * 256 * 2, 96, D, 256, D);
        add(p.in[23], O_L2 + 1 * (size_t)D * 256 * 2, 96, D, 256, D);
        add(p.in[25], O_L2 + 2 * (size_t)D * 256 * 2, 256, D, 256, D);
        add(p.in[31], O_ROUT, D, D, D, D);
        for (int g = 0; g < 4; ++g) add(p.in[32] + (size_t)g * 512 * 512, O_POOL + (size_t)g * 512 * 512 * 2, 512, 512, 512, 512);
        p.ntiles = t0;
        if (nj != NTJ) fprintf(stderr, "kernel_launch: job table size %d != %d\n", nj, NTJ);
    }
    p.out = (float*)d_out; p.ws = (unsigned char*)d_ws; p.lo = 0; p.hi = NSTEPS;
    if (hipMemsetAsync((unsigned char*)d_ws + O_BAR, 0, BAR_BYTES, stream) != hipSuccess) { fprintf(stderr, "kernel_launch: memset of barrier words failed\n"); return; }
    void* args[] = {&p};
    hipError_t e = hipLaunchCooperativeKernel((const void*)fwd_megakernel, dim3(grid), dim3(512), args, LDS_BYTES, stream);
    if (e != hipSuccess) fprintf(stderr, "cooperative launch failed: %s (grid %d)\n", hipGetErrorString(e), grid);
}
```

```cpp
#include <hip/hip_runtime.h>
#include <hip/hip_cooperative_groups.h>
#include <cstdio>
namespace cg = cooperative_groups;

#define LAS __attribute__((address_space(3)))
typedef unsigned short bf16_t;
typedef short bf16x8 __attribute__((ext_vector_type(8)));
typedef float f32x4 __attribute__((ext_vector_type(4)));
typedef float f32x2 __attribute__((ext_vector_type(2)));
typedef unsigned u32x4 __attribute__((ext_vector_type(4)));
typedef unsigned u32x2 __attribute__((ext_vector_type(2)));
typedef __bf16 bfv2 __attribute__((ext_vector_type(2)));
#define DI __device__ __forceinline__

constexpr int T = 16384, D = 2048, SEQ = 4096, DFF = 8192;
constexpr float ALPHA = 1.6817928305074290f;
constexpr float LN_EPS = 1e-5f;

constexpr size_t SZ_DD = (size_t)D * D * 2;
constexpr size_t O_W1T = 0;
constexpr size_t O_W2T = O_W1T + 4 * (size_t)DFF * D * 2;
constexpr size_t O_WIN = O_W2T + 4 * (size_t)DFF * D * 2;
constexpr size_t O_GATES = O_WIN + (size_t)4096 * D * 2;
constexpr size_t O_RGOUT = O_GATES + (size_t)8 * 512 * 256 * 2;
constexpr size_t O_QKV = O_RGOUT + SZ_DD;
constexpr size_t O_MOUT = O_QKV + 3 * SZ_DD;
constexpr size_t O_RKV = O_MOUT + SZ_DD;
constexpr size_t O_L1 = O_RKV + 3 * SZ_DD;
constexpr size_t O_L2 = O_L1 + (size_t)3 * 256 * D * 2;
constexpr size_t O_ROUT = O_L2 + (size_t)3 * D * 256 * 2;
constexpr size_t O_POOL = O_ROUT + SZ_DD;
constexpr size_t O_SLOT = O_POOL + (size_t)4 * 512 * 512 * 2;
constexpr size_t SLOT = (size_t)T * D * 2;
constexpr size_t O_L1O = O_SLOT + 9 * SLOT;
constexpr size_t O_ROPE = O_L1O + (size_t)3 * T * 256 * 2;
constexpr size_t O_KMEAN = O_ROPE + (size_t)2 * SEQ * 16 * 4;
constexpr size_t O_AGG = O_KMEAN + (size_t)64 * 16 * 128 * 4;
constexpr size_t O_SCAL = O_AGG + (size_t)4 * 128 * D * 2 * 4;
constexpr size_t O_BAR = O_SCAL + (size_t)3 * T * 32 * 4;
constexpr size_t BAR_BYTES = 16384;
constexpr size_t WS_END = O_BAR + BAR_BYTES;

constexpr int LDS_BYTES = 131072 + 16;

struct TJob { const float* src; bf16_t* dst; int Ks, Ns, Kd, Nd, tile0, pad; };
constexpr int NTJ = 42;
struct Params {
    const float* in[34];
    float* out;
    unsigned char* ws;
    int lo, hi, ntiles, pad;
    TJob tj[NTJ];
};

DI unsigned pk_bf16(float a, float b) { f32x2 v = {a, b}; bfv2 r = __builtin_convertvector(v, bfv2); return __builtin_bit_cast(unsigned, r); }
DI bf16_t f2bf(float a) { return (bf16_t)(pk_bf16(a, 0.f) & 0xffffu); }
DI float bf2f(bf16_t b) { return __uint_as_float(((unsigned)b) << 16); }
DI float bflo(unsigned u) { return __uint_as_float(u << 16); }
DI float bfhi(unsigned u) { return __uint_as_float(u & 0xffff0000u); }
DI float wave_sum(float v) {
    v += __int_as_float(__builtin_amdgcn_update_dpp(0, __float_as_int(v), 0xB1, 0xF, 0xF, false));
    v += __int_as_float(__builtin_amdgcn_update_dpp(0, __float_as_int(v), 0x4E, 0xF, 0xF, false));
    v += __int_as_float(__builtin_amdgcn_update_dpp(0, __float_as_int(v), 0x141, 0xF, 0xF, false));
    v += __int_as_float(__builtin_amdgcn_update_dpp(0, __float_as_int(v), 0x140, 0xF, 0xF, false));
    const int iv = __float_as_int(v);
    return __int_as_float(__builtin_amdgcn_readlane(iv, 0)) + __int_as_float(__builtin_amdgcn_readlane(iv, 16)) +
           __int_as_float(__builtin_amdgcn_readlane(iv, 32)) + __int_as_float(__builtin_amdgcn_readlane(iv, 48));
}
DI float xmax_fq(float v) {
    const auto a = __builtin_amdgcn_permlane32_swap(__float_as_uint(v), __float_as_uint(v), false, false);
    v = fmaxf(__uint_as_float(a[0]), __uint_as_float(a[1]));
    const auto b = __builtin_amdgcn_permlane16_swap(__float_as_uint(v), __float_as_uint(v), false, false);
    return fmaxf(__uint_as_float(b[0]), __uint_as_float(b[1]));
}
DI float xsum_fq(float v) {
    const auto a = __builtin_amdgcn_permlane32_swap(__float_as_uint(v), __float_as_uint(v), false, false);
    v = __uint_as_float(a[0]) + __uint_as_float(a[1]);
    const auto b = __builtin_amdgcn_permlane16_swap(__float_as_uint(v), __float_as_uint(v), false, false);
    return __uint_as_float(b[0]) + __uint_as_float(b[1]);
}
DI void lds_barrier() { asm volatile("s_waitcnt lgkmcnt(0)" ::: "memory"); __builtin_amdgcn_s_barrier(); asm volatile("" ::: "memory"); }
DI float sigmoidf_(float x) { return __builtin_amdgcn_rcpf(1.f + __expf(-x)); }
DI float tanhf_(float x) { return 1.f - 2.f * __builtin_amdgcn_rcpf(1.f + __expf(2.f * x)); }
DI float gelu_tanh(float x) { const float u = 0.7978845608028654f * (x + 0.044715f * x * x * x); return 0.5f * x * (1.f + tanhf_(u)); }

namespace pg8 {
constexpr int BM = 256, BK = 64, HALF = 128, HTB = HALF * BK * 2, NXCD = 8, WGM = 4;
DI int lds_byte(int r, int c) { const int st = (r >> 4) * 2 + (c >> 5), rr = r & 15, cc = c & 31, ob = rr * 64 + cc * 2; return st * 1024 + (ob ^ (((ob >> 9) & 1) << 5)); }
DI void stage_rc(int b, int& R, int& C) { const int st = b / 1024, sb = b % 1024, swz = sb ^ (((sb >> 9) & 1) << 5); R = (st >> 1) * 16 + swz / 64; C = (st & 1) * 32 + (swz % 64) / 2; }
DI int perm32(int rho) { const int n = rho >> 4, i = rho & 15; return 8 * (i >> 2) + 4 * n + (i & 3); }

struct Unit { int g, pm, pn; };
struct Gemm { const bf16_t* A; const bf16_t* Bt; long sA, sB; int lda, ldb, K, nM, nN, G; };

struct Order {
    int nM, nN, nwg, tot, Gd, c;
    DI void init(const Gemm& g, int Gd_, int c_) { nM = g.nM; nN = g.nN; nwg = nM * nN; tot = nwg * g.G; Gd = Gd_; c = c_; }
    DI bool next(int i, Unit& u) const {
        const long L = (long)i * Gd + c; if (L >= tot) return false;
        const int grp = (int)(L / nwg); int wgid = (int)(L - (long)grp * nwg);
        { const int q = nwg / NXCD, r = nwg % NXCD, xcd = wgid % NXCD, off = wgid / NXCD; wgid = (xcd < r ? xcd * (q + 1) : r * (q + 1) + (xcd - r) * q) + off; }
        const int nig = WGM * nN, gid = wgid / nig, fm = gid * WGM, gsz = (nM - fm) < WGM ? (nM - fm) : WGM;
        u.g = grp; u.pm = fm + ((wgid % nig) % gsz); u.pn = (wgid % nig) / gsz; return true;
    }
};

struct EpiAct {
    static constexpr bool PERM = true;
    bf16_t* C; long sC; int ldc; unsigned acts;
    DI void operator()(const f32x4 (&acc)[2][2][4][2], const Unit& u, int wr, int wc, int fr, int fq) const {
        bf16_t* base = C + (size_t)u.g * sC;
        const int act = (int)((acts >> (4 * u.g)) & 15u);
        const int row0 = u.pm * BM + wr * 64 + fr, col0 = u.pn * BM + wc * 32 + 8 * fq;
#pragma unroll
        for (int ai = 0; ai < 2; ++ai)
#pragma unroll
            for (int m = 0; m < 4; ++m) {
                bf16_t* rowp = base + (size_t)(row0 + ai * HALF + m * 16) * ldc + col0;
#pragma unroll
                for (int bj = 0; bj < 2; ++bj) {
                    float v[8];
#pragma unroll
                    for (int e = 0; e < 4; ++e) { v[e] = acc[ai][bj][m][0][e]; v[4 + e] = acc[ai][bj][m][1][e]; }
                    if (act == 1) {
#pragma unroll
                        for (int e = 0; e < 8; ++e) { const float t = fmaxf(v[e], 0.f); v[e] = t * t; }
                    } else if (act == 2) {
#pragma unroll
                        for (int e = 0; e < 8; ++e) v[e] = tanhf_(v[e]);
                    } else if (act == 3) {
#pragma unroll
                        for (int e = 0; e < 8; ++e) v[e] = sigmoidf_(v[e]);
                    }
                    u32x4 o = {pk_bf16(v[0], v[1]), pk_bf16(v[2], v[3]), pk_bf16(v[4], v[5]), pk_bf16(v[6], v[7])};
                    *(u32x4*)(rowp + bj * HALF) = o;
                }
            }
    }
};
struct EpiRes {
    static constexpr bool PERM = false;
    float* out; const float* res; const float* cscale; float alpha; long sC; int ldc;
    DI void operator()(const f32x4 (&acc)[2][2][4][2], const Unit& u, int wr, int wc, int fr, int fq) const {
        const int row0 = u.pm * BM + wr * 64 + fr, col0 = (int)(u.g * sC) + u.pn * BM + wc * 32 + 4 * fq;
        f32x4 r[2][2][2][2];
        auto ldq = [&](int q, int buf) {
            const int ai = q >> 1, m0 = (q & 1) * 2;
#pragma unroll
            for (int mm = 0; mm < 2; ++mm) {
                const size_t ro = (size_t)(row0 + ai * HALF + (m0 + mm) * 16) * ldc + col0;
#pragma unroll
                for (int bj = 0; bj < 2; ++bj)
#pragma unroll
                    for (int n = 0; n < 2; ++n) r[buf][mm][bj][n] = *(const f32x4*)(res + ro + bj * HALF + n * 16);
            }
        };
        auto stq = [&](int q, int buf) {
            const int ai = q >> 1, m0 = (q & 1) * 2;
#pragma unroll
            for (int mm = 0; mm < 2; ++mm) {
                const size_t ro = (size_t)(row0 + ai * HALF + (m0 + mm) * 16) * ldc + col0;
#pragma unroll
                for (int bj = 0; bj < 2; ++bj)
#pragma unroll
                    for (int n = 0; n < 2; ++n) {
                        f32x4 a = acc[ai][bj][m0 + mm][n];
                        if (cscale) a *= *(const f32x4*)(cscale + col0 + bj * HALF + n * 16);
                        *(f32x4*)(out + ro + bj * HALF + n * 16) = alpha * r[buf][mm][bj][n] + a;
                    }
            }
        };
        ldq(0, 0); ldq(1, 1);
        __builtin_amdgcn_sched_barrier(0);
        stq(0, 0); ldq(2, 0);
        __builtin_amdgcn_sched_barrier(0);
        stq(1, 1); ldq(3, 1);
        __builtin_amdgcn_sched_barrier(0);
        stq(2, 0); stq(3, 1);
    }
};
template <class Epi>
DI void gemm_phase(int tid_, int bid_, LAS unsigned char* lds, const Gemm g, const Epi& E) {
    const int tid = tid_, wid = __builtin_amdgcn_readfirstlane(tid >> 6), lane = tid & 63, wr = wid >> 2, wc = wid & 3, fr = lane & 15, fq = lane >> 4;
    const int K = g.K, nt = K / BK;
    Order S; S.init(g, (int)gridDim.x, (int)bid_);
    unsigned voffA[2], voffB[2];
#pragma unroll
    for (int i = 0; i < 2; ++i) { int R, C; stage_rc(tid * 16 + i * 8192, R, C); const int Rb = Epi::PERM ? ((R & ~31) + perm32(R & 31)) : R;
        voffA[i] = (unsigned)(R * g.lda + C) * 2u; voffB[i] = (unsigned)(Rb * g.ldb + C) * 2u; }
    const size_t kstep = (size_t)(BK * 2);
    const size_t hA = (size_t)HALF * g.lda * 2, hB = (size_t)HALF * g.ldb * 2;
    const unsigned ldsw = (unsigned)wid * 1024u;
    const int aoff = lds_byte(wr * 64 + fr, fq * 8), boff = lds_byte(wc * 32 + fr, fq * 8);
#define PG8_SA(b, h) (((b) * 2 + (h)) * HTB)
#define PG8_SB(b, h) ((4 + (b) * 2 + (h)) * HTB)
#define PG8_STAGE(bufoff, gbase, voff) do { _Pragma("unroll") for (int _i = 0; _i < 2; ++_i) \
        __builtin_amdgcn_global_load_lds((const unsigned*)((const char*)(gbase) + (voff)[_i]), (LAS unsigned*)(lds + (bufoff) + ldsw + _i * 8192), 16, 0, 0); } while (0)
#define PG8_LDA(dst, b, h) do { _Pragma("unroll") for (int m = 0; m < 4; ++m) _Pragma("unroll") for (int k = 0; k < 2; ++k) dst[m][k] = *(const LAS bf16x8*)(lds + PG8_SA(b, h) + aoff + m * 2048 + k * 1024); } while (0)
#define PG8_LDB(dst, b, h) do { _Pragma("unroll") for (int n = 0; n < 2; ++n) _Pragma("unroll") for (int k = 0; k < 2; ++k) dst[n][k] = *(const LAS bf16x8*)(lds + PG8_SB(b, h) + boff + n * 2048 + k * 1024); } while (0)
#define PG8_MMA(ai, bj, At, Bt) do { __builtin_amdgcn_s_setprio(1); _Pragma("unroll") for (int m = 0; m < 4; ++m) _Pragma("unroll") for (int n = 0; n < 2; ++n) _Pragma("unroll") for (int k = 0; k < 2; ++k) \
        acc[ai][bj][m][n] = __builtin_amdgcn_mfma_f32_16x16x32_bf16(Bt[n][k], At[m][k], acc[ai][bj][m][n], 0, 0, 0); __builtin_amdgcn_s_setprio(0); } while (0)
#define PG8_WAIT_V(n) asm volatile("s_waitcnt vmcnt(" #n ")" ::: "memory")
#define PG8_WAIT_L(n) asm volatile("s_waitcnt lgkmcnt(" #n ")" ::: "memory")
#define PG8_BAR __builtin_amdgcn_s_barrier()
#define PG8_SCHED __builtin_amdgcn_sched_barrier(0)
    Unit cur, nxt; int ui = 0;
    if (!S.next(0, cur)) return;
    f32x4 acc[2][2][4][2];
#pragma unroll
    for (int a = 0; a < 2; ++a)
#pragma unroll
        for (int b = 0; b < 2; ++b)
#pragma unroll
            for (int m = 0; m < 4; ++m)
#pragma unroll
                for (int n = 0; n < 2; ++n) acc[a][b][m][n] = (f32x4){0.f, 0.f, 0.f, 0.f};
    bf16x8 At[4][2], B0[2][2], B1[2][2];
    const char* cA = (const char*)g.A + ((size_t)cur.g * g.sA + (size_t)cur.pm * BM * g.lda) * 2;
    const char* cB = (const char*)g.Bt + ((size_t)cur.g * g.sB + (size_t)cur.pn * BM * g.ldb) * 2;
    PG8_STAGE(PG8_SB(0, 0), cB, voffB); PG8_STAGE(PG8_SA(0, 0), cA, voffA); PG8_STAGE(PG8_SB(0, 1), cB + hB, voffB); PG8_STAGE(PG8_SA(0, 1), cA + hA, voffA);
    if (wr == 1) PG8_BAR;
    PG8_WAIT_V(4); PG8_BAR;
    PG8_STAGE(PG8_SB(1, 0), cB + kstep, voffB); PG8_STAGE(PG8_SA(1, 0), cA + kstep, voffA); PG8_STAGE(PG8_SB(1, 1), cB + hB + kstep, voffB);
    PG8_WAIT_V(6); PG8_BAR;
    for (;;) {
        const bool has_next = S.next(ui + 1, nxt);
        const char* nA = has_next ? (const char*)g.A + ((size_t)nxt.g * g.sA + (size_t)nxt.pm * BM * g.lda) * 2 : cA;
        const char* nB = has_next ? (const char*)g.Bt + ((size_t)nxt.g * g.sB + (size_t)nxt.pn * BM * g.ldb) * 2 : cB;
        for (int t = 0; t < nt; t += 2) {
            const bool last = (t == nt - 2);
            const char* a1 = cA + (size_t)(t + 1) * kstep;
            const char* a2 = last ? nA : cA + (size_t)(t + 2) * kstep; const char* b2 = last ? nB : cB + (size_t)(t + 2) * kstep;
            const char* a3 = a2 + kstep; const char* b3 = b2 + kstep;
            PG8_LDB(B0, 0, 0); PG8_SCHED; PG8_LDA(At, 0, 0); PG8_STAGE(PG8_SA(1, 1), a1 + hA, voffA);
            PG8_WAIT_L(8); PG8_BAR; PG8_WAIT_L(0); PG8_MMA(0, 0, At, B0); PG8_BAR; PG8_SCHED;
            PG8_LDB(B1, 0, 1); PG8_STAGE(PG8_SB(0, 0), b2, voffB);
            PG8_BAR; PG8_WAIT_L(0); PG8_MMA(0, 1, At, B1); PG8_BAR;
            PG8_LDA(At, 0, 1); PG8_STAGE(PG8_SA(0, 0), a2, voffA);
            PG8_BAR; PG8_WAIT_L(0); PG8_MMA(1, 0, At, B0); PG8_BAR; PG8_SCHED;
            PG8_STAGE(PG8_SB(0, 1), b2 + hB, voffB);
            PG8_WAIT_V(6); PG8_BAR; PG8_MMA(1, 1, At, B1); PG8_BAR;
            PG8_LDB(B0, 1, 0); PG8_SCHED; PG8_LDA(At, 1, 0); PG8_STAGE(PG8_SA(0, 1), a2 + hA, voffA);
            PG8_WAIT_L(8); PG8_BAR; PG8_WAIT_L(0); PG8_MMA(0, 0, At, B0); PG8_BAR; PG8_SCHED;
            PG8_LDB(B1, 1, 1); PG8_STAGE(PG8_SB(1, 0), b3, voffB);
            PG8_BAR; PG8_WAIT_L(0); PG8_MMA(0, 1, At, B1); PG8_BAR;
            PG8_LDA(At, 1, 1); PG8_STAGE(PG8_SA(1, 0), a3, voffA);
            PG8_BAR; PG8_WAIT_L(0); PG8_MMA(1, 0, At, B0); PG8_BAR; PG8_SCHED;
            PG8_STAGE(PG8_SB(1, 1), b3 + hB, voffB);
            PG8_WAIT_V(6); PG8_BAR; PG8_MMA(1, 1, At, B1); PG8_BAR;
        }
        E(acc, cur, wr, wc, fr, fq);
        if (!has_next) break;
#pragma unroll
        for (int a = 0; a < 2; ++a)
#pragma unroll
            for (int b = 0; b < 2; ++b)
#pragma unroll
                for (int m = 0; m < 4; ++m)
#pragma unroll
                    for (int n = 0; n < 2; ++n) acc[a][b][m][n] = (f32x4){0.f, 0.f, 0.f, 0.f};
        cur = nxt; cA = nA; cB = nB; ++ui;
    }
    PG8_WAIT_V(0);
    if (wr == 0) PG8_BAR;
    PG8_BAR;
#undef PG8_SA
#undef PG8_SB
#undef PG8_STAGE
#undef PG8_LDA
#undef PG8_LDB
#undef PG8_MMA
#undef PG8_WAIT_V
#undef PG8_WAIT_L
#undef PG8_BAR
#undef PG8_SCHED
}
}

DI pg8::Gemm mk_gemm(const bf16_t* A, const bf16_t* Bt, long sA, long sB, int lda, int ldb, int K, int nM, int nN, int G) {
    pg8::Gemm g; g.A = A; g.Bt = Bt; g.sA = sA; g.sB = sB; g.lda = lda; g.ldb = ldb; g.K = K; g.nM = nM; g.nN = nN; g.G = G; return g;
}

DI void prep_phase(int tid_, int bid_, const Params& p, unsigned char* smem) {
    TJob* jobs = (TJob*)smem;
    float* tile = (float*)(smem + 4096);
    const int tid = tid_;
    if (tid < NTJ) jobs[tid] = p.tj[tid];
    __syncthreads();
    const int ntiles = p.ntiles;
    for (int tix = bid_; tix < ntiles; tix += gridDim.x) {
        int j = 0;
        for (int q = 1; q < NTJ; ++q) if (jobs[q].tile0 <= tix) j = q;
        const TJob jb = jobs[j];
        const int lt = tix - jb.tile0, ntk = jb.Kd / 128, k0 = (lt % ntk) * 128, n0 = (lt / ntk) * 128;
        f32x4 v[8];
#pragma unroll
        for (int i = 0; i < 8; ++i) {
            const int idx = tid + i * 512, kk = idx >> 5, n4 = idx & 31;
            const int k = k0 + kk, n = n0 + n4 * 4;
            v[i] = (k < jb.Ks && n < jb.Ns) ? *(const f32x4*)(jb.src + (size_t)k * jb.Ns + n) : (f32x4){0.f, 0.f, 0.f, 0.f};
        }
#pragma unroll
        for (int i = 0; i < 8; ++i) {
            const int idx = tid + i * 512, kk = idx >> 5, n4 = idx & 31;
#pragma unroll
            for (int e = 0; e < 4; ++e) tile[kk * 129 + n4 * 4 + e] = v[i][e];
        }
        __syncthreads();
#pragma unroll
        for (int i = 0; i < 4; ++i) {
            const int idx = tid + i * 512, n = idx >> 4, kc = idx & 15;
            float f[8];
#pragma unroll
            for (int e = 0; e < 8; ++e) f[e] = tile[(kc * 8 + e) * 129 + n];
            u32x4 o = {pk_bf16(f[0], f[1]), pk_bf16(f[2], f[3]), pk_bf16(f[4], f[5]), pk_bf16(f[6], f[7])};
            *(u32x4*)(jb.dst + (size_t)(n0 + n) * jb.Kd + k0 + kc * 8) = o;
        }
        __syncthreads();
    }
    {
        const float* x = p.in[0]; bf16_t* xb = (bf16_t*)(p.ws + O_SLOT + 8 * SLOT);
        const size_t n8 = (size_t)T * D / 8;
        for (size_t i = (size_t)bid_ * 512 + tid; i < n8; i += (size_t)gridDim.x * 512) {
            const f32x4 a = *(const f32x4*)(x + i * 8), b = *(const f32x4*)(x + i * 8 + 4);
            u32x4 o = {pk_bf16(a[0], a[1]), pk_bf16(a[2], a[3]), pk_bf16(b[0], b[1]), pk_bf16(b[2], b[3])};
            *(u32x4*)(xb + i * 8) = o;
        }
    }
    {
        float* ct = (float*)(p.ws + O_ROPE); float* st = ct + SEQ * 16;
        for (int i = bid_ * 512 + tid; i < SEQ * 16; i += gridDim.x * 512) {
            const int pos = i >> 4, f = i & 15;
            const float inv = powf(500000.0f, -(float)(2 * f) / 32.0f);
            const float ang = (float)pos * inv;
            ct[i] = cosf(ang); st[i] = sinf(ang);
        }
    }
}

DI void ln_phase(int tid_, int bid_, const float* zin, float* xout, bf16_t* xb, const float* gam, const float* bet) {
    const int lane = tid_ & 63, wid = tid_ >> 6;
    const int rstride = gridDim.x * 8;
    constexpr int NR = 4;
    for (int row0 = bid_ * 8 + wid; row0 < T; row0 += NR * rstride) {
        f32x4 v[NR][8];
#pragma unroll
        for (int r = 0; r < NR; ++r)
#pragma unroll
            for (int i = 0; i < 8; ++i)
                v[r][i] = (row0 + r * rstride < T) ? *(const f32x4*)(zin + (size_t)(row0 + r * rstride) * D + (i * 64 + lane) * 4) : (f32x4){0.f, 0.f, 0.f, 0.f};
#pragma unroll
        for (int r = 0; r < NR; ++r) {
            const int row = row0 + r * rstride;
            if (row >= T) break;
            float s = 0.f;
#pragma unroll
            for (int i = 0; i < 8; ++i) s += v[r][i][0] + v[r][i][1] + v[r][i][2] + v[r][i][3];
            const float mean = wave_sum(s) * (1.f / D);
            float q = 0.f;
#pragma unroll
            for (int i = 0; i < 8; ++i) { v[r][i] -= mean; q += v[r][i][0] * v[r][i][0] + v[r][i][1] * v[r][i][1] + v[r][i][2] * v[r][i][2] + v[r][i][3] * v[r][i][3]; }
            const float rstd = rsqrtf(wave_sum(q) * (1.f / D) + LN_EPS);
#pragma unroll
            for (int i = 0; i < 8; ++i) {
                const int c = (i * 64 + lane) * 4;
                const f32x4 g = *(const f32x4*)(gam + c), b = *(const f32x4*)(bet + c);
                const f32x4 o = v[r][i] * rstd * g + b;
                *(f32x4*)(xout + (size_t)row * D + c) = o;
                if (xb) { u32x2 w = {pk_bf16(o[0], o[1]), pk_bf16(o[2], o[3])}; *(u32x2*)(xb + (size_t)row * D + c) = w; }
            }
        }
    }
}

DI void rg_conv_phase(int tid_, int bid_, const bf16_t* gu, bf16_t* uc, const float* cw, const float* cb) {
    const size_t n8 = (size_t)T * D / 8;
    const size_t stride = (size_t)gridDim.x * 512;
    constexpr int U = 4;
    for (size_t ib = (size_t)bid_ * 512 + tid_; ib < n8; ib += stride * U) {
        u32x4 uu[U][4];
#pragma unroll
        for (int u = 0; u < U; ++u) {
            const size_t i = ib + u * stride;
            const int t = (int)(i >> 8), c = (int)(i & 255) * 8, s = t & (SEQ - 1);
#pragma unroll
            for (int j = 0; j < 4; ++j)
                uu[u][j] = (i < n8 && s - 3 + j >= 0) ? *(const u32x4*)(gu + (size_t)(t - 3 + j) * 4096 + 2048 + c) : (u32x4){0u, 0u, 0u, 0u};
        }
#pragma unroll
        for (int u = 0; u < U; ++u) {
            const size_t i = ib + u * stride;
            if (i >= n8) break;
            const int c = (int)(i & 255) * 8;
            float a[8];
            { const f32x4 b0 = *(const f32x4*)(cb + c), b1 = *(const f32x4*)(cb + c + 4);
#pragma unroll
              for (int e = 0; e < 4; ++e) { a[e] = b0[e]; a[4 + e] = b1[e]; } }
#pragma unroll
            for (int j = 0; j < 4; ++j) {
                const u32x4 q = uu[u][j];
                const f32x4 w0 = *(const f32x4*)(cw + j * D + c), w1 = *(const f32x4*)(cw + j * D + c + 4);
                a[0] += w0[0] * bflo(q[0]); a[1] += w0[1] * bfhi(q[0]); a[2] += w0[2] * bflo(q[1]); a[3] += w0[3] * bfhi(q[1]);
                a[4] += w1[0] * bflo(q[2]); a[5] += w1[1] * bfhi(q[2]); a[6] += w1[2] * bflo(q[3]); a[7] += w1[3] * bfhi(q[3]);
            }
            u32x4 o = {pk_bf16(a[0], a[1]), pk_bf16(a[2], a[3]), pk_bf16(a[4], a[5]), pk_bf16(a[6], a[7])};
            *(u32x4*)(uc + i * 8) = o;
        }
    }
}
DI void rg_ab(float rpre, float ipre, float u, float ba, float bx, float sp8, float& a, float& b) {
    const float r = sigmoidf_(rpre + ba), ii = sigmoidf_(ipre + bx);
    const float la = -sp8 * r;
    a = __expf(la);
    const float x2 = 2.f * la;
    const float om = (x2 > -0.05f) ? -x2 * (1.f + x2 * (0.5f + x2 * (0.16666667f + x2 * 0.041666668f))) : 1.f - a * a;
    b = u * ii * __builtin_amdgcn_sqrtf(om);
}
template <int MODE>
DI void rg_scan_phase(int tid_, int bid_, const Params& p, const bf16_t* gates, const bf16_t* uc, const bf16_t* gu, float* agg, bf16_t* outg) {
    constexpr int CH = 32;
    const float* gab = p.in[9]; const float* gxb = p.in[11]; const float* lam = p.in[12];
    for (int item = bid_; item < 4 * 128 * 2; item += gridDim.x) {
        const int cg2 = item & 1, chunk = (item >> 1) & 127, b = item >> 8;
        const int ch = cg2 * 1024 + tid_ * 2;
        const int n = ch >> 8, v = ch & 255;
        const f32x2 ba = *(const f32x2*)(gab + ch), bx = *(const f32x2*)(gxb + ch), lm = *(const f32x2*)(lam + ch);
        const float sp0 = 8.f * log1pf(expf(-lm[0])), sp1 = 8.f * log1pf(expf(-lm[1]));
        float h0 = 0.f, h1 = 0.f, P0 = 1.f, P1 = 1.f;
        if (MODE == 1) {
            for (int c0 = 0; c0 < chunk; c0 += 16) {
                f32x4 gv[16];
#pragma unroll
                for (int j = 0; j < 16; ++j) gv[j] = (c0 + j < chunk) ? *(const f32x4*)(agg + (((size_t)b * 128 + c0 + j) * D + ch) * 2) : (f32x4){1.f, 0.f, 1.f, 0.f};
#pragma unroll
                for (int j = 0; j < 16; ++j) { h0 = gv[j][0] * h0 + gv[j][1]; h1 = gv[j][2] * h1 + gv[j][3]; }
            }
        }
        const size_t t0 = (size_t)b * SEQ + (size_t)chunk * CH;
        constexpr int UB = 32;
        for (int tb = 0; tb < CH; tb += UB) {
            unsigned rpv[UB], ipv[UB], uuv[UB], ggv[UB];
#pragma unroll
            for (int j = 0; j < UB; ++j) {
                const size_t t = t0 + tb + j;
                rpv[j] = *(const unsigned*)(gates + t * 4096 + n * 512 + v);
                ipv[j] = *(const unsigned*)(gates + t * 4096 + n * 512 + 256 + v);
                uuv[j] = *(const unsigned*)(uc + t * D + ch);
                if (MODE == 1) ggv[j] = *(const unsigned*)(gu + t * 4096 + ch);
            }
#pragma unroll
            for (int j = 0; j < UB; ++j) {
                const size_t t = t0 + tb + j;
                float a0, b0, a1, b1;
                rg_ab(bflo(rpv[j]), bflo(ipv[j]), bflo(uuv[j]), ba[0], bx[0], sp0, a0, b0);
                rg_ab(bfhi(rpv[j]), bfhi(ipv[j]), bfhi(uuv[j]), ba[1], bx[1], sp1, a1, b1);
                h0 = a0 * h0 + b0; h1 = a1 * h1 + b1;
                if (MODE == 0) { P0 *= a0; P1 *= a1; }
                else *(unsigned*)(outg + t * D + ch) = pk_bf16(gelu_tanh(bflo(ggv[j])) * h0, gelu_tanh(bfhi(ggv[j])) * h1);
            }
        }
        if (MODE == 0) { f32x4 o = {P0, h0, P1, h1}; *(f32x4*)(agg + (((size_t)b * 128 + chunk) * D + ch) * 2) = o; }
    }
}

DI void kmean_phase(int tid_, int bid_, bf16_t* Qx, bf16_t* Kx, float* kmean, const float* ctab, const float* stab, unsigned char* smem) {
    float* redA = (float*)smem;
    float* redB = redA + 1024;
    const int tid = tid_;
    for (int item = bid_; item < 1024; item += gridDim.x) {
        const int blk = item & 15, h = (item >> 4) & 15, b = item >> 8;
        {
            const int i = tid & 15, rg = tid >> 4;
            float s1 = 0.f, s2 = 0.f;
            bf16_t k1v[8], k2v[8], q1v[8], q2v[8]; float cv[8], sv[8];
#pragma unroll
            for (int r = 0; r < 8; ++r) {
                const int pos = blk * 256 + rg * 8 + r;
                const size_t o = ((size_t)b * SEQ + pos) * D + h * 128 + i;
                cv[r] = ctab[pos * 16 + i]; sv[r] = stab[pos * 16 + i];
                k1v[r] = Kx[o]; k2v[r] = Kx[o + 16]; q1v[r] = Qx[o]; q2v[r] = Qx[o + 16];
            }
#pragma unroll
            for (int r = 0; r < 8; ++r) {
                const int pos = blk * 256 + rg * 8 + r;
                const size_t o = ((size_t)b * SEQ + pos) * D + h * 128 + i;
                const float c = cv[r], sn = sv[r];
                const float k1 = bf2f(k1v[r]), k2 = bf2f(k2v[r]);
                const bf16_t k1r = f2bf(k1 * c - k2 * sn), k2r = f2bf(k2 * c + k1 * sn);
                Kx[o] = k1r; Kx[o + 16] = k2r; s1 += bf2f(k1r); s2 += bf2f(k2r);
                const float q1 = bf2f(q1v[r]), q2 = bf2f(q2v[r]);
                Qx[o] = f2bf(q1 * c - q2 * sn); Qx[o + 16] = f2bf(q2 * c + q1 * sn);
            }
            redA[rg * 32 + i] = s1; redA[rg * 32 + 16 + i] = s2;
        }
        {
            const int dp = tid & 63, rg = tid >> 6;
            if (dp >= 16) {
                const bf16_t* base = Kx + ((size_t)b * SEQ + blk * 256 + rg * 32) * D + h * 128 + dp * 2;
                float s0 = 0.f, s1 = 0.f;
                unsigned uv[32];
#pragma unroll
                for (int r = 0; r < 32; ++r) uv[r] = *(const unsigned*)(base + (size_t)r * D);
#pragma unroll
                for (int r = 0; r < 32; ++r) { s0 += bflo(uv[r]); s1 += bfhi(uv[r]); }
                redB[rg * 128 + dp * 2] = s0; redB[rg * 128 + dp * 2 + 1] = s1;
            }
        }
        __syncthreads();
        if (tid < 128) {
            float s = 0.f;
            if (tid < 32) { for (int r = 0; r < 32; ++r) s += redA[r * 32 + tid]; }
            else { for (int r = 0; r < 8; ++r) s += redB[r * 128 + tid]; }
            kmean[(size_t)item * 128 + tid] = s * (1.f / 256.f);
        }
        __syncthreads();
    }
}

DI void attn_phase(int tid_, int bid_, const bf16_t* Q, const bf16_t* Kx, const bf16_t* VT, bf16_t* O, const float* kmean, unsigned char* smem) {
    constexpr int KB_STRIDE = 288, VB_STRIDE = 160;
    constexpr int KBUF = 64 * KB_STRIDE, VBUF = 128 * VB_STRIDE;
    constexpr float QC = 0.08838834764831845f * 1.4426950408889634f;
    constexpr float THR_RAW = 8.0f / 0.08838834764831845f;
#define KBUFP(bi) (smem + (bi) * KBUF)
#define VBUFP(bi) (smem + 2 * KBUF + (bi) * VBUF)
    float* km = (float*)(smem + 2 * KBUF + 2 * VBUF);
    const int tid = tid_, wid = tid >> 6, lane = tid & 63, fr = lane & 15, fq = lane >> 4;
    for (int idx = bid_; idx < 1024; idx += gridDim.x) {
        const int bh = idx & 63, jj = idx >> 6, sub = jj & 3, r2 = jj >> 2;
        const int qb = (r2 == 0) ? sub : (r2 == 1) ? (7 - sub) : (r2 == 2) ? (8 + sub) : (15 - sub);
        const int b = bh >> 4, h = bh & 15;
        const size_t tok0 = (size_t)b * SEQ;
        const int qloc0 = wid * 32 + fr;
        { const f32x4 kv = *(const f32x4*)(kmean + (size_t)bh * 2048 + tid * 4); *(f32x4*)(km + tid * 4) = kv; }
        bf16x8 qf[2][4];
#pragma unroll
        for (int qt = 0; qt < 2; ++qt)
#pragma unroll
            for (int dc = 0; dc < 4; ++dc) qf[qt][dc] = *(const bf16x8*)(Q + (tok0 + qb * 256 + qloc0 + qt * 16) * D + h * 128 + dc * 32 + fq * 8);
        __syncthreads();
        const int ntile = (qb + 1) * 4;
        const int kr0 = tid >> 4, kc0 = tid & 15;
        const int vr0 = tid >> 3, vc0 = tid & 7;
        u32x4 kreg0[2], vreg0[2];
        auto gload = [&](int tt, u32x4 (&kreg)[2], u32x4 (&vreg)[2]) {
            const int key0 = tt * 64;
#pragma unroll
            for (int i = 0; i < 2; ++i) {
                kreg[i] = *(const u32x4*)(Kx + (tok0 + key0 + kr0 + i * 32) * D + h * 128 + kc0 * 8);
                vreg[i] = *(const u32x4*)(VT + (size_t)(h * 128 + vr0 + i * 64) * T + tok0 + key0 + vc0 * 8);
            }
        };
        auto lstore = [&](int bi, const u32x4 (&kreg)[2], const u32x4 (&vreg)[2]) {
#pragma unroll
            for (int i = 0; i < 2; ++i) {
                *(u32x4*)(KBUFP(bi) + (kr0 + i * 32) * KB_STRIDE + kc0 * 16) = kreg[i];
                {
                    unsigned char* vrow = VBUFP(bi) + (vr0 + i * 64) * VB_STRIDE + (vc0 >> 2) * 64;
                    const int c = vc0 & 3, p0 = ((c & 1) * 2) * 16 + (c >> 1) * 8;
                    u32x2 lo = {vreg[i][0], vreg[i][1]}, hi = {vreg[i][2], vreg[i][3]};
                    *(u32x2*)(vrow + p0) = lo; *(u32x2*)(vrow + p0 + 16) = hi;
                }
            }
        };
        gload(0, kreg0, vreg0);
        unsigned mask[2];
#pragma unroll
        for (int qt = 0; qt < 2; ++qt) {
            float v0 = -3e38f, v1 = -3e38f, v2 = -3e38f; int i0 = -1, i1 = -1, i2 = -1;
            for (int j = 0; j < qb; ++j) {
                float g = 0.f;
#pragma unroll
                for (int dc = 0; dc < 4; ++dc) {
                    const f32x4 ka = *(const f32x4*)(km + j * 128 + dc * 32 + fq * 8), kb2 = *(const f32x4*)(km + j * 128 + dc * 32 + fq * 8 + 4);
#pragma unroll
                    for (int e = 0; e < 4; ++e) { g += bf2f((bf16_t)qf[qt][dc][e]) * ka[e]; g += bf2f((bf16_t)qf[qt][dc][4 + e]) * kb2[e]; }
                }
                g = xsum_fq(g);
                if (g > v0) { v2 = v1; i2 = i1; v1 = v0; i1 = i0; v0 = g; i0 = j; }
                else if (g > v1) { v2 = v1; i2 = i1; v1 = g; i1 = j; }
                else if (g > v2) { v2 = g; i2 = j; }
            }
            unsigned mk = 0u;
            if (i0 >= 0) mk |= 1u << i0;
            if (i1 >= 0) mk |= 1u << i1;
            if (i2 >= 0) mk |= 1u << i2;
            mask[qt] = mk;
        }
        float mrun[2] = {-1e30f, -1e30f}, lrun[2] = {0.f, 0.f};
        f32x4 oacc[2][8];
#pragma unroll
        for (int qt = 0; qt < 2; ++qt)
#pragma unroll
            for (int dt = 0; dt < 8; ++dt) oacc[qt][dt] = (f32x4){0.f, 0.f, 0.f, 0.f};
        auto compute = [&](int tt, int bi) {
            const int kb = tt >> 2, kt64 = tt & 3;
            const bool own = (kb == qb);
            bool actq[2];
#pragma unroll
            for (int qt = 0; qt < 2; ++qt) actq[qt] = own ? true : (((mask[qt] >> kb) & 1u) != 0u);
            const bool doit = own ? (kt64 * 64 <= wid * 32 + 31) : (__any((int)(actq[0] || actq[1])) != 0);
            if (doit) {
                f32x4 sacc[2][4];
#pragma unroll
                for (int qt = 0; qt < 2; ++qt)
#pragma unroll
                    for (int kt = 0; kt < 4; ++kt) sacc[qt][kt] = (f32x4){0.f, 0.f, 0.f, 0.f};
#pragma unroll
                for (int dc = 0; dc < 4; ++dc)
#pragma unroll
                    for (int kt = 0; kt < 4; ++kt) {
                        const bf16x8 kf = *(const bf16x8*)(KBUFP(bi) + (kt * 16 + fr) * KB_STRIDE + dc * 64 + fq * 16);
#pragma unroll
                        for (int qt = 0; qt < 2; ++qt) sacc[qt][kt] = __builtin_amdgcn_mfma_f32_16x16x32_bf16(kf, qf[qt][dc], sacc[qt][kt], 0, 0, 0);
                    }
                bf16x8 pf[2][2];
#pragma unroll
                for (int qt = 0; qt < 2; ++qt) {
                    const int lim = own ? (qloc0 + qt * 16 - kt64 * 64 - fq * 4) : (actq[qt] ? 1000 : -1000);
                    float mx = -1e30f;
#pragma unroll
                    for (int kt = 0; kt < 4; ++kt)
#pragma unroll
                        for (int r = 0; r < 4; ++r) {
                            const float sv = (kt * 16 + r <= lim) ? sacc[qt][kt][r] : -__builtin_inff();
                            sacc[qt][kt][r] = sv; mx = fmaxf(mx, sv);
                        }
                    mx = xmax_fq(mx);
                    if (__any((int)(mx > mrun[qt] + THR_RAW))) {
                        const float mnew = fmaxf(mrun[qt], mx);
                        const float alpha = __builtin_amdgcn_exp2f((mrun[qt] - mnew) * QC);
                        mrun[qt] = mnew;
                        lrun[qt] *= alpha;
#pragma unroll
                        for (int dt = 0; dt < 8; ++dt) oacc[qt][dt] *= alpha;
                    }
                    const float mneg = -mrun[qt] * QC;
                    float ps = 0.f;
#pragma unroll
                    for (int kt = 0; kt < 4; ++kt)
#pragma unroll
                        for (int r = 0; r < 4; ++r) { const float pe = __builtin_amdgcn_exp2f(__builtin_fmaf(sacc[qt][kt][r], QC, mneg)); sacc[qt][kt][r] = pe; ps += pe; }
                    lrun[qt] += ps;
#pragma unroll
                    for (int ks = 0; ks < 2; ++ks) {
                        u32x4 w = {pk_bf16(sacc[qt][2 * ks][0], sacc[qt][2 * ks][1]), pk_bf16(sacc[qt][2 * ks][2], sacc[qt][2 * ks][3]),
                                   pk_bf16(sacc[qt][2 * ks + 1][0], sacc[qt][2 * ks + 1][1]), pk_bf16(sacc[qt][2 * ks + 1][2], sacc[qt][2 * ks + 1][3])};
                        pf[qt][ks] = __builtin_bit_cast(bf16x8, w);
                    }
                }
#pragma unroll
                for (int ks = 0; ks < 2; ++ks)
#pragma unroll
                    for (int dt = 0; dt < 8; ++dt) {
                        const bf16x8 vf = *(const bf16x8*)(VBUFP(bi) + (dt * 16 + fr) * VB_STRIDE + ks * 64 + fq * 16);
#pragma unroll
                        for (int qt = 0; qt < 2; ++qt) oacc[qt][dt] = __builtin_amdgcn_mfma_f32_16x16x32_bf16(vf, pf[qt][ks], oacc[qt][dt], 0, 0, 0);
                    }
            }
        };
        lstore(0, kreg0, vreg0);
        __syncthreads();
        for (int tt = 0; tt < ntile; tt += 2) {
            if (tt + 1 < ntile) gload(tt + 1, kreg0, vreg0);
            compute(tt, 0);
            if (tt + 1 < ntile) lstore(1, kreg0, vreg0);
            lds_barrier();
            if (tt + 1 < ntile) {
                if (tt + 2 < ntile) gload(tt + 2, kreg0, vreg0);
                compute(tt + 1, 1);
                if (tt + 2 < ntile) lstore(0, kreg0, vreg0);
                lds_barrier();
            }
        }
        __syncthreads();
#pragma unroll
        for (int qt = 0; qt < 2; ++qt) {
            const float lt = xsum_fq(lrun[qt]);
            const float inv = 1.f / lt;
            bf16_t* orow = O + (tok0 + qb * 256 + qloc0 + qt * 16) * D + h * 128 + fq * 4;
#pragma unroll
            for (int dt = 0; dt < 8; ++dt) {
                const f32x4 o = oacc[qt][dt] * inv;
                u32x2 w = {pk_bf16(o[0], o[1]), pk_bf16(o[2], o[3])};
                *(u32x2*)(orow + dt * 16) = w;
            }
        }
    }
#undef KBUFP
#undef VBUFP
}

DI void rwkv_mix_phase(int tid_, int bid_, const float* x, const float* mu, bf16_t* slots) {
    const size_t n4 = (size_t)T * D / 4;
    const size_t stride = (size_t)gridDim.x * 512;
    constexpr int U = 8;
    for (size_t ib = (size_t)bid_ * 512 + tid_; ib < n4; ib += stride * U) {
        f32x4 xv[U], xp[U];
#pragma unroll
        for (int u = 0; u < U; ++u) {
            const size_t i = ib + u * stride;
            const int t = (int)(i >> 9), s_ = t & (SEQ - 1);
            xv[u] = (i < n4) ? *(const f32x4*)(x + i * 4) : (f32x4){0.f, 0.f, 0.f, 0.f};
            xp[u] = (i < n4 && s_ > 0) ? *(const f32x4*)(x + i * 4 - D) : (f32x4){0.f, 0.f, 0.f, 0.f};
        }
#pragma unroll
        for (int u = 0; u < U; ++u) {
            const size_t i = ib + u * stride;
            if (i >= n4) break;
            const int c = (int)(i & 511) * 4;
            const f32x4 xx = xp[u] - xv[u];
#pragma unroll
            for (int k = 0; k < 6; ++k) {
                const f32x4 m = *(const f32x4*)(mu + k * D + c);
                const f32x4 o = xv[u] + xx * m;
                u32x2 w = {pk_bf16(o[0], o[1]), pk_bf16(o[2], o[3])};
                *(u32x2*)((unsigned char*)slots + k * SLOT + i * 8) = w;
            }
        }
    }
}
DI float softplusf_(float y) { return fmaxf(y, 0.f) + __logf(1.f + __expf(-fabsf(y))); }
DI void rwkv_prep_phase(int tid_, int bid_, const Params& p, unsigned char* sl, float* scal) {
    bf16_t* R = (bf16_t*)(sl + 6 * SLOT); bf16_t* Kk = (bf16_t*)(sl + 7 * SLOT);
    const bf16_t* WP = (const bf16_t*)(sl + 0 * SLOT); bf16_t* AP = (bf16_t*)(sl + 1 * SLOT);
    bf16_t* KX = (bf16_t*)(sl + 3 * SLOT); float* WD = (float*)(sl + 4 * SLOT);
    const float* w0 = p.in[18]; const float* a0 = p.in[21]; const float* k_k = p.in[26]; const float* k_a = p.in[27]; const float* r_k = p.in[28];
    float* BR = scal; float* KR = scal + (size_t)T * 32; float* BO = scal + (size_t)2 * T * 32;
    const int lane = tid_ & 63, wid = tid_ >> 6;
    constexpr int U = 16;
    for (int grp = bid_ * 8 + wid; grp < T * 32 / U; grp += gridDim.x * 8) {
        const int item0 = grp * U;
        const int h0 = item0 & 31; const size_t t = (size_t)(item0 >> 5);
        const size_t o0 = t * D + h0 * 64 + lane;
        bf16_t rr[U], kr_[U], wpr[U], apr[U];
#pragma unroll
        for (int u = 0; u < U; ++u) { rr[u] = R[o0 + u * 64]; kr_[u] = Kk[o0 + u * 64]; wpr[u] = WP[o0 + u * 64]; apr[u] = AP[o0 + u * 64]; }
#pragma unroll
        for (int u = 0; u < U; ++u) {
            const int c = (h0 + u) * 64 + lane; const size_t o = o0 + u * 64;
            const float r = bf2f(rr[u]), k = bf2f(kr_[u]), wp = bf2f(wpr[u]), ap = bf2f(apr[u]);
            const float wlog = -softplusf_(-(w0[c] + wp)) - 0.5f;
            const float dec = __expf(-__expf(wlog));
            const float a = __builtin_amdgcn_rcpf(1.f + __expf(-(a0[c] + ap)));
            float kk = k * k_k[c];
            kk = kk * fminf(__builtin_amdgcn_rsqf(wave_sum(kk * kk)), 1e12f);
            const float kx = k * (1.f + (a - 1.f) * k_a[c]);
            const float bb = kk * a;
            const float br = wave_sum(bb * r), kr = wave_sum(kx * r), bo = wave_sum(r * kx * r_k[c]);
            R[o] = f2bf(dec * r); Kk[o] = f2bf(-kk); AP[o] = f2bf(bb); KX[o] = f2bf(kx); WD[o] = dec;
            if (lane == 0) { BR[item0 + u] = br; KR[item0 + u] = kr; BO[item0 + u] = bo; }
        }
    }
}
DI float dpp_sum8(float v) {
    v += __int_as_float(__builtin_amdgcn_update_dpp(0, __float_as_int(v), 0xB1, 0xF, 0xF, false));
    v += __int_as_float(__builtin_amdgcn_update_dpp(0, __float_as_int(v), 0x4E, 0xF, 0xF, false));
    v += __int_as_float(__builtin_amdgcn_update_dpp(0, __float_as_int(v), 0x141, 0xF, 0xF, false));
    return v;
}
DI void rwkv_scan_phase(int tid_, int bid_, unsigned char* sl, const float* scal, unsigned char* smem) {
    constexpr int TC = 32;
    constexpr int OFF_BB = TC * 128, OFF_KX = OFF_BB + TC * 64, OFF_W = OFF_KX + TC * 64, OFF_V = OFF_W + TC * 64, OFF_SC = OFF_V + TC * 32, BUF_F = OFF_SC + TC * 2;
    constexpr int NCH = SEQ / TC;
#define SBUF(i) ((float*)smem + (i) * BUF_F)
    const bf16_t* NKK = (const bf16_t*)(sl + 7 * SLOT); const bf16_t* WR = (const bf16_t*)(sl + 6 * SLOT);
    const bf16_t* BB = (const bf16_t*)(sl + 1 * SLOT); const bf16_t* KX = (const bf16_t*)(sl + 3 * SLOT);
    const float* WD = (const float*)(sl + 4 * SLOT); const bf16_t* V = (const bf16_t*)(sl + 8 * SLOT);
    bf16_t* Y = (bf16_t*)(sl + 0 * SLOT);
    const float* BR = scal; const float* KR = scal + (size_t)T * 32;
    const int tid = tid_, wid = tid >> 6, lane = tid & 63;
    for (int item = bid_; item < 256; item += gridDim.x) {
        const int half = item & 1, h = (item >> 1) & 31, b = item >> 6;
        const size_t tok0 = (size_t)b * SEQ;
        if (wid >= 4) {
            const int lt = tid - 256, lt_t = lt >> 3, lt_c = lt & 7;
            u32x4 r_nk, r_wr, r_bb, r_kx, r_v = {0u, 0u, 0u, 0u}; f32x4 r_w0, r_w1; float r_s = 0.f;
            auto gload = [&](int c) {
                const size_t tb = tok0 + (size_t)c * TC;
                const size_t o = (tb + lt_t) * D + h * 64 + lt_c * 8;
                r_nk = *(const u32x4*)(NKK + o); r_wr = *(const u32x4*)(WR + o); r_bb = *(const u32x4*)(BB + o); r_kx = *(const u32x4*)(KX + o);
                r_w0 = *(const f32x4*)(WD + (tb + (lt >> 4)) * D + h * 64 + (lt & 15) * 4);
                r_w1 = *(const f32x4*)(WD + (tb + 16 + (lt >> 4)) * D + h * 64 + (lt & 15) * 4);
                if (lt < 128) r_v = *(const u32x4*)(V + (tb + (lt >> 2)) * D + h * 64 + half * 32 + (lt & 3) * 8);
                else if (lt < 192) { const int i = lt - 128; r_s = ((i & 1) ? KR : BR)[(tb + (i >> 1)) * 32 + h]; }
            };
            auto lstore = [&](float* F) {
                float* pp = F + lt_t * 128 + lt_c * 16;
#pragma unroll
                for (int j = 0; j < 4; ++j) { f32x4 q = {bflo(r_nk[j]), bflo(r_wr[j]), bfhi(r_nk[j]), bfhi(r_wr[j])}; *(f32x4*)(pp + j * 4) = q; }
                { float* d = F + OFF_BB + lt_t * 64 + lt_c * 8;
                  f32x4 lo = {bflo(r_bb[0]), bfhi(r_bb[0]), bflo(r_bb[1]), bfhi(r_bb[1])}, hi = {bflo(r_bb[2]), bfhi(r_bb[2]), bflo(r_bb[3]), bfhi(r_bb[3])};
                  *(f32x4*)d = lo; *(f32x4*)(d + 4) = hi; }
                { float* d = F + OFF_KX + lt_t * 64 + lt_c * 8;
                  f32x4 lo = {bflo(r_kx[0]), bfhi(r_kx[0]), bflo(r_kx[1]), bfhi(r_kx[1])}, hi = {bflo(r_kx[2]), bfhi(r_kx[2]), bflo(r_kx[3]), bfhi(r_kx[3])};
                  *(f32x4*)d = lo; *(f32x4*)(d + 4) = hi; }
                *(f32x4*)(F + OFF_W + (lt >> 4) * 64 + (lt & 15) * 4) = r_w0;
                *(f32x4*)(F + OFF_W + (16 + (lt >> 4)) * 64 + (lt & 15) * 4) = r_w1;
                if (lt < 128) { float* d = F + OFF_V + (lt >> 2) * 32 + (lt & 3) * 8;
                  f32x4 lo = {bflo(r_v[0]), bfhi(r_v[0]), bflo(r_v[1]), bfhi(r_v[1])}, hi = {bflo(r_v[2]), bfhi(r_v[2]), bflo(r_v[3]), bfhi(r_v[3])};
                  *(f32x4*)d = lo; *(f32x4*)(d + 4) = hi; }
                else if (lt < 192) F[OFF_SC + (lt - 128)] = r_s;
            };
            gload(0); lstore(SBUF(0)); gload(1);
            __syncthreads();
            for (int c = 0; c < NCH; ++c) {
                if (c + 1 < NCH) lstore(SBUF((c + 1) & 1));
                if (c + 2 < NCH) gload(c + 2);
                lds_barrier();
            }
        } else {
            const int kq = lane & 7, rl = wid * 8 + (lane >> 3);
            f32x2 st[4];
#pragma unroll
            for (int j = 0; j < 4; ++j) st[j] = (f32x2){0.f, 0.f};
            bf16_t* yp = Y + (tok0 + kq) * D + h * 64 + half * 32 + rl;
            __syncthreads();
            struct Ops { f32x4 pq[4], b0, b1, k0, k1, w0, w1; float vv; f32x2 sc; };
            for (int c = 0; c < NCH; ++c) {
                const float* F = SBUF(c & 1);
                const float* fp = F + kq * 16;
                const float* fb = F + OFF_BB + kq * 8;
                auto ld = [&](Ops& o, int t) {
#pragma unroll
                    for (int j = 0; j < 4; ++j) o.pq[j] = *(const f32x4*)(fp + t * 128 + j * 4);
                    o.b0 = *(const f32x4*)(fb + t * 64); o.b1 = *(const f32x4*)(fb + t * 64 + 4);
                    o.k0 = *(const f32x4*)(fb + (OFF_KX - OFF_BB) + t * 64); o.k1 = *(const f32x4*)(fb + (OFF_KX - OFF_BB) + t * 64 + 4);
                    o.w0 = *(const f32x4*)(fb + (OFF_W - OFF_BB) + t * 64); o.w1 = *(const f32x4*)(fb + (OFF_W - OFF_BB) + t * 64 + 4);
                    o.vv = F[OFF_V + t * 32 + rl]; o.sc = *(const f32x2*)(F + OFF_SC + t * 2);
                };
                auto dots = [&](const Ops& o) -> f32x2 {
                    f32x2 acc = {0.f, 0.f}, acc2 = {0.f, 0.f};
#pragma unroll
                    for (int j = 0; j < 4; ++j) {
                        acc += st[j][0] * (f32x2){o.pq[j][0], o.pq[j][1]};
                        acc2 += st[j][1] * (f32x2){o.pq[j][2], o.pq[j][3]};
                    }
                    return acc + acc2;
                };
                auto update = [&](const Ops& o, f32x2 acc) -> float {
                    const float d1 = dpp_sum8(acc[0]), d2 = dpp_sum8(acc[1]);
                    st[0] = st[0] * (f32x2){o.w0[0], o.w0[1]} + d1 * (f32x2){o.b0[0], o.b0[1]} + o.vv * (f32x2){o.k0[0], o.k0[1]};
                    st[1] = st[1] * (f32x2){o.w0[2], o.w0[3]} + d1 * (f32x2){o.b0[2], o.b0[3]} + o.vv * (f32x2){o.k0[2], o.k0[3]};
                    st[2] = st[2] * (f32x2){o.w1[0], o.w1[1]} + d1 * (f32x2){o.b1[0], o.b1[1]} + o.vv * (f32x2){o.k1[0], o.k1[1]};
                    st[3] = st[3] * (f32x2){o.w1[2], o.w1[3]} + d1 * (f32x2){o.b1[2], o.b1[3]} + o.vv * (f32x2){o.k1[2], o.k1[3]};
                    return d2 + d1 * o.sc[0] + o.vv * o.sc[1];
                };
                Ops os[3];
                ld(os[0], 0); ld(os[1], 1);
                float yv = 0.f;
#pragma unroll
                for (int t = 0; t < TC; ++t) {
                    const f32x2 da = dots(os[t % 3]);
                    __builtin_amdgcn_sched_barrier(0);
                    if (t + 2 < TC) ld(os[(t + 2) % 3], t + 2);
                    __builtin_amdgcn_sched_barrier(0);
                    const float ya = update(os[t % 3], da);
                    yv = (kq == (t & 7)) ? ya : yv;
                    if ((t & 7) == 7) yp[(size_t)(c * TC + (t & ~7)) * D] = f2bf(yv);
                }
                lds_barrier();
            }
        }
        __syncthreads();
    }
#undef SBUF
}
DI void rwkv_post_phase(int tid_, int bid_, const Params& p, unsigned char* sl, const float* scal) {
    const bf16_t* Y = (const bf16_t*)(sl + 0 * SLOT); const bf16_t* V = (const bf16_t*)(sl + 8 * SLOT); const bf16_t* G = (const bf16_t*)(sl + 2 * SLOT);
    bf16_t* OUT = (bf16_t*)(sl + 3 * SLOT);
    const float* lg = p.in[29]; const float* lb = p.in[30]; const float* BO = scal + (size_t)2 * T * 32;
    const int lane = tid_ & 63, wid = tid_ >> 6;
    constexpr int U = 16;
    for (int grp = bid_ * 8 + wid; grp < T * 32 / U; grp += gridDim.x * 8) {
        const int item0 = grp * U;
        const int h0 = item0 & 31; const size_t t = (size_t)(item0 >> 5);
        const size_t o0 = t * D + h0 * 64 + lane;
        bf16_t yr[U], vr[U], gr[U]; float bor[U];
#pragma unroll
        for (int u = 0; u < U; ++u) { yr[u] = Y[o0 + u * 64]; vr[u] = V[o0 + u * 64]; gr[u] = G[o0 + u * 64]; bor[u] = BO[item0 + u]; }
#pragma unroll
        for (int u = 0; u < U; ++u) {
            const int c = (h0 + u) * 64 + lane;
            const float y = bf2f(yr[u]);
            const float mean = wave_sum(y) * (1.f / 64.f);
            const float dlt = y - mean;
            const float var = wave_sum(dlt * dlt) * (1.f / 64.f);
            float r = dlt * rsqrtf(var + 64e-5f) * lg[c] + lb[c];
            r += bor[u] * bf2f(vr[u]);
            OUT[o0 + u * 64] = f2bf(r * bf2f(gr[u]));
        }
    }
}

DI void pool_phase(int tid_, int bid_, const float* x, bf16_t* outp) {
    constexpr int CH = 32;
    const int tid = tid_, c = tid * 4, w = 2 << (c >> 9);
    for (int item = bid_; item < T / CH; item += gridDim.x) {
        const int t0 = item * CH, s0 = t0 & (SEQ - 1);
        f32x4 sum = {0.f, 0.f, 0.f, 0.f};
#pragma unroll
        for (int j = 1; j <= 16; ++j) if (j <= w && s0 - j >= 0) sum += *(const f32x4*)(x + (size_t)(t0 - j) * D + c);
#pragma unroll 16
        for (int tt = 0; tt < CH; ++tt) {
            const int t = t0 + tt, s = s0 + tt;
            const f32x4 xv = *(const f32x4*)(x + (size_t)t * D + c);
            sum += xv;
            if (s - w >= 0) sum -= *(const f32x4*)(x + (size_t)(t - w) * D + c);
            const float rc = __builtin_amdgcn_rcpf((float)((s + 1 < w) ? (s + 1) : w));
            const f32x4 o = sum * rc - xv;
            u32x2 wv = {pk_bf16(o[0], o[1]), pk_bf16(o[2], o[3])};
            *(u32x2*)(outp + (size_t)t * D + c) = wv;
        }
    }
}

#define XB_TMO      128
#define XB_XCNT(j)  (256  + 64 * (j))
#define XB_XSUB(j)  (1280 + 64 * (j))
#define XB_XGEN(j)  (2304 + 64 * (j))
#define XB_TOP      3328
#define XB_TOPGEN   3392
#define XCD_BAR_WORDS 3456
#define XB_SPIN_CAP (1u << 18)
DI unsigned xb_ld(unsigned* p) { return __hip_atomic_load(p, __ATOMIC_RELAXED, __HIP_MEMORY_SCOPE_AGENT); }
DI unsigned xb_add(unsigned* p, unsigned v) { return __hip_atomic_fetch_add(p, v, __ATOMIC_RELAXED, __HIP_MEMORY_SCOPE_AGENT); }
DI unsigned xb_xcc_id() { return (unsigned)__builtin_amdgcn_s_getreg((3 << 11) | 20) & 0xFu; }
#define XB_SPIN(cond, bar) do { unsigned _sp = 0; while (cond) { __builtin_amdgcn_s_sleep(1); \
    if ((++_sp & 255u) == 0u) { if (xb_ld(&(bar)[XB_TMO])) break; if (_sp > XB_SPIN_CAP) { atomicAdd(&(bar)[XB_TMO], 1u); break; } } } } while (0)
struct XcdBarrier { unsigned* bar; unsigned x; volatile LAS unsigned* st; };
DI XcdBarrier xcd_barrier_post(int tid, unsigned* bar, volatile LAS unsigned* st) {
    XcdBarrier b; b.bar = bar; b.x = xb_xcc_id(); b.st = st;
    if (tid == 0) (void)xb_add(&bar[XB_XCNT(b.x)], 1u);
    return b;
}
DI void xcd_barrier_complete(unsigned* bar, unsigned x, unsigned& nloc, unsigned& nx) {
    const unsigned G = gridDim.x * gridDim.y * gridDim.z;
    unsigned sum, cnt, mine, sp = 0u;
    for (;;) {
        sum = 0u; cnt = 0u; mine = 0u;
#pragma unroll
        for (unsigned j = 0; j < 16; ++j) { const unsigned c = xb_ld(&bar[XB_XCNT(j)]); sum += c; cnt += (c > 0u) ? 1u : 0u; mine = (j == x) ? c : mine; }
        if (sum == G) break;
        __builtin_amdgcn_s_sleep(1);
        if ((++sp & 255u) == 0u) { if (xb_ld(&bar[XB_TMO])) break; if (sp > XB_SPIN_CAP) { atomicAdd(&bar[XB_TMO], 1u); break; } }
    }
    nloc = mine > 0u ? mine : 1u; nx = cnt > 0u ? cnt : 1u;
}
DI void xcd_barrier(int tid, const XcdBarrier& b) {
    asm volatile("s_waitcnt vmcnt(0)" ::: "memory");
    __syncthreads();
    if (tid == 0) {
        unsigned* bar = b.bar;
        __builtin_amdgcn_s_waitcnt(0);
        unsigned nloc = b.st[0], nx = b.st[1];
        if (nloc == 0u) { xcd_barrier_complete(bar, b.x, nloc, nx); b.st[0] = nloc; b.st[1] = nx; }
        const unsigned old = xb_add(&bar[XB_XSUB(b.x)], 1u);
        const unsigned gen = old / nloc;
        if (old + 1u == (gen + 1u) * nloc) {
            __builtin_amdgcn_fence(__ATOMIC_RELEASE, "agent");
            asm volatile("s_waitcnt vmcnt(0)" ::: "memory");
            const unsigned og = xb_add(&bar[XB_TOP], 1u);
            const unsigned tg = og / nx;
            if (og + 1u == (tg + 1u) * nx) xb_add(&bar[XB_TOPGEN], 1u);
            else XB_SPIN(xb_ld(&bar[XB_TOPGEN]) == tg, bar);
            __builtin_amdgcn_fence(__ATOMIC_ACQUIRE, "agent");
            xb_add(&bar[XB_XGEN(b.x)], 1u);
            asm volatile("s_waitcnt vmcnt(0)" ::: "memory");
        } else {
            XB_SPIN(xb_ld(&bar[XB_XGEN(b.x)]) == gen, bar);
            __builtin_amdgcn_fence(__ATOMIC_ACQUIRE, "agent");
            asm volatile("s_waitcnt vmcnt(0)" ::: "memory");
        }
    }
    __syncthreads();
}

enum { K_PREP = 0, K_GACT, K_GRES, K_LN, K_RGCONV, K_RGSCAN0, K_RGSCAN1, K_KMEAN, K_ATTN, K_RMIX, K_RPREP, K_RSCAN, K_RPOST, K_POOL };
constexpr int NSTEPS = 38;
struct Desc {
    int kind;
    pg8::Gemm g;
    bf16_t* C; const float* res; const float* cscale; long sC; int ldc; unsigned acts;
    int lnidx, lnlast;
};
DI bool step_nosync(int st) { return st == 11 || st == 21; }
DI Desc make_desc(int st, const Params& p, unsigned char* ws) {
    unsigned char* sl = ws + O_SLOT;
    auto slot = [&](int i) { return (bf16_t*)(sl + (size_t)i * SLOT); };
    bf16_t* xb = slot(8);
    Desc d; d.kind = K_PREP; d.g = mk_gemm(nullptr, nullptr, 0, 0, 0, 0, 0, 0, 0, 0);
    d.C = nullptr; d.res = nullptr; d.cscale = nullptr; d.sC = 0; d.ldc = D; d.acts = 0u; d.lnidx = 0; d.lnlast = 0;
    int layer = -1, sub = 0;
    if (st >= 7 && st < 11) { layer = 0; sub = st - 7; }
    else if (st >= 16 && st < 20) { layer = 1; sub = st - 16; }
    else if (st >= 28 && st < 32) { layer = 2; sub = st - 28; }
    else if (st >= 34 && st < 38) { layer = 3; sub = st - 34; }
    if (layer >= 0) {
        if (sub == 0) { d.kind = K_LN; d.lnidx = layer * 2; }
        else if (sub == 1) { d.kind = K_GACT; d.C = slot(0); d.ldc = DFF; d.acts = 1u;
            d.g = mk_gemm(xb, (const bf16_t*)(ws + O_W1T + (size_t)layer * DFF * D * 2), 0, 0, D, D, D, T / 256, DFF / 256, 1); }
        else if (sub == 2) { d.kind = K_GRES;
            d.g = mk_gemm(slot(0), (const bf16_t*)(ws + O_W2T + (size_t)layer * DFF * D * 2), 0, 0, DFF, DFF, DFF, T / 256, D / 256, 1); }
        else { d.kind = K_LN; d.lnidx = layer * 2 + 1; d.lnlast = (layer == 3); }
        return d;
    }
    switch (st) {
    case 0: d.kind = K_PREP; break;
    case 1: d.kind = K_GACT; d.C = slot(0); d.ldc = 4096;
            d.g = mk_gemm(xb, (const bf16_t*)(ws + O_WIN), 0, 0, D, D, D, T / 256, 4096 / 256, 1); break;
    case 2: d.kind = K_RGCONV; break;
    case 3: d.kind = K_GACT; d.C = slot(3); d.sC = 512; d.ldc = 4096;
            d.g = mk_gemm(slot(2), (const bf16_t*)(ws + O_GATES), 256, 512 * 256, D, 256, 256, T / 256, 2, 8); break;
    case 4: d.kind = K_RGSCAN0; break;
    case 5: d.kind = K_RGSCAN1; break;
    case 6: d.kind = K_GRES; d.res = p.in[0];
            d.g = mk_gemm(slot(5), (const bf16_t*)(ws + O_RGOUT), 0, 0, D, D, D, T / 256, D / 256, 1); break;
    case 11: d.kind = K_GACT; d.C = slot(0); d.sC = (long)T * D;
             d.g = mk_gemm(xb, (const bf16_t*)(ws + O_QKV), 0, (long)D * D, D, D, D, T / 256, D / 256, 2); break;
    case 12: d.kind = K_GACT; d.C = slot(2); d.ldc = T;
             d.g = mk_gemm((const bf16_t*)(ws + O_QKV + 2 * SZ_DD), xb, 0, 0, D, D, D, D / 256, T / 256, 1); break;
    case 13: d.kind = K_KMEAN; break;
    case 14: d.kind = K_ATTN; break;
    case 15: d.kind = K_GRES;
             d.g = mk_gemm(slot(3), (const bf16_t*)(ws + O_MOUT), 0, 0, D, D, D, T / 256, D / 256, 1); break;
    case 20: d.kind = K_RMIX; break;
    case 21: d.kind = K_GACT; d.C = slot(6); d.sC = (long)T * D;
             d.g = mk_gemm(slot(0), (const bf16_t*)(ws + O_RKV), (long)T * D, (long)D * D, D, D, D, T / 256, D / 256, 3); break;
    case 22: d.kind = K_GACT; d.C = (bf16_t*)(ws + O_L1O); d.sC = (long)T * 256; d.ldc = 256; d.acts = 0x302u;
             d.g = mk_gemm(slot(3), (const bf16_t*)(ws + O_L1), (long)T * D, (long)256 * D, D, D, D, T / 256, 1, 3); break;
    case 23: d.kind = K_GACT; d.C = slot(0); d.sC = (long)T * D;
             d.g = mk_gemm((const bf16_t*)(ws + O_L1O), (const bf16_t*)(ws + O_L2), (long)T * 256, (long)D * 256, 256, 256, 256, T / 256, D / 256, 3); break;
    case 24: d.kind = K_RPREP; break;
    case 25: d.kind = K_RSCAN; break;
    case 26: d.kind = K_RPOST; break;
    case 27: d.kind = K_GRES;
             d.g = mk_gemm(slot(3), (const bf16_t*)(ws + O_ROUT), 0, 0, D, D, D, T / 256, D / 256, 1); break;
    case 32: d.kind = K_POOL; break;
    case 33: d.kind = K_GRES; d.cscale = p.in[33]; d.sC = 512;
             d.g = mk_gemm(slot(0), (const bf16_t*)(ws + O_POOL), 512, 512 * 512, D, 512, 512, T / 256, 2, 4); break;
    default: break;
    }
    return d;
}

__global__ void __launch_bounds__(512, 2) fwd_megakernel(Params p) {
    extern __shared__ __attribute__((aligned(16))) unsigned char smem[];
    cg::grid_group grid = cg::this_grid();
    LAS unsigned char* lds = (LAS unsigned char*)smem;

    const bool multi = (p.hi - p.lo) > 1;
    volatile LAS unsigned* xst = (volatile LAS unsigned*)(lds + 131072);
    if (__builtin_amdgcn_workitem_id_x() == 0) { xst[0] = 0u; xst[1] = 0u; }
    __syncthreads();
    (void)xcd_barrier_post((int)__builtin_amdgcn_workitem_id_x(), (unsigned*)(p.ws + O_BAR), xst);
    for (int st = p.lo; st < p.hi; ++st) {
        int tid_ = (int)__builtin_amdgcn_workitem_id_x(); asm volatile("" : "+v"(tid_));
        int bid_ = (int)__builtin_amdgcn_workgroup_id_x(); asm volatile("" : "+s"(bid_));
        unsigned char* ws = p.ws; asm volatile("" : "+s"(ws));
        float* xcur = p.out; asm volatile("" : "+s"(xcur));
        unsigned char* sl = ws + O_SLOT;
        auto slot = [&](int i) { return (bf16_t*)(sl + (size_t)i * SLOT); };
        const int stu = __builtin_amdgcn_readfirstlane(st);
        const Desc d = make_desc(stu, p, ws);
        switch (__builtin_amdgcn_readfirstlane(d.kind)) {
        case K_PREP: prep_phase(tid_, bid_, p, smem); break;
        case K_GACT: { pg8::EpiAct E; E.C = d.C; E.sC = d.sC; E.ldc = d.ldc; E.acts = d.acts; pg8::gemm_phase(tid_, bid_, lds, d.g, E); } break;
        case K_GRES: { pg8::EpiRes E; E.out = xcur; E.res = d.res ? d.res : xcur; E.cscale = d.cscale; E.alpha = ALPHA; E.sC = d.sC; E.ldc = D; pg8::gemm_phase(tid_, bid_, lds, d.g, E); } break;
        case K_LN: ln_phase(tid_, bid_, xcur, xcur, d.lnlast ? nullptr : slot(8), p.in[1] + (size_t)d.lnidx * D, p.in[2] + (size_t)d.lnidx * D); break;
        case K_RGCONV: rg_conv_phase(tid_, bid_, slot(0), slot(2), p.in[6], p.in[7]); break;
        case K_RGSCAN0: rg_scan_phase<0>(tid_, bid_, p, slot(3), slot(2), slot(0), (float*)(ws + O_AGG), slot(5)); break;
        case K_RGSCAN1: rg_scan_phase<1>(tid_, bid_, p, slot(3), slot(2), slot(0), (float*)(ws + O_AGG), slot(5)); break;
        case K_KMEAN: kmean_phase(tid_, bid_, slot(0), slot(1), (float*)(ws + O_KMEAN), (const float*)(ws + O_ROPE), (const float*)(ws + O_ROPE) + SEQ * 16, smem); break;
        case K_ATTN: attn_phase(tid_, bid_, slot(0), slot(1), slot(2), slot(3), (const float*)(ws + O_KMEAN), smem); break;
        case K_RMIX: rwkv_mix_phase(tid_, bid_, xcur, p.in[16], slot(0)); break;
        case K_RPREP: rwkv_prep_phase(tid_, bid_, p, sl, (float*)(ws + O_SCAL)); break;
        case K_RSCAN: rwkv_scan_phase(tid_, bid_, sl, (const float*)(ws + O_SCAL), smem); break;
        case K_RPOST: rwkv_post_phase(tid_, bid_, p, sl, (const float*)(ws + O_SCAL)); break;
        case K_POOL: pool_phase(tid_, bid_, xcur, slot(0)); break;
        default: break;
        }
        if (multi && !step_nosync(st) && st + 1 < p.hi) { if (st == p.lo) grid.sync(); else { XcdBarrier xb; xb.bar = (unsigned*)(ws + O_BAR); xb.x = xb_xcc_id(); xb.st = (volatile LAS unsigned*)(lds + 131072); xcd_barrier(tid_, xb); } }
    }
}

extern "C" void kernel_launch(void* const* d_in, const int* in_sizes, int n_in, void* d_out, int out_size, void* d_ws, size_t ws_size, hipStream_t stream) {
    static int grid = 0;
    if (grid == 0) {
        if (n_in != 34 || out_size != T * D || ws_size < WS_END) { fprintf(stderr, "kernel_launch: unexpected shapes (n_in %d out %d ws %zu need %zu)\n", n_in, out_size, ws_size, (size_t)WS_END); grid = -1; return; }
        int dev = 0, cus = 0, per_cu = 0;
        hipGetDevice(&dev);
        hipDeviceGetAttribute(&cus, hipDeviceAttributeMultiprocessorCount, dev);
        if (hipFuncSetAttribute((const void*)fwd_megakernel, hipFuncAttributeMaxDynamicSharedMemorySize, LDS_BYTES) != hipSuccess) { fprintf(stderr, "kernel_launch: hipFuncSetAttribute failed\n"); grid = -1; return; }
        hipOccupancyMaxActiveBlocksPerMultiprocessor(&per_cu, (const void*)fwd_megakernel, 512, LDS_BYTES);
        if (per_cu < 1) { fprintf(stderr, "kernel_launch: occupancy query says %d blocks/CU\n", per_cu); per_cu = 1; }
        (void)hipGetLastError();
        grid = cus;
    }
    if (grid < 0) return;
    Params p{};
    for (int i = 0; i < 34; ++i) p.in[i] = (const float*)d_in[i];
    {
        unsigned char* ws = (unsigned char*)d_ws; int nj = 0, t0 = 0;
        auto add = [&](const float* src, size_t dstoff, int Ks, int Ns, int Kd, int Nd) {
            TJob& j = p.tj[nj]; j.src = src; j.dst = (bf16_t*)(ws + dstoff); j.Ks = Ks; j.Ns = Ns; j.Kd = Kd; j.Nd = Nd; j.tile0 = t0; j.pad = 0;
            t0 += (Kd / 128) * (Nd / 128); ++nj; };
        for (int l = 0; l < 4; ++l) add(p.in[3] + (size_t)l * D * DFF, O_W1T + (size_t)l * DFF * D * 2, D, DFF, D, DFF);
        for (int l = 0; l < 4; ++l) add(p.in[4] + (size_t)l * D * DFF, O_W2T + (size_t)l * DFF * D * 2, DFF, D, DFF, D);
        add(p.in[5], O_WIN, D, 4096, D, 4096);
        for (int n = 0; n < 8; ++n) { add(p.in[8] + (size_t)n * 65536, O_GATES + (size_t)n * 512 * 256 * 2, 256, 256, 256, 256);
                                      add(p.in[10] + (size_t)n * 65536, O_GATES + ((size_t)n * 512 + 256) * 256 * 2, 256, 256, 256, 256); }
        add(p.in[13], O_RGOUT, D, D, D, D);
        add(p.in[14], O_QKV, D, 3 * D, D, 3 * D);
        add(p.in[15], O_MOUT, D, D, D, D);
        for (int g = 0; g < 3; ++g) add(p.in[17] + (size_t)g * D * D, O_RKV + g * SZ_DD, D, D, D, D);
        add(p.in[19], O_L1 + 0 * (size_t)256 * D * 2, D, 96, D, 256);
        add(p.in[22], O_L1 + 1 * (size_t)256 * D * 2, D, 96, D, 256);
        add(p.in[24], O_L1 + 2 * (size_t)256 * D * 2, D, 256, D, 256);
        add(p.in[20], O_L2 + 0 * (size_t)D * 256 * 2, 96, D, 256, D);
        add(p.in[23], O_L2 + 1 * (size_t)D * 256 * 2, 96, D, 256, D);
        add(p.in[25], O_L2 + 2 * (size_t)D * 256 * 2, 256, D, 256, D);
        add(p.in[31], O_ROUT, D, D, D, D);
        for (int g = 0; g < 4; ++g) add(p.in[32] + (size_t)g * 512 * 512, O_POOL + (size_t)g * 512 * 512 * 2, 512, 512, 512, 512);
        p.ntiles = t0;
        if (nj != NTJ) fprintf(stderr, "kernel_launch: job table size %d != %d\n", nj, NTJ);
    }
    p.out = (float*)d_out; p.ws = (unsigned char*)d_ws; p.lo = 0; p.hi = NSTEPS;
    if (hipMemsetAsync((unsigned char*)d_ws + O_BAR, 0, BAR_BYTES, stream) != hipSuccess) { fprintf(stderr, "kernel_launch: memset of barrier words failed\n"); return; }
    void* args[] = {&p};
    hipError_t e = hipLaunchCooperativeKernel((const void*)fwd_megakernel, dim3(grid), dim3(512), args, LDS_BYTES, stream);
    if (e != hipSuccess) fprintf(stderr, "cooperative launch failed: %s (grid %d)\n", hipGetErrorString(e), grid);
}
```

```cpp
#include <hip/hip_runtime.h>
#include <hip/hip_cooperative_groups.h>
#include <cstdio>
namespace cg = cooperative_groups;

#define LAS __attribute__((address_space(3)))
typedef unsigned short bf16_t;
typedef short bf16x8 __attribute__((ext_vector_type(8)));
typedef float f32x4 __attribute__((ext_vector_type(4)));
typedef float f32x2 __attribute__((ext_vector_type(2)));
typedef unsigned u32x4 __attribute__((ext_vector_type(4)));
typedef unsigned u32x2 __attribute__((ext_vector_type(2)));
typedef __bf16 bfv2 __attribute__((ext_vector_type(2)));
#define DI __device__ __forceinline__

constexpr int T = 16384, D = 2048, SEQ = 4096, DFF = 8192;
constexpr float ALPHA = 1.6817928305074290f;
constexpr float LN_EPS = 1e-5f;

constexpr size_t SZ_DD = (size_t)D * D * 2;
constexpr size_t O_W1T = 0;
constexpr size_t O_W2T = O_W1T + 4 * (size_t)DFF * D * 2;
constexpr size_t O_WIN = O_W2T + 4 * (size_t)DFF * D * 2;
constexpr size_t O_GATES = O_WIN + (size_t)4096 * D * 2;
constexpr size_t O_RGOUT = O_GATES + (size_t)8 * 512 * 256 * 2;
constexpr size_t O_QKV = O_RGOUT + SZ_DD;
constexpr size_t O_MOUT = O_QKV + 3 * SZ_DD;
constexpr size_t O_RKV = O_MOUT + SZ_DD;
constexpr size_t O_L1 = O_RKV + 3 * SZ_DD;
constexpr size_t O_L2 = O_L1 + (size_t)3 * 256 * D * 2;
constexpr size_t O_ROUT = O_L2 + (size_t)3 * D * 256 * 2;
constexpr size_t O_POOL = O_ROUT + SZ_DD;
constexpr size_t O_SLOT = O_POOL + (size_t)4 * 512 * 512 * 2;
constexpr size_t SLOT = (size_t)T * D * 2;
constexpr size_t O_L1O = O_SLOT + 9 * SLOT;
constexpr size_t O_ROPE = O_L1O + (size_t)3 * T * 256 * 2;
constexpr size_t O_KMEAN = O_ROPE + (size_t)2 * SEQ * 16 * 4;
constexpr size_t O_AGG = O_KMEAN + (size_t)64 * 16 * 128 * 4;
constexpr size_t O_SCAL = O_AGG + (size_t)4 * 128 * D * 2 * 4;
constexpr size_t O_BAR = O_SCAL + (size_t)3 * T * 32 * 4;
constexpr size_t BAR_BYTES = 16384;
constexpr size_t WS_END = O_BAR + BAR_BYTES;

constexpr int LDS_BYTES = 131072 + 16;

struct TJob { const float* src; bf16_t* dst; int Ks, Ns, Kd, Nd, tile0, pad; };
constexpr int NTJ = 42;
struct Params {
    const float* in[34];
    float* out;
    unsigned char* ws;
    int lo, hi, ntiles, pad;
    TJob tj[NTJ];
};

DI unsigned pk_bf16(float a, float b) { f32x2 v = {a, b}; bfv2 r = __builtin_convertvector(v, bfv2); return __builtin_bit_cast(unsigned, r); }
DI bf16_t f2bf(float a) { return (bf16_t)(pk_bf16(a, 0.f) & 0xffffu); }
DI float bf2f(bf16_t b) { return __uint_as_float(((unsigned)b) << 16); }
DI float bflo(unsigned u) { return __uint_as_float(u << 16); }
DI float bfhi(unsigned u) { return __uint_as_float(u & 0xffff0000u); }
DI float wave_sum(float v) {
    v += __int_as_float(__builtin_amdgcn_update_dpp(0, __float_as_int(v), 0xB1, 0xF, 0xF, false));
    v += __int_as_float(__builtin_amdgcn_update_dpp(0, __float_as_int(v), 0x4E, 0xF, 0xF, false));
    v += __int_as_float(__builtin_amdgcn_update_dpp(0, __float_as_int(v), 0x141, 0xF, 0xF, false));
    v += __int_as_float(__builtin_amdgcn_update_dpp(0, __float_as_int(v), 0x140, 0xF, 0xF, false));
    const int iv = __float_as_int(v);
    return __int_as_float(__builtin_amdgcn_readlane(iv, 0)) + __int_as_float(__builtin_amdgcn_readlane(iv, 16)) +
           __int_as_float(__builtin_amdgcn_readlane(iv, 32)) + __int_as_float(__builtin_amdgcn_readlane(iv, 48));
}
DI float xmax_fq(float v) {
    const auto a = __builtin_amdgcn_permlane32_swap(__float_as_uint(v), __float_as_uint(v), false, false);
    v = fmaxf(__uint_as_float(a[0]), __uint_as_float(a[1]));
    const auto b = __builtin_amdgcn_permlane16_swap(__float_as_uint(v), __float_as_uint(v), false, false);
    return fmaxf(__uint_as_float(b[0]), __uint_as_float(b[1]));
}
DI float xsum_fq(float v) {
    const auto a = __builtin_amdgcn_permlane32_swap(__float_as_uint(v), __float_as_uint(v), false, false);
    v = __uint_as_float(a[0]) + __uint_as_float(a[1]);
    const auto b = __builtin_amdgcn_permlane16_swap(__float_as_uint(v), __float_as_uint(v), false, false);
    return __uint_as_float(b[0]) + __uint_as_float(b[1]);
}
DI void lds_barrier() { asm volatile("s_waitcnt lgkmcnt(0)" ::: "memory"); __builtin_amdgcn_s_barrier(); asm volatile("" ::: "memory"); }
DI float sigmoidf_(float x) { return __builtin_amdgcn_rcpf(1.f + __expf(-x)); }
DI float tanhf_(float x) { return 1.f - 2.f * __builtin_amdgcn_rcpf(1.f + __expf(2.f * x)); }
DI float gelu_tanh(float x) { const float u = 0.7978845608028654f * (x + 0.044715f * x * x * x); return 0.5f * x * (1.f + tanhf_(u)); }

namespace pg8 {
constexpr int BM = 256, BK = 64, HALF = 128, HTB = HALF * BK * 2, NXCD = 8, WGM = 4;
DI int lds_byte(int r, int c) { const int st = (r >> 4) * 2 + (c >> 5), rr = r & 15, cc = c & 31, ob = rr * 64 + cc * 2; return st * 1024 + (ob ^ (((ob >> 9) & 1) << 5)); }
DI void stage_rc(int b, int& R, int& C) { const int st = b / 1024, sb = b % 1024, swz = sb ^ (((sb >> 9) & 1) << 5); R = (st >> 1) * 16 + swz / 64; C = (st & 1) * 32 + (swz % 64) / 2; }
DI int perm32(int rho) { const int n = rho >> 4, i = rho & 15; return 8 * (i >> 2) + 4 * n + (i & 3); }

struct Unit { int g, pm, pn; };
struct Gemm { const bf16_t* A; const bf16_t* Bt; long sA, sB; int lda, ldb, K, nM, nN, G; };

struct Order {
    int nM, nN, nwg, tot, Gd, c;
    DI void init(const Gemm& g, int Gd_, int c_) { nM = g.nM; nN = g.nN; nwg = nM * nN; tot = nwg * g.G; Gd = Gd_; c = c_; }
    DI bool next(int i, Unit& u) const {
        const long L = (long)i * Gd + c; if (L >= tot) return false;
        const int grp = (int)(L / nwg); int wgid = (int)(L - (long)grp * nwg);
        { const int q = nwg / NXCD, r = nwg % NXCD, xcd = wgid % NXCD, off = wgid / NXCD; wgid = (xcd < r ? xcd * (q + 1) : r * (q + 1) + (xcd - r) * q) + off; }
        const int nig = WGM * nN, gid = wgid / nig, fm = gid * WGM, gsz = (nM - fm) < WGM ? (nM - fm) : WGM;
        u.g = grp; u.pm = fm + ((wgid % nig) % gsz); u.pn = (wgid % nig) / gsz; return true;
    }
};

struct EpiAct {
    static constexpr bool PERM = true;
    bf16_t* C; long sC; int ldc; unsigned acts;
    DI void operator()(const f32x4 (&acc)[2][2][4][2], const Unit& u, int wr, int wc, int fr, int fq) const {
        bf16_t* base = C + (size_t)u.g * sC;
        const int act = (int)((acts >> (4 * u.g)) & 15u);
        const int row0 = u.pm * BM + wr * 64 + fr, col0 = u.pn * BM + wc * 32 + 8 * fq;
#pragma unroll
        for (int ai = 0; ai < 2; ++ai)
#pragma unroll
            for (int m = 0; m < 4; ++m) {
                bf16_t* rowp = base + (size_t)(row0 + ai * HALF + m * 16) * ldc + col0;
#pragma unroll
                for (int bj = 0; bj < 2; ++bj) {
                    float v[8];
#pragma unroll
                    for (int e = 0; e < 4; ++e) { v[e] = acc[ai][bj][m][0][e]; v[4 + e] = acc[ai][bj][m][1][e]; }
                    if (act == 1) {
#pragma unroll
                        for (int e = 0; e < 8; ++e) { const float t = fmaxf(v[e], 0.f); v[e] = t * t; }
                    } else if (act == 2) {
#pragma unroll
                        for (int e = 0; e < 8; ++e) v[e] = tanhf_(v[e]);
                    } else if (act == 3) {
#pragma unroll
                        for (int e = 0; e < 8; ++e) v[e] = sigmoidf_(v[e]);
                    }
                    u32x4 o = {pk_bf16(v[0], v[1]), pk_bf16(v[2], v[3]), pk_bf16(v[4], v[5]), pk_bf16(v[6], v[7])};
                    *(u32x4*)(rowp + bj * HALF) = o;
                }
            }
    }
};
struct EpiRes {
    static constexpr bool PERM = false;
    float* out; const float* res; const float* cscale; float alpha; long sC; int ldc;
    DI void operator()(const f32x4 (&acc)[2][2][4][2], const Unit& u, int wr, int wc, int fr, int fq) const {
        const int row0 = u.pm * BM + wr * 64 + fr, col0 = (int)(u.g * sC) + u.pn * BM + wc * 32 + 4 * fq;
        f32x4 r[2][2][2][2];
        auto ldq = [&](int q, int buf) {
            const int ai = q >> 1, m0 = (q & 1) * 2;
#pragma unroll
            for (int mm = 0; mm < 2; ++mm) {
                const size_t ro = (size_t)(row0 + ai * HALF + (m0 + mm) * 16) * ldc + col0;
#pragma unroll
                for (int bj = 0; bj < 2; ++bj)
#pragma unroll
                    for (int n = 0; n < 2; ++n) r[buf][mm][bj][n] = *(const f32x4*)(res + ro + bj * HALF + n * 16);
            }
        };
        auto stq = [&](int q, int buf) {
            const int ai = q >> 1, m0 = (q & 1) * 2;
#pragma unroll
            for (int mm = 0; mm < 2; ++mm) {
                const size_t ro = (size_t)(row0 + ai * HALF + (m0 + mm) * 16) * ldc + col0;
#pragma unroll
                for (int bj = 0; bj < 2; ++bj)
#pragma unroll
                    for (int n = 0; n < 2; ++n) {
                        f32x4 a = acc[ai][bj][m0 + mm][n];
                        if (cscale) a *= *(const f32x4*)(cscale + col0 + bj * HALF + n * 16);
                        *(f32x4*)(out + ro + bj * HALF + n * 16) = alpha * r[buf][mm][bj][n] + a;
                    }
            }
        };
        ldq(0, 0); ldq(1, 1);
        __builtin_amdgcn_sched_barrier(0);
        stq(0, 0); ldq(2, 0);
        __builtin_amdgcn_sched_barrier(0);
        stq(1, 1); ldq(3, 1);
        __builtin_amdgcn_sched_barrier(0);
        stq(2, 0); stq(3, 1);
    }
};
template <class Epi>
DI void gemm_phase(int tid_, int bid_, LAS unsigned char* lds, const Gemm g, const Epi& E) {
    const int tid = tid_, wid = __builtin_amdgcn_readfirstlane(tid >> 6), lane = tid & 63, wr = wid >> 2, wc = wid & 3, fr = lane & 15, fq = lane >> 4;
    const int K = g.K, nt = K / BK;
    Order S; S.init(g, (int)gridDim.x, (int)bid_);
    unsigned voffA[2], voffB[2];
#pragma unroll
    for (int i = 0; i < 2; ++i) { int R, C; stage_rc(tid * 16 + i * 8192, R, C); const int Rb = Epi::PERM ? ((R & ~31) + perm32(R & 31)) : R;
        voffA[i] = (unsigned)(R * g.lda + C) * 2u; voffB[i] = (unsigned)(Rb * g.ldb + C) * 2u; }
    const size_t kstep = (size_t)(BK * 2);
    const size_t hA = (size_t)HALF * g.lda * 2, hB = (size_t)HALF * g.ldb * 2;
    const unsigned ldsw = (unsigned)wid * 1024u;
    const int aoff = lds_byte(wr * 64 + fr, fq * 8), boff = lds_byte(wc * 32 + fr, fq * 8);
#define PG8_SA(b, h) (((b) * 2 + (h)) * HTB)
#define PG8_SB(b, h) ((4 + (b) * 2 + (h)) * HTB)
#define PG8_STAGE(bufoff, gbase, voff) do { _Pragma("unroll") for (int _i = 0; _i < 2; ++_i) \
        __builtin_amdgcn_global_load_lds((const unsigned*)((const char*)(gbase) + (voff)[_i]), (LAS unsigned*)(lds + (bufoff) + ldsw + _i * 8192), 16, 0, 0); } while (0)
#define PG8_LDA(dst, b, h) do { _Pragma("unroll") for (int m = 0; m < 4; ++m) _Pragma("unroll") for (int k = 0; k < 2; ++k) dst[m][k] = *(const LAS bf16x8*)(lds + PG8_SA(b, h) + aoff + m * 2048 + k * 1024); } while (0)
#define PG8_LDB(dst, b, h) do { _Pragma("unroll") for (int n = 0; n < 2; ++n) _Pragma("unroll") for (int k = 0; k < 2; ++k) dst[n][k] = *(const LAS bf16x8*)(lds + PG8_SB(b, h) + boff + n * 2048 + k * 1024); } while (0)
#define PG8_MMA(ai, bj, At, Bt) do { __builtin_amdgcn_s_setprio(1); _Pragma("unroll") for (int m = 0; m < 4; ++m) _Pragma("unroll") for (int n = 0; n < 2; ++n) _Pragma("unroll") for (int k = 0; k < 2; ++k) \
        acc[ai][bj][m][n] = __builtin_amdgcn_mfma_f32_16x16x32_bf16(Bt[n][k], At[m][k], acc[ai][bj][m][n], 0, 0, 0); __builtin_amdgcn_s_setprio(0); } while (0)
#define PG8_WAIT_V(n) asm volatile("s_waitcnt vmcnt(" #n ")" ::: "memory")
#define PG8_WAIT_L(n) asm volatile("s_waitcnt lgkmcnt(" #n ")" ::: "memory")
#define PG8_BAR __builtin_amdgcn_s_barrier()
#define PG8_SCHED __builtin_amdgcn_sched_barrier(0)
    Unit cur, nxt; int ui = 0;
    if (!S.next(0, cur)) return;
    f32x4 acc[2][2][4][2];
#pragma unroll
    for (int a = 0; a < 2; ++a)
#pragma unroll
        for (int b = 0; b < 2; ++b)
#pragma unroll
            for (int m = 0; m < 4; ++m)
#pragma unroll
                for (int n = 0; n < 2; ++n) acc[a][b][m][n] = (f32x4){0.f, 0.f, 0.f, 0.f};
    bf16x8 At[4][2], B0[2][2], B1[2][2];
    const char* cA = (const char*)g.A + ((size_t)cur.g * g.sA + (size_t)cur.pm * BM * g.lda) * 2;
    const char* cB = (const char*)g.Bt + ((size_t)cur.g * g.sB + (size_t)cur.pn * BM * g.ldb) * 2;
    PG8_STAGE(PG8_SB(0, 0), cB, voffB); PG8_STAGE(PG8_SA(0, 0), cA, voffA); PG8_STAGE(PG8_SB(0, 1), cB + hB, voffB); PG8_STAGE(PG8_SA(0, 1), cA + hA, voffA);
    if (wr == 1) PG8_BAR;
    PG8_WAIT_V(4); PG8_BAR;
    PG8_STAGE(PG8_SB(1, 0), cB + kstep, voffB); PG8_STAGE(PG8_SA(1, 0), cA + kstep, voffA); PG8_STAGE(PG8_SB(1, 1), cB + hB + kstep, voffB);
    PG8_WAIT_V(6); PG8_BAR;
    for (;;) {
        const bool has_next = S.next(ui + 1, nxt);
        const char* nA = has_next ? (const char*)g.A + ((size_t)nxt.g * g.sA + (size_t)nxt.pm * BM * g.lda) * 2 : cA;
        const char* nB = has_next ? (const char*)g.Bt + ((size_t)nxt.g * g.sB + (size_t)nxt.pn * BM * g.ldb) * 2 : cB;
        for (int t = 0; t < nt; t += 2) {
            const bool last = (t == nt - 2);
            const char* a1 = cA + (size_t)(t + 1) * kstep;
            const char* a2 = last ? nA : cA + (size_t)(t + 2) * kstep; const char* b2 = last ? nB : cB + (size_t)(t + 2) * kstep;
            const char* a3 = a2 + kstep; const char* b3 = b2 + kstep;
            PG8_LDB(B0, 0, 0); PG8_SCHED; PG8_LDA(At, 0, 0); PG8_STAGE(PG8_SA(1, 1), a1 + hA, voffA);
            PG8_WAIT_L(8); PG8_BAR; PG8_WAIT_L(0); PG8_MMA(0, 0, At, B0); PG8_BAR; PG8_SCHED;
            PG8_LDB(B1, 0, 1); PG8_STAGE(PG8_SB(0, 0), b2, voffB);
            PG8_BAR; PG8_WAIT_L(0); PG8_MMA(0, 1, At, B1); PG8_BAR;
            PG8_LDA(At, 0, 1); PG8_STAGE(PG8_SA(0, 0), a2, voffA);
            PG8_BAR; PG8_WAIT_L(0); PG8_MMA(1, 0, At, B0); PG8_BAR; PG8_SCHED;
            PG8_STAGE(PG8_SB(0, 1), b2 + hB, voffB);
            PG8_WAIT_V(6); PG8_BAR; PG8_MMA(1, 1, At, B1); PG8_BAR;
            PG8_LDB(B0, 1, 0); PG8_SCHED; PG8_LDA(At, 1, 0); PG8_STAGE(PG8_SA(0, 1), a2 + hA, voffA);
            PG8_WAIT_L(8); PG8_BAR; PG8_WAIT_L(0); PG8_MMA(0, 0, At, B0); PG8_BAR; PG8_SCHED;
            PG8_LDB(B1, 1, 1); PG8_STAGE(PG8_SB(1, 0), b3, voffB);
            PG8_BAR; PG8_WAIT_L(0); PG8_MMA(0, 1, At, B1); PG8_BAR;
            PG8_LDA(At, 1, 1); PG8_STAGE(PG8_SA(1, 0), a3, voffA);
            PG8_BAR; PG8_WAIT_L(0); PG8_MMA(1, 0, At, B0); PG8_BAR; PG8_SCHED;
            PG8_STAGE(PG8_SB(1, 1), b3 + hB, voffB);
            PG8_WAIT_V(6); PG8_BAR; PG8_MMA(1, 1, At, B1); PG8_BAR;
        }
        E(acc, cur, wr, wc, fr, fq);
        if (!has_next) break;
#pragma unroll
        for (int a = 0; a < 2; ++a)
#pragma unroll
            for (int b = 0; b < 2; ++b)
#pragma unroll
                for (int m = 0; m < 4; ++m)
#pragma unroll
                    for (int n = 0; n < 2; ++n) acc[a][b][m][n] = (f32x4){0.f, 0.f, 0.f, 0.f};
        cur = nxt; cA = nA; cB = nB; ++ui;
    }
    PG8_WAIT_V(0);
    if (wr == 0) PG8_BAR;
    PG8_BAR;
#undef PG8_SA
#undef PG8_SB
#undef PG8_STAGE
#undef PG8_LDA
#undef PG8_LDB
#undef PG8_MMA
#undef PG8_WAIT_V
#undef PG8_WAIT_L
#undef PG8_BAR
#undef PG8_SCHED
}
}

DI pg8::Gemm mk_gemm(const bf16_t* A, const bf16_t* Bt, long sA, long sB, int lda, int ldb, int K, int nM, int nN, int G) {
    pg8::Gemm g; g.A = A; g.Bt = Bt; g.sA = sA; g.sB = sB; g.lda = lda; g.ldb = ldb; g.K = K; g.nM = nM; g.nN = nN; g.G = G; return g;
}

DI void prep_phase(int tid_, int bid_, const Params& p, unsigned char* smem) {
    TJob* jobs = (TJob*)smem;
    float* tile = (float*)(smem + 4096);
    const int tid = tid_;
    if (tid < NTJ) jobs[tid] = p.tj[tid];
    __syncthreads();
    const int ntiles = p.ntiles;
    for (int tix = bid_; tix < ntiles; tix += gridDim.x) {
        int j = 0;
        for (int q = 1; q < NTJ; ++q) if (jobs[q].tile0 <= tix) j = q;
        const TJob jb = jobs[j];
        const int lt = tix - jb.tile0, ntk = jb.Kd / 128, k0 = (lt % ntk) * 128, n0 = (lt / ntk) * 128;
        f32x4 v[8];
#pragma unroll
        for (int i = 0; i < 8; ++i) {
            const int idx = tid + i * 512, kk = idx >> 5, n4 = idx & 31;
            const int k = k0 + kk, n = n0 + n4 * 4;
            v[i] = (k < jb.Ks && n < jb.Ns) ? *(const f32x4*)(jb.src + (size_t)k * jb.Ns + n) : (f32x4){0.f, 0.f, 0.f, 0.f};
        }
#pragma unroll
        for (int i = 0; i < 8; ++i) {
            const int idx = tid + i * 512, kk = idx >> 5, n4 = idx & 31;
#pragma unroll
            for (int e = 0; e < 4; ++e) tile[kk * 129 + n4 * 4 + e] = v[i][e];
        }
        __syncthreads();
#pragma unroll
        for (int i = 0; i < 4; ++i) {
            const int idx = tid + i * 512, n = idx >> 4, kc = idx & 15;
            float f[8];
#pragma unroll
            for (int e = 0; e < 8; ++e) f[e] = tile[(kc * 8 + e) * 129 + n];
            u32x4 o = {pk_bf16(f[0], f[1]), pk_bf16(f[2], f[3]), pk_bf16(f[4], f[5]), pk_bf16(f[6], f[7])};
            *(u32x4*)(jb.dst + (size_t)(n0 + n) * jb.Kd + k0 + kc * 8) = o;
        }
        __syncthreads();
    }
    {
        const float* x = p.in[0]; bf16_t* xb = (bf16_t*)(p.ws + O_SLOT + 8 * SLOT);
        const size_t n8 = (size_t)T * D / 8;
        for (size_t i = (size_t)bid_ * 512 + tid; i < n8; i += (size_t)gridDim.x * 512) {
            const f32x4 a = *(const f32x4*)(x + i * 8), b = *(const f32x4*)(x + i * 8 + 4);
            u32x4 o = {pk_bf16(a[0], a[1]), pk_bf16(a[2], a[3]), pk_bf16(b[0], b[1]), pk_bf16(b[2], b[3])};
            *(u32x4*)(xb + i * 8) = o;
        }
    }
    {
        float* ct = (float*)(p.ws + O_ROPE); float* st = ct + SEQ * 16;
        for (int i = bid_ * 512 + tid; i < SEQ * 16; i += gridDim.x * 512) {
            const int pos = i >> 4, f = i & 15;
            const float inv = powf(500000.0f, -(float)(2 * f) / 32.0f);
            const float ang = (float)pos * inv;
            ct[i] = cosf(ang); st[i] = sinf(ang);
        }
    }
}

DI void ln_phase(int tid_, int bid_, const float* zin, float* xout, bf16_t* xb, const float* gam, const float* bet) {
    const int lane = tid_ & 63, wid = tid_ >> 6;
    const int rstride = gridDim.x * 8;
    constexpr int NR = 4;
    for (int row0 = bid_ * 8 + wid; row0 < T; row0 += NR * rstride) {
        f32x4 v[NR][8];
#pragma unroll
        for (int r = 0; r < NR; ++r)
#pragma unroll
            for (int i = 0; i < 8; ++i)
                v[r][i] = (row0 + r * rstride < T) ? *(const f32x4*)(zin + (size_t)(row0 + r * rstride) * D + (i * 64 + lane) * 4) : (f32x4){0.f, 0.f, 0.f, 0.f};
#pragma unroll
        for (int r = 0; r < NR; ++r) {
            const int row = row0 + r * rstride;
            if (row >= T) break;
            float s = 0.f;
#pragma unroll
            for (int i = 0; i < 8; ++i) s += v[r][i][0] + v[r][i][1] + v[r][i][2] + v[r][i][3];
            const float mean = wave_sum(s) * (1.f / D);
            float q = 0.f;
#pragma unroll
            for (int i = 0; i < 8; ++i) { v[r][i] -= mean; q += v[r][i][0] * v[r][i][0] + v[r][i][1] * v[r][i][1] + v[r][i][2] * v[r][i][2] + v[r][i][3] * v[r][i][3]; }
            const float rstd = rsqrtf(wave_sum(q) * (1.f / D) + LN_EPS);
#pragma unroll
            for (int i = 0; i < 8; ++i) {
                const int c = (i * 64 + lane) * 4;
                const f32x4 g = *(const f32x4*)(gam + c), b = *(const f32x4*)(bet + c);
                const f32x4 o = v[r][i] * rstd * g + b;
                *(f32x4*)(xout + (size_t)row * D + c) = o;
                if (xb) { u32x2 w = {pk_bf16(o[0], o[1]), pk_bf16(o[2], o[3])}; *(u32x2*)(xb + (size_t)row * D + c) = w; }
            }
        }
    }
}

DI void rg_conv_phase(int tid_, int bid_, const bf16_t* gu, bf16_t* uc, const float* cw, const float* cb) {
    const size_t n8 = (size_t)T * D / 8;
    const size_t stride = (size_t)gridDim.x * 512;
    constexpr int U = 4;
    for (size_t ib = (size_t)bid_ * 512 + tid_; ib < n8; ib += stride * U) {
        u32x4 uu[U][4];
#pragma unroll
        for (int u = 0; u < U; ++u) {
            const size_t i = ib + u * stride;
            const int t = (int)(i >> 8), c = (int)(i & 255) * 8, s = t & (SEQ - 1);
#pragma unroll
            for (int j = 0; j < 4; ++j)
                uu[u][j] = (i < n8 && s - 3 + j >= 0) ? *(const u32x4*)(gu + (size_t)(t - 3 + j) * 4096 + 2048 + c) : (u32x4){0u, 0u, 0u, 0u};
        }
#pragma unroll
        for (int u = 0; u < U; ++u) {
            const size_t i = ib + u * stride;
            if (i >= n8) break;
            const int c = (int)(i & 255) * 8;
            float a[8];
            { const f32x4 b0 = *(const f32x4*)(cb + c), b1 = *(const f32x4*)(cb + c + 4);
#pragma unroll
              for (int e = 0; e < 4; ++e) { a[e] = b0[e]; a[4 + e] = b1[e]; } }
#pragma unroll
            for (int j = 0; j < 4; ++j) {
                const u32x4 q = uu[u][j];
                const f32x4 w0 = *(const f32x4*)(cw + j * D + c), w1 = *(const f32x4*)(cw + j * D + c + 4);
                a[0] += w0[0] * bflo(q[0]); a[1] += w0[1] * bfhi(q[0]); a[2] += w0[2] * bflo(q[1]); a[3] += w0[3] * bfhi(q[1]);
                a[4] += w1[0] * bflo(q[2]); a[5] += w1[1] * bfhi(q[2]); a[6] += w1[2] * bflo(q[3]); a[7] += w1[3] * bfhi(q[3]);
            }
            u32x4 o = {pk_bf16(a[0], a[1]), pk_bf16(a[2], a[3]), pk_bf16(a[4], a[5]), pk_bf16(a[6], a[7])};
            *(u32x4*)(uc + i * 8) = o;
        }
    }
}
DI void rg_ab(float rpre, float ipre, float u, float ba, float bx, float sp8, float& a, float& b) {
    const float r = sigmoidf_(rpre + ba), ii = sigmoidf_(ipre + bx);
    const float la = -sp8 * r;
    a = __expf(la);
    const float x2 = 2.f * la;
    const float om = (x2 > -0.05f) ? -x2 * (1.f + x2 * (0.5f + x2 * (0.16666667f + x2 * 0.041666668f))) : 1.f - a * a;
    b = u * ii * __builtin_amdgcn_sqrtf(om);
}
template <int MODE>
DI void rg_scan_phase(int tid_, int bid_, const Params& p, const bf16_t* gates, const bf16_t* uc, const bf16_t* gu, float* agg, bf16_t* outg) {
    constexpr int CH = 32;
    const float* gab = p.in[9]; const float* gxb = p.in[11]; const float* lam = p.in[12];
    for (int item = bid_; item < 4 * 128 * 2; item += gridDim.x) {
        const int cg2 = item & 1, chunk = (item >> 1) & 127, b = item >> 8;
        const int ch = cg2 * 1024 + tid_ * 2;
        const int n = ch >> 8, v = ch & 255;
        const f32x2 ba = *(const f32x2*)(gab + ch), bx = *(const f32x2*)(gxb + ch), lm = *(const f32x2*)(lam + ch);
        const float sp0 = 8.f * log1pf(expf(-lm[0])), sp1 = 8.f * log1pf(expf(-lm[1]));
        float h0 = 0.f, h1 = 0.f, P0 = 1.f, P1 = 1.f;
        if (MODE == 1) {
            for (int c0 = 0; c0 < chunk; c0 += 16) {
                f32x4 gv[16];
#pragma unroll
                for (int j = 0; j < 16; ++j) gv[j] = (c0 + j < chunk) ? *(const f32x4*)(agg + (((size_t)b * 128 + c0 + j) * D + ch) * 2) : (f32x4){1.f, 0.f, 1.f, 0.f};
#pragma unroll
                for (int j = 0; j < 16; ++j) { h0 = gv[j][0] * h0 + gv[j][1]; h1 = gv[j][2] * h1 + gv[j][3]; }
            }
        }
        const size_t t0 = (size_t)b * SEQ + (size_t)chunk * CH;
        constexpr int UB = 32;
        for (int tb = 0; tb < CH; tb += UB) {
            unsigned rpv[UB], ipv[UB], uuv[UB], ggv[UB];
#pragma unroll
            for (int j = 0; j < UB; ++j) {
                const size_t t = t0 + tb + j;
                rpv[j] = *(const unsigned*)(gates + t * 4096 + n * 512 + v);
                ipv[j] = *(const unsigned*)(gates + t * 4096 + n * 512 + 256 + v);
                uuv[j] = *(const unsigned*)(uc + t * D + ch);
                if (MODE == 1) ggv[j] = *(const unsigned*)(gu + t * 4096 + ch);
            }
#pragma unroll
            for (int j = 0; j < UB; ++j) {
                const size_t t = t0 + tb + j;
                float a0, b0, a1, b1;
                rg_ab(bflo(rpv[j]), bflo(ipv[j]), bflo(uuv[j]), ba[0], bx[0], sp0, a0, b0);
                rg_ab(bfhi(rpv[j]), bfhi(ipv[j]), bfhi(uuv[j]), ba[1], bx[1], sp1, a1, b1);
                h0 = a0 * h0 + b0; h1 = a1 * h1 + b1;
                if (MODE == 0) { P0 *= a0; P1 *= a1; }
                else *(unsigned*)(outg + t * D + ch) = pk_bf16(gelu_tanh(bflo(ggv[j])) * h0, gelu_tanh(bfhi(ggv[j])) * h1);
            }
        }
        if (MODE == 0) { f32x4 o = {P0, h0, P1, h1}; *(f32x4*)(agg + (((size_t)b * 128 + chunk) * D + ch) * 2) = o; }
    }
}

DI void kmean_phase(int tid_, int bid_, bf16_t* Qx, bf16_t* Kx, float* kmean, const float* ctab, const float* stab, unsigned char* smem) {
    float* redA = (float*)smem;
    float* redB = redA + 1024;
    const int tid = tid_;
    for (int item = bid_; item < 1024; item += gridDim.x) {
        const int blk = item & 15, h = (item >> 4) & 15, b = item >> 8;
        {
            const int i = tid & 15, rg = tid >> 4;
            float s1 = 0.f, s2 = 0.f;
            bf16_t k1v[8], k2v[8], q1v[8], q2v[8]; float cv[8], sv[8];
#pragma unroll
            for (int r = 0; r < 8; ++r) {
                const int pos = blk * 256 + rg * 8 + r;
                const size_t o = ((size_t)b * SEQ + pos) * D + h * 128 + i;
                cv[r] = ctab[pos * 16 + i]; sv[r] = stab[pos * 16 + i];
                k1v[r] = Kx[o]; k2v[r] = Kx[o + 16]; q1v[r] = Qx[o]; q2v[r] = Qx[o + 16];
            }
#pragma unroll
            for (int r = 0; r < 8; ++r) {
                const int pos = blk * 256 + rg * 8 + r;
                const size_t o = ((size_t)b * SEQ + pos) * D + h * 128 + i;
                const float c = cv[r], sn = sv[r];
                const float k1 = bf2f(k1v[r]), k2 = bf2f(k2v[r]);
                const bf16_t k1r = f2bf(k1 * c - k2 * sn), k2r = f2bf(k2 * c + k1 * sn);
                Kx[o] = k1r; Kx[o + 16] = k2r; s1 += bf2f(k1r); s2 += bf2f(k2r);
                const float q1 = bf2f(q1v[r]), q2 = bf2f(q2v[r]);
                Qx[o] = f2bf(q1 * c - q2 * sn); Qx[o + 16] = f2bf(q2 * c + q1 * sn);
            }
            redA[rg * 32 + i] = s1; redA[rg * 32 + 16 + i] = s2;
        }
        {
            const int dp = tid & 63, rg = tid >> 6;
            if (dp >= 16) {
                const bf16_t* base = Kx + ((size_t)b * SEQ + blk * 256 + rg * 32) * D + h * 128 + dp * 2;
                float s0 = 0.f, s1 = 0.f;
                unsigned uv[32];
#pragma unroll
                for (int r = 0; r < 32; ++r) uv[r] = *(const unsigned*)(base + (size_t)r * D);
#pragma unroll
                for (int r = 0; r < 32; ++r) { s0 += bflo(uv[r]); s1 += bfhi(uv[r]); }
                redB[rg * 128 + dp * 2] = s0; redB[rg * 128 + dp * 2 + 1] = s1;
            }
        }
        __syncthreads();
        if (tid < 128) {
            float s = 0.f;
            if (tid < 32) { for (int r = 0; r < 32; ++r) s += redA[r * 32 + tid]; }
            else { for (int r = 0; r < 8; ++r) s += redB[r * 128 + tid]; }
            kmean[(size_t)item * 128 + tid] = s * (1.f / 256.f);
        }
        __syncthreads();
    }
}

DI void attn_phase(int tid_, int bid_, const bf16_t* Q, const bf16_t* Kx, const bf16_t* VT, bf16_t* O, const float* kmean, unsigned char* smem) {
    constexpr int KB_STRIDE = 288, VB_STRIDE = 160;
    constexpr int KBUF = 64 * KB_STRIDE, VBUF = 128 * VB_STRIDE;
    constexpr float QC = 0.08838834764831845f * 1.4426950408889634f;
    constexpr float THR_RAW = 8.0f / 0.08838834764831845f;
#define KBUFP(bi) (smem + (bi) * KBUF)
#define VBUFP(bi) (smem + 2 * KBUF + (bi) * VBUF)
    float* km = (float*)(smem + 2 * KBUF + 2 * VBUF);
    const int tid = tid_, wid = tid >> 6, lane = tid & 63, fr = lane & 15, fq = lane >> 4;
    for (int idx = bid_; idx < 1024; idx += gridDim.x) {
        const int bh = idx & 63, jj = idx >> 6, sub = jj & 3, r2 = jj >> 2;
        const int qb = (r2 == 0) ? sub : (r2 == 1) ? (7 - sub) : (r2 == 2) ? (8 + sub) : (15 - sub);
        const int b = bh >> 4, h = bh & 15;
        const size_t tok0 = (size_t)b * SEQ;
        const int qloc0 = wid * 32 + fr;
        { const f32x4 kv = *(const f32x4*)(kmean + (size_t)bh * 2048 + tid * 4); *(f32x4*)(km + tid * 4) = kv; }
        bf16x8 qf[2][4];
#pragma unroll
        for (int qt = 0; qt < 2; ++qt)
#pragma unroll
            for (int dc = 0; dc < 4; ++dc) qf[qt][dc] = *(const bf16x8*)(Q + (tok0 + qb * 256 + qloc0 + qt * 16) * D + h * 128 + dc * 32 + fq * 8);
        __syncthreads();
        const int ntile = (qb + 1) * 4;
        const int kr0 = tid >> 4, kc0 = tid & 15;
        const int vr0 = tid >> 3, vc0 = tid & 7;
        u32x4 kreg0[2], vreg0[2];
        auto gload = [&](int tt, u32x4 (&kreg)[2], u32x4 (&vreg)[2]) {
            const int key0 = tt * 64;
#pragma unroll
            for (int i = 0; i < 2; ++i) {
                kreg[i] = *(const u32x4*)(Kx + (tok0 + key0 + kr0 + i * 32) * D + h * 128 + kc0 * 8);
                vreg[i] = *(const u32x4*)(VT + (size_t)(h * 128 + vr0 + i * 64) * T + tok0 + key0 + vc0 * 8);
            }
        };
        auto lstore = [&](int bi, const u32x4 (&kreg)[2], const u32x4 (&vreg)[2]) {
#pragma unroll
            for (int i = 0; i < 2; ++i) {
                *(u32x4*)(KBUFP(bi) + (kr0 + i * 32) * KB_STRIDE + kc0 * 16) = kreg[i];
                {
                    unsigned char* vrow = VBUFP(bi) + (vr0 + i * 64) * VB_STRIDE + (vc0 >> 2) * 64;
                    const int c = vc0 & 3, p0 = ((c & 1) * 2) * 16 + (c >> 1) * 8;
                    u32x2 lo = {vreg[i][0], vreg[i][1]}, hi = {vreg[i][2], vreg[i][3]};
                    *(u32x2*)(vrow + p0) = lo; *(u32x2*)(vrow + p0 + 16) = hi;
                }
            }
        };
        gload(0, kreg0, vreg0);
        unsigned mask[2];
#pragma unroll
        for (int qt = 0; qt < 2; ++qt) {
            float v0 = -3e38f, v1 = -3e38f, v2 = -3e38f; int i0 = -1, i1 = -1, i2 = -1;
            for (int j = 0; j < qb; ++j) {
                float g = 0.f;
#pragma unroll
                for (int dc = 0; dc < 4; ++dc) {
                    const f32x4 ka = *(const f32x4*)(km + j * 128 + dc * 32 + fq * 8), kb2 = *(const f32x4*)(km + j * 128 + dc * 32 + fq * 8 + 4);
#pragma unroll
                    for (int e = 0; e < 4; ++e) { g += bf2f((bf16_t)qf[qt][dc][e]) * ka[e]; g += bf2f((bf16_t)qf[qt][dc][4 + e]) * kb2[e]; }
                }
                g = xsum_fq(g);
                if (g > v0) { v2 = v1; i2 = i1; v1 = v0; i1 = i0; v0 = g; i0 = j; }
                else if (g > v1) { v2 = v1; i2 = i1; v1 = g; i1 = j; }
                else if (g > v2) { v2 = g; i2 = j; }
            }
            unsigned mk = 0u;
            if (i0 >= 0) mk |= 1u << i0;
            if (i1 >= 0) mk |= 1u << i1;
            if (i2 >= 0) mk |= 1u << i2;
            mask[qt] = mk;
        }
        float mrun[2] = {-1e30f, -1e30f}, lrun[2] = {0.f, 0.f};
        f32x4 oacc[2][8];
#pragma unroll
        for (int qt = 0; qt < 2; ++qt)
#pragma unroll
            for (int dt = 0; dt < 8; ++dt) oacc[qt][dt] = (f32x4){0.f, 0.f, 0.f, 0.f};
        auto compute = [&](int tt, int bi) {
            const int kb = tt >> 2, kt64 = tt & 3;
            const bool own = (kb == qb);
            bool actq[2];
#pragma unroll
            for (int qt = 0; qt < 2; ++qt) actq[qt] = own ? true : (((mask[qt] >> kb) & 1u) != 0u);
            const bool doit = own ? (kt64 * 64 <= wid * 32 + 31) : (__any((int)(actq[0] || actq[1])) != 0);
            const bool elem = own && (kt64 * 64 + 63 > wid * 32);
            if (doit) {
                f32x4 sacc[2][4];
#pragma unroll
                for (int qt = 0; qt < 2; ++qt)
#pragma unroll
                    for (int kt = 0; kt < 4; ++kt) sacc[qt][kt] = (f32x4){0.f, 0.f, 0.f, 0.f};
#pragma unroll
                for (int dc = 0; dc < 4; ++dc)
#pragma unroll
                    for (int kt = 0; kt < 4; ++kt) {
                        const bf16x8 kf = *(const bf16x8*)(KBUFP(bi) + (kt * 16 + fr) * KB_STRIDE + dc * 64 + fq * 16);
#pragma unroll
                        for (int qt = 0; qt < 2; ++qt) sacc[qt][kt] = __builtin_amdgcn_mfma_f32_16x16x32_bf16(kf, qf[qt][dc], sacc[qt][kt], 0, 0, 0);
                    }
                bf16x8 pf[2][2];
#pragma unroll
                for (int qt = 0; qt < 2; ++qt) {
                    const int lim = own ? (qloc0 + qt * 16 - kt64 * 64 - fq * 4) : (actq[qt] ? 1000 : -1000);
                    float mx = -1e30f;
                    if (elem) {
#pragma unroll
                        for (int kt = 0; kt < 4; ++kt)
#pragma unroll
                            for (int r = 0; r < 4; ++r) {
                                const float sv = (kt * 16 + r <= lim) ? sacc[qt][kt][r] : -__builtin_inff();
                                sacc[qt][kt][r] = sv; mx = fmaxf(mx, sv);
                            }
                    } else {
#pragma unroll
                        for (int kt = 0; kt < 4; ++kt)
#pragma unroll
                            for (int r = 0; r < 4; ++r) mx = fmaxf(mx, sacc[qt][kt][r]);
                        mx = actq[qt] ? mx : -__builtin_inff();
                    }
                    mx = xmax_fq(mx);
                    if (__any((int)(mx > mrun[qt] + THR_RAW))) {
                        const float mnew = fmaxf(mrun[qt], mx);
                        const float alpha = __builtin_amdgcn_exp2f((mrun[qt] - mnew) * QC);
                        mrun[qt] = mnew;
                        lrun[qt] *= alpha;
#pragma unroll
                        for (int dt = 0; dt < 8; ++dt) oacc[qt][dt] *= alpha;
                    }
                    const float mneg = (elem || actq[qt]) ? -mrun[qt] * QC : -__builtin_inff();
                    float ps = 0.f;
#pragma unroll
                    for (int kt = 0; kt < 4; ++kt)
#pragma unroll
                        for (int r = 0; r < 4; ++r) { const float pe = __builtin_amdgcn_exp2f(__builtin_fmaf(sacc[qt][kt][r], QC, mneg)); sacc[qt][kt][r] = pe; ps += pe; }
                    lrun[qt] += ps;
#pragma unroll
                    for (int ks = 0; ks < 2; ++ks) {
                        u32x4 w = {pk_bf16(sacc[qt][2 * ks][0], sacc[qt][2 * ks][1]), pk_bf16(sacc[qt][2 * ks][2], sacc[qt][2 * ks][3]),
                                   pk_bf16(sacc[qt][2 * ks + 1][0], sacc[qt][2 * ks + 1][1]), pk_bf16(sacc[qt][2 * ks + 1][2], sacc[qt][2 * ks + 1][3])};
                        pf[qt][ks] = __builtin_bit_cast(bf16x8, w);
                    }
                }
#pragma unroll
                for (int ks = 0; ks < 2; ++ks)
#pragma unroll
                    for (int dt = 0; dt < 8; ++dt) {
                        const bf16x8 vf = *(const bf16x8*)(VBUFP(bi) + (dt * 16 + fr) * VB_STRIDE + ks * 64 + fq * 16);
#pragma unroll
                        for (int qt = 0; qt < 2; ++qt) oacc[qt][dt] = __builtin_amdgcn_mfma_f32_16x16x32_bf16(vf, pf[qt][ks], oacc[qt][dt], 0, 0, 0);
                    }
            }
        };
        lstore(0, kreg0, vreg0);
        __syncthreads();
        for (int tt = 0; tt < ntile; tt += 2) {
            if (tt + 1 < ntile) gload(tt + 1, kreg0, vreg0);
            compute(tt, 0);
            if (tt + 1 < ntile) lstore(1, kreg0, vreg0);
            lds_barrier();
            if (tt + 1 < ntile) {
                if (tt + 2 < ntile) gload(tt + 2, kreg0, vreg0);
                compute(tt + 1, 1);
                if (tt + 2 < ntile) lstore(0, kreg0, vreg0);
                lds_barrier();
            }
        }
        __syncthreads();
#pragma unroll
        for (int qt = 0; qt < 2; ++qt) {
            const float lt = xsum_fq(lrun[qt]);
            const float inv = 1.f / lt;
            bf16_t* orow = O + (tok0 + qb * 256 + qloc0 + qt * 16) * D + h * 128 + fq * 4;
#pragma unroll
            for (int dt = 0; dt < 8; ++dt) {
                const f32x4 o = oacc[qt][dt] * inv;
                u32x2 w = {pk_bf16(o[0], o[1]), pk_bf16(o[2], o[3])};
                *(u32x2*)(orow + dt * 16) = w;
            }
        }
    }
#undef KBUFP
#undef VBUFP
}

DI void rwkv_mix_phase(int tid_, int bid_, const float* x, const float* mu, bf16_t* slots) {
    const size_t n4 = (size_t)T * D / 4;
    const size_t stride = (size_t)gridDim.x * 512;
    constexpr int U = 8;
    for (size_t ib = (size_t)bid_ * 512 + tid_; ib < n4; ib += stride * U) {
        f32x4 xv[U], xp[U];
#pragma unroll
        for (int u = 0; u < U; ++u) {
            const size_t i = ib + u * stride;
            const int t = (int)(i >> 9), s_ = t & (SEQ - 1);
            xv[u] = (i < n4) ? *(const f32x4*)(x + i * 4) : (f32x4){0.f, 0.f, 0.f, 0.f};
            xp[u] = (i < n4 && s_ > 0) ? *(const f32x4*)(x + i * 4 - D) : (f32x4){0.f, 0.f, 0.f, 0.f};
        }
#pragma unroll
        for (int u = 0; u < U; ++u) {
            const size_t i = ib + u * stride;
            if (i >= n4) break;
            const int c = (int)(i & 511) * 4;
            const f32x4 xx = xp[u] - xv[u];
#pragma unroll
            for (int k = 0; k < 6; ++k) {
                const f32x4 m = *(const f32x4*)(mu + k * D + c);
                const f32x4 o = xv[u] + xx * m;
                u32x2 w = {pk_bf16(o[0], o[1]), pk_bf16(o[2], o[3])};
                *(u32x2*)((unsigned char*)slots + k * SLOT + i * 8) = w;
            }
        }
    }
}
DI float softplusf_(float y) { return fmaxf(y, 0.f) + __logf(1.f + __expf(-fabsf(y))); }
DI void rwkv_prep_phase(int tid_, int bid_, const Params& p, unsigned char* sl, float* scal) {
    bf16_t* R = (bf16_t*)(sl + 6 * SLOT); bf16_t* Kk = (bf16_t*)(sl + 7 * SLOT);
    const bf16_t* WP = (const bf16_t*)(sl + 0 * SLOT); bf16_t* AP = (bf16_t*)(sl + 1 * SLOT);
    bf16_t* KX = (bf16_t*)(sl + 3 * SLOT); float* WD = (float*)(sl + 4 * SLOT);
    const float* w0 = p.in[18]; const float* a0 = p.in[21]; const float* k_k = p.in[26]; const float* k_a = p.in[27]; const float* r_k = p.in[28];
    float* BR = scal; float* KR = scal + (size_t)T * 32; float* BO = scal + (size_t)2 * T * 32;
    const int lane = tid_ & 63, wid = tid_ >> 6;
    constexpr int U = 16;
    for (int grp = bid_ * 8 + wid; grp < T * 32 / U; grp += gridDim.x * 8) {
        const int item0 = grp * U;
        const int h0 = item0 & 31; const size_t t = (size_t)(item0 >> 5);
        const size_t o0 = t * D + h0 * 64 + lane;
        bf16_t rr[U], kr_[U], wpr[U], apr[U];
#pragma unroll
        for (int u = 0; u < U; ++u) { rr[u] = R[o0 + u * 64]; kr_[u] = Kk[o0 + u * 64]; wpr[u] = WP[o0 + u * 64]; apr[u] = AP[o0 + u * 64]; }
#pragma unroll
        for (int u = 0; u < U; ++u) {
            const int c = (h0 + u) * 64 + lane; const size_t o = o0 + u * 64;
            const float r = bf2f(rr[u]), k = bf2f(kr_[u]), wp = bf2f(wpr[u]), ap = bf2f(apr[u]);
            const float wlog = -softplusf_(-(w0[c] + wp)) - 0.5f;
            const float dec = __expf(-__expf(wlog));
            const float a = __builtin_amdgcn_rcpf(1.f + __expf(-(a0[c] + ap)));
            float kk = k * k_k[c];
            kk = kk * fminf(__builtin_amdgcn_rsqf(wave_sum(kk * kk)), 1e12f);
            const float kx = k * (1.f + (a - 1.f) * k_a[c]);
            const float bb = kk * a;
            const float br = wave_sum(bb * r), kr = wave_sum(kx * r), bo = wave_sum(r * kx * r_k[c]);
            R[o] = f2bf(dec * r); Kk[o] = f2bf(-kk); AP[o] = f2bf(bb); KX[o] = f2bf(kx); WD[o] = dec;
            if (lane == 0) { BR[item0 + u] = br; KR[item0 + u] = kr; BO[item0 + u] = bo; }
        }
    }
}
DI float dpp_sum8(float v) {
    v += __int_as_float(__builtin_amdgcn_update_dpp(0, __float_as_int(v), 0xB1, 0xF, 0xF, false));
    v += __int_as_float(__builtin_amdgcn_update_dpp(0, __float_as_int(v), 0x4E, 0xF, 0xF, false));
    v += __int_as_float(__builtin_amdgcn_update_dpp(0, __float_as_int(v), 0x141, 0xF, 0xF, false));
    return v;
}
DI void rwkv_scan_phase(int tid_, int bid_, unsigned char* sl, const float* scal, unsigned char* smem) {
    constexpr int TC = 32;
    constexpr int OFF_BB = TC * 128, OFF_KX = OFF_BB + TC * 64, OFF_W = OFF_KX + TC * 64, OFF_V = OFF_W + TC * 64, OFF_SC = OFF_V + TC * 32, BUF_F = OFF_SC + TC * 2;
    constexpr int NCH = SEQ / TC;
#define SBUF(i) ((float*)smem + (i) * BUF_F)
    const bf16_t* NKK = (const bf16_t*)(sl + 7 * SLOT); const bf16_t* WR = (const bf16_t*)(sl + 6 * SLOT);
    const bf16_t* BB = (const bf16_t*)(sl + 1 * SLOT); const bf16_t* KX = (const bf16_t*)(sl + 3 * SLOT);
    const float* WD = (const float*)(sl + 4 * SLOT); const bf16_t* V = (const bf16_t*)(sl + 8 * SLOT);
    bf16_t* Y = (bf16_t*)(sl + 0 * SLOT);
    const float* BR = scal; const float* KR = scal + (size_t)T * 32;
    const int tid = tid_, wid = tid >> 6, lane = tid & 63;
    for (int item = bid_; item < 256; item += gridDim.x) {
        const int half = item & 1, h = (item >> 1) & 31, b = item >> 6;
        const size_t tok0 = (size_t)b * SEQ;
        if (wid >= 4) {
            const int lt = tid - 256, lt_t = lt >> 3, lt_c = lt & 7;
            u32x4 r_nk, r_wr, r_bb, r_kx, r_v = {0u, 0u, 0u, 0u}; f32x4 r_w0, r_w1; float r_s = 0.f;
            auto gload = [&](int c) {
                const size_t tb = tok0 + (size_t)c * TC;
                const size_t o = (tb + lt_t) * D + h * 64 + lt_c * 8;
                r_nk = *(const u32x4*)(NKK + o); r_wr = *(const u32x4*)(WR + o); r_bb = *(const u32x4*)(BB + o); r_kx = *(const u32x4*)(KX + o);
                r_w0 = *(const f32x4*)(WD + (tb + (lt >> 4)) * D + h * 64 + (lt & 15) * 4);
                r_w1 = *(const f32x4*)(WD + (tb + 16 + (lt >> 4)) * D + h * 64 + (lt & 15) * 4);
                if (lt < 128) r_v = *(const u32x4*)(V + (tb + (lt >> 2)) * D + h * 64 + half * 32 + (lt & 3) * 8);
                else if (lt < 192) { const int i = lt - 128; r_s = ((i & 1) ? KR : BR)[(tb + (i >> 1)) * 32 + h]; }
            };
            auto lstore = [&](float* F) {
                float* pp = F + lt_t * 128 + lt_c * 16;
#pragma unroll
                for (int j = 0; j < 4; ++j) { f32x4 q = {bflo(r_nk[j]), bflo(r_wr[j]), bfhi(r_nk[j]), bfhi(r_wr[j])}; *(f32x4*)(pp + j * 4) = q; }
                { float* d = F + OFF_BB + lt_t * 64 + lt_c * 8;
                  f32x4 lo = {bflo(r_bb[0]), bfhi(r_bb[0]), bflo(r_bb[1]), bfhi(r_bb[1])}, hi = {bflo(r_bb[2]), bfhi(r_bb[2]), bflo(r_bb[3]), bfhi(r_bb[3])};
                  *(f32x4*)d = lo; *(f32x4*)(d + 4) = hi; }
                { float* d = F + OFF_KX + lt_t * 64 + lt_c * 8;
                  f32x4 lo = {bflo(r_kx[0]), bfhi(r_kx[0]), bflo(r_kx[1]), bfhi(r_kx[1])}, hi = {bflo(r_kx[2]), bfhi(r_kx[2]), bflo(r_kx[3]), bfhi(r_kx[3])};
                  *(f32x4*)d = lo; *(f32x4*)(d + 4) = hi; }
                *(f32x4*)(F + OFF_W + (lt >> 4) * 64 + (lt & 15) * 4) = r_w0;
                *(f32x4*)(F + OFF_W + (16 + (lt >> 4)) * 64 + (lt & 15) * 4) = r_w1;
                if (lt < 128) { float* d = F + OFF_V + (lt >> 2) * 32 + (lt & 3) * 8;
                  f32x4 lo = {bflo(r_v[0]), bfhi(r_v[0]), bflo(r_v[1]), bfhi(r_v[1])}, hi = {bflo(r_v[2]), bfhi(r_v[2]), bflo(r_v[3]), bfhi(r_v[3])};
                  *(f32x4*)d = lo; *(f32x4*)(d + 4) = hi; }
                else if (lt < 192) F[OFF_SC + (lt - 128)] = r_s;
            };
            gload(0); lstore(SBUF(0)); gload(1);
            __syncthreads();
            for (int c = 0; c < NCH; ++c) {
                if (c + 1 < NCH) lstore(SBUF((c + 1) & 1));
                if (c + 2 < NCH) gload(c + 2);
                lds_barrier();
            }
        } else {
            const int kq = lane & 7, rl = wid * 8 + (lane >> 3);
            f32x2 st[4];
#pragma unroll
            for (int j = 0; j < 4; ++j) st[j] = (f32x2){0.f, 0.f};
            bf16_t* yp = Y + (tok0 + kq) * D + h * 64 + half * 32 + rl;
            __syncthreads();
            struct Ops { f32x4 pq[4], b0, b1, k0, k1, w0, w1; float vv; f32x2 sc; };
            for (int c = 0; c < NCH; ++c) {
                const float* F = SBUF(c & 1);
                const float* fp = F + kq * 16;
                const float* fb = F + OFF_BB + kq * 8;
                auto ld = [&](Ops& o, int t) {
#pragma unroll
                    for (int j = 0; j < 4; ++j) o.pq[j] = *(const f32x4*)(fp + t * 128 + j * 4);
                    o.b0 = *(const f32x4*)(fb + t * 64); o.b1 = *(const f32x4*)(fb + t * 64 + 4);
                    o.k0 = *(const f32x4*)(fb + (OFF_KX - OFF_BB) + t * 64); o.k1 = *(const f32x4*)(fb + (OFF_KX - OFF_BB) + t * 64 + 4);
                    o.w0 = *(const f32x4*)(fb + (OFF_W - OFF_BB) + t * 64); o.w1 = *(const f32x4*)(fb + (OFF_W - OFF_BB) + t * 64 + 4);
                    o.vv = F[OFF_V + t * 32 + rl]; o.sc = *(const f32x2*)(F + OFF_SC + t * 2);
                };
                auto dots = [&](const Ops& o) -> f32x2 {
                    f32x2 acc = {0.f, 0.f}, acc2 = {0.f, 0.f};
#pragma unroll
                    for (int j = 0; j < 4; ++j) {
                        acc += st[j][0] * (f32x2){o.pq[j][0], o.pq[j][1]};
                        acc2 += st[j][1] * (f32x2){o.pq[j][2], o.pq[j][3]};
                    }
                    return acc + acc2;
                };
                auto update = [&](const Ops& o, f32x2 acc) -> float {
                    const float d1 = dpp_sum8(acc[0]), d2 = dpp_sum8(acc[1]);
                    st[0] = st[0] * (f32x2){o.w0[0], o.w0[1]} + d1 * (f32x2){o.b0[0], o.b0[1]} + o.vv * (f32x2){o.k0[0], o.k0[1]};
                    st[1] = st[1] * (f32x2){o.w0[2], o.w0[3]} + d1 * (f32x2){o.b0[2], o.b0[3]} + o.vv * (f32x2){o.k0[2], o.k0[3]};
                    st[2] = st[2] * (f32x2){o.w1[0], o.w1[1]} + d1 * (f32x2){o.b1[0], o.b1[1]} + o.vv * (f32x2){o.k1[0], o.k1[1]};
                    st[3] = st[3] * (f32x2){o.w1[2], o.w1[3]} + d1 * (f32x2){o.b1[2], o.b1[3]} + o.vv * (f32x2){o.k1[2], o.k1[3]};
                    return d2 + d1 * o.sc[0] + o.vv * o.sc[1];
                };
                Ops os[3];
                ld(os[0], 0); ld(os[1], 1);
                float yv = 0.f;
#pragma unroll
                for (int t = 0; t < TC; ++t) {
                    const f32x2 da = dots(os[t % 3]);
                    __builtin_amdgcn_sched_barrier(0);
                    if (t + 2 < TC) ld(os[(t + 2) % 3], t + 2);
                    __builtin_amdgcn_sched_barrier(0);
                    const float ya = update(os[t % 3], da);
                    yv = (kq == (t & 7)) ? ya : yv;
                    if ((t & 7) == 7) yp[(size_t)(c * TC + (t & ~7)) * D] = f2bf(yv);
                }
                lds_barrier();
            }
        }
        __syncthreads();
    }
#undef SBUF
}
DI void rwkv_post_phase(int tid_, int bid_, const Params& p, unsigned char* sl, const float* scal) {
    const bf16_t* Y = (const bf16_t*)(sl + 0 * SLOT); const bf16_t* V = (const bf16_t*)(sl + 8 * SLOT); const bf16_t* G = (const bf16_t*)(sl + 2 * SLOT);
    bf16_t* OUT = (bf16_t*)(sl + 3 * SLOT);
    const float* lg = p.in[29]; const float* lb = p.in[30]; const float* BO = scal + (size_t)2 * T * 32;
    const int lane = tid_ & 63, wid = tid_ >> 6;
    constexpr int U = 16;
    for (int grp = bid_ * 8 + wid; grp < T * 32 / U; grp += gridDim.x * 8) {
        const int item0 = grp * U;
        const int h0 = item0 & 31; const size_t t = (size_t)(item0 >> 5);
        const size_t o0 = t * D + h0 * 64 + lane;
        bf16_t yr[U], vr[U], gr[U]; float bor[U];
#pragma unroll
        for (int u = 0; u < U; ++u) { yr[u] = Y[o0 + u * 64]; vr[u] = V[o0 + u * 64]; gr[u] = G[o0 + u * 64]; bor[u] = BO[item0 + u]; }
#pragma unroll
        for (int u = 0; u < U; ++u) {
            const int c = (h0 + u) * 64 + lane;
            const float y = bf2f(yr[u]);
            const float mean = wave_sum(y) * (1.f / 64.f);
            const float dlt = y - mean;
            const float var = wave_sum(dlt * dlt) * (1.f / 64.f);
            float r = dlt * rsqrtf(var + 64e-5f) * lg[c] + lb[c];
            r += bor[u] * bf2f(vr[u]);
            OUT[o0 + u * 64] = f2bf(r * bf2f(gr[u]));
        }
    }
}

DI void pool_phase(int tid_, int bid_, const float* x, bf16_t* outp) {
    constexpr int CH = 32;
    const int tid = tid_, c = tid * 4, w = 2 << (c >> 9);
    for (int item = bid_; item < T / CH; item += gridDim.x) {
        const int t0 = item * CH, s0 = t0 & (SEQ - 1);
        f32x4 sum = {0.f, 0.f, 0.f, 0.f};
#pragma unroll
        for (int j = 1; j <= 16; ++j) if (j <= w && s0 - j >= 0) sum += *(const f32x4*)(x + (size_t)(t0 - j) * D + c);
#pragma unroll 16
        for (int tt = 0; tt < CH; ++tt) {
            const int t = t0 + tt, s = s0 + tt;
            const f32x4 xv = *(const f32x4*)(x + (size_t)t * D + c);
            sum += xv;
            if (s - w >= 0) sum -= *(const f32x4*)(x + (size_t)(t - w) * D + c);
            const float rc = __builtin_amdgcn_rcpf((float)((s + 1 < w) ? (s + 1) : w));
            const f32x4 o = sum * rc - xv;
            u32x2 wv = {pk_bf16(o[0], o[1]), pk_bf16(o[2], o[3])};
            *(u32x2*)(outp + (size_t)t * D + c) = wv;
        }
    }
}

#define XB_TMO      128
#define XB_XCNT(j)  (256  + 64 * (j))
#define XB_XSUB(j)  (1280 + 64 * (j))
#define XB_XGEN(j)  (2304 + 64 * (j))
#define XB_TOP      3328
#define XB_TOPGEN   3392
#define XCD_BAR_WORDS 3456
#define XB_SPIN_CAP (1u << 18)
DI unsigned xb_ld(unsigned* p) { return __hip_atomic_load(p, __ATOMIC_RELAXED, __HIP_MEMORY_SCOPE_AGENT); }
DI unsigned xb_add(unsigned* p, unsigned v) { return __hip_atomic_fetch_add(p, v, __ATOMIC_RELAXED, __HIP_MEMORY_SCOPE_AGENT); }
DI unsigned xb_xcc_id() { return (unsigned)__builtin_amdgcn_s_getreg((3 << 11) | 20) & 0xFu; }
#define XB_SPIN(cond, bar) do { unsigned _sp = 0; while (cond) { __builtin_amdgcn_s_sleep(1); \
    if ((++_sp & 255u) == 0u) { if (xb_ld(&(bar)[XB_TMO])) break; if (_sp > XB_SPIN_CAP) { atomicAdd(&(bar)[XB_TMO], 1u); break; } } } } while (0)
struct XcdBarrier { unsigned* bar; unsigned x; volatile LAS unsigned* st; };
DI XcdBarrier xcd_barrier_post(int tid, unsigned* bar, volatile LAS unsigned* st) {
    XcdBarrier b; b.bar = bar; b.x = xb_xcc_id(); b.st = st;
    if (tid == 0) (void)xb_add(&bar[XB_XCNT(b.x)], 1u);
    return b;
}
DI void xcd_barrier_complete(unsigned* bar, unsigned x, unsigned& nloc, unsigned& nx) {
    const unsigned G = gridDim.x * gridDim.y * gridDim.z;
    unsigned sum, cnt, mine, sp = 0u;
    for (;;) {
        sum = 0u; cnt = 0u; mine = 0u;
#pragma unroll
        for (unsigned j = 0; j < 16; ++j) { const unsigned c = xb_ld(&bar[XB_XCNT(j)]); sum += c; cnt += (c > 0u) ? 1u : 0u; mine = (j == x) ? c : mine; }
        if (sum == G) break;
        __builtin_amdgcn_s_sleep(1);
        if ((++sp & 255u) == 0u) { if (xb_ld(&bar[XB_TMO])) break; if (sp > XB_SPIN_CAP) { atomicAdd(&bar[XB_TMO], 1u); break; } }
    }
    nloc = mine > 0u ? mine : 1u; nx = cnt > 0u ? cnt : 1u;
}
DI void xcd_barrier(int tid, const XcdBarrier& b) {
    asm volatile("s_waitcnt vmcnt(0)" ::: "memory");
    __syncthreads();
    if (tid == 0) {
        unsigned* bar = b.bar;
        __builtin_amdgcn_s_waitcnt(0);
        unsigned nloc = b.st[0], nx = b.st[1];
        if (nloc == 0u) { xcd_barrier_complete(bar, b.x, nloc, nx); b.st[0] = nloc; b.st[1] = nx; }
        const unsigned old = xb_add(&bar[XB_XSUB(b.x)], 1u);
        const unsigned gen = old / nloc;
        if (old + 1u == (gen + 1u) * nloc) {
            __builtin_amdgcn_fence(__ATOMIC_RELEASE, "agent");
            asm volatile("s_waitcnt vmcnt(0)" ::: "memory");
            const unsigned og = xb_add(&bar[XB_TOP], 1u);
            const unsigned tg = og / nx;
            if (og + 1u == (tg + 1u) * nx) xb_add(&bar[XB_TOPGEN], 1u);
            else XB_SPIN(xb_ld(&bar[XB_TOPGEN]) == tg, bar);
            __builtin_amdgcn_fence(__ATOMIC_ACQUIRE, "agent");
            xb_add(&bar[XB_XGEN(b.x)], 1u);
            asm volatile("s_waitcnt vmcnt(0)" ::: "memory");
        } else {
            XB_SPIN(xb_ld(&bar[XB_XGEN(b.x)]) == gen, bar);
            __builtin_amdgcn_fence(__ATOMIC_ACQUIRE, "agent");
            asm volatile("s_waitcnt vmcnt(0)" ::: "memory");
        }
    }
    __syncthreads();
}

enum { K_PREP = 0, K_GACT, K_GRES, K_LN, K_RGCONV, K_RGSCAN0, K_RGSCAN1, K_KMEAN, K_ATTN, K_RMIX, K_RPREP, K_RSCAN, K_RPOST, K_POOL };
constexpr int NSTEPS = 38;
struct Desc {
    int kind;
    pg8::Gemm g;
    bf16_t* C; const float* res; const float* cscale; long sC; int ldc; unsigned acts;
    int lnidx, lnlast;
};
DI bool step_nosync(int st) { return st == 11 || st == 21; }
DI Desc make_desc(int st, const Params& p, unsigned char* ws) {
    unsigned char* sl = ws + O_SLOT;
    auto slot = [&](int i) { return (bf16_t*)(sl + (size_t)i * SLOT); };
    bf16_t* xb = slot(8);
    Desc d; d.kind = K_PREP; d.g = mk_gemm(nullptr, nullptr, 0, 0, 0, 0, 0, 0, 0, 0);
    d.C = nullptr; d.res = nullptr; d.cscale = nullptr; d.sC = 0; d.ldc = D; d.acts = 0u; d.lnidx = 0; d.lnlast = 0;
    int layer = -1, sub = 0;
    if (st >= 7 && st < 11) { layer = 0; sub = st - 7; }
    else if (st >= 16 && st < 20) { layer = 1; sub = st - 16; }
    else if (st >= 28 && st < 32) { layer = 2; sub = st - 28; }
    else if (st >= 34 && st < 38) { layer = 3; sub = st - 34; }
    if (layer >= 0) {
        if (sub == 0) { d.kind = K_LN; d.lnidx = layer * 2; }
        else if (sub == 1) { d.kind = K_GACT; d.C = slot(0); d.ldc = DFF; d.acts = 1u;
            d.g = mk_gemm(xb, (const bf16_t*)(ws + O_W1T + (size_t)layer * DFF * D * 2), 0, 0, D, D, D, T / 256, DFF / 256, 1); }
        else if (sub == 2) { d.kind = K_GRES;
            d.g = mk_gemm(slot(0), (const bf16_t*)(ws + O_W2T + (size_t)layer * DFF * D * 2), 0, 0, DFF, DFF, DFF, T / 256, D / 256, 1); }
        else { d.kind = K_LN; d.lnidx = layer * 2 + 1; d.lnlast = (layer == 3); }
        return d;
    }
    switch (st) {
    case 0: d.kind = K_PREP; break;
    case 1: d.kind = K_GACT; d.C = slot(0); d.ldc = 4096;
            d.g = mk_gemm(xb, (const bf16_t*)(ws + O_WIN), 0, 0, D, D, D, T / 256, 4096 / 256, 1); break;
    case 2: d.kind = K_RGCONV; break;
    case 3: d.kind = K_GACT; d.C = slot(3); d.sC = 512; d.ldc = 4096;
            d.g = mk_gemm(slot(2), (const bf16_t*)(ws + O_GATES), 256, 512 * 256, D, 256, 256, T / 256, 2, 8); break;
    case 4: d.kind = K_RGSCAN0; break;
    case 5: d.kind = K_RGSCAN1; break;
    case 6: d.kind = K_GRES; d.res = p.in[0];
            d.g = mk_gemm(slot(5), (const bf16_t*)(ws + O_RGOUT), 0, 0, D, D, D, T / 256, D / 256, 1); break;
    case 11: d.kind = K_GACT; d.C = slot(0); d.sC = (long)T * D;
             d.g = mk_gemm(xb, (const bf16_t*)(ws + O_QKV), 0, (long)D * D, D, D, D, T / 256, D / 256, 2); break;
    case 12: d.kind = K_GACT; d.C = slot(2); d.ldc = T;
             d.g = mk_gemm((const bf16_t*)(ws + O_QKV + 2 * SZ_DD), xb, 0, 0, D, D, D, D / 256, T / 256, 1); break;
    case 13: d.kind = K_KMEAN; break;
    case 14: d.kind = K_ATTN; break;
    case 15: d.kind = K_GRES;
             d.g = mk_gemm(slot(3), (const bf16_t*)(ws + O_MOUT), 0, 0, D, D, D, T / 256, D / 256, 1); break;
    case 20: d.kind = K_RMIX; break;
    case 21: d.kind = K_GACT; d.C = slot(6); d.sC = (long)T * D;
             d.g = mk_gemm(slot(0), (const bf16_t*)(ws + O_RKV), (long)T * D, (long)D * D, D, D, D, T / 256, D / 256, 3); break;
    case 22: d.kind = K_GACT; d.C = (bf16_t*)(ws + O_L1O); d.sC = (long)T * 256; d.ldc = 256; d.acts = 0x302u;
             d.g = mk_gemm(slot(3), (const bf16_t*)(ws + O_L1), (long)T * D, (long)256 * D, D, D, D, T / 256, 1, 3); break;
    case 23: d.kind = K_GACT; d.C = slot(0); d.sC = (long)T * D;
             d.g = mk_gemm((const bf16_t*)(ws + O_L1O), (const bf16_t*)(ws + O_L2), (long)T * 256, (long)D * 256, 256, 256, 256, T / 256, D / 256, 3); break;
    case 24: d.kind = K_RPREP; break;
    case 25: d.kind = K_RSCAN; break;
    case 26: d.kind = K_RPOST; break;
    case 27: d.kind = K_GRES;
             d.g = mk_gemm(slot(3), (const bf16_t*)(ws + O_ROUT), 0, 0, D, D, D, T / 256, D / 256, 1); break;
    case 32: d.kind = K_POOL; break;
    case 33: d.kind = K_GRES; d.cscale = p.in[33]; d.sC = 512;
             d.g = mk_gemm(slot(0), (const bf16_t*)(ws + O_POOL), 512, 512 * 512, D, 512, 512, T / 256, 2, 4); break;
    default: break;
    }
    return d;
}

__global__ void __launch_bounds__(512, 2) fwd_megakernel(Params p) {
    extern __shared__ __attribute__((aligned(16))) unsigned char smem[];
    cg::grid_group grid = cg::this_grid();
    LAS unsigned char* lds = (LAS unsigned char*)smem;

    const bool multi = (p.hi - p.lo) > 1;
    volatile LAS unsigned* xst = (volatile LAS unsigned*)(lds + 131072);
    if (__builtin_amdgcn_workitem_id_x() == 0) { xst[0] = 0u; xst[1] = 0u; }
    __syncthreads();
    (void)xcd_barrier_post((int)__builtin_amdgcn_workitem_id_x(), (unsigned*)(p.ws + O_BAR), xst);
    for (int st = p.lo; st < p.hi; ++st) {
        int tid_ = (int)__builtin_amdgcn_workitem_id_x(); asm volatile("" : "+v"(tid_));
        int bid_ = (int)__builtin_amdgcn_workgroup_id_x(); asm volatile("" : "+s"(bid_));
        unsigned char* ws = p.ws; asm volatile("" : "+s"(ws));
        float* xcur = p.out; asm volatile("" : "+s"(xcur));
        unsigned char* sl = ws + O_SLOT;
        auto slot = [&](int i) { return (bf16_t*)(sl + (size_t)i * SLOT); };
        const int stu = __builtin_amdgcn_readfirstlane(st);
        const Desc d = make_desc(stu, p, ws);
        switch (__builtin_amdgcn_readfirstlane(d.kind)) {
        case K_PREP: prep_phase(tid_, bid_, p, smem); break;
        case K_GACT: { pg8::EpiAct E; E.C = d.C; E.sC = d.sC; E.ldc = d.ldc; E.acts = d.acts; pg8::gemm_phase(tid_, bid_, lds, d.g, E); } break;
        case K_GRES: { pg8::EpiRes E; E.out = xcur; E.res = d.res ? d.res : xcur; E.cscale = d.cscale; E.alpha = ALPHA; E.sC = d.sC; E.ldc = D; pg8::gemm_phase(tid_, bid_, lds, d.g, E); } break;
        case K_LN: ln_phase(tid_, bid_, xcur, xcur, d.lnlast ? nullptr : slot(8), p.in[1] + (size_t)d.lnidx * D, p.in[2] + (size_t)d.lnidx * D); break;
        case K_RGCONV: rg_conv_phase(tid_, bid_, slot(0), slot(2), p.in[6], p.in[7]); break;
        case K_RGSCAN0: rg_scan_phase<0>(tid_, bid_, p, slot(3), slot(2), slot(0), (float*)(ws + O_AGG), slot(5)); break;
        case K_RGSCAN1: rg_scan_phase<1>(tid_, bid_, p, slot(3), slot(2), slot(0), (float*)(ws + O_AGG), slot(5)); break;
        case K_KMEAN: kmean_phase(tid_, bid_, slot(0), slot(1), (float*)(ws + O_KMEAN), (const float*)(ws + O_ROPE), (const float*)(ws + O_ROPE) + SEQ * 16, smem); break;
        case K_ATTN: attn_phase(tid_, bid_, slot(0), slot(1), slot(2), slot(3), (const float*)(ws + O_KMEAN), smem); break;
        case K_RMIX: rwkv_mix_phase(tid_, bid_, xcur, p.in[16], slot(0)); break;
        case K_RPREP: rwkv_prep_phase(tid_, bid_, p, sl, (float*)(ws + O_SCAL)); break;
        case K_RSCAN: rwkv_scan_phase(tid_, bid_, sl, (const float*)(ws + O_SCAL), smem); break;
        case K_RPOST: rwkv_post_phase(tid_, bid_, p, sl, (const float*)(ws + O_SCAL)); break;
        case K_POOL: pool_phase(tid_, bid_, xcur, slot(0)); break;
        default: break;
        }
        if (multi && !step_nosync(st) && st + 1 < p.hi) { if (st == p.lo) grid.sync(); else { XcdBarrier xb; xb.bar = (unsigned*)(ws + O_BAR); xb.x = xb_xcc_id(); xb.st = (volatile LAS unsigned*)(lds + 131072); xcd_barrier(tid_, xb); } }
    }
}

extern "C" void kernel_launch(void* const* d_in, const int* in_sizes, int n_in, void* d_out, int out_size, void* d_ws, size_t ws_size, hipStream_t stream) {
    static int grid = 0;
    if (grid == 0) {
        if (n_in != 34 || out_size != T * D || ws_size < WS_END) { fprintf(stderr, "kernel_launch: unexpected shapes (n_in %d out %d ws %zu need %zu)\n", n_in, out_size, ws_size, (size_t)WS_END); grid = -1; return; }
        int dev = 0, cus = 0, per_cu = 0;
        hipGetDevice(&dev);
        hipDeviceGetAttribute(&cus, hipDeviceAttributeMultiprocessorCount, dev);
        if (hipFuncSetAttribute((const void*)fwd_megakernel, hipFuncAttributeMaxDynamicSharedMemorySize, LDS_BYTES) != hipSuccess) { fprintf(stderr, "kernel_launch: hipFuncSetAttribute failed\n"); grid = -1; return; }
        hipOccupancyMaxActiveBlocksPerMultiprocessor(&per_cu, (const void*)fwd_megakernel, 512, LDS_BYTES);
        if (per_cu < 1) { fprintf(stderr, "kernel_launch: occupancy query says %d blocks/CU\n", per_cu); per_cu = 1; }
        (void)hipGetLastError();
        grid = cus;
    }
    if (grid < 0) return;
    Params p{};
    for (int i = 0; i < 34; ++i) p.in[i] = (const float*)d_in[i];
    {
        unsigned char* ws = (unsigned char*)d_ws; int nj = 0, t0 = 0;
        auto add = [&](const float* src, size_t dstoff, int Ks, int Ns, int Kd, int Nd) {
            TJob& j = p.tj[nj]; j.src = src; j.dst = (bf16_t*)(ws + dstoff); j.Ks = Ks; j.Ns = Ns; j.Kd = Kd; j.Nd = Nd; j.tile0 = t0; j.pad = 0;
            t0 += (Kd / 128) * (Nd / 128); ++nj; };
        for (int l = 0; l < 4; ++l) add(p.in[3] + (size_t)l * D * DFF, O_W1T + (size_t)l * DFF * D * 2, D, DFF, D, DFF);
        for (int l = 0; l < 4; ++l) add(p.in[4] + (size_t)l * D * DFF, O_W2T + (size_t)l * DFF * D * 2, DFF, D, DFF, D);
        add(p.in[5], O_WIN, D, 4096, D, 4096);
        for (int n = 0; n < 8; ++n) { add(p.in[8] + (size_t)n * 65536, O_GATES + (size_t)n * 512 * 256 * 2, 256, 256, 256, 256);
                                      add(p.in[10] + (size_t)n * 65536, O_GATES + ((size_t)n * 512 + 256) * 256 * 2, 256, 256, 256, 256); }
        add(p.in[13], O_RGOUT, D, D, D, D);
        add(p.in[14], O_QKV, D, 3 * D, D, 3 * D);
        add(p.in[15], O_MOUT, D, D, D, D);
        for (int g = 0; g < 3; ++g) add(p.in[17] + (size_t)g * D * D, O_RKV + g * SZ_DD, D, D, D, D);
        add(p.in[19], O_L1 + 0 * (size_t)256 * D * 2, D, 96, D, 256);
        add(p.in[22], O_L1 + 1 * (size_t)256 * D * 2, D, 96, D, 256);
        add(p.in[24], O_L1 + 2 * (size_t)256 * D * 2, D, 256, D, 256);
        add(p.in[20], O_L2 + 0 * (size_t)D * 256 * 2, 96, D, 256, D);
        add(p.in[23], O_L2 + 1 * (size_t)D * 256 * 2, 96, D, 256, D);
        add(p.in[25], O_L2 + 2 * (size_t)D * 256 * 2, 256, D, 256, D);
        add(p.in[31], O_ROUT, D, D, D, D);
        for (int g = 0; g < 4; ++g) add(p.in[32] + (size_t)g * 512 * 512, O_POOL + (size_t)g * 512 * 512 * 2, 512, 512, 512, 512);
        p.ntiles = t0;
        if (nj != NTJ) fprintf(stderr, "kernel_launch: job table size %d != %d\n", nj, NTJ);
    }
    p.out = (float*)d_out; p.ws = (unsigned char*)d_ws; p.lo = 0; p.hi = NSTEPS;
    if (hipMemsetAsync((unsigned char*)d_ws + O_BAR, 0, BAR_BYTES, stream) != hipSuccess) { fprintf(stderr, "kernel_launch: memset of barrier words failed\n"); return; }
    void* args[] = {&p};
    hipError_t e = hipLaunchCooperativeKernel((const void*)fwd_megakernel, dim3(grid), dim3(512), args, LDS_BYTES, stream);
    if (e != hipSuccess) fprintf(stderr, "cooperative launch failed: %s (grid %d)\n", hipGetErrorString(e), grid);
}
```

```cpp
#include <hip/hip_runtime.h>
#include <hip/hip_cooperative_groups.h>
#include <cstdio>
namespace cg = cooperative_groups;

#define LAS __attribute__((address_space(3)))
typedef unsigned short bf16_t;
typedef short bf16x8 __attribute__((ext_vector_type(8)));
typedef float f32x4 __attribute__((ext_vector_type(4)));
typedef float f32x2 __attribute__((ext_vector_type(2)));
typedef unsigned u32x4 __attribute__((ext_vector_type(4)));
typedef unsigned u32x2 __attribute__((ext_vector_type(2)));
typedef __bf16 bfv2 __attribute__((ext_vector_type(2)));
#define DI __device__ __forceinline__

constexpr int T = 16384, D = 2048, SEQ = 4096, DFF = 8192;
constexpr float ALPHA = 1.6817928305074290f;
constexpr float LN_EPS = 1e-5f;

constexpr size_t SZ_DD = (size_t)D * D * 2;
constexpr size_t O_W1T = 0;
constexpr size_t O_W2T = O_W1T + 4 * (size_t)DFF * D * 2;
constexpr size_t O_WIN = O_W2T + 4 * (size_t)DFF * D * 2;
constexpr size_t O_GATES = O_WIN + (size_t)4096 * D * 2;
constexpr size_t O_RGOUT = O_GATES + (size_t)8 * 512 * 256 * 2;
constexpr size_t O_QKV = O_RGOUT + SZ_DD;
constexpr size_t O_MOUT = O_QKV + 3 * SZ_DD;
constexpr size_t O_RKV = O_MOUT + SZ_DD;
constexpr size_t O_L1 = O_RKV + 3 * SZ_DD;
constexpr size_t O_L2 = O_L1 + (size_t)3 * 256 * D * 2;
constexpr size_t O_ROUT = O_L2 + (size_t)3 * D * 256 * 2;
constexpr size_t O_POOL = O_ROUT + SZ_DD;
constexpr size_t O_SLOT = O_POOL + (size_t)4 * 512 * 512 * 2;
constexpr size_t SLOT = (size_t)T * D * 2;
constexpr size_t O_L1O = O_SLOT + 9 * SLOT;
constexpr size_t O_ROPE = O_L1O + (size_t)3 * T * 256 * 2;
constexpr size_t O_KMEAN = O_ROPE + (size_t)2 * SEQ * 16 * 4;
constexpr size_t O_AGG = O_KMEAN + (size_t)64 * 16 * 128 * 4;
constexpr size_t O_SCAL = O_AGG + (size_t)4 * 128 * D * 2 * 4;
constexpr size_t O_BAR = O_SCAL + (size_t)3 * T * 32 * 4;
constexpr size_t BAR_BYTES = 16384;
constexpr size_t WS_END = O_BAR + BAR_BYTES;

constexpr int LDS_BYTES = 131072 + 16;

struct TJob { const float* src; bf16_t* dst; int Ks, Ns, Kd, Nd, tile0, pad; };
constexpr int NTJ = 42;
struct Params {
    const float* in[34];
    float* out;
    unsigned char* ws;
    int lo, hi, ntiles, pad;
    TJob tj[NTJ];
};

DI unsigned pk_bf16(float a, float b) { f32x2 v = {a, b}; bfv2 r = __builtin_convertvector(v, bfv2); return __builtin_bit_cast(unsigned, r); }
DI bf16_t f2bf(float a) { return (bf16_t)(pk_bf16(a, 0.f) & 0xffffu); }
DI float bf2f(bf16_t b) { return __uint_as_float(((unsigned)b) << 16); }
DI float bflo(unsigned u) { return __uint_as_float(u << 16); }
DI float bfhi(unsigned u) { return __uint_as_float(u & 0xffff0000u); }
DI float wave_sum(float v) {
    v += __int_as_float(__builtin_amdgcn_update_dpp(0, __float_as_int(v), 0xB1, 0xF, 0xF, false));
    v += __int_as_float(__builtin_amdgcn_update_dpp(0, __float_as_int(v), 0x4E, 0xF, 0xF, false));
    v += __int_as_float(__builtin_amdgcn_update_dpp(0, __float_as_int(v), 0x141, 0xF, 0xF, false));
    v += __int_as_float(__builtin_amdgcn_update_dpp(0, __float_as_int(v), 0x140, 0xF, 0xF, false));
    const int iv = __float_as_int(v);
    return __int_as_float(__builtin_amdgcn_readlane(iv, 0)) + __int_as_float(__builtin_amdgcn_readlane(iv, 16)) +
           __int_as_float(__builtin_amdgcn_readlane(iv, 32)) + __int_as_float(__builtin_amdgcn_readlane(iv, 48));
}
DI float xmax_fq(float v) {
    const auto a = __builtin_amdgcn_permlane32_swap(__float_as_uint(v), __float_as_uint(v), false, false);
    v = fmaxf(__uint_as_float(a[0]), __uint_as_float(a[1]));
    const auto b = __builtin_amdgcn_permlane16_swap(__float_as_uint(v), __float_as_uint(v), false, false);
    return fmaxf(__uint_as_float(b[0]), __uint_as_float(b[1]));
}
DI float xsum_fq(float v) {
    const auto a = __builtin_amdgcn_permlane32_swap(__float_as_uint(v), __float_as_uint(v), false, false);
    v = __uint_as_float(a[0]) + __uint_as_float(a[1]);
    const auto b = __builtin_amdgcn_permlane16_swap(__float_as_uint(v), __float_as_uint(v), false, false);
    return __uint_as_float(b[0]) + __uint_as_float(b[1]);
}
DI float half_sum(float v) {
    v += __int_as_float(__builtin_amdgcn_update_dpp(0, __float_as_int(v), 0xB1, 0xF, 0xF, false));
    v += __int_as_float(__builtin_amdgcn_update_dpp(0, __float_as_int(v), 0x4E, 0xF, 0xF, false));
    v += __int_as_float(__builtin_amdgcn_update_dpp(0, __float_as_int(v), 0x141, 0xF, 0xF, false));
    v += __int_as_float(__builtin_amdgcn_update_dpp(0, __float_as_int(v), 0x140, 0xF, 0xF, false));
    const auto b = __builtin_amdgcn_permlane16_swap(__float_as_uint(v), __float_as_uint(v), false, false);
    return __uint_as_float(b[0]) + __uint_as_float(b[1]);
}
DI void lds_barrier() { asm volatile("s_waitcnt lgkmcnt(0)" ::: "memory"); __builtin_amdgcn_s_barrier(); asm volatile("" ::: "memory"); }
DI float sigmoidf_(float x) { return __builtin_amdgcn_rcpf(1.f + __expf(-x)); }
DI float tanhf_(float x) { return 1.f - 2.f * __builtin_amdgcn_rcpf(1.f + __expf(2.f * x)); }
DI float gelu_tanh(float x) { const float u = 0.7978845608028654f * (x + 0.044715f * x * x * x); return 0.5f * x * (1.f + tanhf_(u)); }

namespace pg8 {
constexpr int BM = 256, BK = 64, HALF = 128, HTB = HALF * BK * 2, NXCD = 8, WGM = 4;
DI int lds_byte(int r, int c) { const int st = (r >> 4) * 2 + (c >> 5), rr = r & 15, cc = c & 31, ob = rr * 64 + cc * 2; return st * 1024 + (ob ^ (((ob >> 9) & 1) << 5)); }
DI void stage_rc(int b, int& R, int& C) { const int st = b / 1024, sb = b % 1024, swz = sb ^ (((sb >> 9) & 1) << 5); R = (st >> 1) * 16 + swz / 64; C = (st & 1) * 32 + (swz % 64) / 2; }
DI int perm32(int rho) { const int n = rho >> 4, i = rho & 15; return 8 * (i >> 2) + 4 * n + (i & 3); }

struct Unit { int g, pm, pn; };
struct Gemm { const bf16_t* A; const bf16_t* Bt; long sA, sB; int lda, ldb, K, nM, nN, G; };

struct Order {
    int nM, nN, nwg, tot, Gd, c;
    DI void init(const Gemm& g, int Gd_, int c_) { nM = g.nM; nN = g.nN; nwg = nM * nN; tot = nwg * g.G; Gd = Gd_; c = c_; }
    DI bool next(int i, Unit& u) const {
        const long L = (long)i * Gd + c; if (L >= tot) return false;
        const int grp = (int)(L / nwg); int wgid = (int)(L - (long)grp * nwg);
        { const int q = nwg / NXCD, r = nwg % NXCD, xcd = wgid % NXCD, off = wgid / NXCD; wgid = (xcd < r ? xcd * (q + 1) : r * (q + 1) + (xcd - r) * q) + off; }
        const int nig = WGM * nN, gid = wgid / nig, fm = gid * WGM, gsz = (nM - fm) < WGM ? (nM - fm) : WGM;
        u.g = grp; u.pm = fm + ((wgid % nig) % gsz); u.pn = (wgid % nig) / gsz; return true;
    }
};

struct EpiAct {
    static constexpr bool PERM = true;
    bf16_t* C; long sC; int ldc; unsigned acts;
    DI void operator()(const f32x4 (&acc)[2][2][4][2], const Unit& u, int wr, int wc, int fr, int fq) const {
        bf16_t* base = C + (size_t)u.g * sC;
        const int act = (int)((acts >> (4 * u.g)) & 15u);
        const int row0 = u.pm * BM + wr * 64 + fr, col0 = u.pn * BM + wc * 32 + 8 * fq;
#pragma unroll
        for (int ai = 0; ai < 2; ++ai)
#pragma unroll
            for (int m = 0; m < 4; ++m) {
                bf16_t* rowp = base + (size_t)(row0 + ai * HALF + m * 16) * ldc + col0;
#pragma unroll
                for (int bj = 0; bj < 2; ++bj) {
                    float v[8];
#pragma unroll
                    for (int e = 0; e < 4; ++e) { v[e] = acc[ai][bj][m][0][e]; v[4 + e] = acc[ai][bj][m][1][e]; }
                    if (act == 1) {
#pragma unroll
                        for (int e = 0; e < 8; ++e) { const float t = fmaxf(v[e], 0.f); v[e] = t * t; }
                    } else if (act == 2) {
#pragma unroll
                        for (int e = 0; e < 8; ++e) v[e] = tanhf_(v[e]);
                    } else if (act == 3) {
#pragma unroll
                        for (int e = 0; e < 8; ++e) v[e] = sigmoidf_(v[e]);
                    }
                    u32x4 o = {pk_bf16(v[0], v[1]), pk_bf16(v[2], v[3]), pk_bf16(v[4], v[5]), pk_bf16(v[6], v[7])};
                    *(u32x4*)(rowp + bj * HALF) = o;
                }
            }
    }
};
struct EpiRes {
    static constexpr bool PERM = false;
    float* out; const float* res; const float* cscale; float alpha; long sC; int ldc;
    DI void operator()(const f32x4 (&acc)[2][2][4][2], const Unit& u, int wr, int wc, int fr, int fq) const {
        const int row0 = u.pm * BM + wr * 64 + fr, col0 = (int)(u.g * sC) + u.pn * BM + wc * 32 + 4 * fq;
        f32x4 r[2][2][2][2];
        auto ldq = [&](int q, int buf) {
            const int ai = q >> 1, m0 = (q & 1) * 2;
#pragma unroll
            for (int mm = 0; mm < 2; ++mm) {
                const size_t ro = (size_t)(row0 + ai * HALF + (m0 + mm) * 16) * ldc + col0;
#pragma unroll
                for (int bj = 0; bj < 2; ++bj)
#pragma unroll
                    for (int n = 0; n < 2; ++n) r[buf][mm][bj][n] = *(const f32x4*)(res + ro + bj * HALF + n * 16);
            }
        };
        auto stq = [&](int q, int buf) {
            const int ai = q >> 1, m0 = (q & 1) * 2;
#pragma unroll
            for (int mm = 0; mm < 2; ++mm) {
                const size_t ro = (size_t)(row0 + ai * HALF + (m0 + mm) * 16) * ldc + col0;
#pragma unroll
                for (int bj = 0; bj < 2; ++bj)
#pragma unroll
                    for (int n = 0; n < 2; ++n) {
                        f32x4 a = acc[ai][bj][m0 + mm][n];
                        if (cscale) a *= *(const f32x4*)(cscale + col0 + bj * HALF + n * 16);
                        *(f32x4*)(out + ro + bj * HALF + n * 16) = alpha * r[buf][mm][bj][n] + a;
                    }
            }
        };
        ldq(0, 0); ldq(1, 1);
        __builtin_amdgcn_sched_barrier(0);
        stq(0, 0); ldq(2, 0);
        __builtin_amdgcn_sched_barrier(0);
        stq(1, 1); ldq(3, 1);
        __builtin_amdgcn_sched_barrier(0);
        stq(2, 0); stq(3, 1);
    }
};
template <class Epi>
DI void gemm_phase(int tid_, int bid_, LAS unsigned char* lds, const Gemm g, const Epi& E) {
    const int tid = tid_, wid = __builtin_amdgcn_readfirstlane(tid >> 6), lane = tid & 63, wr = wid >> 2, wc = wid & 3, fr = lane & 15, fq = lane >> 4;
    const int K = g.K, nt = K / BK;
    Order S; S.init(g, (int)gridDim.x, (int)bid_);
    unsigned voffA[2], voffB[2];
#pragma unroll
    for (int i = 0; i < 2; ++i) { int R, C; stage_rc(tid * 16 + i * 8192, R, C); const int Rb = Epi::PERM ? ((R & ~31) + perm32(R & 31)) : R;
        voffA[i] = (unsigned)(R * g.lda + C) * 2u; voffB[i] = (unsigned)(Rb * g.ldb + C) * 2u; }
    const size_t kstep = (size_t)(BK * 2);
    const size_t hA = (size_t)HALF * g.lda * 2, hB = (size_t)HALF * g.ldb * 2;
    const unsigned ldsw = (unsigned)wid * 1024u;
    const int aoff = lds_byte(wr * 64 + fr, fq * 8), boff = lds_byte(wc * 32 + fr, fq * 8);
#define PG8_SA(b, h) (((b) * 2 + (h)) * HTB)
#define PG8_SB(b, h) ((4 + (b) * 2 + (h)) * HTB)
#define PG8_STAGE(bufoff, gbase, voff) do { _Pragma("unroll") for (int _i = 0; _i < 2; ++_i) \
        __builtin_amdgcn_global_load_lds((const unsigned*)((const char*)(gbase) + (voff)[_i]), (LAS unsigned*)(lds + (bufoff) + ldsw + _i * 8192), 16, 0, 0); } while (0)
#define PG8_LDA(dst, b, h) do { _Pragma("unroll") for (int m = 0; m < 4; ++m) _Pragma("unroll") for (int k = 0; k < 2; ++k) dst[m][k] = *(const LAS bf16x8*)(lds + PG8_SA(b, h) + aoff + m * 2048 + k * 1024); } while (0)
#define PG8_LDB(dst, b, h) do { _Pragma("unroll") for (int n = 0; n < 2; ++n) _Pragma("unroll") for (int k = 0; k < 2; ++k) dst[n][k] = *(const LAS bf16x8*)(lds + PG8_SB(b, h) + boff + n * 2048 + k * 1024); } while (0)
#define PG8_MMA(ai, bj, At, Bt) do { __builtin_amdgcn_s_setprio(1); _Pragma("unroll") for (int m = 0; m < 4; ++m) _Pragma("unroll") for (int n = 0; n < 2; ++n) _Pragma("unroll") for (int k = 0; k < 2; ++k) \
        acc[ai][bj][m][n] = __builtin_amdgcn_mfma_f32_16x16x32_bf16(Bt[n][k], At[m][k], acc[ai][bj][m][n], 0, 0, 0); __builtin_amdgcn_s_setprio(0); } while (0)
#define PG8_WAIT_V(n) asm volatile("s_waitcnt vmcnt(" #n ")" ::: "memory")
#define PG8_WAIT_L(n) asm volatile("s_waitcnt lgkmcnt(" #n ")" ::: "memory")
#define PG8_BAR __builtin_amdgcn_s_barrier()
#define PG8_SCHED __builtin_amdgcn_sched_barrier(0)
    Unit cur, nxt; int ui = 0;
    if (!S.next(0, cur)) return;
    f32x4 acc[2][2][4][2];
#pragma unroll
    for (int a = 0; a < 2; ++a)
#pragma unroll
        for (int b = 0; b < 2; ++b)
#pragma unroll
            for (int m = 0; m < 4; ++m)
#pragma unroll
                for (int n = 0; n < 2; ++n) acc[a][b][m][n] = (f32x4){0.f, 0.f, 0.f, 0.f};
    bf16x8 At[4][2], B0[2][2], B1[2][2];
    const char* cA = (const char*)g.A + ((size_t)cur.g * g.sA + (size_t)cur.pm * BM * g.lda) * 2;
    const char* cB = (const char*)g.Bt + ((size_t)cur.g * g.sB + (size_t)cur.pn * BM * g.ldb) * 2;
    PG8_STAGE(PG8_SB(0, 0), cB, voffB); PG8_STAGE(PG8_SA(0, 0), cA, voffA); PG8_STAGE(PG8_SB(0, 1), cB + hB, voffB); PG8_STAGE(PG8_SA(0, 1), cA + hA, voffA);
    if (wr == 1) PG8_BAR;
    PG8_WAIT_V(4); PG8_BAR;
    PG8_STAGE(PG8_SB(1, 0), cB + kstep, voffB); PG8_STAGE(PG8_SA(1, 0), cA + kstep, voffA); PG8_STAGE(PG8_SB(1, 1), cB + hB + kstep, voffB);
    PG8_WAIT_V(6); PG8_BAR;
    for (;;) {
        const bool has_next = S.next(ui + 1, nxt);
        const char* nA = has_next ? (const char*)g.A + ((size_t)nxt.g * g.sA + (size_t)nxt.pm * BM * g.lda) * 2 : cA;
        const char* nB = has_next ? (const char*)g.Bt + ((size_t)nxt.g * g.sB + (size_t)nxt.pn * BM * g.ldb) * 2 : cB;
        for (int t = 0; t < nt; t += 2) {
            const bool last = (t == nt - 2);
            const char* a1 = cA + (size_t)(t + 1) * kstep;
            const char* a2 = last ? nA : cA + (size_t)(t + 2) * kstep; const char* b2 = last ? nB : cB + (size_t)(t + 2) * kstep;
            const char* a3 = a2 + kstep; const char* b3 = b2 + kstep;
            PG8_LDB(B0, 0, 0); PG8_SCHED; PG8_LDA(At, 0, 0); PG8_STAGE(PG8_SA(1, 1), a1 + hA, voffA);
            PG8_WAIT_L(8); PG8_BAR; PG8_WAIT_L(0); PG8_MMA(0, 0, At, B0); PG8_BAR; PG8_SCHED;
            PG8_LDB(B1, 0, 1); PG8_STAGE(PG8_SB(0, 0), b2, voffB);
            PG8_BAR; PG8_WAIT_L(0); PG8_MMA(0, 1, At, B1); PG8_BAR;
            PG8_LDA(At, 0, 1); PG8_STAGE(PG8_SA(0, 0), a2, voffA);
            PG8_BAR; PG8_WAIT_L(0); PG8_MMA(1, 0, At, B0); PG8_BAR; PG8_SCHED;
            PG8_STAGE(PG8_SB(0, 1), b2 + hB, voffB);
            PG8_WAIT_V(6); PG8_BAR; PG8_MMA(1, 1, At, B1); PG8_BAR;
            PG8_LDB(B0, 1, 0); PG8_SCHED; PG8_LDA(At, 1, 0); PG8_STAGE(PG8_SA(0, 1), a2 + hA, voffA);
            PG8_WAIT_L(8); PG8_BAR; PG8_WAIT_L(0); PG8_MMA(0, 0, At, B0); PG8_BAR; PG8_SCHED;
            PG8_LDB(B1, 1, 1); PG8_STAGE(PG8_SB(1, 0), b3, voffB);
            PG8_BAR; PG8_WAIT_L(0); PG8_MMA(0, 1, At, B1); PG8_BAR;
            PG8_LDA(At, 1, 1); PG8_STAGE(PG8_SA(1, 0), a3, voffA);
            PG8_BAR; PG8_WAIT_L(0); PG8_MMA(1, 0, At, B0); PG8_BAR; PG8_SCHED;
            PG8_STAGE(PG8_SB(1, 1), b3 + hB, voffB);
            PG8_WAIT_V(6); PG8_BAR; PG8_MMA(1, 1, At, B1); PG8_BAR;
        }
        E(acc, cur, wr, wc, fr, fq);
        if (!has_next) break;
#pragma unroll
        for (int a = 0; a < 2; ++a)
#pragma unroll
            for (int b = 0; b < 2; ++b)
#pragma unroll
                for (int m = 0; m < 4; ++m)
#pragma unroll
                    for (int n = 0; n < 2; ++n) acc[a][b][m][n] = (f32x4){0.f, 0.f, 0.f, 0.f};
        cur = nxt; cA = nA; cB = nB; ++ui;
    }
    PG8_WAIT_V(0);
    if (wr == 0) PG8_BAR;
    PG8_BAR;
#undef PG8_SA
#undef PG8_SB
#undef PG8_STAGE
#undef PG8_LDA
#undef PG8_LDB
#undef PG8_MMA
#undef PG8_WAIT_V
#undef PG8_WAIT_L
#undef PG8_BAR
#undef PG8_SCHED
}
}

DI pg8::Gemm mk_gemm(const bf16_t* A, const bf16_t* Bt, long sA, long sB, int lda, int ldb, int K, int nM, int nN, int G) {
    pg8::Gemm g; g.A = A; g.Bt = Bt; g.sA = sA; g.sB = sB; g.lda = lda; g.ldb = ldb; g.K = K; g.nM = nM; g.nN = nN; g.G = G; return g;
}

DI void prep_phase(int tid_, int bid_, const Params& p, unsigned char* smem) {
    TJob* jobs = (TJob*)smem;
    float* tile = (float*)(smem + 4096);
    const int tid = tid_;
    if (tid < NTJ) jobs[tid] = p.tj[tid];
    __syncthreads();
    const int ntiles = p.ntiles;
    for (int tix = bid_; tix < ntiles; tix += gridDim.x) {
        int j = 0;
        for (int q = 1; q < NTJ; ++q) if (jobs[q].tile0 <= tix) j = q;
        const TJob jb = jobs[j];
        const int lt = tix - jb.tile0, ntk = jb.Kd / 128, k0 = (lt % ntk) * 128, n0 = (lt / ntk) * 128;
        f32x4 v[8];
#pragma unroll
        for (int i = 0; i < 8; ++i) {
            const int idx = tid + i * 512, kk = idx >> 5, n4 = idx & 31;
            const int k = k0 + kk, n = n0 + n4 * 4;
            v[i] = (k < jb.Ks && n < jb.Ns) ? *(const f32x4*)(jb.src + (size_t)k * jb.Ns + n) : (f32x4){0.f, 0.f, 0.f, 0.f};
        }
#pragma unroll
        for (int i = 0; i < 8; ++i) {
            const int idx = tid + i * 512, kk = idx >> 5, n4 = idx & 31;
#pragma unroll
            for (int e = 0; e < 4; ++e) tile[kk * 129 + n4 * 4 + e] = v[i][e];
        }
        __syncthreads();
#pragma unroll
        for (int i = 0; i < 4; ++i) {
            const int idx = tid + i * 512, n = idx >> 4, kc = idx & 15;
            float f[8];
#pragma unroll
            for (int e = 0; e < 8; ++e) f[e] = tile[(kc * 8 + e) * 129 + n];
            u32x4 o = {pk_bf16(f[0], f[1]), pk_bf16(f[2], f[3]), pk_bf16(f[4], f[5]), pk_bf16(f[6], f[7])};
            *(u32x4*)(jb.dst + (size_t)(n0 + n) * jb.Kd + k0 + kc * 8) = o;
        }
        __syncthreads();
    }
    {
        const float* x = p.in[0]; bf16_t* xb = (bf16_t*)(p.ws + O_SLOT + 8 * SLOT);
        const size_t n8 = (size_t)T * D / 8;
        for (size_t i = (size_t)bid_ * 512 + tid; i < n8; i += (size_t)gridDim.x * 512) {
            const f32x4 a = *(const f32x4*)(x + i * 8), b = *(const f32x4*)(x + i * 8 + 4);
            u32x4 o = {pk_bf16(a[0], a[1]), pk_bf16(a[2], a[3]), pk_bf16(b[0], b[1]), pk_bf16(b[2], b[3])};
            *(u32x4*)(xb + i * 8) = o;
        }
    }
    {
        float* ct = (float*)(p.ws + O_ROPE); float* st = ct + SEQ * 16;
        for (int i = bid_ * 512 + tid; i < SEQ * 16; i += gridDim.x * 512) {
            const int pos = i >> 4, f = i & 15;
            const float inv = powf(500000.0f, -(float)(2 * f) / 32.0f);
            const float ang = (float)pos * inv;
            ct[i] = cosf(ang); st[i] = sinf(ang);
        }
    }
}

DI void ln_phase(int tid_, int bid_, const float* zin, float* xout, bf16_t* xb, const float* gam, const float* bet) {
    const int lane = tid_ & 63, wid = tid_ >> 6;
    const int rstride = gridDim.x * 8;
    constexpr int NR = 4;
    for (int row0 = bid_ * 8 + wid; row0 < T; row0 += NR * rstride) {
        f32x4 v[NR][8];
#pragma unroll
        for (int r = 0; r < NR; ++r)
#pragma unroll
            for (int i = 0; i < 8; ++i)
                v[r][i] = (row0 + r * rstride < T) ? *(const f32x4*)(zin + (size_t)(row0 + r * rstride) * D + (i * 64 + lane) * 4) : (f32x4){0.f, 0.f, 0.f, 0.f};
#pragma unroll
        for (int r = 0; r < NR; ++r) {
            const int row = row0 + r * rstride;
            if (row >= T) break;
            float s = 0.f;
#pragma unroll
            for (int i = 0; i < 8; ++i) s += v[r][i][0] + v[r][i][1] + v[r][i][2] + v[r][i][3];
            const float mean = wave_sum(s) * (1.f / D);
            float q = 0.f;
#pragma unroll
            for (int i = 0; i < 8; ++i) { v[r][i] -= mean; q += v[r][i][0] * v[r][i][0] + v[r][i][1] * v[r][i][1] + v[r][i][2] * v[r][i][2] + v[r][i][3] * v[r][i][3]; }
            const float rstd = rsqrtf(wave_sum(q) * (1.f / D) + LN_EPS);
#pragma unroll
            for (int i = 0; i < 8; ++i) {
                const int c = (i * 64 + lane) * 4;
                const f32x4 g = *(const f32x4*)(gam + c), b = *(const f32x4*)(bet + c);
                const f32x4 o = v[r][i] * rstd * g + b;
                *(f32x4*)(xout + (size_t)row * D + c) = o;
                if (xb) { u32x2 w = {pk_bf16(o[0], o[1]), pk_bf16(o[2], o[3])}; *(u32x2*)(xb + (size_t)row * D + c) = w; }
            }
        }
    }
}

DI void rg_conv_phase(int tid_, int bid_, const bf16_t* gu, bf16_t* uc, const float* cw, const float* cb) {
    const size_t n8 = (size_t)T * D / 8;
    const size_t stride = (size_t)gridDim.x * 512;
    constexpr int U = 4;
    for (size_t ib = (size_t)bid_ * 512 + tid_; ib < n8; ib += stride * U) {
        u32x4 uu[U][4];
#pragma unroll
        for (int u = 0; u < U; ++u) {
            const size_t i = ib + u * stride;
            const int t = (int)(i >> 8), c = (int)(i & 255) * 8, s = t & (SEQ - 1);
#pragma unroll
            for (int j = 0; j < 4; ++j)
                uu[u][j] = (i < n8 && s - 3 + j >= 0) ? *(const u32x4*)(gu + (size_t)(t - 3 + j) * 4096 + 2048 + c) : (u32x4){0u, 0u, 0u, 0u};
        }
#pragma unroll
        for (int u = 0; u < U; ++u) {
            const size_t i = ib + u * stride;
            if (i >= n8) break;
            const int c = (int)(i & 255) * 8;
            float a[8];
            { const f32x4 b0 = *(const f32x4*)(cb + c), b1 = *(const f32x4*)(cb + c + 4);
#pragma unroll
              for (int e = 0; e < 4; ++e) { a[e] = b0[e]; a[4 + e] = b1[e]; } }
#pragma unroll
            for (int j = 0; j < 4; ++j) {
                const u32x4 q = uu[u][j];
                const f32x4 w0 = *(const f32x4*)(cw + j * D + c), w1 = *(const f32x4*)(cw + j * D + c + 4);
                a[0] += w0[0] * bflo(q[0]); a[1] += w0[1] * bfhi(q[0]); a[2] += w0[2] * bflo(q[1]); a[3] += w0[3] * bfhi(q[1]);
                a[4] += w1[0] * bflo(q[2]); a[5] += w1[1] * bfhi(q[2]); a[6] += w1[2] * bflo(q[3]); a[7] += w1[3] * bfhi(q[3]);
            }
            u32x4 o = {pk_bf16(a[0], a[1]), pk_bf16(a[2], a[3]), pk_bf16(a[4], a[5]), pk_bf16(a[6], a[7])};
            *(u32x4*)(uc + i * 8) = o;
        }
    }
}
DI void rg_ab(float rpre, float ipre, float u, float ba, float bx, float sp8, float& a, float& b) {
    const float r = sigmoidf_(rpre + ba), ii = sigmoidf_(ipre + bx);
    const float la = -sp8 * r;
    a = __expf(la);
    const float x2 = 2.f * la;
    const float om = (x2 > -0.05f) ? -x2 * (1.f + x2 * (0.5f + x2 * (0.16666667f + x2 * 0.041666668f))) : 1.f - a * a;
    b = u * ii * __builtin_amdgcn_sqrtf(om);
}
template <int MODE>
DI void rg_scan_phase(int tid_, int bid_, const Params& p, const bf16_t* gates, const bf16_t* uc, const bf16_t* gu, float* agg, bf16_t* outg) {
    constexpr int CH = 32;
    const float* gab = p.in[9]; const float* gxb = p.in[11]; const float* lam = p.in[12];
    for (int item = bid_; item < 4 * 128 * 2; item += gridDim.x) {
        const int cg2 = item & 1, chunk = (item >> 1) & 127, b = item >> 8;
        const int ch = cg2 * 1024 + tid_ * 2;
        const int n = ch >> 8, v = ch & 255;
        const f32x2 ba = *(const f32x2*)(gab + ch), bx = *(const f32x2*)(gxb + ch), lm = *(const f32x2*)(lam + ch);
        const float sp0 = 8.f * log1pf(expf(-lm[0])), sp1 = 8.f * log1pf(expf(-lm[1]));
        float h0 = 0.f, h1 = 0.f, P0 = 1.f, P1 = 1.f;
        if (MODE == 1) {
            for (int c0 = 0; c0 < chunk; c0 += 16) {
                f32x4 gv[16];
#pragma unroll
                for (int j = 0; j < 16; ++j) gv[j] = (c0 + j < chunk) ? *(const f32x4*)(agg + (((size_t)b * 128 + c0 + j) * D + ch) * 2) : (f32x4){1.f, 0.f, 1.f, 0.f};
#pragma unroll
                for (int j = 0; j < 16; ++j) { h0 = gv[j][0] * h0 + gv[j][1]; h1 = gv[j][2] * h1 + gv[j][3]; }
            }
        }
        const size_t t0 = (size_t)b * SEQ + (size_t)chunk * CH;
        constexpr int UB = 32;
        for (int tb = 0; tb < CH; tb += UB) {
            unsigned rpv[UB], ipv[UB], uuv[UB], ggv[UB];
#pragma unroll
            for (int j = 0; j < UB; ++j) {
                const size_t t = t0 + tb + j;
                rpv[j] = *(const unsigned*)(gates + t * 4096 + n * 512 + v);
                ipv[j] = *(const unsigned*)(gates + t * 4096 + n * 512 + 256 + v);
                uuv[j] = *(const unsigned*)(uc + t * D + ch);
                if (MODE == 1) ggv[j] = *(const unsigned*)(gu + t * 4096 + ch);
            }
#pragma unroll
            for (int j = 0; j < UB; ++j) {
                const size_t t = t0 + tb + j;
                float a0, b0, a1, b1;
                rg_ab(bflo(rpv[j]), bflo(ipv[j]), bflo(uuv[j]), ba[0], bx[0], sp0, a0, b0);
                rg_ab(bfhi(rpv[j]), bfhi(ipv[j]), bfhi(uuv[j]), ba[1], bx[1], sp1, a1, b1);
                h0 = a0 * h0 + b0; h1 = a1 * h1 + b1;
                if (MODE == 0) { P0 *= a0; P1 *= a1; }
                else *(unsigned*)(outg + t * D + ch) = pk_bf16(gelu_tanh(bflo(ggv[j])) * h0, gelu_tanh(bfhi(ggv[j])) * h1);
            }
        }
        if (MODE == 0) { f32x4 o = {P0, h0, P1, h1}; *(f32x4*)(agg + (((size_t)b * 128 + chunk) * D + ch) * 2) = o; }
    }
}

DI void kmean_phase(int tid_, int bid_, bf16_t* Qx, bf16_t* Kx, float* kmean, const float* ctab, const float* stab, unsigned char* smem) {
    float* redA = (float*)smem;
    float* redB = redA + 1024;
    const int tid = tid_;
    for (int item = bid_; item < 1024; item += gridDim.x) {
        const int blk = item & 15, h = (item >> 4) & 15, b = item >> 8;
        {
            const int i = tid & 15, rg = tid >> 4;
            float s1 = 0.f, s2 = 0.f;
            bf16_t k1v[8], k2v[8], q1v[8], q2v[8]; float cv[8], sv[8];
#pragma unroll
            for (int r = 0; r < 8; ++r) {
                const int pos = blk * 256 + rg * 8 + r;
                const size_t o = ((size_t)b * SEQ + pos) * D + h * 128 + i;
                cv[r] = ctab[pos * 16 + i]; sv[r] = stab[pos * 16 + i];
                k1v[r] = Kx[o]; k2v[r] = Kx[o + 16]; q1v[r] = Qx[o]; q2v[r] = Qx[o + 16];
            }
#pragma unroll
            for (int r = 0; r < 8; ++r) {
                const int pos = blk * 256 + rg * 8 + r;
                const size_t o = ((size_t)b * SEQ + pos) * D + h * 128 + i;
                const float c = cv[r], sn = sv[r];
                const float k1 = bf2f(k1v[r]), k2 = bf2f(k2v[r]);
                const bf16_t k1r = f2bf(k1 * c - k2 * sn), k2r = f2bf(k2 * c + k1 * sn);
                Kx[o] = k1r; Kx[o + 16] = k2r; s1 += bf2f(k1r); s2 += bf2f(k2r);
                const float q1 = bf2f(q1v[r]), q2 = bf2f(q2v[r]);
                Qx[o] = f2bf(q1 * c - q2 * sn); Qx[o + 16] = f2bf(q2 * c + q1 * sn);
            }
            redA[rg * 32 + i] = s1; redA[rg * 32 + 16 + i] = s2;
        }
        {
            const int dp = tid & 63, rg = tid >> 6;
            if (dp >= 16) {
                const bf16_t* base = Kx + ((size_t)b * SEQ + blk * 256 + rg * 32) * D + h * 128 + dp * 2;
                float s0 = 0.f, s1 = 0.f;
                unsigned uv[32];
#pragma unroll
                for (int r = 0; r < 32; ++r) uv[r] = *(const unsigned*)(base + (size_t)r * D);
#pragma unroll
                for (int r = 0; r < 32; ++r) { s0 += bflo(uv[r]); s1 += bfhi(uv[r]); }
                redB[rg * 128 + dp * 2] = s0; redB[rg * 128 + dp * 2 + 1] = s1;
            }
        }
        __syncthreads();
        if (tid < 128) {
            float s = 0.f;
            if (tid < 32) { for (int r = 0; r < 32; ++r) s += redA[r * 32 + tid]; }
            else { for (int r = 0; r < 8; ++r) s += redB[r * 128 + tid]; }
            kmean[(size_t)item * 128 + tid] = s * (1.f / 256.f);
        }
        __syncthreads();
    }
}

DI void attn_phase(int tid_, int bid_, const bf16_t* Q, const bf16_t* Kx, const bf16_t* VT, bf16_t* O, const float* kmean, unsigned char* smem) {
    constexpr int KB_STRIDE = 288, VB_STRIDE = 160;
    constexpr int KBUF = 64 * KB_STRIDE, VBUF = 128 * VB_STRIDE;
    constexpr float QC = 0.08838834764831845f * 1.4426950408889634f;
    constexpr float THR_RAW = 8.0f / 0.08838834764831845f;
#define KBUFP(bi) (smem + (bi) * KBUF)
#define VBUFP(bi) (smem + 2 * KBUF + (bi) * VBUF)
    float* km = (float*)(smem + 2 * KBUF + 2 * VBUF);
    const int tid = tid_, wid = tid >> 6, lane = tid & 63, fr = lane & 15, fq = lane >> 4;
    for (int idx = bid_; idx < 1024; idx += gridDim.x) {
        const int bh = idx & 63, jj = idx >> 6, sub = jj & 3, r2 = jj >> 2;
        const int qb = (r2 == 0) ? sub : (r2 == 1) ? (7 - sub) : (r2 == 2) ? (8 + sub) : (15 - sub);
        const int b = bh >> 4, h = bh & 15;
        const size_t tok0 = (size_t)b * SEQ;
        const int qloc0 = wid * 32 + fr;
        { const f32x4 kv = *(const f32x4*)(kmean + (size_t)bh * 2048 + tid * 4); *(f32x4*)(km + tid * 4) = kv; }
        bf16x8 qf[2][4];
#pragma unroll
        for (int qt = 0; qt < 2; ++qt)
#pragma unroll
            for (int dc = 0; dc < 4; ++dc) qf[qt][dc] = *(const bf16x8*)(Q + (tok0 + qb * 256 + qloc0 + qt * 16) * D + h * 128 + dc * 32 + fq * 8);
        __syncthreads();
        const int ntile = (qb + 1) * 4;
        const int kr0 = tid >> 4, kc0 = tid & 15;
        const int vr0 = tid >> 3, vc0 = tid & 7;
        u32x4 kreg0[2], vreg0[2];
        auto gload = [&](int tt, u32x4 (&kreg)[2], u32x4 (&vreg)[2]) {
            const int key0 = tt * 64;
#pragma unroll
            for (int i = 0; i < 2; ++i) {
                kreg[i] = *(const u32x4*)(Kx + (tok0 + key0 + kr0 + i * 32) * D + h * 128 + kc0 * 8);
                vreg[i] = *(const u32x4*)(VT + (size_t)(h * 128 + vr0 + i * 64) * T + tok0 + key0 + vc0 * 8);
            }
        };
        auto lstore = [&](int bi, const u32x4 (&kreg)[2], const u32x4 (&vreg)[2]) {
#pragma unroll
            for (int i = 0; i < 2; ++i) {
                *(u32x4*)(KBUFP(bi) + (kr0 + i * 32) * KB_STRIDE + kc0 * 16) = kreg[i];
                {
                    unsigned char* vrow = VBUFP(bi) + (vr0 + i * 64) * VB_STRIDE + (vc0 >> 2) * 64;
                    const int c = vc0 & 3, p0 = ((c & 1) * 2) * 16 + (c >> 1) * 8;
                    u32x2 lo = {vreg[i][0], vreg[i][1]}, hi = {vreg[i][2], vreg[i][3]};
                    *(u32x2*)(vrow + p0) = lo; *(u32x2*)(vrow + p0 + 16) = hi;
                }
            }
        };
        gload(0, kreg0, vreg0);
        unsigned mask[2];
#pragma unroll
        for (int qt = 0; qt < 2; ++qt) {
            float v0 = -3e38f, v1 = -3e38f, v2 = -3e38f; int i0 = -1, i1 = -1, i2 = -1;
            for (int j = 0; j < qb; ++j) {
                float g = 0.f;
#pragma unroll
                for (int dc = 0; dc < 4; ++dc) {
                    const f32x4 ka = *(const f32x4*)(km + j * 128 + dc * 32 + fq * 8), kb2 = *(const f32x4*)(km + j * 128 + dc * 32 + fq * 8 + 4);
#pragma unroll
                    for (int e = 0; e < 4; ++e) { g += bf2f((bf16_t)qf[qt][dc][e]) * ka[e]; g += bf2f((bf16_t)qf[qt][dc][4 + e]) * kb2[e]; }
                }
                g = xsum_fq(g);
                if (g > v0) { v2 = v1; i2 = i1; v1 = v0; i1 = i0; v0 = g; i0 = j; }
                else if (g > v1) { v2 = v1; i2 = i1; v1 = g; i1 = j; }
                else if (g > v2) { v2 = g; i2 = j; }
            }
            unsigned mk = 0u;
            if (i0 >= 0) mk |= 1u << i0;
            if (i1 >= 0) mk |= 1u << i1;
            if (i2 >= 0) mk |= 1u << i2;
            mask[qt] = mk;
        }
        float mrun[2] = {-1e30f, -1e30f}, lrun[2] = {0.f, 0.f};
        f32x4 oacc[2][8];
#pragma unroll
        for (int qt = 0; qt < 2; ++qt)
#pragma unroll
            for (int dt = 0; dt < 8; ++dt) oacc[qt][dt] = (f32x4){0.f, 0.f, 0.f, 0.f};
        auto compute = [&](int tt, int bi) {
            const int kb = tt >> 2, kt64 = tt & 3;
            const bool own = (kb == qb);
            bool actq[2];
#pragma unroll
            for (int qt = 0; qt < 2; ++qt) actq[qt] = own ? true : (((mask[qt] >> kb) & 1u) != 0u);
            const bool doit = own ? (kt64 * 64 <= wid * 32 + 31) : (__any((int)(actq[0] || actq[1])) != 0);
            const bool elem = own && (kt64 * 64 + 63 > wid * 32);
            if (doit) {
                f32x4 sacc[2][4];
#pragma unroll
                for (int qt = 0; qt < 2; ++qt)
#pragma unroll
                    for (int kt = 0; kt < 4; ++kt) sacc[qt][kt] = (f32x4){0.f, 0.f, 0.f, 0.f};
#pragma unroll
                for (int dc = 0; dc < 4; ++dc)
#pragma unroll
                    for (int kt = 0; kt < 4; ++kt) {
                        const bf16x8 kf = *(const bf16x8*)(KBUFP(bi) + (kt * 16 + fr) * KB_STRIDE + dc * 64 + fq * 16);
#pragma unroll
                        for (int qt = 0; qt < 2; ++qt) sacc[qt][kt] = __builtin_amdgcn_mfma_f32_16x16x32_bf16(kf, qf[qt][dc], sacc[qt][kt], 0, 0, 0);
                    }
                bf16x8 pf[2][2];
#pragma unroll
                for (int qt = 0; qt < 2; ++qt) {
                    const int lim = own ? (qloc0 + qt * 16 - kt64 * 64 - fq * 4) : (actq[qt] ? 1000 : -1000);
                    float mx = -1e30f;
                    if (elem) {
#pragma unroll
                        for (int kt = 0; kt < 4; ++kt)
#pragma unroll
                            for (int r = 0; r < 4; ++r) {
                                const float sv = (kt * 16 + r <= lim) ? sacc[qt][kt][r] : -__builtin_inff();
                                sacc[qt][kt][r] = sv; mx = fmaxf(mx, sv);
                            }
                    } else {
#pragma unroll
                        for (int kt = 0; kt < 4; ++kt)
#pragma unroll
                            for (int r = 0; r < 4; ++r) mx = fmaxf(mx, sacc[qt][kt][r]);
                        mx = actq[qt] ? mx : -__builtin_inff();
                    }
                    mx = xmax_fq(mx);
                    if (__any((int)(mx > mrun[qt] + THR_RAW))) {
                        const float mnew = fmaxf(mrun[qt], mx);
                        const float alpha = __builtin_amdgcn_exp2f((mrun[qt] - mnew) * QC);
                        mrun[qt] = mnew;
                        lrun[qt] *= alpha;
#pragma unroll
                        for (int dt = 0; dt < 8; ++dt) oacc[qt][dt] *= alpha;
                    }
                    const float mneg = (elem || actq[qt]) ? -mrun[qt] * QC : -__builtin_inff();
                    float ps = 0.f;
#pragma unroll
                    for (int kt = 0; kt < 4; ++kt)
#pragma unroll
                        for (int r = 0; r < 4; ++r) { const float pe = __builtin_amdgcn_exp2f(__builtin_fmaf(sacc[qt][kt][r], QC, mneg)); sacc[qt][kt][r] = pe; ps += pe; }
                    lrun[qt] += ps;
#pragma unroll
                    for (int ks = 0; ks < 2; ++ks) {
                        u32x4 w = {pk_bf16(sacc[qt][2 * ks][0], sacc[qt][2 * ks][1]), pk_bf16(sacc[qt][2 * ks][2], sacc[qt][2 * ks][3]),
                                   pk_bf16(sacc[qt][2 * ks + 1][0], sacc[qt][2 * ks + 1][1]), pk_bf16(sacc[qt][2 * ks + 1][2], sacc[qt][2 * ks + 1][3])};
                        pf[qt][ks] = __builtin_bit_cast(bf16x8, w);
                    }
                }
#pragma unroll
                for (int ks = 0; ks < 2; ++ks)
#pragma unroll
                    for (int dt = 0; dt < 8; ++dt) {
                        const bf16x8 vf = *(const bf16x8*)(VBUFP(bi) + (dt * 16 + fr) * VB_STRIDE + ks * 64 + fq * 16);
#pragma unroll
                        for (int qt = 0; qt < 2; ++qt) oacc[qt][dt] = __builtin_amdgcn_mfma_f32_16x16x32_bf16(vf, pf[qt][ks], oacc[qt][dt], 0, 0, 0);
                    }
            }
        };
        lstore(0, kreg0, vreg0);
        __syncthreads();
        for (int tt = 0; tt < ntile; tt += 2) {
            if (tt + 1 < ntile) gload(tt + 1, kreg0, vreg0);
            compute(tt, 0);
            if (tt + 1 < ntile) lstore(1, kreg0, vreg0);
            lds_barrier();
            if (tt + 1 < ntile) {
                if (tt + 2 < ntile) gload(tt + 2, kreg0, vreg0);
                compute(tt + 1, 1);
                if (tt + 2 < ntile) lstore(0, kreg0, vreg0);
                lds_barrier();
            }
        }
        __syncthreads();
#pragma unroll
        for (int qt = 0; qt < 2; ++qt) {
            const float lt = xsum_fq(lrun[qt]);
            const float inv = 1.f / lt;
            bf16_t* orow = O + (tok0 + qb * 256 + qloc0 + qt * 16) * D + h * 128 + fq * 4;
#pragma unroll
            for (int dt = 0; dt < 8; ++dt) {
                const f32x4 o = oacc[qt][dt] * inv;
                u32x2 w = {pk_bf16(o[0], o[1]), pk_bf16(o[2], o[3])};
                *(u32x2*)(orow + dt * 16) = w;
            }
        }
    }
#undef KBUFP
#undef VBUFP
}

DI void rwkv_mix_phase(int tid_, int bid_, const float* x, const float* mu, bf16_t* slots) {
    const size_t n4 = (size_t)T * D / 4;
    const size_t stride = (size_t)gridDim.x * 512;
    constexpr int U = 8;
    for (size_t ib = (size_t)bid_ * 512 + tid_; ib < n4; ib += stride * U) {
        f32x4 xv[U], xp[U];
#pragma unroll
        for (int u = 0; u < U; ++u) {
            const size_t i = ib + u * stride;
            const int t = (int)(i >> 9), s_ = t & (SEQ - 1);
            xv[u] = (i < n4) ? *(const f32x4*)(x + i * 4) : (f32x4){0.f, 0.f, 0.f, 0.f};
            xp[u] = (i < n4 && s_ > 0) ? *(const f32x4*)(x + i * 4 - D) : (f32x4){0.f, 0.f, 0.f, 0.f};
        }
#pragma unroll
        for (int u = 0; u < U; ++u) {
            const size_t i = ib + u * stride;
            if (i >= n4) break;
            const int c = (int)(i & 511) * 4;
            const f32x4 xx = xp[u] - xv[u];
#pragma unroll
            for (int k = 0; k < 6; ++k) {
                const f32x4 m = *(const f32x4*)(mu + k * D + c);
                const f32x4 o = xv[u] + xx * m;
                u32x2 w = {pk_bf16(o[0], o[1]), pk_bf16(o[2], o[3])};
                *(u32x2*)((unsigned char*)slots + k * SLOT + i * 8) = w;
            }
        }
    }
}
DI float softplusf_(float y) { return fmaxf(y, 0.f) + __logf(1.f + __expf(-fabsf(y))); }
DI void rwkv_prep_phase(int tid_, int bid_, const Params& p, unsigned char* sl, float* scal) {
    bf16_t* R = (bf16_t*)(sl + 6 * SLOT); bf16_t* Kk = (bf16_t*)(sl + 7 * SLOT);
    const bf16_t* WP = (const bf16_t*)(sl + 0 * SLOT); bf16_t* AP = (bf16_t*)(sl + 1 * SLOT);
    bf16_t* KX = (bf16_t*)(sl + 3 * SLOT); float* WD = (float*)(sl + 4 * SLOT);
    const float* w0 = p.in[18]; const float* a0 = p.in[21]; const float* k_k = p.in[26]; const float* k_a = p.in[27]; const float* r_k = p.in[28];
    float* BR = scal; float* KR = scal + (size_t)T * 32; float* BO = scal + (size_t)2 * T * 32;
    const int lane = tid_ & 63, wid = tid_ >> 6, hh = lane >> 5, k2 = (lane & 31) * 2;
    constexpr int U = 8;
    for (int grp = bid_ * 8 + wid; grp < T * 2; grp += gridDim.x * 8) {
        const size_t t = (size_t)(grp >> 1); const int hp0 = (grp & 1) * 8;
        const size_t o0 = t * D + (size_t)(hp0 * 2 + hh) * 64 + k2;
        unsigned rr[U], kr_[U], wpr[U], apr[U];
#pragma unroll
        for (int u = 0; u < U; ++u) { rr[u] = *(const unsigned*)(R + o0 + u * 128); kr_[u] = *(const unsigned*)(Kk + o0 + u * 128); wpr[u] = *(const unsigned*)(WP + o0 + u * 128); apr[u] = *(const unsigned*)(AP + o0 + u * 128); }
#pragma unroll
        for (int u = 0; u < U; ++u) {
            const int h = (hp0 + u) * 2 + hh, c = h * 64 + k2; const size_t o = o0 + u * 128;
            const f32x2 w0v = *(const f32x2*)(w0 + c), a0v = *(const f32x2*)(a0 + c), kkv = *(const f32x2*)(k_k + c), kav = *(const f32x2*)(k_a + c), rkv = *(const f32x2*)(r_k + c);
            float r[2] = {bflo(rr[u]), bfhi(rr[u])}, k[2] = {bflo(kr_[u]), bfhi(kr_[u])}, wp[2] = {bflo(wpr[u]), bfhi(wpr[u])}, ap[2] = {bflo(apr[u]), bfhi(apr[u])};
            float dec[2], a[2], kk[2], kx[2];
#pragma unroll
            for (int e = 0; e < 2; ++e) {
                const float wlog = -softplusf_(-(w0v[e] + wp[e])) - 0.5f;
                dec[e] = __expf(-__expf(wlog));
                a[e] = __builtin_amdgcn_rcpf(1.f + __expf(-(a0v[e] + ap[e])));
                kk[e] = k[e] * kkv[e];
                kx[e] = k[e] * (1.f + (a[e] - 1.f) * kav[e]);
            }
            const float rn = fminf(__builtin_amdgcn_rsqf(half_sum(kk[0] * kk[0] + kk[1] * kk[1])), 1e12f);
            kk[0] *= rn; kk[1] *= rn;
            const float bb0 = kk[0] * a[0], bb1 = kk[1] * a[1];
            const float br = half_sum(bb0 * r[0] + bb1 * r[1]), kr = half_sum(kx[0] * r[0] + kx[1] * r[1]), bo = half_sum(r[0] * kx[0] * rkv[0] + r[1] * kx[1] * rkv[1]);
            *(unsigned*)(R + o) = pk_bf16(dec[0] * r[0], dec[1] * r[1]); *(unsigned*)(Kk + o) = pk_bf16(-kk[0], -kk[1]);
            *(unsigned*)(AP + o) = pk_bf16(bb0, bb1); *(unsigned*)(KX + o) = pk_bf16(kx[0], kx[1]);
            { f32x2 dv = {dec[0], dec[1]}; *(f32x2*)(WD + o) = dv; }
            if ((lane & 31) == 0) { const size_t it = t * 32 + h; BR[it] = br; KR[it] = kr; BO[it] = bo; }
        }
    }
}
DI float dpp_sum8(float v) {
    v += __int_as_float(__builtin_amdgcn_update_dpp(0, __float_as_int(v), 0xB1, 0xF, 0xF, false));
    v += __int_as_float(__builtin_amdgcn_update_dpp(0, __float_as_int(v), 0x4E, 0xF, 0xF, false));
    v += __int_as_float(__builtin_amdgcn_update_dpp(0, __float_as_int(v), 0x141, 0xF, 0xF, false));
    return v;
}
DI void rwkv_scan_phase(int tid_, int bid_, unsigned char* sl, const float* scal, unsigned char* smem) {
    constexpr int TC = 32;
    constexpr int OFF_BB = TC * 128, OFF_KX = OFF_BB + TC * 64, OFF_W = OFF_KX + TC * 64, OFF_V = OFF_W + TC * 64, OFF_SC = OFF_V + TC * 32, BUF_F = OFF_SC + TC * 2;
    constexpr int NCH = SEQ / TC;
#define SBUF(i) ((float*)smem + (i) * BUF_F)
    const bf16_t* NKK = (const bf16_t*)(sl + 7 * SLOT); const bf16_t* WR = (const bf16_t*)(sl + 6 * SLOT);
    const bf16_t* BB = (const bf16_t*)(sl + 1 * SLOT); const bf16_t* KX = (const bf16_t*)(sl + 3 * SLOT);
    const float* WD = (const float*)(sl + 4 * SLOT); const bf16_t* V = (const bf16_t*)(sl + 8 * SLOT);
    bf16_t* Y = (bf16_t*)(sl + 0 * SLOT);
    const float* BR = scal; const float* KR = scal + (size_t)T * 32;
    const int tid = tid_, wid = tid >> 6, lane = tid & 63;
    for (int item = bid_; item < 256; item += gridDim.x) {
        const int half = item & 1, h = (item >> 1) & 31, b = item >> 6;
        const size_t tok0 = (size_t)b * SEQ;
        if (wid >= 4) {
            const int lt = tid - 256, lt_t = lt >> 3, lt_c = lt & 7;
            u32x4 r_nk, r_wr, r_bb, r_kx, r_v = {0u, 0u, 0u, 0u}; f32x4 r_w0, r_w1; float r_s = 0.f;
            auto gload = [&](int c) {
                const size_t tb = tok0 + (size_t)c * TC;
                const size_t o = (tb + lt_t) * D + h * 64 + lt_c * 8;
                r_nk = *(const u32x4*)(NKK + o); r_wr = *(const u32x4*)(WR + o); r_bb = *(const u32x4*)(BB + o); r_kx = *(const u32x4*)(KX + o);
                r_w0 = *(const f32x4*)(WD + (tb + (lt >> 4)) * D + h * 64 + (lt & 15) * 4);
                r_w1 = *(const f32x4*)(WD + (tb + 16 + (lt >> 4)) * D + h * 64 + (lt & 15) * 4);
                if (lt < 128) r_v = *(const u32x4*)(V + (tb + (lt >> 2)) * D + h * 64 + half * 32 + (lt & 3) * 8);
                else if (lt < 192) { const int i = lt - 128; r_s = ((i & 1) ? KR : BR)[(tb + (i >> 1)) * 32 + h]; }
            };
            auto lstore = [&](float* F) {
                float* pp = F + lt_t * 128 + lt_c * 16;
#pragma unroll
                for (int j = 0; j < 4; ++j) { f32x4 q = {bflo(r_nk[j]), bflo(r_wr[j]), bfhi(r_nk[j]), bfhi(r_wr[j])}; *(f32x4*)(pp + j * 4) = q; }
                { float* d = F + OFF_BB + lt_t * 64 + lt_c * 8;
                  f32x4 lo = {bflo(r_bb[0]), bfhi(r_bb[0]), bflo(r_bb[1]), bfhi(r_bb[1])}, hi = {bflo(r_bb[2]), bfhi(r_bb[2]), bflo(r_bb[3]), bfhi(r_bb[3])};
                  *(f32x4*)d = lo; *(f32x4*)(d + 4) = hi; }
                { float* d = F + OFF_KX + lt_t * 64 + lt_c * 8;
                  f32x4 lo = {bflo(r_kx[0]), bfhi(r_kx[0]), bflo(r_kx[1]), bfhi(r_kx[1])}, hi = {bflo(r_kx[2]), bfhi(r_kx[2]), bflo(r_kx[3]), bfhi(r_kx[3])};
                  *(f32x4*)d = lo; *(f32x4*)(d + 4) = hi; }
                *(f32x4*)(F + OFF_W + (lt >> 4) * 64 + (lt & 15) * 4) = r_w0;
                *(f32x4*)(F + OFF_W + (16 + (lt >> 4)) * 64 + (lt & 15) * 4) = r_w1;
                if (lt < 128) { float* d = F + OFF_V + (lt >> 2) * 32 + (lt & 3) * 8;
                  f32x4 lo = {bflo(r_v[0]), bfhi(r_v[0]), bflo(r_v[1]), bfhi(r_v[1])}, hi = {bflo(r_v[2]), bfhi(r_v[2]), bflo(r_v[3]), bfhi(r_v[3])};
                  *(f32x4*)d = lo; *(f32x4*)(d + 4) = hi; }
                else if (lt < 192) F[OFF_SC + (lt - 128)] = r_s;
            };
            gload(0); lstore(SBUF(0)); gload(1);
            __syncthreads();
            for (int c = 0; c < NCH; ++c) {
                if (c + 1 < NCH) lstore(SBUF((c + 1) & 1));
                if (c + 2 < NCH) gload(c + 2);
                lds_barrier();
            }
        } else {
            const int kq = lane & 7, rl = wid * 8 + (lane >> 3);
            f32x2 st[4];
#pragma unroll
            for (int j = 0; j < 4; ++j) st[j] = (f32x2){0.f, 0.f};
            bf16_t* yp = Y + (tok0 + kq) * D + h * 64 + half * 32 + rl;
            __syncthreads();
            struct Ops { f32x4 pq[4], b0, b1, k0, k1, w0, w1; float vv; f32x2 sc; };
            for (int c = 0; c < NCH; ++c) {
                const float* F = SBUF(c & 1);
                const float* fp = F + kq * 16;
                const float* fb = F + OFF_BB + kq * 8;
                auto ld = [&](Ops& o, int t) {
#pragma unroll
                    for (int j = 0; j < 4; ++j) o.pq[j] = *(const f32x4*)(fp + t * 128 + j * 4);
                    o.b0 = *(const f32x4*)(fb + t * 64); o.b1 = *(const f32x4*)(fb + t * 64 + 4);
                    o.k0 = *(const f32x4*)(fb + (OFF_KX - OFF_BB) + t * 64); o.k1 = *(const f32x4*)(fb + (OFF_KX - OFF_BB) + t * 64 + 4);
                    o.w0 = *(const f32x4*)(fb + (OFF_W - OFF_BB) + t * 64); o.w1 = *(const f32x4*)(fb + (OFF_W - OFF_BB) + t * 64 + 4);
                    o.vv = F[OFF_V + t * 32 + rl]; o.sc = *(const f32x2*)(F + OFF_SC + t * 2);
                };
                auto dots = [&](const Ops& o) -> f32x2 {
                    f32x2 acc = {0.f, 0.f}, acc2 = {0.f, 0.f};
#pragma unroll
                    for (int j = 0; j < 4; ++j) {
                        acc += st[j][0] * (f32x2){o.pq[j][0], o.pq[j][1]};
                        acc2 += st[j][1] * (f32x2){o.pq[j][2], o.pq[j][3]};
                    }
                    return acc + acc2;
                };
                auto update = [&](const Ops& o, f32x2 acc) -> float {
                    const float d1 = dpp_sum8(acc[0]), d2 = dpp_sum8(acc[1]);
                    st[0] = st[0] * (f32x2){o.w0[0], o.w0[1]} + d1 * (f32x2){o.b0[0], o.b0[1]} + o.vv * (f32x2){o.k0[0], o.k0[1]};
                    st[1] = st[1] * (f32x2){o.w0[2], o.w0[3]} + d1 * (f32x2){o.b0[2], o.b0[3]} + o.vv * (f32x2){o.k0[2], o.k0[3]};
                    st[2] = st[2] * (f32x2){o.w1[0], o.w1[1]} + d1 * (f32x2){o.b1[0], o.b1[1]} + o.vv * (f32x2){o.k1[0], o.k1[1]};
                    st[3] = st[3] * (f32x2){o.w1[2], o.w1[3]} + d1 * (f32x2){o.b1[2], o.b1[3]} + o.vv * (f32x2){o.k1[2], o.k1[3]};
                    return d2 + d1 * o.sc[0] + o.vv * o.sc[1];
                };
                Ops os[3];
                ld(os[0], 0); ld(os[1], 1);
                float yv = 0.f;
#pragma unroll
                for (int t = 0; t < TC; ++t) {
                    const f32x2 da = dots(os[t % 3]);
                    __builtin_amdgcn_sched_barrier(0);
                    if (t + 2 < TC) ld(os[(t + 2) % 3], t + 2);
                    __builtin_amdgcn_sched_barrier(0);
                    const float ya = update(os[t % 3], da);
                    yv = (kq == (t & 7)) ? ya : yv;
                    if ((t & 7) == 7) yp[(size_t)(c * TC + (t & ~7)) * D] = f2bf(yv);
                }
                lds_barrier();
            }
        }
        __syncthreads();
    }
#undef SBUF
}
DI void rwkv_post_phase(int tid_, int bid_, const Params& p, unsigned char* sl, const float* scal) {
    const bf16_t* Y = (const bf16_t*)(sl + 0 * SLOT); const bf16_t* V = (const bf16_t*)(sl + 8 * SLOT); const bf16_t* G = (const bf16_t*)(sl + 2 * SLOT);
    bf16_t* OUT = (bf16_t*)(sl + 3 * SLOT);
    const float* lg = p.in[29]; const float* lb = p.in[30]; const float* BO = scal + (size_t)2 * T * 32;
    const int lane = tid_ & 63, wid = tid_ >> 6, hh = lane >> 5, k2 = (lane & 31) * 2;
    constexpr int U = 8;
    for (int grp = bid_ * 8 + wid; grp < T * 2; grp += gridDim.x * 8) {
        const size_t t = (size_t)(grp >> 1); const int hp0 = (grp & 1) * 8;
        const size_t o0 = t * D + (size_t)(hp0 * 2 + hh) * 64 + k2;
        unsigned yr[U], vr[U], gr[U]; float bor[U];
#pragma unroll
        for (int u = 0; u < U; ++u) { yr[u] = *(const unsigned*)(Y + o0 + u * 128); vr[u] = *(const unsigned*)(V + o0 + u * 128); gr[u] = *(const unsigned*)(G + o0 + u * 128); bor[u] = BO[t * 32 + (hp0 + u) * 2 + hh]; }
#pragma unroll
        for (int u = 0; u < U; ++u) {
            const int c = ((hp0 + u) * 2 + hh) * 64 + k2;
            const f32x2 lgv = *(const f32x2*)(lg + c), lbv = *(const f32x2*)(lb + c);
            const float y0 = bflo(yr[u]), y1 = bfhi(yr[u]);
            const float mean = half_sum(y0 + y1) * (1.f / 64.f);
            const float d0 = y0 - mean, d1 = y1 - mean;
            const float rs = rsqrtf(half_sum(d0 * d0 + d1 * d1) * (1.f / 64.f) + 64e-5f);
            const float r0 = d0 * rs * lgv[0] + lbv[0] + bor[u] * bflo(vr[u]);
            const float r1 = d1 * rs * lgv[1] + lbv[1] + bor[u] * bfhi(vr[u]);
            *(unsigned*)(OUT + o0 + u * 128) = pk_bf16(r0 * bflo(gr[u]), r1 * bfhi(gr[u]));
        }
    }
}

DI void pool_phase(int tid_, int bid_, const float* x, bf16_t* outp) {
    constexpr int CH = 32;
    const int tid = tid_, c = tid * 4, w = 2 << (c >> 9);
    for (int item = bid_; item < T / CH; item += gridDim.x) {
        const int t0 = item * CH, s0 = t0 & (SEQ - 1);
        f32x4 sum = {0.f, 0.f, 0.f, 0.f};
#pragma unroll
        for (int j = 1; j <= 16; ++j) if (j <= w && s0 - j >= 0) sum += *(const f32x4*)(x + (size_t)(t0 - j) * D + c);
#pragma unroll 16
        for (int tt = 0; tt < CH; ++tt) {
            const int t = t0 + tt, s = s0 + tt;
            const f32x4 xv = *(const f32x4*)(x + (size_t)t * D + c);
            sum += xv;
            if (s - w >= 0) sum -= *(const f32x4*)(x + (size_t)(t - w) * D + c);
            const float rc = __builtin_amdgcn_rcpf((float)((s + 1 < w) ? (s + 1) : w));
            const f32x4 o = sum * rc - xv;
            u32x2 wv = {pk_bf16(o[0], o[1]), pk_bf16(o[2], o[3])};
            *(u32x2*)(outp + (size_t)t * D + c) = wv;
        }
    }
}

#define XB_TMO      128
#define XB_XCNT(j)  (256  + 64 * (j))
#define XB_XSUB(j)  (1280 + 64 * (j))
#define XB_XGEN(j)  (2304 + 64 * (j))
#define XB_TOP      3328
#define XB_TOPGEN   3392
#define XCD_BAR_WORDS 3456
#define XB_SPIN_CAP (1u << 18)
DI unsigned xb_ld(unsigned* p) { return __hip_atomic_load(p, __ATOMIC_RELAXED, __HIP_MEMORY_SCOPE_AGENT); }
DI unsigned xb_add(unsigned* p, unsigned v) { return __hip_atomic_fetch_add(p, v, __ATOMIC_RELAXED, __HIP_MEMORY_SCOPE_AGENT); }
DI unsigned xb_xcc_id() { return (unsigned)__builtin_amdgcn_s_getreg((3 << 11) | 20) & 0xFu; }
#define XB_SPIN(cond, bar) do { unsigned _sp = 0; while (cond) { __builtin_amdgcn_s_sleep(1); \
    if ((++_sp & 255u) == 0u) { if (xb_ld(&(bar)[XB_TMO])) break; if (_sp > XB_SPIN_CAP) { atomicAdd(&(bar)[XB_TMO], 1u); break; } } } } while (0)
struct XcdBarrier { unsigned* bar; unsigned x; volatile LAS unsigned* st; };
DI XcdBarrier xcd_barrier_post(int tid, unsigned* bar, volatile LAS unsigned* st) {
    XcdBarrier b; b.bar = bar; b.x = xb_xcc_id(); b.st = st;
    if (tid == 0) (void)xb_add(&bar[XB_XCNT(b.x)], 1u);
    return b;
}
DI void xcd_barrier_complete(unsigned* bar, unsigned x, unsigned& nloc, unsigned& nx) {
    const unsigned G = gridDim.x * gridDim.y * gridDim.z;
    unsigned sum, cnt, mine, sp = 0u;
    for (;;) {
        sum = 0u; cnt = 0u; mine = 0u;
#pragma unroll
        for (unsigned j = 0; j < 16; ++j) { const unsigned c = xb_ld(&bar[XB_XCNT(j)]); sum += c; cnt += (c > 0u) ? 1u : 0u; mine = (j == x) ? c : mine; }
        if (sum == G) break;
        __builtin_amdgcn_s_sleep(1);
        if ((++sp & 255u) == 0u) { if (xb_ld(&bar[XB_TMO])) break; if (sp > XB_SPIN_CAP) { atomicAdd(&bar[XB_TMO], 1u); break; } }
    }
    nloc = mine > 0u ? mine : 1u; nx = cnt > 0u ? cnt : 1u;
}
DI void xcd_barrier(int tid, const XcdBarrier& b) {
    asm volatile("s_waitcnt vmcnt(0)" ::: "memory");
    __syncthreads();
    if (tid == 0) {
        unsigned* bar = b.bar;
        __builtin_amdgcn_s_waitcnt(0);
        unsigned nloc = b.st[0], nx = b.st[1];
        if (nloc == 0u) { xcd_barrier_complete(bar, b.x, nloc, nx); b.st[0] = nloc; b.st[1] = nx; }
        const unsigned old = xb_add(&bar[XB_XSUB(b.x)], 1u);
        const unsigned gen = old / nloc;
        if (old + 1u == (gen + 1u) * nloc) {
            __builtin_amdgcn_fence(__ATOMIC_RELEASE, "agent");
            asm volatile("s_waitcnt vmcnt(0)" ::: "memory");
            const unsigned og = xb_add(&bar[XB_TOP], 1u);
            const unsigned tg = og / nx;
            if (og + 1u == (tg + 1u) * nx) xb_add(&bar[XB_TOPGEN], 1u);
            else XB_SPIN(xb_ld(&bar[XB_TOPGEN]) == tg, bar);
            __builtin_amdgcn_fence(__ATOMIC_ACQUIRE, "agent");
            xb_add(&bar[XB_XGEN(b.x)], 1u);
            asm volatile("s_waitcnt vmcnt(0)" ::: "memory");
        } else {
            XB_SPIN(xb_ld(&bar[XB_XGEN(b.x)]) == gen, bar);
            __builtin_amdgcn_fence(__ATOMIC_ACQUIRE, "agent");
            asm volatile("s_waitcnt vmcnt(0)" ::: "memory");
        }
    }
    __syncthreads();
}

enum { K_PREP = 0, K_GACT, K_GRES, K_LN, K_RGCONV, K_RGSCAN0, K_RGSCAN1, K_KMEAN, K_ATTN, K_RMIX, K_RPREP, K_RSCAN, K_RPOST, K_POOL };
constexpr int NSTEPS = 38;
struct Desc {
    int kind;
    pg8::Gemm g;
    bf16_t* C; const float* res; const float* cscale; long sC; int ldc; unsigned acts;
    int lnidx, lnlast;
};
DI bool step_nosync(int st) { return st == 11 || st == 21; }
DI Desc make_desc(int st, const Params& p, unsigned char* ws) {
    unsigned char* sl = ws + O_SLOT;
    auto slot = [&](int i) { return (bf16_t*)(sl + (size_t)i * SLOT); };
    bf16_t* xb = slot(8);
    Desc d; d.kind = K_PREP; d.g = mk_gemm(nullptr, nullptr, 0, 0, 0, 0, 0, 0, 0, 0);
    d.C = nullptr; d.res = nullptr; d.cscale = nullptr; d.sC = 0; d.ldc = D; d.acts = 0u; d.lnidx = 0; d.lnlast = 0;
    int layer = -1, sub = 0;
    if (st >= 7 && st < 11) { layer = 0; sub = st - 7; }
    else if (st >= 16 && st < 20) { layer = 1; sub = st - 16; }
    else if (st >= 28 && st < 32) { layer = 2; sub = st - 28; }
    else if (st >= 34 && st < 38) { layer = 3; sub = st - 34; }
    if (layer >= 0) {
        if (sub == 0) { d.kind = K_LN; d.lnidx = layer * 2; }
        else if (sub == 1) { d.kind = K_GACT; d.C = slot(0); d.ldc = DFF; d.acts = 1u;
            d.g = mk_gemm(xb, (const bf16_t*)(ws + O_W1T + (size_t)layer * DFF * D * 2), 0, 0, D, D, D, T / 256, DFF / 256, 1); }
        else if (sub == 2) { d.kind = K_GRES;
            d.g = mk_gemm(slot(0), (const bf16_t*)(ws + O_W2T + (size_t)layer * DFF * D * 2), 0, 0, DFF, DFF, DFF, T / 256, D / 256, 1); }
        else { d.kind = K_LN; d.lnidx = layer * 2 + 1; d.lnlast = (layer == 3); }
        return d;
    }
    switch (st) {
    case 0: d.kind = K_PREP; break;
    case 1: d.kind = K_GACT; d.C = slot(0); d.ldc = 4096;
            d.g = mk_gemm(xb, (const bf16_t*)(ws + O_WIN), 0, 0, D, D, D, T / 256, 4096 / 256, 1); break;
    case 2: d.kind = K_RGCONV; break;
    case 3: d.kind = K_GACT; d.C = slot(3); d.sC = 512; d.ldc = 4096;
            d.g = mk_gemm(slot(2), (const bf16_t*)(ws + O_GATES), 256, 512 * 256, D, 256, 256, T / 256, 2, 8); break;
    case 4: d.kind = K_RGSCAN0; break;
    case 5: d.kind = K_RGSCAN1; break;
    case 6: d.kind = K_GRES; d.res = p.in[0];
            d.g = mk_gemm(slot(5), (const bf16_t*)(ws + O_RGOUT), 0, 0, D, D, D, T / 256, D / 256, 1); break;
    case 11: d.kind = K_GACT; d.C = slot(0); d.sC = (long)T * D;
             d.g = mk_gemm(xb, (const bf16_t*)(ws + O_QKV), 0, (long)D * D, D, D, D, T / 256, D / 256, 2); break;
    case 12: d.kind = K_GACT; d.C = slot(2); d.ldc = T;
             d.g = mk_gemm((const bf16_t*)(ws + O_QKV + 2 * SZ_DD), xb, 0, 0, D, D, D, D / 256, T / 256, 1); break;
    case 13: d.kind = K_KMEAN; break;
    case 14: d.kind = K_ATTN; break;
    case 15: d.kind = K_GRES;
             d.g = mk_gemm(slot(3), (const bf16_t*)(ws + O_MOUT), 0, 0, D, D, D, T / 256, D / 256, 1); break;
    case 20: d.kind = K_RMIX; break;
    case 21: d.kind = K_GACT; d.C = slot(6); d.sC = (long)T * D;
             d.g = mk_gemm(slot(0), (const bf16_t*)(ws + O_RKV), (long)T * D, (long)D * D, D, D, D, T / 256, D / 256, 3); break;
    case 22: d.kind = K_GACT; d.C = (bf16_t*)(ws + O_L1O); d.sC = (long)T * 256; d.ldc = 256; d.acts = 0x302u;
             d.g = mk_gemm(slot(3), (const bf16_t*)(ws + O_L1), (long)T * D, (long)256 * D, D, D, D, T / 256, 1, 3); break;
    case 23: d.kind = K_GACT; d.C = slot(0); d.sC = (long)T * D;
             d.g = mk_gemm((const bf16_t*)(ws + O_L1O), (const bf16_t*)(ws + O_L2), (long)T * 256, (long)D * 256, 256, 256, 256, T / 256, D / 256, 3); break;
    case 24: d.kind = K_RPREP; break;
    case 25: d.kind = K_RSCAN; break;
    case 26: d.kind = K_RPOST; break;
    case 27: d.kind = K_GRES;
             d.g = mk_gemm(slot(3), (const bf16_t*)(ws + O_ROUT), 0, 0, D, D, D, T / 256, D / 256, 1); break;
    case 32: d.kind = K_POOL; break;
    case 33: d.kind = K_GRES; d.cscale = p.in[33]; d.sC = 512;
             d.g = mk_gemm(slot(0), (const bf16_t*)(ws + O_POOL), 512, 512 * 512, D, 512, 512, T / 256, 2, 4); break;
    default: break;
    }
    return d;
}

__global__ void __launch_bounds__(512, 2) fwd_megakernel(Params p) {
    extern __shared__ __attribute__((aligned(16))) unsigned char smem[];
    cg::grid_group grid = cg::this_grid();
    LAS unsigned char* lds = (LAS unsigned char*)smem;

    const bool multi = (p.hi - p.lo) > 1;
    volatile LAS unsigned* xst = (volatile LAS unsigned*)(lds + 131072);
    if (__builtin_amdgcn_workitem_id_x() == 0) { xst[0] = 0u; xst[1] = 0u; }
    __syncthreads();
    (void)xcd_barrier_post((int)__builtin_amdgcn_workitem_id_x(), (unsigned*)(p.ws + O_BAR), xst);
    for (int st = p.lo; st < p.hi; ++st) {
        int tid_ = (int)__builtin_amdgcn_workitem_id_x(); asm volatile("" : "+v"(tid_));
        int bid_ = (int)__builtin_amdgcn_workgroup_id_x(); asm volatile("" : "+s"(bid_));
        unsigned char* ws = p.ws; asm volatile("" : "+s"(ws));
        float* xcur = p.out; asm volatile("" : "+s"(xcur));
        unsigned char* sl = ws + O_SLOT;
        auto slot = [&](int i) { return (bf16_t*)(sl + (size_t)i * SLOT); };
        const int stu = __builtin_amdgcn_readfirstlane(st);
        const Desc d = make_desc(stu, p, ws);
        switch (__builtin_amdgcn_readfirstlane(d.kind)) {
        case K_PREP: prep_phase(tid_, bid_, p, smem); break;
        case K_GACT: { pg8::EpiAct E; E.C = d.C; E.sC = d.sC; E.ldc = d.ldc; E.acts = d.acts; pg8::gemm_phase(tid_, bid_, lds, d.g, E); } break;
        case K_GRES: { pg8::EpiRes E; E.out = xcur; E.res = d.res ? d.res : xcur; E.cscale = d.cscale; E.alpha = ALPHA; E.sC = d.sC; E.ldc = D; pg8::gemm_phase(tid_, bid_, lds, d.g, E); } break;
        case K_LN: ln_phase(tid_, bid_, xcur, xcur, d.lnlast ? nullptr : slot(8), p.in[1] + (size_t)d.lnidx * D, p.in[2] + (size_t)d.lnidx * D); break;
        case K_RGCONV: rg_conv_phase(tid_, bid_, slot(0), slot(2), p.in[6], p.in[7]); break;
        case K_RGSCAN0: rg_scan_phase<0>(tid_, bid_, p, slot(3), slot(2), slot(0), (float*)(ws + O_AGG), slot(5)); break;
        case K_RGSCAN1: rg_scan_phase<1>(tid_, bid_, p, slot(3), slot(2), slot(0), (float*)(ws + O_AGG), slot(5)); break;
        case K_KMEAN: kmean_phase(tid_, bid_, slot(0), slot(1), (float*)(ws + O_KMEAN), (const float*)(ws + O_ROPE), (const float*)(ws + O_ROPE) + SEQ * 16, smem); break;
        case K_ATTN: attn_phase(tid_, bid_, slot(0), slot(1), slot(2), slot(3), (const float*)(ws + O_KMEAN), smem); break;
        case K_RMIX: rwkv_mix_phase(tid_, bid_, xcur, p.in[16], slot(0)); break;
        case K_RPREP: rwkv_prep_phase(tid_, bid_, p, sl, (float*)(ws + O_SCAL)); break;
        case K_RSCAN: rwkv_scan_phase(tid_, bid_, sl, (const float*)(ws + O_SCAL), smem); break;
        case K_RPOST: rwkv_post_phase(tid_, bid_, p, sl, (const float*)(ws + O_SCAL)); break;
        case K_POOL: pool_phase(tid_, bid_, xcur, slot(0)); break;
        default: break;
        }
        if (multi && !step_nosync(st) && st + 1 < p.hi) { if (st == p.lo) grid.sync(); else { XcdBarrier xb; xb.bar = (unsigned*)(ws + O_BAR); xb.x = xb_xcc_id(); xb.st = (volatile LAS unsigned*)(lds + 131072); xcd_barrier(tid_, xb); } }
    }
}

extern "C" void kernel_launch(void* const* d_in, const int* in_sizes, int n_in, void* d_out, int out_size, void* d_ws, size_t ws_size, hipStream_t stream) {
    static int grid = 0;
    if (grid == 0) {
        if (n_in != 34 || out_size != T * D || ws_size < WS_END) { fprintf(stderr, "kernel_launch: unexpected shapes (n_in %d out %d ws %zu need %zu)\n", n_in, out_size, ws_size, (size_t)WS_END); grid = -1; return; }
        int dev = 0, cus = 0, per_cu = 0;
        hipGetDevice(&dev);
        hipDeviceGetAttribute(&cus, hipDeviceAttributeMultiprocessorCount, dev);
        if (hipFuncSetAttribute((const void*)fwd_megakernel, hipFuncAttributeMaxDynamicSharedMemorySize, LDS_BYTES) != hipSuccess) { fprintf(stderr, "kernel_launch: hipFuncSetAttribute failed\n"); grid = -1; return; }
        hipOccupancyMaxActiveBlocksPerMultiprocessor(&per_cu, (const void*)fwd_megakernel, 512, LDS_BYTES);
        if (per_cu < 1) { fprintf(stderr, "kernel_launch: occupancy query says %d blocks/CU\n", per_cu); per_cu = 1; }
        (void)hipGetLastError();
        grid = cus;
    }
    if (grid < 0) return;
    Params p{};
    for (int i = 0; i < 34; ++i) p.in[i] = (const float*)d_in[i];
    {
        unsigned char* ws = (unsigned char*)d_ws; int nj = 0, t0 = 0;
        auto add = [&](const float* src, size_t dstoff, int Ks, int Ns, int Kd, int Nd) {
            TJob& j = p.tj[nj]; j.src = src; j.dst = (bf16_t*)(ws + dstoff); j.Ks = Ks; j.Ns = Ns; j.Kd = Kd; j.Nd = Nd; j.tile0 = t0; j.pad = 0;
            t0 += (Kd / 128) * (Nd / 128); ++nj; };
        for (int l = 0; l < 4; ++l) add(p.in[3] + (size_t)l * D * DFF, O_W1T + (size_t)l * DFF * D * 2, D, DFF, D, DFF);
        for (int l = 0; l < 4; ++l) add(p.in[4] + (size_t)l * D * DFF, O_W2T + (size_t)l * DFF * D * 2, DFF, D, DFF, D);
        add(p.in[5], O_WIN, D, 4096, D, 4096);
        for (int n = 0; n < 8; ++n) { add(p.in[8] + (size_t)n * 65536, O_GATES + (size_t)n * 512 * 256 * 2, 256, 256, 256, 256);
                                      add(p.in[10] + (size_t)n * 65536, O_GATES + ((size_t)n * 512 + 256) * 256 * 2, 256, 256, 256, 256); }
        add(p.in[13], O_RGOUT, D, D, D, D);
        add(p.in[14], O_QKV, D, 3 * D, D, 3 * D);
        add(p.in[15], O_MOUT, D, D, D, D);
        for (int g = 0; g < 3; ++g) add(p.in[17] + (size_t)g * D * D, O_RKV + g * SZ_DD, D, D, D, D);
        add(p.in[19], O_L1 + 0 * (size_t)256 * D * 2, D, 96, D, 256);
        add(p.in[22], O_L1 + 1 * (size_t)256 * D * 2, D, 96, D, 256);
        add(p.in[24], O_L1 + 2 * (size_t)256 * D * 2, D, 256, D, 256);
        add(p.in[20], O_L2 + 0 * (size_t)D * 256 * 2, 96, D, 256, D);
        add(p.in[23], O_L2 + 1 * (size_t)D * 256 * 2, 96, D, 256, D);
        add(p.in[25], O_L2 + 2 * (size_t)D * 256 * 2, 256, D, 256, D);
        add(p.in[31], O_ROUT, D, D, D, D);
        for (int g = 0; g < 4; ++g) add(p.in[32] + (size_t)g * 512 * 512, O_POOL + (size_t)g * 512 * 512 * 2, 512, 512, 512, 512);
        p.ntiles = t0;
        if (nj != NTJ) fprintf(stderr, "kernel_launch: job table size %d != %d\n", nj, NTJ);
    }
    p.out = (float*)d_out; p.ws = (unsigned char*)d_ws; p.lo = 0; p.hi = NSTEPS;
    if (hipMemsetAsync((unsigned char*)d_ws + O_BAR, 0, BAR_BYTES, stream) != hipSuccess) { fprintf(stderr, "kernel_launch: memset of barrier words failed\n"); return; }
    void* args[] = {&p};
    hipError_t e = hipLaunchCooperativeKernel((const void*)fwd_megakernel, dim3(grid), dim3(512), args, LDS_BYTES, stream);
    if (e != hipSuccess) fprintf(stderr, "cooperative launch failed: %s (grid %d)\n", hipGetErrorString(e), grid);
}
```

```cpp
#include <hip/hip_runtime.h>
#include <hip/hip_cooperative_groups.h>
#include <cstdio>
namespace cg = cooperative_groups;

#define LAS __attribute__((address_space(3)))
typedef unsigned short bf16_t;
typedef short bf16x8 __attribute__((ext_vector_type(8)));
typedef float f32x4 __attribute__((ext_vector_type(4)));
typedef float f32x2 __attribute__((ext_vector_type(2)));
typedef unsigned u32x4 __attribute__((ext_vector_type(4)));
typedef unsigned u32x2 __attribute__((ext_vector_type(2)));
typedef __bf16 bfv2 __attribute__((ext_vector_type(2)));
#define DI __device__ __forceinline__

constexpr int T = 16384, D = 2048, SEQ = 4096, DFF = 8192;
constexpr float ALPHA = 1.6817928305074290f;
constexpr float LN_EPS = 1e-5f;

constexpr size_t SZ_DD = (size_t)D * D * 2;
constexpr size_t O_W1T = 0;
constexpr size_t O_W2T = O_W1T + 4 * (size_t)DFF * D * 2;
constexpr size_t O_WIN = O_W2T + 4 * (size_t)DFF * D * 2;
constexpr size_t O_GATES = O_WIN + (size_t)4096 * D * 2;
constexpr size_t O_RGOUT = O_GATES + (size_t)8 * 512 * 256 * 2;
constexpr size_t O_QKV = O_RGOUT + SZ_DD;
constexpr size_t O_MOUT = O_QKV + 3 * SZ_DD;
constexpr size_t O_RKV = O_MOUT + SZ_DD;
constexpr size_t O_L1 = O_RKV + 3 * SZ_DD;
constexpr size_t O_L2 = O_L1 + (size_t)3 * 256 * D * 2;
constexpr size_t O_ROUT = O_L2 + (size_t)3 * D * 256 * 2;
constexpr size_t O_POOL = O_ROUT + SZ_DD;
constexpr size_t O_SLOT = O_POOL + (size_t)4 * 512 * 512 * 2;
constexpr size_t SLOT = (size_t)T * D * 2;
constexpr size_t O_L1O = O_SLOT + 9 * SLOT;
constexpr size_t O_ROPE = O_L1O + (size_t)3 * T * 256 * 2;
constexpr size_t O_KMEAN = O_ROPE + (size_t)2 * SEQ * 16 * 4;
constexpr size_t O_AGG = O_KMEAN + (size_t)64 * 16 * 128 * 4;
constexpr size_t O_SCAL = O_AGG + (size_t)4 * 128 * D * 2 * 4;
constexpr size_t O_BAR = O_SCAL + (size_t)3 * T * 32 * 4;
constexpr size_t BAR_BYTES = 16384;
constexpr size_t WS_END = O_BAR + BAR_BYTES;

constexpr int LDS_BYTES = 131072 + 16;

struct TJob { const float* src; bf16_t* dst; int Ks, Ns, Kd, Nd, tile0, pad; };
constexpr int NTJ = 42;
struct Params {
    const float* in[34];
    float* out;
    unsigned char* ws;
    int lo, hi, ntiles, pad;
    TJob tj[NTJ];
};

DI unsigned pk_bf16(float a, float b) { f32x2 v = {a, b}; bfv2 r = __builtin_convertvector(v, bfv2); return __builtin_bit_cast(unsigned, r); }
DI bf16_t f2bf(float a) { return (bf16_t)(pk_bf16(a, 0.f) & 0xffffu); }
DI float bf2f(bf16_t b) { return __uint_as_float(((unsigned)b) << 16); }
DI float bflo(unsigned u) { return __uint_as_float(u << 16); }
DI float bfhi(unsigned u) { return __uint_as_float(u & 0xffff0000u); }
DI float wave_sum(float v) {
    v += __int_as_float(__builtin_amdgcn_update_dpp(0, __float_as_int(v), 0xB1, 0xF, 0xF, false));
    v += __int_as_float(__builtin_amdgcn_update_dpp(0, __float_as_int(v), 0x4E, 0xF, 0xF, false));
    v += __int_as_float(__builtin_amdgcn_update_dpp(0, __float_as_int(v), 0x141, 0xF, 0xF, false));
    v += __int_as_float(__builtin_amdgcn_update_dpp(0, __float_as_int(v), 0x140, 0xF, 0xF, false));
    const int iv = __float_as_int(v);
    return __int_as_float(__builtin_amdgcn_readlane(iv, 0)) + __int_as_float(__builtin_amdgcn_readlane(iv, 16)) +
           __int_as_float(__builtin_amdgcn_readlane(iv, 32)) + __int_as_float(__builtin_amdgcn_readlane(iv, 48));
}
DI float xmax_fq(float v) {
    const auto a = __builtin_amdgcn_permlane32_swap(__float_as_uint(v), __float_as_uint(v), false, false);
    v = fmaxf(__uint_as_float(a[0]), __uint_as_float(a[1]));
    const auto b = __builtin_amdgcn_permlane16_swap(__float_as_uint(v), __float_as_uint(v), false, false);
    return fmaxf(__uint_as_float(b[0]), __uint_as_float(b[1]));
}
DI float xsum_fq(float v) {
    const auto a = __builtin_amdgcn_permlane32_swap(__float_as_uint(v), __float_as_uint(v), false, false);
    v = __uint_as_float(a[0]) + __uint_as_float(a[1]);
    const auto b = __builtin_amdgcn_permlane16_swap(__float_as_uint(v), __float_as_uint(v), false, false);
    return __uint_as_float(b[0]) + __uint_as_float(b[1]);
}
DI float row_sum16(float v) {
    v += __int_as_float(__builtin_amdgcn_update_dpp(0, __float_as_int(v), 0xB1, 0xF, 0xF, false));
    v += __int_as_float(__builtin_amdgcn_update_dpp(0, __float_as_int(v), 0x4E, 0xF, 0xF, false));
    v += __int_as_float(__builtin_amdgcn_update_dpp(0, __float_as_int(v), 0x141, 0xF, 0xF, false));
    v += __int_as_float(__builtin_amdgcn_update_dpp(0, __float_as_int(v), 0x140, 0xF, 0xF, false));
    return v;
}
DI float half_sum(float v) {
    v += __int_as_float(__builtin_amdgcn_update_dpp(0, __float_as_int(v), 0xB1, 0xF, 0xF, false));
    v += __int_as_float(__builtin_amdgcn_update_dpp(0, __float_as_int(v), 0x4E, 0xF, 0xF, false));
    v += __int_as_float(__builtin_amdgcn_update_dpp(0, __float_as_int(v), 0x141, 0xF, 0xF, false));
    v += __int_as_float(__builtin_amdgcn_update_dpp(0, __float_as_int(v), 0x140, 0xF, 0xF, false));
    const auto b = __builtin_amdgcn_permlane16_swap(__float_as_uint(v), __float_as_uint(v), false, false);
    return __uint_as_float(b[0]) + __uint_as_float(b[1]);
}
DI void lds_barrier() { asm volatile("s_waitcnt lgkmcnt(0)" ::: "memory"); __builtin_amdgcn_s_barrier(); asm volatile("" ::: "memory"); }
DI float sigmoidf_(float x) { return __builtin_amdgcn_rcpf(1.f + __expf(-x)); }
DI float tanhf_(float x) { return 1.f - 2.f * __builtin_amdgcn_rcpf(1.f + __expf(2.f * x)); }
DI float gelu_tanh(float x) { const float u = 0.7978845608028654f * (x + 0.044715f * x * x * x); return 0.5f * x * (1.f + tanhf_(u)); }

namespace pg8 {
constexpr int BM = 256, BK = 64, HALF = 128, HTB = HALF * BK * 2, NXCD = 8, WGM = 4;
DI int lds_byte(int r, int c) { const int st = (r >> 4) * 2 + (c >> 5), rr = r & 15, cc = c & 31, ob = rr * 64 + cc * 2; return st * 1024 + (ob ^ (((ob >> 9) & 1) << 5)); }
DI void stage_rc(int b, int& R, int& C) { const int st = b / 1024, sb = b % 1024, swz = sb ^ (((sb >> 9) & 1) << 5); R = (st >> 1) * 16 + swz / 64; C = (st & 1) * 32 + (swz % 64) / 2; }
DI int perm32(int rho) { const int n = rho >> 4, i = rho & 15; return 8 * (i >> 2) + 4 * n + (i & 3); }

struct Unit { int g, pm, pn; };
struct Gemm { const bf16_t* A; const bf16_t* Bt; long sA, sB; int lda, ldb, K, nM, nN, G; };

struct Order {
    int nM, nN, nwg, tot, Gd, c;
    DI void init(const Gemm& g, int Gd_, int c_) { nM = g.nM; nN = g.nN; nwg = nM * nN; tot = nwg * g.G; Gd = Gd_; c = c_; }
    DI bool next(int i, Unit& u) const {
        const long L = (long)i * Gd + c; if (L >= tot) return false;
        const int grp = (int)(L / nwg); int wgid = (int)(L - (long)grp * nwg);
        { const int q = nwg / NXCD, r = nwg % NXCD, xcd = wgid % NXCD, off = wgid / NXCD; wgid = (xcd < r ? xcd * (q + 1) : r * (q + 1) + (xcd - r) * q) + off; }
        const int nig = WGM * nN, gid = wgid / nig, fm = gid * WGM, gsz = (nM - fm) < WGM ? (nM - fm) : WGM;
        u.g = grp; u.pm = fm + ((wgid % nig) % gsz); u.pn = (wgid % nig) / gsz; return true;
    }
};

struct EpiAct {
    static constexpr bool PERM = true;
    bf16_t* C; long sC; int ldc; unsigned acts;
    DI void operator()(const f32x4 (&acc)[2][2][4][2], const Unit& u, int wr, int wc, int fr, int fq) const {
        bf16_t* base = C + (size_t)u.g * sC;
        const int act = (int)((acts >> (4 * u.g)) & 15u);
        const int row0 = u.pm * BM + wr * 64 + fr, col0 = u.pn * BM + wc * 32 + 8 * fq;
#pragma unroll
        for (int ai = 0; ai < 2; ++ai)
#pragma unroll
            for (int m = 0; m < 4; ++m) {
                bf16_t* rowp = base + (size_t)(row0 + ai * HALF + m * 16) * ldc + col0;
#pragma unroll
                for (int bj = 0; bj < 2; ++bj) {
                    float v[8];
#pragma unroll
                    for (int e = 0; e < 4; ++e) { v[e] = acc[ai][bj][m][0][e]; v[4 + e] = acc[ai][bj][m][1][e]; }
                    if (act == 1) {
#pragma unroll
                        for (int e = 0; e < 8; ++e) { const float t = fmaxf(v[e], 0.f); v[e] = t * t; }
                    } else if (act == 2) {
#pragma unroll
                        for (int e = 0; e < 8; ++e) v[e] = tanhf_(v[e]);
                    } else if (act == 3) {
#pragma unroll
                        for (int e = 0; e < 8; ++e) v[e] = sigmoidf_(v[e]);
                    }
                    u32x4 o = {pk_bf16(v[0], v[1]), pk_bf16(v[2], v[3]), pk_bf16(v[4], v[5]), pk_bf16(v[6], v[7])};
                    *(u32x4*)(rowp + bj * HALF) = o;
                }
            }
    }
};
struct EpiRes {
    static constexpr bool PERM = false;
    float* out; const float* res; const float* cscale; float alpha; long sC; int ldc;
    DI void operator()(const f32x4 (&acc)[2][2][4][2], const Unit& u, int wr, int wc, int fr, int fq) const {
        const int row0 = u.pm * BM + wr * 64 + fr, col0 = (int)(u.g * sC) + u.pn * BM + wc * 32 + 4 * fq;
        f32x4 r[2][2][2][2];
        auto ldq = [&](int q, int buf) {
            const int ai = q >> 1, m0 = (q & 1) * 2;
#pragma unroll
            for (int mm = 0; mm < 2; ++mm) {
                const size_t ro = (size_t)(row0 + ai * HALF + (m0 + mm) * 16) * ldc + col0;
#pragma unroll
                for (int bj = 0; bj < 2; ++bj)
#pragma unroll
                    for (int n = 0; n < 2; ++n) r[buf][mm][bj][n] = *(const f32x4*)(res + ro + bj * HALF + n * 16);
            }
        };
        auto stq = [&](int q, int buf) {
            const int ai = q >> 1, m0 = (q & 1) * 2;
#pragma unroll
            for (int mm = 0; mm < 2; ++mm) {
                const size_t ro = (size_t)(row0 + ai * HALF + (m0 + mm) * 16) * ldc + col0;
#pragma unroll
                for (int bj = 0; bj < 2; ++bj)
#pragma unroll
                    for (int n = 0; n < 2; ++n) {
                        f32x4 a = acc[ai][bj][m0 + mm][n];
                        if (cscale) a *= *(const f32x4*)(cscale + col0 + bj * HALF + n * 16);
                        *(f32x4*)(out + ro + bj * HALF + n * 16) = alpha * r[buf][mm][bj][n] + a;
                    }
            }
        };
        ldq(0, 0); ldq(1, 1);
        __builtin_amdgcn_sched_barrier(0);
        stq(0, 0); ldq(2, 0);
        __builtin_amdgcn_sched_barrier(0);
        stq(1, 1); ldq(3, 1);
        __builtin_amdgcn_sched_barrier(0);
        stq(2, 0); stq(3, 1);
    }
};
template <class Epi>
DI void gemm_phase(int tid_, int bid_, LAS unsigned char* lds, const Gemm g, const Epi& E) {
    const int tid = tid_, wid = __builtin_amdgcn_readfirstlane(tid >> 6), lane = tid & 63, wr = wid >> 2, wc = wid & 3, fr = lane & 15, fq = lane >> 4;
    const int K = g.K, nt = K / BK;
    Order S; S.init(g, (int)gridDim.x, (int)bid_);
    unsigned voffA[2], voffB[2];
#pragma unroll
    for (int i = 0; i < 2; ++i) { int R, C; stage_rc(tid * 16 + i * 8192, R, C); const int Rb = Epi::PERM ? ((R & ~31) + perm32(R & 31)) : R;
        voffA[i] = (unsigned)(R * g.lda + C) * 2u; voffB[i] = (unsigned)(Rb * g.ldb + C) * 2u; }
    const size_t kstep = (size_t)(BK * 2);
    const size_t hA = (size_t)HALF * g.lda * 2, hB = (size_t)HALF * g.ldb * 2;
    const unsigned ldsw = (unsigned)wid * 1024u;
    const int aoff = lds_byte(wr * 64 + fr, fq * 8), boff = lds_byte(wc * 32 + fr, fq * 8);
#define PG8_SA(b, h) (((b) * 2 + (h)) * HTB)
#define PG8_SB(b, h) ((4 + (b) * 2 + (h)) * HTB)
#define PG8_STAGE(bufoff, gbase, voff) do { _Pragma("unroll") for (int _i = 0; _i < 2; ++_i) \
        __builtin_amdgcn_global_load_lds((const unsigned*)((const char*)(gbase) + (voff)[_i]), (LAS unsigned*)(lds + (bufoff) + ldsw + _i * 8192), 16, 0, 0); } while (0)
#define PG8_LDA(dst, b, h) do { _Pragma("unroll") for (int m = 0; m < 4; ++m) _Pragma("unroll") for (int k = 0; k < 2; ++k) dst[m][k] = *(const LAS bf16x8*)(lds + PG8_SA(b, h) + aoff + m * 2048 + k * 1024); } while (0)
#define PG8_LDB(dst, b, h) do { _Pragma("unroll") for (int n = 0; n < 2; ++n) _Pragma("unroll") for (int k = 0; k < 2; ++k) dst[n][k] = *(const LAS bf16x8*)(lds + PG8_SB(b, h) + boff + n * 2048 + k * 1024); } while (0)
#define PG8_MMA(ai, bj, At, Bt) do { __builtin_amdgcn_s_setprio(1); _Pragma("unroll") for (int m = 0; m < 4; ++m) _Pragma("unroll") for (int n = 0; n < 2; ++n) _Pragma("unroll") for (int k = 0; k < 2; ++k) \
        acc[ai][bj][m][n] = __builtin_amdgcn_mfma_f32_16x16x32_bf16(Bt[n][k], At[m][k], acc[ai][bj][m][n], 0, 0, 0); __builtin_amdgcn_s_setprio(0); } while (0)
#define PG8_WAIT_V(n) asm volatile("s_waitcnt vmcnt(" #n ")" ::: "memory")
#define PG8_WAIT_L(n) asm volatile("s_waitcnt lgkmcnt(" #n ")" ::: "memory")
#define PG8_BAR __builtin_amdgcn_s_barrier()
#define PG8_SCHED __builtin_amdgcn_sched_barrier(0)
    Unit cur, nxt; int ui = 0;
    if (!S.next(0, cur)) return;
    f32x4 acc[2][2][4][2];
#pragma unroll
    for (int a = 0; a < 2; ++a)
#pragma unroll
        for (int b = 0; b < 2; ++b)
#pragma unroll
            for (int m = 0; m < 4; ++m)
#pragma unroll
                for (int n = 0; n < 2; ++n) acc[a][b][m][n] = (f32x4){0.f, 0.f, 0.f, 0.f};
    bf16x8 At[4][2], B0[2][2], B1[2][2];
    const char* cA = (const char*)g.A + ((size_t)cur.g * g.sA + (size_t)cur.pm * BM * g.lda) * 2;
    const char* cB = (const char*)g.Bt + ((size_t)cur.g * g.sB + (size_t)cur.pn * BM * g.ldb) * 2;
    PG8_STAGE(PG8_SB(0, 0), cB, voffB); PG8_STAGE(PG8_SA(0, 0), cA, voffA); PG8_STAGE(PG8_SB(0, 1), cB + hB, voffB); PG8_STAGE(PG8_SA(0, 1), cA + hA, voffA);
    if (wr == 1) PG8_BAR;
    PG8_WAIT_V(4); PG8_BAR;
    PG8_STAGE(PG8_SB(1, 0), cB + kstep, voffB); PG8_STAGE(PG8_SA(1, 0), cA + kstep, voffA); PG8_STAGE(PG8_SB(1, 1), cB + hB + kstep, voffB);
    PG8_WAIT_V(6); PG8_BAR;
    for (;;) {
        const bool has_next = S.next(ui + 1, nxt);
        const char* nA = has_next ? (const char*)g.A + ((size_t)nxt.g * g.sA + (size_t)nxt.pm * BM * g.lda) * 2 : cA;
        const char* nB = has_next ? (const char*)g.Bt + ((size_t)nxt.g * g.sB + (size_t)nxt.pn * BM * g.ldb) * 2 : cB;
        for (int t = 0; t < nt; t += 2) {
            const bool last = (t == nt - 2);
            const char* a1 = cA + (size_t)(t + 1) * kstep;
            const char* a2 = last ? nA : cA + (size_t)(t + 2) * kstep; const char* b2 = last ? nB : cB + (size_t)(t + 2) * kstep;
            const char* a3 = a2 + kstep; const char* b3 = b2 + kstep;
            PG8_LDB(B0, 0, 0); PG8_SCHED; PG8_LDA(At, 0, 0); PG8_STAGE(PG8_SA(1, 1), a1 + hA, voffA);
            PG8_WAIT_L(8); PG8_BAR; PG8_WAIT_L(0); PG8_MMA(0, 0, At, B0); PG8_BAR; PG8_SCHED;
            PG8_LDB(B1, 0, 1); PG8_STAGE(PG8_SB(0, 0), b2, voffB);
            PG8_BAR; PG8_WAIT_L(0); PG8_MMA(0, 1, At, B1); PG8_BAR;
            PG8_LDA(At, 0, 1); PG8_STAGE(PG8_SA(0, 0), a2, voffA);
            PG8_BAR; PG8_WAIT_L(0); PG8_MMA(1, 0, At, B0); PG8_BAR; PG8_SCHED;
            PG8_STAGE(PG8_SB(0, 1), b2 + hB, voffB);
            PG8_WAIT_V(6); PG8_BAR; PG8_MMA(1, 1, At, B1); PG8_BAR;
            PG8_LDB(B0, 1, 0); PG8_SCHED; PG8_LDA(At, 1, 0); PG8_STAGE(PG8_SA(0, 1), a2 + hA, voffA);
            PG8_WAIT_L(8); PG8_BAR; PG8_WAIT_L(0); PG8_MMA(0, 0, At, B0); PG8_BAR; PG8_SCHED;
            PG8_LDB(B1, 1, 1); PG8_STAGE(PG8_SB(1, 0), b3, voffB);
            PG8_BAR; PG8_WAIT_L(0); PG8_MMA(0, 1, At, B1); PG8_BAR;
            PG8_LDA(At, 1, 1); PG8_STAGE(PG8_SA(1, 0), a3, voffA);
            PG8_BAR; PG8_WAIT_L(0); PG8_MMA(1, 0, At, B0); PG8_BAR; PG8_SCHED;
            PG8_STAGE(PG8_SB(1, 1), b3 + hB, voffB);
            PG8_WAIT_V(6); PG8_BAR; PG8_MMA(1, 1, At, B1); PG8_BAR;
        }
        E(acc, cur, wr, wc, fr, fq);
        if (!has_next) break;
#pragma unroll
        for (int a = 0; a < 2; ++a)
#pragma unroll
            for (int b = 0; b < 2; ++b)
#pragma unroll
                for (int m = 0; m < 4; ++m)
#pragma unroll
                    for (int n = 0; n < 2; ++n) acc[a][b][m][n] = (f32x4){0.f, 0.f, 0.f, 0.f};
        cur = nxt; cA = nA; cB = nB; ++ui;
    }
    PG8_WAIT_V(0);
    if (wr == 0) PG8_BAR;
    PG8_BAR;
#undef PG8_SA
#undef PG8_SB
#undef PG8_STAGE
#undef PG8_LDA
#undef PG8_LDB
#undef PG8_MMA
#undef PG8_WAIT_V
#undef PG8_WAIT_L
#undef PG8_BAR
#undef PG8_SCHED
}
}

DI pg8::Gemm mk_gemm(const bf16_t* A, const bf16_t* Bt, long sA, long sB, int lda, int ldb, int K, int nM, int nN, int G) {
    pg8::Gemm g; g.A = A; g.Bt = Bt; g.sA = sA; g.sB = sB; g.lda = lda; g.ldb = ldb; g.K = K; g.nM = nM; g.nN = nN; g.G = G; return g;
}

DI void prep_phase(int tid_, int bid_, const Params& p, unsigned char* smem) {
    TJob* jobs = (TJob*)smem;
    float* tile = (float*)(smem + 4096);
    const int tid = tid_;
    if (tid < NTJ) jobs[tid] = p.tj[tid];
    __syncthreads();
    const int ntiles = p.ntiles;
    for (int tix = bid_; tix < ntiles; tix += gridDim.x) {
        int j = 0;
        for (int q = 1; q < NTJ; ++q) if (jobs[q].tile0 <= tix) j = q;
        const TJob jb = jobs[j];
        const int lt = tix - jb.tile0, ntk = jb.Kd / 128, k0 = (lt % ntk) * 128, n0 = (lt / ntk) * 128;
        f32x4 v[8];
#pragma unroll
        for (int i = 0; i < 8; ++i) {
            const int idx = tid + i * 512, kk = idx >> 5, n4 = idx & 31;
            const int k = k0 + kk, n = n0 + n4 * 4;
            v[i] = (k < jb.Ks && n < jb.Ns) ? *(const f32x4*)(jb.src + (size_t)k * jb.Ns + n) : (f32x4){0.f, 0.f, 0.f, 0.f};
        }
#pragma unroll
        for (int i = 0; i < 8; ++i) {
            const int idx = tid + i * 512, kk = idx >> 5, n4 = idx & 31;
#pragma unroll
            for (int e = 0; e < 4; ++e) tile[kk * 129 + n4 * 4 + e] = v[i][e];
        }
        __syncthreads();
#pragma unroll
        for (int i = 0; i < 4; ++i) {
            const int idx = tid + i * 512, n = idx >> 4, kc = idx & 15;
            float f[8];
#pragma unroll
            for (int e = 0; e < 8; ++e) f[e] = tile[(kc * 8 + e) * 129 + n];
            u32x4 o = {pk_bf16(f[0], f[1]), pk_bf16(f[2], f[3]), pk_bf16(f[4], f[5]), pk_bf16(f[6], f[7])};
            *(u32x4*)(jb.dst + (size_t)(n0 + n) * jb.Kd + k0 + kc * 8) = o;
        }
        __syncthreads();
    }
    {
        const float* x = p.in[0]; bf16_t* xb = (bf16_t*)(p.ws + O_SLOT + 8 * SLOT);
        const size_t n8 = (size_t)T * D / 8;
        for (size_t i = (size_t)bid_ * 512 + tid; i < n8; i += (size_t)gridDim.x * 512) {
            const f32x4 a = *(const f32x4*)(x + i * 8), b = *(const f32x4*)(x + i * 8 + 4);
            u32x4 o = {pk_bf16(a[0], a[1]), pk_bf16(a[2], a[3]), pk_bf16(b[0], b[1]), pk_bf16(b[2], b[3])};
            *(u32x4*)(xb + i * 8) = o;
        }
    }
    {
        float* ct = (float*)(p.ws + O_ROPE); float* st = ct + SEQ * 16;
        for (int i = bid_ * 512 + tid; i < SEQ * 16; i += gridDim.x * 512) {
            const int pos = i >> 4, f = i & 15;
            const float inv = powf(500000.0f, -(float)(2 * f) / 32.0f);
            const float ang = (float)pos * inv;
            ct[i] = cosf(ang); st[i] = sinf(ang);
        }
    }
}

DI void ln_phase(int tid_, int bid_, const float* zin, float* xout, bf16_t* xb, const float* gam, const float* bet) {
    const int lane = tid_ & 63, wid = tid_ >> 6;
    const int rstride = gridDim.x * 8;
    constexpr int NR = 4;
    for (int row0 = bid_ * 8 + wid; row0 < T; row0 += NR * rstride) {
        f32x4 v[NR][8];
#pragma unroll
        for (int r = 0; r < NR; ++r)
#pragma unroll
            for (int i = 0; i < 8; ++i)
                v[r][i] = (row0 + r * rstride < T) ? *(const f32x4*)(zin + (size_t)(row0 + r * rstride) * D + (i * 64 + lane) * 4) : (f32x4){0.f, 0.f, 0.f, 0.f};
#pragma unroll
        for (int r = 0; r < NR; ++r) {
            const int row = row0 + r * rstride;
            if (row >= T) break;
            float s = 0.f;
#pragma unroll
            for (int i = 0; i < 8; ++i) s += v[r][i][0] + v[r][i][1] + v[r][i][2] + v[r][i][3];
            const float mean = wave_sum(s) * (1.f / D);
            float q = 0.f;
#pragma unroll
            for (int i = 0; i < 8; ++i) { v[r][i] -= mean; q += v[r][i][0] * v[r][i][0] + v[r][i][1] * v[r][i][1] + v[r][i][2] * v[r][i][2] + v[r][i][3] * v[r][i][3]; }
            const float rstd = rsqrtf(wave_sum(q) * (1.f / D) + LN_EPS);
#pragma unroll
            for (int i = 0; i < 8; ++i) {
                const int c = (i * 64 + lane) * 4;
                const f32x4 g = *(const f32x4*)(gam + c), b = *(const f32x4*)(bet + c);
                const f32x4 o = v[r][i] * rstd * g + b;
                *(f32x4*)(xout + (size_t)row * D + c) = o;
                if (xb) { u32x2 w = {pk_bf16(o[0], o[1]), pk_bf16(o[2], o[3])}; *(u32x2*)(xb + (size_t)row * D + c) = w; }
            }
        }
    }
}

DI void rg_conv_phase(int tid_, int bid_, const bf16_t* gu, bf16_t* uc, const float* cw, const float* cb) {
    const size_t n8 = (size_t)T * D / 8;
    const size_t stride = (size_t)gridDim.x * 512;
    constexpr int U = 4;
    for (size_t ib = (size_t)bid_ * 512 + tid_; ib < n8; ib += stride * U) {
        u32x4 uu[U][4];
#pragma unroll
        for (int u = 0; u < U; ++u) {
            const size_t i = ib + u * stride;
            const int t = (int)(i >> 8), c = (int)(i & 255) * 8, s = t & (SEQ - 1);
#pragma unroll
            for (int j = 0; j < 4; ++j)
                uu[u][j] = (i < n8 && s - 3 + j >= 0) ? *(const u32x4*)(gu + (size_t)(t - 3 + j) * 4096 + 2048 + c) : (u32x4){0u, 0u, 0u, 0u};
        }
#pragma unroll
        for (int u = 0; u < U; ++u) {
            const size_t i = ib + u * stride;
            if (i >= n8) break;
            const int c = (int)(i & 255) * 8;
            float a[8];
            { const f32x4 b0 = *(const f32x4*)(cb + c), b1 = *(const f32x4*)(cb + c + 4);
#pragma unroll
              for (int e = 0; e < 4; ++e) { a[e] = b0[e]; a[4 + e] = b1[e]; } }
#pragma unroll
            for (int j = 0; j < 4; ++j) {
                const u32x4 q = uu[u][j];
                const f32x4 w0 = *(const f32x4*)(cw + j * D + c), w1 = *(const f32x4*)(cw + j * D + c + 4);
                a[0] += w0[0] * bflo(q[0]); a[1] += w0[1] * bfhi(q[0]); a[2] += w0[2] * bflo(q[1]); a[3] += w0[3] * bfhi(q[1]);
                a[4] += w1[0] * bflo(q[2]); a[5] += w1[1] * bfhi(q[2]); a[6] += w1[2] * bflo(q[3]); a[7] += w1[3] * bfhi(q[3]);
            }
            u32x4 o = {pk_bf16(a[0], a[1]), pk_bf16(a[2], a[3]), pk_bf16(a[4], a[5]), pk_bf16(a[6], a[7])};
            *(u32x4*)(uc + i * 8) = o;
        }
    }
}
DI void rg_ab(float rpre, float ipre, float u, float ba, float bx, float sp8, float& a, float& b) {
    const float r = sigmoidf_(rpre + ba), ii = sigmoidf_(ipre + bx);
    const float la = -sp8 * r;
    a = __expf(la);
    const float x2 = 2.f * la;
    const float om = (x2 > -0.05f) ? -x2 * (1.f + x2 * (0.5f + x2 * (0.16666667f + x2 * 0.041666668f))) : 1.f - a * a;
    b = u * ii * __builtin_amdgcn_sqrtf(om);
}
template <int MODE>
DI void rg_scan_phase(int tid_, int bid_, const Params& p, const bf16_t* gates, const bf16_t* uc, const bf16_t* gu, float* agg, bf16_t* outg) {
    constexpr int CH = 32;
    const float* gab = p.in[9]; const float* gxb = p.in[11]; const float* lam = p.in[12];
    const int ch = tid_ * 4, n = ch >> 8, v = ch & 255;
    for (int item = bid_; item < 4 * 128; item += gridDim.x) {
        const int chunk = item & 127, b = item >> 7;
        const f32x4 ba = *(const f32x4*)(gab + ch), bx = *(const f32x4*)(gxb + ch), lm = *(const f32x4*)(lam + ch);
        float sp[4], h[4] = {0.f, 0.f, 0.f, 0.f}, P[4] = {1.f, 1.f, 1.f, 1.f};
#pragma unroll
        for (int e = 0; e < 4; ++e) sp[e] = 8.f * log1pf(expf(-lm[e]));
        if (MODE == 1) {
            for (int c0 = 0; c0 < chunk; c0 += 8) {
                f32x4 gv[8][2];
#pragma unroll
                for (int j = 0; j < 8; ++j) {
                    const float* ap = agg + (((size_t)b * 128 + c0 + j) * D + ch) * 2;
                    gv[j][0] = (c0 + j < chunk) ? *(const f32x4*)ap : (f32x4){1.f, 0.f, 1.f, 0.f};
                    gv[j][1] = (c0 + j < chunk) ? *(const f32x4*)(ap + 4) : (f32x4){1.f, 0.f, 1.f, 0.f};
                }
#pragma unroll
                for (int j = 0; j < 8; ++j) { h[0] = gv[j][0][0] * h[0] + gv[j][0][1]; h[1] = gv[j][0][2] * h[1] + gv[j][0][3]; h[2] = gv[j][1][0] * h[2] + gv[j][1][1]; h[3] = gv[j][1][2] * h[3] + gv[j][1][3]; }
            }
        }
        const size_t t0 = (size_t)b * SEQ + (size_t)chunk * CH;
        constexpr int UB = 8;
        for (int tb = 0; tb < CH; tb += UB) {
            u32x2 rpv[UB], ipv[UB], uuv[UB], ggv[UB];
#pragma unroll
            for (int j = 0; j < UB; ++j) {
                const size_t t = t0 + tb + j;
                rpv[j] = *(const u32x2*)(gates + t * 4096 + n * 512 + v);
                ipv[j] = *(const u32x2*)(gates + t * 4096 + n * 512 + 256 + v);
                uuv[j] = *(const u32x2*)(uc + t * D + ch);
                if (MODE == 1) ggv[j] = *(const u32x2*)(gu + t * 4096 + ch);
            }
#pragma unroll
            for (int j = 0; j < UB; ++j) {
                const size_t t = t0 + tb + j;
                const float rp[4] = {bflo(rpv[j][0]), bfhi(rpv[j][0]), bflo(rpv[j][1]), bfhi(rpv[j][1])};
                const float ip[4] = {bflo(ipv[j][0]), bfhi(ipv[j][0]), bflo(ipv[j][1]), bfhi(ipv[j][1])};
                const float uu[4] = {bflo(uuv[j][0]), bfhi(uuv[j][0]), bflo(uuv[j][1]), bfhi(uuv[j][1])};
#pragma unroll
                for (int e = 0; e < 4; ++e) {
                    float a, bb;
                    rg_ab(rp[e], ip[e], uu[e], ba[e], bx[e], sp[e], a, bb);
                    h[e] = a * h[e] + bb;
                    if (MODE == 0) P[e] *= a;
                }
                if (MODE == 1) {
                    const float gg[4] = {bflo(ggv[j][0]), bfhi(ggv[j][0]), bflo(ggv[j][1]), bfhi(ggv[j][1])};
                    u32x2 w = {pk_bf16(gelu_tanh(gg[0]) * h[0], gelu_tanh(gg[1]) * h[1]), pk_bf16(gelu_tanh(gg[2]) * h[2], gelu_tanh(gg[3]) * h[3])};
                    *(u32x2*)(outg + t * D + ch) = w;
                }
            }
        }
        if (MODE == 0) {
            float* ap = agg + (((size_t)b * 128 + chunk) * D + ch) * 2;
            f32x4 o0 = {P[0], h[0], P[1], h[1]}, o1 = {P[2], h[2], P[3], h[3]};
            *(f32x4*)ap = o0; *(f32x4*)(ap + 4) = o1;
        }
    }
}

DI void kmean_phase(int tid_, int bid_, bf16_t* Qx, bf16_t* Kx, float* kmean, const float* ctab, const float* stab, unsigned char* smem) {
    float* redA = (float*)smem;
    float* redB = redA + 1024;
    const int tid = tid_;
    for (int item = bid_; item < 1024; item += gridDim.x) {
        const int blk = item & 15, h = (item >> 4) & 15, b = item >> 8;
        {
            const int i = tid & 15, rg = tid >> 4;
            float s1 = 0.f, s2 = 0.f;
            bf16_t k1v[8], k2v[8], q1v[8], q2v[8]; float cv[8], sv[8];
#pragma unroll
            for (int r = 0; r < 8; ++r) {
                const int pos = blk * 256 + rg * 8 + r;
                const size_t o = ((size_t)b * SEQ + pos) * D + h * 128 + i;
                cv[r] = ctab[pos * 16 + i]; sv[r] = stab[pos * 16 + i];
                k1v[r] = Kx[o]; k2v[r] = Kx[o + 16]; q1v[r] = Qx[o]; q2v[r] = Qx[o + 16];
            }
#pragma unroll
            for (int r = 0; r < 8; ++r) {
                const int pos = blk * 256 + rg * 8 + r;
                const size_t o = ((size_t)b * SEQ + pos) * D + h * 128 + i;
                const float c = cv[r], sn = sv[r];
                const float k1 = bf2f(k1v[r]), k2 = bf2f(k2v[r]);
                const bf16_t k1r = f2bf(k1 * c - k2 * sn), k2r = f2bf(k2 * c + k1 * sn);
                Kx[o] = k1r; Kx[o + 16] = k2r; s1 += bf2f(k1r); s2 += bf2f(k2r);
                const float q1 = bf2f(q1v[r]), q2 = bf2f(q2v[r]);
                Qx[o] = f2bf(q1 * c - q2 * sn); Qx[o + 16] = f2bf(q2 * c + q1 * sn);
            }
            redA[rg * 32 + i] = s1; redA[rg * 32 + 16 + i] = s2;
        }
        {
            const int dp = tid & 63, rg = tid >> 6;
            if (dp >= 16) {
                const bf16_t* base = Kx + ((size_t)b * SEQ + blk * 256 + rg * 32) * D + h * 128 + dp * 2;
                float s0 = 0.f, s1 = 0.f;
                unsigned uv[32];
#pragma unroll
                for (int r = 0; r < 32; ++r) uv[r] = *(const unsigned*)(base + (size_t)r * D);
#pragma unroll
                for (int r = 0; r < 32; ++r) { s0 += bflo(uv[r]); s1 += bfhi(uv[r]); }
                redB[rg * 128 + dp * 2] = s0; redB[rg * 128 + dp * 2 + 1] = s1;
            }
        }
        __syncthreads();
        if (tid < 128) {
            float s = 0.f;
            if (tid < 32) { for (int r = 0; r < 32; ++r) s += redA[r * 32 + tid]; }
            else { for (int r = 0; r < 8; ++r) s += redB[r * 128 + tid]; }
            kmean[(size_t)item * 128 + tid] = s * (1.f / 256.f);
        }
        __syncthreads();
    }
}

DI void attn_phase(int tid_, int bid_, const bf16_t* Q, const bf16_t* Kx, const bf16_t* VT, bf16_t* O, const float* kmean, unsigned char* smem) {
    constexpr int KB_STRIDE = 288, VB_STRIDE = 160;
    constexpr int KBUF = 64 * KB_STRIDE, VBUF = 128 * VB_STRIDE;
    constexpr float QC = 0.08838834764831845f * 1.4426950408889634f;
    constexpr float THR_RAW = 8.0f / 0.08838834764831845f;
#define KBUFP(bi) (smem + (bi) * KBUF)
#define VBUFP(bi) (smem + 2 * KBUF + (bi) * VBUF)
    float* km = (float*)(smem + 2 * KBUF + 2 * VBUF);
    const int tid = tid_, wid = tid >> 6, lane = tid & 63, fr = lane & 15, fq = lane >> 4;
    for (int idx = bid_; idx < 1024; idx += gridDim.x) {
        const int bh = idx & 63, jj = idx >> 6, sub = jj & 3, r2 = jj >> 2;
        const int qb = (r2 == 0) ? sub : (r2 == 1) ? (7 - sub) : (r2 == 2) ? (8 + sub) : (15 - sub);
        const int b = bh >> 4, h = bh & 15;
        const size_t tok0 = (size_t)b * SEQ;
        const int qloc0 = wid * 32 + fr;
        { const f32x4 kv = *(const f32x4*)(kmean + (size_t)bh * 2048 + tid * 4); *(f32x4*)(km + tid * 4) = kv; }
        bf16x8 qf[2][4];
#pragma unroll
        for (int qt = 0; qt < 2; ++qt)
#pragma unroll
            for (int dc = 0; dc < 4; ++dc) qf[qt][dc] = *(const bf16x8*)(Q + (tok0 + qb * 256 + qloc0 + qt * 16) * D + h * 128 + dc * 32 + fq * 8);
        __syncthreads();
        const int ntile = (qb + 1) * 4;
        const int kr0 = tid >> 4, kc0 = tid & 15;
        const int vr0 = tid >> 3, vc0 = tid & 7;
        u32x4 kreg0[2], vreg0[2];
        auto gload = [&](int tt, u32x4 (&kreg)[2], u32x4 (&vreg)[2]) {
            const int key0 = tt * 64;
#pragma unroll
            for (int i = 0; i < 2; ++i) {
                kreg[i] = *(const u32x4*)(Kx + (tok0 + key0 + kr0 + i * 32) * D + h * 128 + kc0 * 8);
                vreg[i] = *(const u32x4*)(VT + (size_t)(h * 128 + vr0 + i * 64) * T + tok0 + key0 + vc0 * 8);
            }
        };
        auto lstore = [&](int bi, const u32x4 (&kreg)[2], const u32x4 (&vreg)[2]) {
#pragma unroll
            for (int i = 0; i < 2; ++i) {
                *(u32x4*)(KBUFP(bi) + (kr0 + i * 32) * KB_STRIDE + kc0 * 16) = kreg[i];
                {
                    unsigned char* vrow = VBUFP(bi) + (vr0 + i * 64) * VB_STRIDE + (vc0 >> 2) * 64;
                    const int c = vc0 & 3, p0 = ((c & 1) * 2) * 16 + (c >> 1) * 8;
                    u32x2 lo = {vreg[i][0], vreg[i][1]}, hi = {vreg[i][2], vreg[i][3]};
                    *(u32x2*)(vrow + p0) = lo; *(u32x2*)(vrow + p0 + 16) = hi;
                }
            }
        };
        gload(0, kreg0, vreg0);
        unsigned mask[2];
#pragma unroll
        for (int qt = 0; qt < 2; ++qt) {
            float v0 = -3e38f, v1 = -3e38f, v2 = -3e38f; int i0 = -1, i1 = -1, i2 = -1;
            for (int j = 0; j < qb; ++j) {
                float g = 0.f;
#pragma unroll
                for (int dc = 0; dc < 4; ++dc) {
                    const f32x4 ka = *(const f32x4*)(km + j * 128 + dc * 32 + fq * 8), kb2 = *(const f32x4*)(km + j * 128 + dc * 32 + fq * 8 + 4);
#pragma unroll
                    for (int e = 0; e < 4; ++e) { g += bf2f((bf16_t)qf[qt][dc][e]) * ka[e]; g += bf2f((bf16_t)qf[qt][dc][4 + e]) * kb2[e]; }
                }
                g = xsum_fq(g);
                if (g > v0) { v2 = v1; i2 = i1; v1 = v0; i1 = i0; v0 = g; i0 = j; }
                else if (g > v1) { v2 = v1; i2 = i1; v1 = g; i1 = j; }
                else if (g > v2) { v2 = g; i2 = j; }
            }
            unsigned mk = 0u;
            if (i0 >= 0) mk |= 1u << i0;
            if (i1 >= 0) mk |= 1u << i1;
            if (i2 >= 0) mk |= 1u << i2;
            mask[qt] = mk;
        }
        float mrun[2] = {-1e30f, -1e30f}, lrun[2] = {0.f, 0.f};
        f32x4 oacc[2][8];
#pragma unroll
        for (int qt = 0; qt < 2; ++qt)
#pragma unroll
            for (int dt = 0; dt < 8; ++dt) oacc[qt][dt] = (f32x4){0.f, 0.f, 0.f, 0.f};
        auto compute = [&](int tt, int bi) {
            const int kb = tt >> 2, kt64 = tt & 3;
            const bool own = (kb == qb);
            bool actq[2];
#pragma unroll
            for (int qt = 0; qt < 2; ++qt) actq[qt] = own ? true : (((mask[qt] >> kb) & 1u) != 0u);
            const bool doit = own ? (kt64 * 64 <= wid * 32 + 31) : (__any((int)(actq[0] || actq[1])) != 0);
            const bool elem = own && (kt64 * 64 + 63 > wid * 32);
            if (doit) {
                f32x4 sacc[2][4];
#pragma unroll
                for (int qt = 0; qt < 2; ++qt)
#pragma unroll
                    for (int kt = 0; kt < 4; ++kt) sacc[qt][kt] = (f32x4){0.f, 0.f, 0.f, 0.f};
#pragma unroll
                for (int dc = 0; dc < 4; ++dc)
#pragma unroll
                    for (int kt = 0; kt < 4; ++kt) {
                        const bf16x8 kf = *(const bf16x8*)(KBUFP(bi) + (kt * 16 + fr) * KB_STRIDE + dc * 64 + fq * 16);
#pragma unroll
                        for (int qt = 0; qt < 2; ++qt) sacc[qt][kt] = __builtin_amdgcn_mfma_f32_16x16x32_bf16(kf, qf[qt][dc], sacc[qt][kt], 0, 0, 0);
                    }
                bf16x8 pf[2][2];
#pragma unroll
                for (int qt = 0; qt < 2; ++qt) {
                    const int lim = own ? (qloc0 + qt * 16 - kt64 * 64 - fq * 4) : (actq[qt] ? 1000 : -1000);
                    float mx = -1e30f;
                    if (elem) {
#pragma unroll
                        for (int kt = 0; kt < 4; ++kt)
#pragma unroll
                            for (int r = 0; r < 4; ++r) {
                                const float sv = (kt * 16 + r <= lim) ? sacc[qt][kt][r] : -__builtin_inff();
                                sacc[qt][kt][r] = sv; mx = fmaxf(mx, sv);
                            }
                    } else {
#pragma unroll
                        for (int kt = 0; kt < 4; ++kt)
#pragma unroll
                            for (int r = 0; r < 4; ++r) mx = fmaxf(mx, sacc[qt][kt][r]);
                        mx = actq[qt] ? mx : -__builtin_inff();
                    }
                    mx = xmax_fq(mx);
                    if (__any((int)(mx > mrun[qt] + THR_RAW))) {
                        const float mnew = fmaxf(mrun[qt], mx);
                        const float alpha = __builtin_amdgcn_exp2f((mrun[qt] - mnew) * QC);
                        mrun[qt] = mnew;
                        lrun[qt] *= alpha;
#pragma unroll
                        for (int dt = 0; dt < 8; ++dt) oacc[qt][dt] *= alpha;
                    }
                    const float mneg = (elem || actq[qt]) ? -mrun[qt] * QC : -__builtin_inff();
                    float ps = 0.f;
#pragma unroll
                    for (int kt = 0; kt < 4; ++kt)
#pragma unroll
                        for (int r = 0; r < 4; ++r) { const float pe = __builtin_amdgcn_exp2f(__builtin_fmaf(sacc[qt][kt][r], QC, mneg)); sacc[qt][kt][r] = pe; ps += pe; }
                    lrun[qt] += ps;
#pragma unroll
                    for (int ks = 0; ks < 2; ++ks) {
                        u32x4 w = {pk_bf16(sacc[qt][2 * ks][0], sacc[qt][2 * ks][1]), pk_bf16(sacc[qt][2 * ks][2], sacc[qt][2 * ks][3]),
                                   pk_bf16(sacc[qt][2 * ks + 1][0], sacc[qt][2 * ks + 1][1]), pk_bf16(sacc[qt][2 * ks + 1][2], sacc[qt][2 * ks + 1][3])};
                        pf[qt][ks] = __builtin_bit_cast(bf16x8, w);
                    }
                }
#pragma unroll
                for (int ks = 0; ks < 2; ++ks)
#pragma unroll
                    for (int dt = 0; dt < 8; ++dt) {
                        const bf16x8 vf = *(const bf16x8*)(VBUFP(bi) + (dt * 16 + fr) * VB_STRIDE + ks * 64 + fq * 16);
#pragma unroll
                        for (int qt = 0; qt < 2; ++qt) oacc[qt][dt] = __builtin_amdgcn_mfma_f32_16x16x32_bf16(vf, pf[qt][ks], oacc[qt][dt], 0, 0, 0);
                    }
            }
        };
        lstore(0, kreg0, vreg0);
        __syncthreads();
        for (int tt = 0; tt < ntile; tt += 2) {
            if (tt + 1 < ntile) gload(tt + 1, kreg0, vreg0);
            compute(tt, 0);
            if (tt + 1 < ntile) lstore(1, kreg0, vreg0);
            lds_barrier();
            if (tt + 1 < ntile) {
                if (tt + 2 < ntile) gload(tt + 2, kreg0, vreg0);
                compute(tt + 1, 1);
                if (tt + 2 < ntile) lstore(0, kreg0, vreg0);
                lds_barrier();
            }
        }
        __syncthreads();
#pragma unroll
        for (int qt = 0; qt < 2; ++qt) {
            const float lt = xsum_fq(lrun[qt]);
            const float inv = 1.f / lt;
            bf16_t* orow = O + (tok0 + qb * 256 + qloc0 + qt * 16) * D + h * 128 + fq * 4;
#pragma unroll
            for (int dt = 0; dt < 8; ++dt) {
                const f32x4 o = oacc[qt][dt] * inv;
                u32x2 w = {pk_bf16(o[0], o[1]), pk_bf16(o[2], o[3])};
                *(u32x2*)(orow + dt * 16) = w;
            }
        }
    }
#undef KBUFP
#undef VBUFP
}

DI void rwkv_mix_phase(int tid_, int bid_, const float* x, const float* mu, bf16_t* slots) {
    const size_t n4 = (size_t)T * D / 4;
    const size_t stride = (size_t)gridDim.x * 512;
    constexpr int U = 8;
    for (size_t ib = (size_t)bid_ * 512 + tid_; ib < n4; ib += stride * U) {
        f32x4 xv[U], xp[U];
#pragma unroll
        for (int u = 0; u < U; ++u) {
            const size_t i = ib + u * stride;
            const int t = (int)(i >> 9), s_ = t & (SEQ - 1);
            xv[u] = (i < n4) ? *(const f32x4*)(x + i * 4) : (f32x4){0.f, 0.f, 0.f, 0.f};
            xp[u] = (i < n4 && s_ > 0) ? *(const f32x4*)(x + i * 4 - D) : (f32x4){0.f, 0.f, 0.f, 0.f};
        }
#pragma unroll
        for (int u = 0; u < U; ++u) {
            const size_t i = ib + u * stride;
            if (i >= n4) break;
            const int c = (int)(i & 511) * 4;
            const f32x4 xx = xp[u] - xv[u];
#pragma unroll
            for (int k = 0; k < 6; ++k) {
                const f32x4 m = *(const f32x4*)(mu + k * D + c);
                const f32x4 o = xv[u] + xx * m;
                u32x2 w = {pk_bf16(o[0], o[1]), pk_bf16(o[2], o[3])};
                *(u32x2*)((unsigned char*)slots + k * SLOT + i * 8) = w;
            }
        }
    }
}
DI float softplusf_(float y) { return fmaxf(y, 0.f) + __logf(1.f + __expf(-fabsf(y))); }
DI void rwkv_prep_phase(int tid_, int bid_, const Params& p, unsigned char* sl, float* scal) {
    bf16_t* R = (bf16_t*)(sl + 6 * SLOT); bf16_t* Kk = (bf16_t*)(sl + 7 * SLOT);
    const bf16_t* WP = (const bf16_t*)(sl + 0 * SLOT); bf16_t* AP = (bf16_t*)(sl + 1 * SLOT);
    bf16_t* KX = (bf16_t*)(sl + 3 * SLOT); float* WD = (float*)(sl + 4 * SLOT);
    const float* w0 = p.in[18]; const float* a0 = p.in[21]; const float* k_k = p.in[26]; const float* k_a = p.in[27]; const float* r_k = p.in[28];
    float* BR = scal; float* KR = scal + (size_t)T * 32; float* BO = scal + (size_t)2 * T * 32;
    const int lane = tid_ & 63, wid = tid_ >> 6, hq = lane >> 4, k4 = (lane & 15) * 4;
    constexpr int U = 4;
    for (int grp = bid_ * 8 + wid; grp < T * 2; grp += gridDim.x * 8) {
        const size_t t = (size_t)(grp >> 1); const int q0 = (grp & 1) * 4;
        const size_t o0 = t * D + (size_t)(q0 * 4 + hq) * 64 + k4;
        u32x2 rr[U], kr_[U], wpr[U], apr[U];
#pragma unroll
        for (int u = 0; u < U; ++u) { rr[u] = *(const u32x2*)(R + o0 + u * 256); kr_[u] = *(const u32x2*)(Kk + o0 + u * 256); wpr[u] = *(const u32x2*)(WP + o0 + u * 256); apr[u] = *(const u32x2*)(AP + o0 + u * 256); }
#pragma unroll
        for (int u = 0; u < U; ++u) {
            const int h = (q0 + u) * 4 + hq, c = h * 64 + k4; const size_t o = o0 + u * 256;
            const f32x4 w0v = *(const f32x4*)(w0 + c), a0v = *(const f32x4*)(a0 + c), kkv = *(const f32x4*)(k_k + c), kav = *(const f32x4*)(k_a + c), rkv = *(const f32x4*)(r_k + c);
            const float r[4] = {bflo(rr[u][0]), bfhi(rr[u][0]), bflo(rr[u][1]), bfhi(rr[u][1])}, k[4] = {bflo(kr_[u][0]), bfhi(kr_[u][0]), bflo(kr_[u][1]), bfhi(kr_[u][1])};
            const float wp[4] = {bflo(wpr[u][0]), bfhi(wpr[u][0]), bflo(wpr[u][1]), bfhi(wpr[u][1])}, ap[4] = {bflo(apr[u][0]), bfhi(apr[u][0]), bflo(apr[u][1]), bfhi(apr[u][1])};
            float dec[4], a[4], kk[4], kx[4]; float ss = 0.f;
#pragma unroll
            for (int e = 0; e < 4; ++e) {
                const float wlog = -softplusf_(-(w0v[e] + wp[e])) - 0.5f;
                dec[e] = __expf(-__expf(wlog));
                a[e] = __builtin_amdgcn_rcpf(1.f + __expf(-(a0v[e] + ap[e])));
                kk[e] = k[e] * kkv[e]; ss += kk[e] * kk[e];
                kx[e] = k[e] * (1.f + (a[e] - 1.f) * kav[e]);
            }
            const float rn = fminf(__builtin_amdgcn_rsqf(row_sum16(ss)), 1e12f);
            float bb[4], s1 = 0.f, s2 = 0.f, s3 = 0.f;
#pragma unroll
            for (int e = 0; e < 4; ++e) { kk[e] *= rn; bb[e] = kk[e] * a[e]; s1 += bb[e] * r[e]; s2 += kx[e] * r[e]; s3 += r[e] * kx[e] * rkv[e]; }
            const float br = row_sum16(s1), kr = row_sum16(s2), bo = row_sum16(s3);
            { u32x2 w = {pk_bf16(dec[0] * r[0], dec[1] * r[1]), pk_bf16(dec[2] * r[2], dec[3] * r[3])}; *(u32x2*)(R + o) = w; }
            { u32x2 w = {pk_bf16(-kk[0], -kk[1]), pk_bf16(-kk[2], -kk[3])}; *(u32x2*)(Kk + o) = w; }
            { u32x2 w = {pk_bf16(bb[0], bb[1]), pk_bf16(bb[2], bb[3])}; *(u32x2*)(AP + o) = w; }
            { u32x2 w = {pk_bf16(kx[0], kx[1]), pk_bf16(kx[2], kx[3])}; *(u32x2*)(KX + o) = w; }
            { f32x4 dv = {dec[0], dec[1], dec[2], dec[3]}; *(f32x4*)(WD + o) = dv; }
            if ((lane & 15) == 0) { const size_t it = t * 32 + h; BR[it] = br; KR[it] = kr; BO[it] = bo; }
        }
    }
}
DI float dpp_sum8(float v) {
    v += __int_as_float(__builtin_amdgcn_update_dpp(0, __float_as_int(v), 0xB1, 0xF, 0xF, false));
    v += __int_as_float(__builtin_amdgcn_update_dpp(0, __float_as_int(v), 0x4E, 0xF, 0xF, false));
    v += __int_as_float(__builtin_amdgcn_update_dpp(0, __float_as_int(v), 0x141, 0xF, 0xF, false));
    return v;
}
DI void rwkv_scan_phase(int tid_, int bid_, unsigned char* sl, const float* scal, unsigned char* smem) {
    constexpr int TC = 32;
    constexpr int OFF_BB = TC * 128, OFF_KX = OFF_BB + TC * 64, OFF_W = OFF_KX + TC * 64, OFF_V = OFF_W + TC * 64, OFF_SC = OFF_V + TC * 32, BUF_F = OFF_SC + TC * 2;
    constexpr int NCH = SEQ / TC;
#define SBUF(i) ((float*)smem + (i) * BUF_F)
    const bf16_t* NKK = (const bf16_t*)(sl + 7 * SLOT); const bf16_t* WR = (const bf16_t*)(sl + 6 * SLOT);
    const bf16_t* BB = (const bf16_t*)(sl + 1 * SLOT); const bf16_t* KX = (const bf16_t*)(sl + 3 * SLOT);
    const float* WD = (const float*)(sl + 4 * SLOT); const bf16_t* V = (const bf16_t*)(sl + 8 * SLOT);
    bf16_t* Y = (bf16_t*)(sl + 0 * SLOT);
    const float* BR = scal; const float* KR = scal + (size_t)T * 32;
    const int tid = tid_, wid = tid >> 6, lane = tid & 63;
    for (int item = bid_; item < 256; item += gridDim.x) {
        const int half = item & 1, h = (item >> 1) & 31, b = item >> 6;
        const size_t tok0 = (size_t)b * SEQ;
        if (wid >= 4) {
            const int lt = tid - 256, lt_t = lt >> 3, lt_c = lt & 7;
            u32x4 r_nk, r_wr, r_bb, r_kx, r_v = {0u, 0u, 0u, 0u}; f32x4 r_w0, r_w1; float r_s = 0.f;
            auto gload = [&](int c) {
                const size_t tb = tok0 + (size_t)c * TC;
                const size_t o = (tb + lt_t) * D + h * 64 + lt_c * 8;
                r_nk = *(const u32x4*)(NKK + o); r_wr = *(const u32x4*)(WR + o); r_bb = *(const u32x4*)(BB + o); r_kx = *(const u32x4*)(KX + o);
                r_w0 = *(const f32x4*)(WD + (tb + (lt >> 4)) * D + h * 64 + (lt & 15) * 4);
                r_w1 = *(const f32x4*)(WD + (tb + 16 + (lt >> 4)) * D + h * 64 + (lt & 15) * 4);
                if (lt < 128) r_v = *(const u32x4*)(V + (tb + (lt >> 2)) * D + h * 64 + half * 32 + (lt & 3) * 8);
                else if (lt < 192) { const int i = lt - 128; r_s = ((i & 1) ? KR : BR)[(tb + (i >> 1)) * 32 + h]; }
            };
            auto lstore = [&](float* F) {
                float* pp = F + lt_t * 128 + lt_c * 16;
#pragma unroll
                for (int j = 0; j < 4; ++j) { f32x4 q = {bflo(r_nk[j]), bflo(r_wr[j]), bfhi(r_nk[j]), bfhi(r_wr[j])}; *(f32x4*)(pp + j * 4) = q; }
                { float* d = F + OFF_BB + lt_t * 64 + lt_c * 8;
                  f32x4 lo = {bflo(r_bb[0]), bfhi(r_bb[0]), bflo(r_bb[1]), bfhi(r_bb[1])}, hi = {bflo(r_bb[2]), bfhi(r_bb[2]), bflo(r_bb[3]), bfhi(r_bb[3])};
                  *(f32x4*)d = lo; *(f32x4*)(d + 4) = hi; }
                { float* d = F + OFF_KX + lt_t * 64 + lt_c * 8;
                  f32x4 lo = {bflo(r_kx[0]), bfhi(r_kx[0]), bflo(r_kx[1]), bfhi(r_kx[1])}, hi = {bflo(r_kx[2]), bfhi(r_kx[2]), bflo(r_kx[3]), bfhi(r_kx[3])};
                  *(f32x4*)d = lo; *(f32x4*)(d + 4) = hi; }
                *(f32x4*)(F + OFF_W + (lt >> 4) * 64 + (lt & 15) * 4) = r_w0;
                *(f32x4*)(F + OFF_W + (16 + (lt >> 4)) * 64 + (lt & 15) * 4) = r_w1;
                if (lt < 128) { float* d = F + OFF_V + (lt >> 2) * 32 + (lt & 3) * 8;
                  f32x4 lo = {bflo(r_v[0]), bfhi(r_v[0]), bflo(r_v[1]), bfhi(r_v[1])}, hi = {bflo(r_v[2]), bfhi(r_v[2]), bflo(r_v[3]), bfhi(r_v[3])};
                  *(f32x4*)d = lo; *(f32x4*)(d + 4) = hi; }
                else if (lt < 192) F[OFF_SC + (lt - 128)] = r_s;
            };
            gload(0); lstore(SBUF(0)); gload(1);
            __syncthreads();
            for (int c = 0; c < NCH; ++c) {
                if (c + 1 < NCH) lstore(SBUF((c + 1) & 1));
                if (c + 2 < NCH) gload(c + 2);
                lds_barrier();
            }
        } else {
            const int kq = lane & 7, rl = wid * 8 + (lane >> 3);
            f32x2 st[4];
#pragma unroll
            for (int j = 0; j < 4; ++j) st[j] = (f32x2){0.f, 0.f};
            bf16_t* yp = Y + (tok0 + kq) * D + h * 64 + half * 32 + rl;
            __syncthreads();
            struct Ops { f32x4 pq[4], b0, b1, k0, k1, w0, w1; float vv; f32x2 sc; };
            for (int c = 0; c < NCH; ++c) {
                const float* F = SBUF(c & 1);
                const float* fp = F + kq * 16;
                const float* fb = F + OFF_BB + kq * 8;
                auto ld = [&](Ops& o, int t) {
#pragma unroll
                    for (int j = 0; j < 4; ++j) o.pq[j] = *(const f32x4*)(fp + t * 128 + j * 4);
                    o.b0 = *(const f32x4*)(fb + t * 64); o.b1 = *(const f32x4*)(fb + t * 64 + 4);
                    o.k0 = *(const f32x4*)(fb + (OFF_KX - OFF_BB) + t * 64); o.k1 = *(const f32x4*)(fb + (OFF_KX - OFF_BB) + t * 64 + 4);
                    o.w0 = *(const f32x4*)(fb + (OFF_W - OFF_BB) + t * 64); o.w1 = *(const f32x4*)(fb + (OFF_W - OFF_BB) + t * 64 + 4);
                    o.vv = F[OFF_V + t * 32 + rl]; o.sc = *(const f32x2*)(F + OFF_SC + t * 2);
                };
                auto dots = [&](const Ops& o) -> f32x2 {
                    f32x2 acc = {0.f, 0.f}, acc2 = {0.f, 0.f};
#pragma unroll
                    for (int j = 0; j < 4; ++j) {
                        acc += st[j][0] * (f32x2){o.pq[j][0], o.pq[j][1]};
                        acc2 += st[j][1] * (f32x2){o.pq[j][2], o.pq[j][3]};
                    }
                    return acc + acc2;
                };
                auto update = [&](const Ops& o, f32x2 acc) -> float {
                    const float d1 = dpp_sum8(acc[0]), d2 = dpp_sum8(acc[1]);
                    st[0] = st[0] * (f32x2){o.w0[0], o.w0[1]} + d1 * (f32x2){o.b0[0], o.b0[1]} + o.vv * (f32x2){o.k0[0], o.k0[1]};
                    st[1] = st[1] * (f32x2){o.w0[2], o.w0[3]} + d1 * (f32x2){o.b0[2], o.b0[3]} + o.vv * (f32x2){o.k0[2], o.k0[3]};
                    st[2] = st[2] * (f32x2){o.w1[0], o.w1[1]} + d1 * (f32x2){o.b1[0], o.b1[1]} + o.vv * (f32x2){o.k1[0], o.k1[1]};
                    st[3] = st[3] * (f32x2){o.w1[2], o.w1[3]} + d1 * (f32x2){o.b1[2], o.b1[3]} + o.vv * (f32x2){o.k1[2], o.k1[3]};
                    return d2 + d1 * o.sc[0] + o.vv * o.sc[1];
                };
                Ops os[3];
                ld(os[0], 0); ld(os[1], 1);
                float yv = 0.f;
#pragma unroll
                for (int t = 0; t < TC; ++t) {
                    const f32x2 da = dots(os[t % 3]);
                    __builtin_amdgcn_sched_barrier(0);
                    if (t + 2 < TC) ld(os[(t + 2) % 3], t + 2);
                    __builtin_amdgcn_sched_barrier(0);
                    const float ya = update(os[t % 3], da);
                    yv = (kq == (t & 7)) ? ya : yv;
                    if ((t & 7) == 7) yp[(size_t)(c * TC + (t & ~7)) * D] = f2bf(yv);
                }
                lds_barrier();
            }
        }
        __syncthreads();
    }
#undef SBUF
}
DI void rwkv_post_phase(int tid_, int bid_, const Params& p, unsigned char* sl, const float* scal) {
    const bf16_t* Y = (const bf16_t*)(sl + 0 * SLOT); const bf16_t* V = (const bf16_t*)(sl + 8 * SLOT); const bf16_t* G = (const bf16_t*)(sl + 2 * SLOT);
    bf16_t* OUT = (bf16_t*)(sl + 3 * SLOT);
    const float* lg = p.in[29]; const float* lb = p.in[30]; const float* BO = scal + (size_t)2 * T * 32;
    const int lane = tid_ & 63, wid = tid_ >> 6, hq = lane >> 4, k4 = (lane & 15) * 4;
    constexpr int U = 4;
    for (int grp = bid_ * 8 + wid; grp < T * 2; grp += gridDim.x * 8) {
        const size_t t = (size_t)(grp >> 1); const int q0 = (grp & 1) * 4;
        const size_t o0 = t * D + (size_t)(q0 * 4 + hq) * 64 + k4;
        u32x2 yr[U], vr[U], gr[U]; float bor[U];
#pragma unroll
        for (int u = 0; u < U; ++u) { yr[u] = *(const u32x2*)(Y + o0 + u * 256); vr[u] = *(const u32x2*)(V + o0 + u * 256); gr[u] = *(const u32x2*)(G + o0 + u * 256); bor[u] = BO[t * 32 + (q0 + u) * 4 + hq]; }
#pragma unroll
        for (int u = 0; u < U; ++u) {
            const int c = ((q0 + u) * 4 + hq) * 64 + k4;
            const f32x4 lgv = *(const f32x4*)(lg + c), lbv = *(const f32x4*)(lb + c);
            const float y[4] = {bflo(yr[u][0]), bfhi(yr[u][0]), bflo(yr[u][1]), bfhi(yr[u][1])};
            const float vv[4] = {bflo(vr[u][0]), bfhi(vr[u][0]), bflo(vr[u][1]), bfhi(vr[u][1])};
            const float gg[4] = {bflo(gr[u][0]), bfhi(gr[u][0]), bflo(gr[u][1]), bfhi(gr[u][1])};
            const float mean = row_sum16(y[0] + y[1] + y[2] + y[3]) * (1.f / 64.f);
            float d[4], q = 0.f;
#pragma unroll
            for (int e = 0; e < 4; ++e) { d[e] = y[e] - mean; q += d[e] * d[e]; }
            const float rs = rsqrtf(row_sum16(q) * (1.f / 64.f) + 64e-5f);
            float r[4];
#pragma unroll
            for (int e = 0; e < 4; ++e) r[e] = (d[e] * rs * lgv[e] + lbv[e] + bor[u] * vv[e]) * gg[e];
            u32x2 w = {pk_bf16(r[0], r[1]), pk_bf16(r[2], r[3])};
            *(u32x2*)(OUT + o0 + u * 256) = w;
        }
    }
}

DI void pool_phase(int tid_, int bid_, const float* x, bf16_t* outp) {
    constexpr int CH = 32;
    const int tid = tid_, c = tid * 4, w = 2 << (c >> 9);
    for (int item = bid_; item < T / CH; item += gridDim.x) {
        const int t0 = item * CH, s0 = t0 & (SEQ - 1);
        f32x4 sum = {0.f, 0.f, 0.f, 0.f};
#pragma unroll
        for (int j = 1; j <= 16; ++j) if (j <= w && s0 - j >= 0) sum += *(const f32x4*)(x + (size_t)(t0 - j) * D + c);
#pragma unroll 16
        for (int tt = 0; tt < CH; ++tt) {
            const int t = t0 + tt, s = s0 + tt;
            const f32x4 xv = *(const f32x4*)(x + (size_t)t * D + c);
            sum += xv;
            if (s - w >= 0) sum -= *(const f32x4*)(x + (size_t)(t - w) * D + c);
            const float rc = __builtin_amdgcn_rcpf((float)((s + 1 < w) ? (s + 1) : w));
            const f32x4 o = sum * rc - xv;
            u32x2 wv = {pk_bf16(o[0], o[1]), pk_bf16(o[2], o[3])};
            *(u32x2*)(outp + (size_t)t * D + c) = wv;
        }
    }
}

#define XB_TMO      128
#define XB_XCNT(j)  (256  + 64 * (j))
#define XB_XSUB(j)  (1280 + 64 * (j))
#define XB_XGEN(j)  (2304 + 64 * (j))
#define XB_TOP      3328
#define XB_TOPGEN   3392
#define XCD_BAR_WORDS 3456
#define XB_SPIN_CAP (1u << 18)
DI unsigned xb_ld(unsigned* p) { return __hip_atomic_load(p, __ATOMIC_RELAXED, __HIP_MEMORY_SCOPE_AGENT); }
DI unsigned xb_add(unsigned* p, unsigned v) { return __hip_atomic_fetch_add(p, v, __ATOMIC_RELAXED, __HIP_MEMORY_SCOPE_AGENT); }
DI unsigned xb_xcc_id() { return (unsigned)__builtin_amdgcn_s_getreg((3 << 11) | 20) & 0xFu; }
#define XB_SPIN(cond, bar) do { unsigned _sp = 0; while (cond) { __builtin_amdgcn_s_sleep(1); \
    if ((++_sp & 255u) == 0u) { if (xb_ld(&(bar)[XB_TMO])) break; if (_sp > XB_SPIN_CAP) { atomicAdd(&(bar)[XB_TMO], 1u); break; } } } } while (0)
struct XcdBarrier { unsigned* bar; unsigned x; volatile LAS unsigned* st; };
DI XcdBarrier xcd_barrier_post(int tid, unsigned* bar, volatile LAS unsigned* st) {
    XcdBarrier b; b.bar = bar; b.x = xb_xcc_id(); b.st = st;
    if (tid == 0) (void)xb_add(&bar[XB_XCNT(b.x)], 1u);
    return b;
}
DI void xcd_barrier_complete(unsigned* bar, unsigned x, unsigned& nloc, unsigned& nx) {
    const unsigned G = gridDim.x * gridDim.y * gridDim.z;
    unsigned sum, cnt, mine, sp = 0u;
    for (;;) {
        sum = 0u; cnt = 0u; mine = 0u;
#pragma unroll
        for (unsigned j = 0; j < 16; ++j) { const unsigned c = xb_ld(&bar[XB_XCNT(j)]); sum += c; cnt += (c > 0u) ? 1u : 0u; mine = (j == x) ? c : mine; }
        if (sum == G) break;
        __builtin_amdgcn_s_sleep(1);
        if ((++sp & 255u) == 0u) { if (xb_ld(&bar[XB_TMO])) break; if (sp > XB_SPIN_CAP) { atomicAdd(&bar[XB_TMO], 1u); break; } }
    }
    nloc = mine > 0u ? mine : 1u; nx = cnt > 0u ? cnt : 1u;
}
DI void xcd_barrier(int tid, const XcdBarrier& b) {
    asm volatile("s_waitcnt vmcnt(0)" ::: "memory");
    __syncthreads();
    if (tid == 0) {
        unsigned* bar = b.bar;
        __builtin_amdgcn_s_waitcnt(0);
        unsigned nloc = b.st[0], nx = b.st[1];
        if (nloc == 0u) { xcd_barrier_complete(bar, b.x, nloc, nx); b.st[0] = nloc; b.st[1] = nx; }
        const unsigned old = xb_add(&bar[XB_XSUB(b.x)], 1u);
        const unsigned gen = old / nloc;
        if (old + 1u == (gen + 1u) * nloc) {
            __builtin_amdgcn_fence(__ATOMIC_RELEASE, "agent");
            asm volatile("s_waitcnt vmcnt(0)" ::: "memory");
            const unsigned og = xb_add(&bar[XB_TOP], 1u);
            const unsigned tg = og / nx;
            if (og + 1u == (tg + 1u) * nx) xb_add(&bar[XB_TOPGEN], 1u);
            else XB_SPIN(xb_ld(&bar[XB_TOPGEN]) == tg, bar);
            __builtin_amdgcn_fence(__ATOMIC_ACQUIRE, "agent");
            xb_add(&bar[XB_XGEN(b.x)], 1u);
            asm volatile("s_waitcnt vmcnt(0)" ::: "memory");
        } else {
            XB_SPIN(xb_ld(&bar[XB_XGEN(b.x)]) == gen, bar);
            __builtin_amdgcn_fence(__ATOMIC_ACQUIRE, "agent");
            asm volatile("s_waitcnt vmcnt(0)" ::: "memory");
        }
    }
    __syncthreads();
}

enum { K_PREP = 0, K_GACT, K_GRES, K_LN, K_RGCONV, K_RGSCAN0, K_RGSCAN1, K_KMEAN, K_ATTN, K_RMIX, K_RPREP, K_RSCAN, K_RPOST, K_POOL };
constexpr int NSTEPS = 38;
struct Desc {
    int kind;
    pg8::Gemm g;
    bf16_t* C; const float* res; const float* cscale; long sC; int ldc; unsigned acts;
    int lnidx, lnlast;
};
DI bool step_nosync(int st) { return st == 11 || st == 21; }
DI Desc make_desc(int st, const Params& p, unsigned char* ws) {
    unsigned char* sl = ws + O_SLOT;
    auto slot = [&](int i) { return (bf16_t*)(sl + (size_t)i * SLOT); };
    bf16_t* xb = slot(8);
    Desc d; d.kind = K_PREP; d.g = mk_gemm(nullptr, nullptr, 0, 0, 0, 0, 0, 0, 0, 0);
    d.C = nullptr; d.res = nullptr; d.cscale = nullptr; d.sC = 0; d.ldc = D; d.acts = 0u; d.lnidx = 0; d.lnlast = 0;
    int layer = -1, sub = 0;
    if (st >= 7 && st < 11) { layer = 0; sub = st - 7; }
    else if (st >= 16 && st < 20) { layer = 1; sub = st - 16; }
    else if (st >= 28 && st < 32) { layer = 2; sub = st - 28; }
    else if (st >= 34 && st < 38) { layer = 3; sub = st - 34; }
    if (layer >= 0) {
        if (sub == 0) { d.kind = K_LN; d.lnidx = layer * 2; }
        else if (sub == 1) { d.kind = K_GACT; d.C = slot(0); d.ldc = DFF; d.acts = 1u;
            d.g = mk_gemm(xb, (const bf16_t*)(ws + O_W1T + (size_t)layer * DFF * D * 2), 0, 0, D, D, D, T / 256, DFF / 256, 1); }
        else if (sub == 2) { d.kind = K_GRES;
            d.g = mk_gemm(slot(0), (const bf16_t*)(ws + O_W2T + (size_t)layer * DFF * D * 2), 0, 0, DFF, DFF, DFF, T / 256, D / 256, 1); }
        else { d.kind = K_LN; d.lnidx = layer * 2 + 1; d.lnlast = (layer == 3); }
        return d;
    }
    switch (st) {
    case 0: d.kind = K_PREP; break;
    case 1: d.kind = K_GACT; d.C = slot(0); d.ldc = 4096;
            d.g = mk_gemm(xb, (const bf16_t*)(ws + O_WIN), 0, 0, D, D, D, T / 256, 4096 / 256, 1); break;
    case 2: d.kind = K_RGCONV; break;
    case 3: d.kind = K_GACT; d.C = slot(3); d.sC = 512; d.ldc = 4096;
            d.g = mk_gemm(slot(2), (const bf16_t*)(ws + O_GATES), 256, 512 * 256, D, 256, 256, T / 256, 2, 8); break;
    case 4: d.kind = K_RGSCAN0; break;
    case 5: d.kind = K_RGSCAN1; break;
    case 6: d.kind = K_GRES; d.res = p.in[0];
            d.g = mk_gemm(slot(5), (const bf16_t*)(ws + O_RGOUT), 0, 0, D, D, D, T / 256, D / 256, 1); break;
    case 11: d.kind = K_GACT; d.C = slot(0); d.sC = (long)T * D;
             d.g = mk_gemm(xb, (const bf16_t*)(ws + O_QKV), 0, (long)D * D, D, D, D, T / 256, D / 256, 2); break;
    case 12: d.kind = K_GACT; d.C = slot(2); d.ldc = T;
             d.g = mk_gemm((const bf16_t*)(ws + O_QKV + 2 * SZ_DD), xb, 0, 0, D, D, D, D / 256, T / 256, 1); break;
    case 13: d.kind = K_KMEAN; break;
    case 14: d.kind = K_ATTN; break;
    case 15: d.kind = K_GRES;
             d.g = mk_gemm(slot(3), (const bf16_t*)(ws + O_MOUT), 0, 0, D, D, D, T / 256, D / 256, 1); break;
    case 20: d.kind = K_RMIX; break;
    case 21: d.kind = K_GACT; d.C = slot(6); d.sC = (long)T * D;
             d.g = mk_gemm(slot(0), (const bf16_t*)(ws + O_RKV), (long)T * D, (long)D * D, D, D, D, T / 256, D / 256, 3); break;
    case 22: d.kind = K_GACT; d.C = (bf16_t*)(ws + O_L1O); d.sC = (long)T * 256; d.ldc = 256; d.acts = 0x302u;
             d.g = mk_gemm(slot(3), (const bf16_t*)(ws + O_L1), (long)T * D, (long)256 * D, D, D, D, T / 256, 1, 3); break;
    case 23: d.kind = K_GACT; d.C = slot(0); d.sC = (long)T * D;
             d.g = mk_gemm((const bf16_t*)(ws + O_L1O), (const bf16_t*)(ws + O_L2), (long)T * 256, (long)D * 256, 256, 256, 256, T / 256, D / 256, 3); break;
    case 24: d.kind = K_RPREP; break;
    case 25: d.kind = K_RSCAN; break;
    case 26: d.kind = K_RPOST; break;
    case 27: d.kind = K_GRES;
             d.g = mk_gemm(slot(3), (const bf16_t*)(ws + O_ROUT), 0, 0, D, D, D, T / 256, D / 256, 1); break;
    case 32: d.kind = K_POOL; break;
    case 33: d.kind = K_GRES; d.cscale = p.in[33]; d.sC = 512;
             d.g = mk_gemm(slot(0), (const bf16_t*)(ws + O_POOL), 512, 512 * 512, D, 512, 512, T / 256, 2, 4); break;
    default: break;
    }
    return d;
}

__global__ void __launch_bounds__(512, 2) fwd_megakernel(Params p) {
    extern __shared__ __attribute__((aligned(16))) unsigned char smem[];
    cg::grid_group grid = cg::this_grid();
    LAS unsigned char* lds = (LAS unsigned char*)smem;

    const bool multi = (p.hi - p.lo) > 1;
    volatile LAS unsigned* xst = (volatile LAS unsigned*)(lds + 131072);
    if (__builtin_amdgcn_workitem_id_x() == 0) { xst[0] = 0u; xst[1] = 0u; }
    __syncthreads();
    (void)xcd_barrier_post((int)__builtin_amdgcn_workitem_id_x(), (unsigned*)(p.ws + O_BAR), xst);
    for (int st = p.lo; st < p.hi; ++st) {
        int tid_ = (int)__builtin_amdgcn_workitem_id_x(); asm volatile("" : "+v"(tid_));
        int bid_ = (int)__builtin_amdgcn_workgroup_id_x(); asm volatile("" : "+s"(bid_));
        unsigned char* ws = p.ws; asm volatile("" : "+s"(ws));
        float* xcur = p.out; asm volatile("" : "+s"(xcur));
        unsigned char* sl = ws + O_SLOT;
        auto slot = [&](int i) { return (bf16_t*)(sl + (size_t)i * SLOT); };
        const int stu = __builtin_amdgcn_readfirstlane(st);
        const Desc d = make_desc(stu, p, ws);
        switch (__builtin_amdgcn_readfirstlane(d.kind)) {
        case K_PREP: prep_phase(tid_, bid_, p, smem); break;
        case K_GACT: { pg8::EpiAct E; E.C = d.C; E.sC = d.sC; E.ldc = d.ldc; E.acts = d.acts; pg8::gemm_phase(tid_, bid_, lds, d.g, E); } break;
        case K_GRES: { pg8::EpiRes E; E.out = xcur; E.res = d.res ? d.res : xcur; E.cscale = d.cscale; E.alpha = ALPHA; E.sC = d.sC; E.ldc = D; pg8::gemm_phase(tid_, bid_, lds, d.g, E); } break;
        case K_LN: ln_phase(tid_, bid_, xcur, xcur, d.lnlast ? nullptr : slot(8), p.in[1] + (size_t)d.lnidx * D, p.in[2] + (size_t)d.lnidx * D); break;
        case K_RGCONV: rg_conv_phase(tid_, bid_, slot(0), slot(2), p.in[6], p.in[7]); break;
        case K_RGSCAN0: rg_scan_phase<0>(tid_, bid_, p, slot(3), slot(2), slot(0), (float*)(ws + O_AGG), slot(5)); break;
        case K_RGSCAN1: rg_scan_phase<1>(tid_, bid_, p, slot(3), slot(2), slot(0), (float*)(ws + O_AGG), slot(5)); break;
        case K_KMEAN: kmean_phase(tid_, bid_, slot(0), slot(1), (float*)(ws + O_KMEAN), (const float*)(ws + O_ROPE), (const float*)(ws + O_ROPE) + SEQ * 16, smem); break;
        case K_ATTN: attn_phase(tid_, bid_, slot(0), slot(1), slot(2), slot(3), (const float*)(ws + O_KMEAN), smem); break;
        case K_RMIX: rwkv_mix_phase(tid_, bid_, xcur, p.in[16], slot(0)); break;
        case K_RPREP: rwkv_prep_phase(tid_, bid_, p, sl, (float*)(ws + O_SCAL)); break;
        case K_RSCAN: rwkv_scan_phase(tid_, bid_, sl, (const float*)(ws + O_SCAL), smem); break;
        case K_RPOST: rwkv_post_phase(tid_, bid_, p, sl, (const float*)(ws + O_SCAL)); break;
        case K_POOL: pool_phase(tid_, bid_, xcur, slot(0)); break;
        default: break;
        }
        if (multi && !step_nosync(st) && st + 1 < p.hi) { if (st == p.lo) grid.sync(); else { XcdBarrier xb; xb.bar = (unsigned*)(ws + O_BAR); xb.x = xb_xcc_id(); xb.st = (volatile LAS unsigned*)(lds + 131072); xcd_barrier(tid_, xb); } }
    }
}

extern "C" void kernel_launch(void* const* d_in, const int* in_sizes, int n_in, void* d_out, int out_size, void* d_ws, size_t ws_size, hipStream_t stream) {
    static int grid = 0;
    if (grid == 0) {
        if (n_in != 34 || out_size != T * D || ws_size < WS_END) { fprintf(stderr, "kernel_launch: unexpected shapes (n_in %d out %d ws %zu need %zu)\n", n_in, out_size, ws_size, (size_t)WS_END); grid = -1; return; }
        int dev = 0, cus = 0, per_cu = 0;
        hipGetDevice(&dev);
        hipDeviceGetAttribute(&cus, hipDeviceAttributeMultiprocessorCount, dev);
        if (hipFuncSetAttribute((const void*)fwd_megakernel, hipFuncAttributeMaxDynamicSharedMemorySize, LDS_BYTES) != hipSuccess) { fprintf(stderr, "kernel_launch: hipFuncSetAttribute failed\n"); grid = -1; return; }
        hipOccupancyMaxActiveBlocksPerMultiprocessor(&per_cu, (const void*)fwd_megakernel, 512, LDS_BYTES);
        if (per_cu < 1) { fprintf(stderr, "kernel_launch: occupancy query says %d blocks/CU\n", per_cu); per_cu = 1; }
        (void)hipGetLastError();
        grid = cus;
    }
    if (grid < 0) return;
    Params p{};
    for (int i = 0; i < 34; ++i) p.in[i] = (const float*)d_in[i];
    {
        unsigned char* ws = (unsigned char*)d_ws; int nj = 0, t0 = 0;
        auto add = [&](const float* src, size_t dstoff, int Ks, int Ns, int Kd, int Nd) {
            TJob& j = p.tj[nj]; j.src = src; j.dst = (bf16_t*)(ws + dstoff); j.Ks = Ks; j.Ns = Ns; j.Kd = Kd; j.Nd = Nd; j.tile0 = t0; j.pad = 0;
            t0 += (Kd / 128) * (Nd / 128); ++nj; };
        for (int l = 0; l < 4; ++l) add(p.in[3] + (size_t)l * D * DFF, O_W1T + (size_t)l * DFF * D * 2, D, DFF, D, DFF);
        for (int l = 0; l < 4; ++l) add(p.in[4] + (size_t)l * D * DFF, O_W2T + (size_t)l * DFF * D * 2, DFF, D, DFF, D);
        add(p.in[5], O_WIN, D, 4096, D, 4096);
        for (int n = 0; n < 8; ++n) { add(p.in[8] + (size_t)n * 65536, O_GATES + (size_t)n * 512 * 256 * 2, 256, 256, 256, 256);
                                      add(p.in[10] + (size_t)n * 65536, O_GATES + ((size_t)n * 512 + 256) * 256 * 2, 256, 256, 256, 256); }
        add(p.in[13], O_RGOUT, D, D, D, D);
        add(p.in[14], O_QKV, D, 3 * D, D, 3 * D);
        add(p.in[15], O_MOUT, D, D, D, D);
        for (int g = 0; g < 3; ++g) add(p.in[17] + (size_t)g * D * D, O_RKV + g * SZ_DD, D, D, D, D);
        add(p.in[19], O_L1 + 0 * (size_t)256 * D * 2, D, 96, D, 256);
        add(p.in[22], O_L1 + 1 * (size_t)256 * D * 2, D, 96, D, 256);
        add(p.in[24], O_L1 + 2 * (size_t)256 * D * 2, D, 256, D, 256);
        add(p.in[20], O_L2 + 0 * (size_t)D * 256 * 2, 96, D, 256, D);
        add(p.in[23], O_L2 + 1 * (size_t)D * 256 * 2, 96, D, 256, D);
        add(p.in[25], O_L2 + 2 * (size_t)D * 256 * 2, 256, D, 256, D);
        add(p.in[31], O_ROUT, D, D, D, D);
        for (int g = 0; g < 4; ++g) add(p.in[32] + (size_t)g * 512 * 512, O_POOL + (size_t)g * 512 * 512 * 2, 512, 512, 512, 512);
        p.ntiles = t0;
        if (nj != NTJ) fprintf(stderr, "kernel_launch: job table size %d != %d\n", nj, NTJ);
    }
    p.out = (float*)d_out; p.ws = (unsigned char*)d_ws; p.lo = 0; p.hi = NSTEPS;
    if (hipMemsetAsync((unsigned char*)d_ws + O_BAR, 0, BAR_BYTES, stream) != hipSuccess) { fprintf(stderr, "kernel_launch: memset of barrier words failed\n"); return; }
    void* args[] = {&p};
    hipError_t e = hipLaunchCooperativeKernel((const void*)fwd_megakernel, dim3(grid), dim3(512), args, LDS_BYTES, stream);
    if (e != hipSuccess) fprintf(stderr, "cooperative launch failed: %s (grid %d)\n", hipGetErrorString(e), grid);
}
```

```cpp
#include <hip/hip_runtime.h>
#include <hip/hip_cooperative_groups.h>
#include <cstdio>
namespace cg = cooperative_groups;

#define LAS __attribute__((address_space(3)))
typedef unsigned short bf16_t;
typedef short bf16x8 __attribute__((ext_vector_type(8)));
typedef float f32x4 __attribute__((ext_vector_type(4)));
typedef float f32x2 __attribute__((ext_vector_type(2)));
typedef unsigned u32x4 __attribute__((ext_vector_type(4)));
typedef unsigned u32x2 __attribute__((ext_vector_type(2)));
typedef __bf16 bfv2 __attribute__((ext_vector_type(2)));
#define DI __device__ __forceinline__

constexpr int T = 16384, D = 2048, SEQ = 4096, DFF = 8192;
constexpr float ALPHA = 1.6817928305074290f;
constexpr float LN_EPS = 1e-5f;

constexpr size_t SZ_DD = (size_t)D * D * 2;
constexpr size_t O_W1T = 0;
constexpr size_t O_W2T = O_W1T + 4 * (size_t)DFF * D * 2;
constexpr size_t O_WIN = O_W2T + 4 * (size_t)DFF * D * 2;
constexpr size_t O_GATES = O_WIN + (size_t)4096 * D * 2;
constexpr size_t O_RGOUT = O_GATES + (size_t)8 * 512 * 256 * 2;
constexpr size_t O_QKV = O_RGOUT + SZ_DD;
constexpr size_t O_MOUT = O_QKV + 3 * SZ_DD;
constexpr size_t O_RKV = O_MOUT + SZ_DD;
constexpr size_t O_L1 = O_RKV + 3 * SZ_DD;
constexpr size_t O_L2 = O_L1 + (size_t)3 * 256 * D * 2;
constexpr size_t O_ROUT = O_L2 + (size_t)3 * D * 256 * 2;
constexpr size_t O_POOL = O_ROUT + SZ_DD;
constexpr size_t O_SLOT = O_POOL + (size_t)4 * 512 * 512 * 2;
constexpr size_t SLOT = (size_t)T * D * 2;
constexpr size_t O_L1O = O_SLOT + 9 * SLOT;
constexpr size_t O_ROPE = O_L1O + (size_t)3 * T * 256 * 2;
constexpr size_t O_KMEAN = O_ROPE + (size_t)2 * SEQ * 16 * 4;
constexpr size_t O_AGG = O_KMEAN + (size_t)64 * 16 * 128 * 4;
constexpr size_t O_SCAL = O_AGG + (size_t)4 * 128 * D * 2 * 4;
constexpr size_t O_BAR = O_SCAL + (size_t)3 * T * 32 * 4;
constexpr size_t BAR_BYTES = 16384;
constexpr size_t WS_END = O_BAR + BAR_BYTES;

constexpr int LDS_BYTES = 131072 + 16;

struct TJob { const float* src; bf16_t* dst; int Ks, Ns, Kd, Nd, tile0, pad; };
constexpr int NTJ = 42;
struct Params {
    const float* in[34];
    float* out;
    unsigned char* ws;
    int lo, hi, ntiles, pad;
    TJob tj[NTJ];
};

DI unsigned pk_bf16(float a, float b) { f32x2 v = {a, b}; bfv2 r = __builtin_convertvector(v, bfv2); return __builtin_bit_cast(unsigned, r); }
DI bf16_t f2bf(float a) { return (bf16_t)(pk_bf16(a, 0.f) & 0xffffu); }
DI float bf2f(bf16_t b) { return __uint_as_float(((unsigned)b) << 16); }
DI float bflo(unsigned u) { return __uint_as_float(u << 16); }
DI float bfhi(unsigned u) { return __uint_as_float(u & 0xffff0000u); }
DI float wave_sum(float v) {
    v += __int_as_float(__builtin_amdgcn_update_dpp(0, __float_as_int(v), 0xB1, 0xF, 0xF, false));
    v += __int_as_float(__builtin_amdgcn_update_dpp(0, __float_as_int(v), 0x4E, 0xF, 0xF, false));
    v += __int_as_float(__builtin_amdgcn_update_dpp(0, __float_as_int(v), 0x141, 0xF, 0xF, false));
    v += __int_as_float(__builtin_amdgcn_update_dpp(0, __float_as_int(v), 0x140, 0xF, 0xF, false));
    const int iv = __float_as_int(v);
    return __int_as_float(__builtin_amdgcn_readlane(iv, 0)) + __int_as_float(__builtin_amdgcn_readlane(iv, 16)) +
           __int_as_float(__builtin_amdgcn_readlane(iv, 32)) + __int_as_float(__builtin_amdgcn_readlane(iv, 48));
}
DI float xmax_fq(float v) {
    const auto a = __builtin_amdgcn_permlane32_swap(__float_as_uint(v), __float_as_uint(v), false, false);
    v = fmaxf(__uint_as_float(a[0]), __uint_as_float(a[1]));
    const auto b = __builtin_amdgcn_permlane16_swap(__float_as_uint(v), __float_as_uint(v), false, false);
    return fmaxf(__uint_as_float(b[0]), __uint_as_float(b[1]));
}
DI float xsum_fq(float v) {
    const auto a = __builtin_amdgcn_permlane32_swap(__float_as_uint(v), __float_as_uint(v), false, false);
    v = __uint_as_float(a[0]) + __uint_as_float(a[1]);
    const auto b = __builtin_amdgcn_permlane16_swap(__float_as_uint(v), __float_as_uint(v), false, false);
    return __uint_as_float(b[0]) + __uint_as_float(b[1]);
}
DI float row_sum16(float v) {
    v += __int_as_float(__builtin_amdgcn_update_dpp(0, __float_as_int(v), 0xB1, 0xF, 0xF, false));
    v += __int_as_float(__builtin_amdgcn_update_dpp(0, __float_as_int(v), 0x4E, 0xF, 0xF, false));
    v += __int_as_float(__builtin_amdgcn_update_dpp(0, __float_as_int(v), 0x141, 0xF, 0xF, false));
    v += __int_as_float(__builtin_amdgcn_update_dpp(0, __float_as_int(v), 0x140, 0xF, 0xF, false));
    return v;
}
DI float half_sum(float v) {
    v += __int_as_float(__builtin_amdgcn_update_dpp(0, __float_as_int(v), 0xB1, 0xF, 0xF, false));
    v += __int_as_float(__builtin_amdgcn_update_dpp(0, __float_as_int(v), 0x4E, 0xF, 0xF, false));
    v += __int_as_float(__builtin_amdgcn_update_dpp(0, __float_as_int(v), 0x141, 0xF, 0xF, false));
    v += __int_as_float(__builtin_amdgcn_update_dpp(0, __float_as_int(v), 0x140, 0xF, 0xF, false));
    const auto b = __builtin_amdgcn_permlane16_swap(__float_as_uint(v), __float_as_uint(v), false, false);
    return __uint_as_float(b[0]) + __uint_as_float(b[1]);
}
DI void lds_barrier() { asm volatile("s_waitcnt lgkmcnt(0)" ::: "memory"); __builtin_amdgcn_s_barrier(); asm volatile("" ::: "memory"); }
DI float sigmoidf_(float x) { return __builtin_amdgcn_rcpf(1.f + __expf(-x)); }
DI float tanhf_(float x) { return 1.f - 2.f * __builtin_amdgcn_rcpf(1.f + __expf(2.f * x)); }
DI float gelu_tanh(float x) { const float u = 0.7978845608028654f * (x + 0.044715f * x * x * x); return 0.5f * x * (1.f + tanhf_(u)); }

namespace pg8 {
constexpr int BM = 256, BK = 64, HALF = 128, HTB = HALF * BK * 2, NXCD = 8, WGM = 4;
DI int lds_byte(int r, int c) { const int st = (r >> 4) * 2 + (c >> 5), rr = r & 15, cc = c & 31, ob = rr * 64 + cc * 2; return st * 1024 + (ob ^ (((ob >> 9) & 1) << 5)); }
DI void stage_rc(int b, int& R, int& C) { const int st = b / 1024, sb = b % 1024, swz = sb ^ (((sb >> 9) & 1) << 5); R = (st >> 1) * 16 + swz / 64; C = (st & 1) * 32 + (swz % 64) / 2; }
DI int perm32(int rho) { const int n = rho >> 4, i = rho & 15; return 8 * (i >> 2) + 4 * n + (i & 3); }

struct Unit { int g, pm, pn; };
struct Gemm { const bf16_t* A; const bf16_t* Bt; long sA, sB; int lda, ldb, K, nM, nN, G; };

struct Order {
    int nM, nN, nwg, tot, Gd, c;
    DI void init(const Gemm& g, int Gd_, int c_) { nM = g.nM; nN = g.nN; nwg = nM * nN; tot = nwg * g.G; Gd = Gd_; c = c_; }
    DI bool next(int i, Unit& u) const {
        const long L = (long)i * Gd + c; if (L >= tot) return false;
        const int grp = (int)(L / nwg); int wgid = (int)(L - (long)grp * nwg);
        { const int q = nwg / NXCD, r = nwg % NXCD, xcd = wgid % NXCD, off = wgid / NXCD; wgid = (xcd < r ? xcd * (q + 1) : r * (q + 1) + (xcd - r) * q) + off; }
        const int nig = WGM * nN, gid = wgid / nig, fm = gid * WGM, gsz = (nM - fm) < WGM ? (nM - fm) : WGM;
        u.g = grp; u.pm = fm + ((wgid % nig) % gsz); u.pn = (wgid % nig) / gsz; return true;
    }
};

struct EpiAct {
    static constexpr bool PERM = true;
    bf16_t* C; long sC; int ldc; unsigned acts;
    DI void operator()(const f32x4 (&acc)[2][2][4][2], const Unit& u, int wr, int wc, int fr, int fq) const {
        bf16_t* base = C + (size_t)u.g * sC;
        const int act = (int)((acts >> (4 * u.g)) & 15u);
        const int row0 = u.pm * BM + wr * 64 + fr, col0 = u.pn * BM + wc * 32 + 8 * fq;
#pragma unroll
        for (int ai = 0; ai < 2; ++ai)
#pragma unroll
            for (int m = 0; m < 4; ++m) {
                bf16_t* rowp = base + (size_t)(row0 + ai * HALF + m * 16) * ldc + col0;
#pragma unroll
                for (int bj = 0; bj < 2; ++bj) {
                    float v[8];
#pragma unroll
                    for (int e = 0; e < 4; ++e) { v[e] = acc[ai][bj][m][0][e]; v[4 + e] = acc[ai][bj][m][1][e]; }
                    if (act == 1) {
#pragma unroll
                        for (int e = 0; e < 8; ++e) { const float t = fmaxf(v[e], 0.f); v[e] = t * t; }
                    } else if (act == 2) {
#pragma unroll
                        for (int e = 0; e < 8; ++e) v[e] = tanhf_(v[e]);
                    } else if (act == 3) {
#pragma unroll
                        for (int e = 0; e < 8; ++e) v[e] = sigmoidf_(v[e]);
                    }
                    u32x4 o = {pk_bf16(v[0], v[1]), pk_bf16(v[2], v[3]), pk_bf16(v[4], v[5]), pk_bf16(v[6], v[7])};
                    *(u32x4*)(rowp + bj * HALF) = o;
                }
            }
    }
};
struct EpiRes {
    static constexpr bool PERM = false;
    float* out; const float* res; const float* cscale; float alpha; long sC; int ldc;
    DI void operator()(const f32x4 (&acc)[2][2][4][2], const Unit& u, int wr, int wc, int fr, int fq) const {
        const int row0 = u.pm * BM + wr * 64 + fr, col0 = (int)(u.g * sC) + u.pn * BM + wc * 32 + 4 * fq;
        f32x4 r[2][2][2][2];
        auto ldq = [&](int q, int buf) {
            const int ai = q >> 1, m0 = (q & 1) * 2;
#pragma unroll
            for (int mm = 0; mm < 2; ++mm) {
                const size_t ro = (size_t)(row0 + ai * HALF + (m0 + mm) * 16) * ldc + col0;
#pragma unroll
                for (int bj = 0; bj < 2; ++bj)
#pragma unroll
                    for (int n = 0; n < 2; ++n) r[buf][mm][bj][n] = *(const f32x4*)(res + ro + bj * HALF + n * 16);
            }
        };
        auto stq = [&](int q, int buf) {
            const int ai = q >> 1, m0 = (q & 1) * 2;
#pragma unroll
            for (int mm = 0; mm < 2; ++mm) {
                const size_t ro = (size_t)(row0 + ai * HALF + (m0 + mm) * 16) * ldc + col0;
#pragma unroll
                for (int bj = 0; bj < 2; ++bj)
#pragma unroll
                    for (int n = 0; n < 2; ++n) {
                        f32x4 a = acc[ai][bj][m0 + mm][n];
                        if (cscale) a *= *(const f32x4*)(cscale + col0 + bj * HALF + n * 16);
                        *(f32x4*)(out + ro + bj * HALF + n * 16) = alpha * r[buf][mm][bj][n] + a;
                    }
            }
        };
        ldq(0, 0); ldq(1, 1);
        __builtin_amdgcn_sched_barrier(0);
        stq(0, 0); ldq(2, 0);
        __builtin_amdgcn_sched_barrier(0);
        stq(1, 1); ldq(3, 1);
        __builtin_amdgcn_sched_barrier(0);
        stq(2, 0); stq(3, 1);
    }
};
template <class Epi>
DI void gemm_phase(int tid_, int bid_, LAS unsigned char* lds, const Gemm g, const Epi& E) {
    const int tid = tid_, wid = __builtin_amdgcn_readfirstlane(tid >> 6), lane = tid & 63, wr = wid >> 2, wc = wid & 3, fr = lane & 15, fq = lane >> 4;
    const int K = g.K, nt = K / BK;
    Order S; S.init(g, (int)gridDim.x, (int)bid_);
    unsigned voffA[2], voffB[2];
#pragma unroll
    for (int i = 0; i < 2; ++i) { int R, C; stage_rc(tid * 16 + i * 8192, R, C); const int Rb = Epi::PERM ? ((R & ~31) + perm32(R & 31)) : R;
        voffA[i] = (unsigned)(R * g.lda + C) * 2u; voffB[i] = (unsigned)(Rb * g.ldb + C) * 2u; }
    const size_t kstep = (size_t)(BK * 2);
    const size_t hA = (size_t)HALF * g.lda * 2, hB = (size_t)HALF * g.ldb * 2;
    const unsigned ldsw = (unsigned)wid * 1024u;
    const int aoff = lds_byte(wr * 64 + fr, fq * 8), boff = lds_byte(wc * 32 + fr, fq * 8);
#define PG8_SA(b, h) (((b) * 2 + (h)) * HTB)
#define PG8_SB(b, h) ((4 + (b) * 2 + (h)) * HTB)
#define PG8_STAGE(bufoff, gbase, voff) do { _Pragma("unroll") for (int _i = 0; _i < 2; ++_i) \
        __builtin_amdgcn_global_load_lds((const unsigned*)((const char*)(gbase) + (voff)[_i]), (LAS unsigned*)(lds + (bufoff) + ldsw + _i * 8192), 16, 0, 0); } while (0)
#define PG8_LDA(dst, b, h) do { _Pragma("unroll") for (int m = 0; m < 4; ++m) _Pragma("unroll") for (int k = 0; k < 2; ++k) dst[m][k] = *(const LAS bf16x8*)(lds + PG8_SA(b, h) + aoff + m * 2048 + k * 1024); } while (0)
#define PG8_LDB(dst, b, h) do { _Pragma("unroll") for (int n = 0; n < 2; ++n) _Pragma("unroll") for (int k = 0; k < 2; ++k) dst[n][k] = *(const LAS bf16x8*)(lds + PG8_SB(b, h) + boff + n * 2048 + k * 1024); } while (0)
#define PG8_MMA(ai, bj, At, Bt) do { __builtin_amdgcn_s_setprio(1); _Pragma("unroll") for (int m = 0; m < 4; ++m) _Pragma("unroll") for (int n = 0; n < 2; ++n) _Pragma("unroll") for (int k = 0; k < 2; ++k) \
        acc[ai][bj][m][n] = __builtin_amdgcn_mfma_f32_16x16x32_bf16(Bt[n][k], At[m][k], acc[ai][bj][m][n], 0, 0, 0); __builtin_amdgcn_s_setprio(0); } while (0)
#define PG8_WAIT_V(n) asm volatile("s_waitcnt vmcnt(" #n ")" ::: "memory")
#define PG8_WAIT_L(n) asm volatile("s_waitcnt lgkmcnt(" #n ")" ::: "memory")
#define PG8_BAR __builtin_amdgcn_s_barrier()
#define PG8_SCHED __builtin_amdgcn_sched_barrier(0)
    Unit cur, nxt; int ui = 0;
    if (!S.next(0, cur)) return;
    f32x4 acc[2][2][4][2];
#pragma unroll
    for (int a = 0; a < 2; ++a)
#pragma unroll
        for (int b = 0; b < 2; ++b)
#pragma unroll
            for (int m = 0; m < 4; ++m)
#pragma unroll
                for (int n = 0; n < 2; ++n) acc[a][b][m][n] = (f32x4){0.f, 0.f, 0.f, 0.f};
    bf16x8 At[4][2], B0[2][2], B1[2][2];
    const char* cA = (const char*)g.A + ((size_t)cur.g * g.sA + (size_t)cur.pm * BM * g.lda) * 2;
    const char* cB = (const char*)g.Bt + ((size_t)cur.g * g.sB + (size_t)cur.pn * BM * g.ldb) * 2;
    PG8_STAGE(PG8_SB(0, 0), cB, voffB); PG8_STAGE(PG8_SA(0, 0), cA, voffA); PG8_STAGE(PG8_SB(0, 1), cB + hB, voffB); PG8_STAGE(PG8_SA(0, 1), cA + hA, voffA);
    if (wr == 1) PG8_BAR;
    PG8_WAIT_V(4); PG8_BAR;
    PG8_STAGE(PG8_SB(1, 0), cB + kstep, voffB); PG8_STAGE(PG8_SA(1, 0), cA + kstep, voffA); PG8_STAGE(PG8_SB(1, 1), cB + hB + kstep, voffB);
    PG8_WAIT_V(6); PG8_BAR;
    for (;;) {
        const bool has_next = S.next(ui + 1, nxt);
        const char* nA = has_next ? (const char*)g.A + ((size_t)nxt.g * g.sA + (size_t)nxt.pm * BM * g.lda) * 2 : cA;
        const char* nB = has_next ? (const char*)g.Bt + ((size_t)nxt.g * g.sB + (size_t)nxt.pn * BM * g.ldb) * 2 : cB;
        for (int t = 0; t < nt; t += 2) {
            const bool last = (t == nt - 2);
            const char* a1 = cA + (size_t)(t + 1) * kstep;
            const char* a2 = last ? nA : cA + (size_t)(t + 2) * kstep; const char* b2 = last ? nB : cB + (size_t)(t + 2) * kstep;
            const char* a3 = a2 + kstep; const char* b3 = b2 + kstep;
            PG8_LDB(B0, 0, 0); PG8_SCHED; PG8_LDA(At, 0, 0); PG8_STAGE(PG8_SA(1, 1), a1 + hA, voffA);
            PG8_WAIT_L(8); PG8_BAR; PG8_WAIT_L(0); PG8_MMA(0, 0, At, B0); PG8_BAR; PG8_SCHED;
            PG8_LDB(B1, 0, 1); PG8_STAGE(PG8_SB(0, 0), b2, voffB);
            PG8_BAR; PG8_WAIT_L(0); PG8_MMA(0, 1, At, B1); PG8_BAR;
            PG8_LDA(At, 0, 1); PG8_STAGE(PG8_SA(0, 0), a2, voffA);
            PG8_BAR; PG8_WAIT_L(0); PG8_MMA(1, 0, At, B0); PG8_BAR; PG8_SCHED;
            PG8_STAGE(PG8_SB(0, 1), b2 + hB, voffB);
            PG8_WAIT_V(6); PG8_BAR; PG8_MMA(1, 1, At, B1); PG8_BAR;
            PG8_LDB(B0, 1, 0); PG8_SCHED; PG8_LDA(At, 1, 0); PG8_STAGE(PG8_SA(0, 1), a2 + hA, voffA);
            PG8_WAIT_L(8); PG8_BAR; PG8_WAIT_L(0); PG8_MMA(0, 0, At, B0); PG8_BAR; PG8_SCHED;
            PG8_LDB(B1, 1, 1); PG8_STAGE(PG8_SB(1, 0), b3, voffB);
            PG8_BAR; PG8_WAIT_L(0); PG8_MMA(0, 1, At, B1); PG8_BAR;
            PG8_LDA(At, 1, 1); PG8_STAGE(PG8_SA(1, 0), a3, voffA);
            PG8_BAR; PG8_WAIT_L(0); PG8_MMA(1, 0, At, B0); PG8_BAR; PG8_SCHED;
            PG8_STAGE(PG8_SB(1, 1), b3 + hB, voffB);
            PG8_WAIT_V(6); PG8_BAR; PG8_MMA(1, 1, At, B1); PG8_BAR;
        }
        E(acc, cur, wr, wc, fr, fq);
        if (!has_next) break;
#pragma unroll
        for (int a = 0; a < 2; ++a)
#pragma unroll
            for (int b = 0; b < 2; ++b)
#pragma unroll
                for (int m = 0; m < 4; ++m)
#pragma unroll
                    for (int n = 0; n < 2; ++n) acc[a][b][m][n] = (f32x4){0.f, 0.f, 0.f, 0.f};
        cur = nxt; cA = nA; cB = nB; ++ui;
    }
    PG8_WAIT_V(0);
    if (wr == 0) PG8_BAR;
    PG8_BAR;
#undef PG8_SA
#undef PG8_SB
#undef PG8_STAGE
#undef PG8_LDA
#undef PG8_LDB
#undef PG8_MMA
#undef PG8_WAIT_V
#undef PG8_WAIT_L
#undef PG8_BAR
#undef PG8_SCHED
}
}

DI pg8::Gemm mk_gemm(const bf16_t* A, const bf16_t* Bt, long sA, long sB, int lda, int ldb, int K, int nM, int nN, int G) {
    pg8::Gemm g; g.A = A; g.Bt = Bt; g.sA = sA; g.sB = sB; g.lda = lda; g.ldb = ldb; g.K = K; g.nM = nM; g.nN = nN; g.G = G; return g;
}

DI void prep_phase(int tid_, int bid_, const Params& p, unsigned char* smem) {
    TJob* jobs = (TJob*)smem;
    float* tile = (float*)(smem + 4096);
    const int tid = tid_;
    if (tid < NTJ) jobs[tid] = p.tj[tid];
    __syncthreads();
    const int ntiles = p.ntiles;
    for (int tix = bid_; tix < ntiles; tix += gridDim.x) {
        int j = 0;
        for (int q = 1; q < NTJ; ++q) if (jobs[q].tile0 <= tix) j = q;
        const TJob jb = jobs[j];
        const int lt = tix - jb.tile0, ntk = jb.Kd / 128, k0 = (lt % ntk) * 128, n0 = (lt / ntk) * 128;
        f32x4 v[8];
#pragma unroll
        for (int i = 0; i < 8; ++i) {
            const int idx = tid + i * 512, kk = idx >> 5, n4 = idx & 31;
            const int k = k0 + kk, n = n0 + n4 * 4;
            v[i] = (k < jb.Ks && n < jb.Ns) ? *(const f32x4*)(jb.src + (size_t)k * jb.Ns + n) : (f32x4){0.f, 0.f, 0.f, 0.f};
        }
#pragma unroll
        for (int i = 0; i < 8; ++i) {
            const int idx = tid + i * 512, kk = idx >> 5, n4 = idx & 31;
#pragma unroll
            for (int e = 0; e < 4; ++e) tile[kk * 129 + n4 * 4 + e] = v[i][e];
        }
        __syncthreads();
#pragma unroll
        for (int i = 0; i < 4; ++i) {
            const int idx = tid + i * 512, n = idx >> 4, kc = idx & 15;
            float f[8];
#pragma unroll
            for (int e = 0; e < 8; ++e) f[e] = tile[(kc * 8 + e) * 129 + n];
            u32x4 o = {pk_bf16(f[0], f[1]), pk_bf16(f[2], f[3]), pk_bf16(f[4], f[5]), pk_bf16(f[6], f[7])};
            *(u32x4*)(jb.dst + (size_t)(n0 + n) * jb.Kd + k0 + kc * 8) = o;
        }
        __syncthreads();
    }
    {
        const float* x = p.in[0]; bf16_t* xb = (bf16_t*)(p.ws + O_SLOT + 8 * SLOT);
        const size_t n8 = (size_t)T * D / 8;
        for (size_t i = (size_t)bid_ * 512 + tid; i < n8; i += (size_t)gridDim.x * 512) {
            const f32x4 a = *(const f32x4*)(x + i * 8), b = *(const f32x4*)(x + i * 8 + 4);
            u32x4 o = {pk_bf16(a[0], a[1]), pk_bf16(a[2], a[3]), pk_bf16(b[0], b[1]), pk_bf16(b[2], b[3])};
            *(u32x4*)(xb + i * 8) = o;
        }
    }
    {
        float* ct = (float*)(p.ws + O_ROPE); float* st = ct + SEQ * 16;
        for (int i = bid_ * 512 + tid; i < SEQ * 16; i += gridDim.x * 512) {
            const int pos = i >> 4, f = i & 15;
            const float inv = powf(500000.0f, -(float)(2 * f) / 32.0f);
            const float ang = (float)pos * inv;
            ct[i] = cosf(ang); st[i] = sinf(ang);
        }
    }
}

DI void ln_phase(int tid_, int bid_, const float* zin, float* xout, bf16_t* xb, const float* gam, const float* bet) {
    const int lane = tid_ & 63, wid = tid_ >> 6;
    const int rstride = gridDim.x * 8;
    constexpr int NR = 3;
    f32x4 gq[8], bq[8];
#pragma unroll
    for (int i = 0; i < 8; ++i) { gq[i] = *(const f32x4*)(gam + (i * 64 + lane) * 4); bq[i] = *(const f32x4*)(bet + (i * 64 + lane) * 4); }
    for (int row0 = bid_ * 8 + wid; row0 < T; row0 += NR * rstride) {
        f32x4 v[NR][8];
#pragma unroll
        for (int r = 0; r < NR; ++r)
#pragma unroll
            for (int i = 0; i < 8; ++i)
                v[r][i] = (row0 + r * rstride < T) ? *(const f32x4*)(zin + (size_t)(row0 + r * rstride) * D + (i * 64 + lane) * 4) : (f32x4){0.f, 0.f, 0.f, 0.f};
#pragma unroll
        for (int r = 0; r < NR; ++r) {
            const int row = row0 + r * rstride;
            if (row >= T) break;
            float s = 0.f;
#pragma unroll
            for (int i = 0; i < 8; ++i) s += v[r][i][0] + v[r][i][1] + v[r][i][2] + v[r][i][3];
            const float mean = wave_sum(s) * (1.f / D);
            float q = 0.f;
#pragma unroll
            for (int i = 0; i < 8; ++i) { v[r][i] -= mean; q += v[r][i][0] * v[r][i][0] + v[r][i][1] * v[r][i][1] + v[r][i][2] * v[r][i][2] + v[r][i][3] * v[r][i][3]; }
            const float rstd = rsqrtf(wave_sum(q) * (1.f / D) + LN_EPS);
#pragma unroll
            for (int i = 0; i < 8; ++i) {
                const int c = (i * 64 + lane) * 4;
                const f32x4 o = v[r][i] * rstd * gq[i] + bq[i];
                *(f32x4*)(xout + (size_t)row * D + c) = o;
                if (xb) { u32x2 w = {pk_bf16(o[0], o[1]), pk_bf16(o[2], o[3])}; *(u32x2*)(xb + (size_t)row * D + c) = w; }
            }
        }
    }
}

DI void rg_conv_phase(int tid_, int bid_, const bf16_t* gu, bf16_t* uc, const float* cw, const float* cb) {
    const size_t n8 = (size_t)T * D / 8;
    const size_t stride = (size_t)gridDim.x * 512;
    constexpr int U = 4;
    const int cc = (tid_ & 255) * 8;
    f32x4 wq[4][2], bq0, bq1;
#pragma unroll
    for (int j = 0; j < 4; ++j) { wq[j][0] = *(const f32x4*)(cw + j * D + cc); wq[j][1] = *(const f32x4*)(cw + j * D + cc + 4); }
    bq0 = *(const f32x4*)(cb + cc); bq1 = *(const f32x4*)(cb + cc + 4);
    for (size_t ib = (size_t)bid_ * 512 + tid_; ib < n8; ib += stride * U) {
        u32x4 uu[U][4];
#pragma unroll
        for (int u = 0; u < U; ++u) {
            const size_t i = ib + u * stride;
            const int t = (int)(i >> 8), c = (int)(i & 255) * 8, s = t & (SEQ - 1);
#pragma unroll
            for (int j = 0; j < 4; ++j)
                uu[u][j] = (i < n8 && s - 3 + j >= 0) ? *(const u32x4*)(gu + (size_t)(t - 3 + j) * 4096 + 2048 + c) : (u32x4){0u, 0u, 0u, 0u};
        }
#pragma unroll
        for (int u = 0; u < U; ++u) {
            const size_t i = ib + u * stride;
            if (i >= n8) break;
            const int c = (int)(i & 255) * 8;
            float a[8];
#pragma unroll
            for (int e = 0; e < 4; ++e) { a[e] = bq0[e]; a[4 + e] = bq1[e]; }
#pragma unroll
            for (int j = 0; j < 4; ++j) {
                const u32x4 q = uu[u][j];
                const f32x4 w0 = wq[j][0], w1 = wq[j][1];
                a[0] += w0[0] * bflo(q[0]); a[1] += w0[1] * bfhi(q[0]); a[2] += w0[2] * bflo(q[1]); a[3] += w0[3] * bfhi(q[1]);
                a[4] += w1[0] * bflo(q[2]); a[5] += w1[1] * bfhi(q[2]); a[6] += w1[2] * bflo(q[3]); a[7] += w1[3] * bfhi(q[3]);
            }
            u32x4 o = {pk_bf16(a[0], a[1]), pk_bf16(a[2], a[3]), pk_bf16(a[4], a[5]), pk_bf16(a[6], a[7])};
            *(u32x4*)(uc + i * 8) = o;
        }
    }
}
DI void rg_ab(float rpre, float ipre, float u, float ba, float bx, float sp8, float& a, float& b) {
    const float r = sigmoidf_(rpre + ba), ii = sigmoidf_(ipre + bx);
    const float la = -sp8 * r;
    a = __expf(la);
    const float x2 = 2.f * la;
    const float om = (x2 > -0.05f) ? -x2 * (1.f + x2 * (0.5f + x2 * (0.16666667f + x2 * 0.041666668f))) : 1.f - a * a;
    b = u * ii * __builtin_amdgcn_sqrtf(om);
}
template <int MODE>
DI void rg_scan_phase(int tid_, int bid_, const Params& p, const bf16_t* gates, const bf16_t* uc, const bf16_t* gu, float* agg, bf16_t* outg) {
    constexpr int CH = 32;
    const float* gab = p.in[9]; const float* gxb = p.in[11]; const float* lam = p.in[12];
    const int ch = tid_ * 4, n = ch >> 8, v = ch & 255;
    for (int item = bid_; item < 4 * 128; item += gridDim.x) {
        const int chunk = item & 127, b = item >> 7;
        const f32x4 ba = *(const f32x4*)(gab + ch), bx = *(const f32x4*)(gxb + ch), lm = *(const f32x4*)(lam + ch);
        float sp[4], h[4] = {0.f, 0.f, 0.f, 0.f}, P[4] = {1.f, 1.f, 1.f, 1.f};
#pragma unroll
        for (int e = 0; e < 4; ++e) sp[e] = 8.f * log1pf(expf(-lm[e]));
        if (MODE == 1) {
            for (int c0 = 0; c0 < chunk; c0 += 8) {
                f32x4 gv[8][2];
#pragma unroll
                for (int j = 0; j < 8; ++j) {
                    const float* ap = agg + (((size_t)b * 128 + c0 + j) * D + ch) * 2;
                    gv[j][0] = (c0 + j < chunk) ? *(const f32x4*)ap : (f32x4){1.f, 0.f, 1.f, 0.f};
                    gv[j][1] = (c0 + j < chunk) ? *(const f32x4*)(ap + 4) : (f32x4){1.f, 0.f, 1.f, 0.f};
                }
#pragma unroll
                for (int j = 0; j < 8; ++j) { h[0] = gv[j][0][0] * h[0] + gv[j][0][1]; h[1] = gv[j][0][2] * h[1] + gv[j][0][3]; h[2] = gv[j][1][0] * h[2] + gv[j][1][1]; h[3] = gv[j][1][2] * h[3] + gv[j][1][3]; }
            }
        }
        const size_t t0 = (size_t)b * SEQ + (size_t)chunk * CH;
        constexpr int UB = 8;
        for (int tb = 0; tb < CH; tb += UB) {
            u32x2 rpv[UB], ipv[UB], uuv[UB], ggv[UB];
#pragma unroll
            for (int j = 0; j < UB; ++j) {
                const size_t t = t0 + tb + j;
                rpv[j] = *(const u32x2*)(gates + t * 4096 + n * 512 + v);
                ipv[j] = *(const u32x2*)(gates + t * 4096 + n * 512 + 256 + v);
                uuv[j] = *(const u32x2*)(uc + t * D + ch);
                if (MODE == 1) ggv[j] = *(const u32x2*)(gu + t * 4096 + ch);
            }
#pragma unroll
            for (int j = 0; j < UB; ++j) {
                const size_t t = t0 + tb + j;
                const float rp[4] = {bflo(rpv[j][0]), bfhi(rpv[j][0]), bflo(rpv[j][1]), bfhi(rpv[j][1])};
                const float ip[4] = {bflo(ipv[j][0]), bfhi(ipv[j][0]), bflo(ipv[j][1]), bfhi(ipv[j][1])};
                const float uu[4] = {bflo(uuv[j][0]), bfhi(uuv[j][0]), bflo(uuv[j][1]), bfhi(uuv[j][1])};
#pragma unroll
                for (int e = 0; e < 4; ++e) {
                    float a, bb;
                    rg_ab(rp[e], ip[e], uu[e], ba[e], bx[e], sp[e], a, bb);
                    h[e] = a * h[e] + bb;
                    if (MODE == 0) P[e] *= a;
                }
                if (MODE == 1) {
                    const float gg[4] = {bflo(ggv[j][0]), bfhi(ggv[j][0]), bflo(ggv[j][1]), bfhi(ggv[j][1])};
                    u32x2 w = {pk_bf16(gelu_tanh(gg[0]) * h[0], gelu_tanh(gg[1]) * h[1]), pk_bf16(gelu_tanh(gg[2]) * h[2], gelu_tanh(gg[3]) * h[3])};
                    *(u32x2*)(outg + t * D + ch) = w;
                }
            }
        }
        if (MODE == 0) {
            float* ap = agg + (((size_t)b * 128 + chunk) * D + ch) * 2;
            f32x4 o0 = {P[0], h[0], P[1], h[1]}, o1 = {P[2], h[2], P[3], h[3]};
            *(f32x4*)ap = o0; *(f32x4*)(ap + 4) = o1;
        }
    }
}

DI void kmean_phase(int tid_, int bid_, bf16_t* Qx, bf16_t* Kx, float* kmean, const float* ctab, const float* stab, unsigned char* smem) {
    float* redA = (float*)smem;
    float* redB = redA + 1024;
    const int tid = tid_;
    for (int item = bid_; item < 1024; item += gridDim.x) {
        const int blk = item & 15, h = (item >> 4) & 15, b = item >> 8;
        {
            const int i = tid & 15, rg = tid >> 4;
            float s1 = 0.f, s2 = 0.f;
            bf16_t k1v[8], k2v[8], q1v[8], q2v[8]; float cv[8], sv[8];
#pragma unroll
            for (int r = 0; r < 8; ++r) {
                const int pos = blk * 256 + rg * 8 + r;
                const size_t o = ((size_t)b * SEQ + pos) * D + h * 128 + i;
                cv[r] = ctab[pos * 16 + i]; sv[r] = stab[pos * 16 + i];
                k1v[r] = Kx[o]; k2v[r] = Kx[o + 16]; q1v[r] = Qx[o]; q2v[r] = Qx[o + 16];
            }
#pragma unroll
            for (int r = 0; r < 8; ++r) {
                const int pos = blk * 256 + rg * 8 + r;
                const size_t o = ((size_t)b * SEQ + pos) * D + h * 128 + i;
                const float c = cv[r], sn = sv[r];
                const float k1 = bf2f(k1v[r]), k2 = bf2f(k2v[r]);
                const bf16_t k1r = f2bf(k1 * c - k2 * sn), k2r = f2bf(k2 * c + k1 * sn);
                Kx[o] = k1r; Kx[o + 16] = k2r; s1 += bf2f(k1r); s2 += bf2f(k2r);
                const float q1 = bf2f(q1v[r]), q2 = bf2f(q2v[r]);
                Qx[o] = f2bf(q1 * c - q2 * sn); Qx[o + 16] = f2bf(q2 * c + q1 * sn);
            }
            redA[rg * 32 + i] = s1; redA[rg * 32 + 16 + i] = s2;
        }
        {
            const int dp = tid & 63, rg = tid >> 6;
            if (dp >= 16) {
                const bf16_t* base = Kx + ((size_t)b * SEQ + blk * 256 + rg * 32) * D + h * 128 + dp * 2;
                float s0 = 0.f, s1 = 0.f;
                unsigned uv[32];
#pragma unroll
                for (int r = 0; r < 32; ++r) uv[r] = *(const unsigned*)(base + (size_t)r * D);
#pragma unroll
                for (int r = 0; r < 32; ++r) { s0 += bflo(uv[r]); s1 += bfhi(uv[r]); }
                redB[rg * 128 + dp * 2] = s0; redB[rg * 128 + dp * 2 + 1] = s1;
            }
        }
        __syncthreads();
        if (tid < 128) {
            float s = 0.f;
            if (tid < 32) { for (int r = 0; r < 32; ++r) s += redA[r * 32 + tid]; }
            else { for (int r = 0; r < 8; ++r) s += redB[r * 128 + tid]; }
            kmean[(size_t)item * 128 + tid] = s * (1.f / 256.f);
        }
        __syncthreads();
    }
}

DI void attn_phase(int tid_, int bid_, const bf16_t* Q, const bf16_t* Kx, const bf16_t* VT, bf16_t* O, const float* kmean, unsigned char* smem) {
    constexpr int KB_STRIDE = 288, VB_STRIDE = 160;
    constexpr int KBUF = 64 * KB_STRIDE, VBUF = 128 * VB_STRIDE;
    constexpr float QC = 0.08838834764831845f * 1.4426950408889634f;
    constexpr float THR_RAW = 8.0f / 0.08838834764831845f;
#define KBUFP(bi) (smem + (bi) * KBUF)
#define VBUFP(bi) (smem + 2 * KBUF + (bi) * VBUF)
    float* km = (float*)(smem + 2 * KBUF + 2 * VBUF);
    const int tid = tid_, wid = tid >> 6, lane = tid & 63, fr = lane & 15, fq = lane >> 4;
    for (int idx = bid_; idx < 1024; idx += gridDim.x) {
        const int bh = idx & 63, jj = idx >> 6, sub = jj & 3, r2 = jj >> 2;
        const int qb = (r2 == 0) ? sub : (r2 == 1) ? (7 - sub) : (r2 == 2) ? (8 + sub) : (15 - sub);
        const int b = bh >> 4, h = bh & 15;
        const size_t tok0 = (size_t)b * SEQ;
        const int qloc0 = wid * 32 + fr;
        { const f32x4 kv = *(const f32x4*)(kmean + (size_t)bh * 2048 + tid * 4); *(f32x4*)(km + tid * 4) = kv; }
        bf16x8 qf[2][4];
#pragma unroll
        for (int qt = 0; qt < 2; ++qt)
#pragma unroll
            for (int dc = 0; dc < 4; ++dc) qf[qt][dc] = *(const bf16x8*)(Q + (tok0 + qb * 256 + qloc0 + qt * 16) * D + h * 128 + dc * 32 + fq * 8);
        __syncthreads();
        const int ntile = (qb + 1) * 4;
        const int kr0 = tid >> 4, kc0 = tid & 15;
        const int vr0 = tid >> 3, vc0 = tid & 7;
        u32x4 kreg0[2], vreg0[2];
        auto gload = [&](int tt, u32x4 (&kreg)[2], u32x4 (&vreg)[2]) {
            const int key0 = tt * 64;
#pragma unroll
            for (int i = 0; i < 2; ++i) {
                kreg[i] = *(const u32x4*)(Kx + (tok0 + key0 + kr0 + i * 32) * D + h * 128 + kc0 * 8);
                vreg[i] = *(const u32x4*)(VT + (size_t)(h * 128 + vr0 + i * 64) * T + tok0 + key0 + vc0 * 8);
            }
        };
        auto lstore = [&](int bi, const u32x4 (&kreg)[2], const u32x4 (&vreg)[2]) {
#pragma unroll
            for (int i = 0; i < 2; ++i) {
                *(u32x4*)(KBUFP(bi) + (kr0 + i * 32) * KB_STRIDE + kc0 * 16) = kreg[i];
                {
                    unsigned char* vrow = VBUFP(bi) + (vr0 + i * 64) * VB_STRIDE + (vc0 >> 2) * 64;
                    const int c = vc0 & 3, p0 = ((c & 1) * 2) * 16 + (c >> 1) * 8;
                    u32x2 lo = {vreg[i][0], vreg[i][1]}, hi = {vreg[i][2], vreg[i][3]};
                    *(u32x2*)(vrow + p0) = lo; *(u32x2*)(vrow + p0 + 16) = hi;
                }
            }
        };
        gload(0, kreg0, vreg0);
        unsigned mask[2];
#pragma unroll
        for (int qt = 0; qt < 2; ++qt) {
            float v0 = -3e38f, v1 = -3e38f, v2 = -3e38f; int i0 = -1, i1 = -1, i2 = -1;
            for (int j = 0; j < qb; ++j) {
                float g = 0.f;
#pragma unroll
                for (int dc = 0; dc < 4; ++dc) {
                    const f32x4 ka = *(const f32x4*)(km + j * 128 + dc * 32 + fq * 8), kb2 = *(const f32x4*)(km + j * 128 + dc * 32 + fq * 8 + 4);
#pragma unroll
                    for (int e = 0; e < 4; ++e) { g += bf2f((bf16_t)qf[qt][dc][e]) * ka[e]; g += bf2f((bf16_t)qf[qt][dc][4 + e]) * kb2[e]; }
                }
                g = xsum_fq(g);
                if (g > v0) { v2 = v1; i2 = i1; v1 = v0; i1 = i0; v0 = g; i0 = j; }
                else if (g > v1) { v2 = v1; i2 = i1; v1 = g; i1 = j; }
                else if (g > v2) { v2 = g; i2 = j; }
            }
            unsigned mk = 0u;
            if (i0 >= 0) mk |= 1u << i0;
            if (i1 >= 0) mk |= 1u << i1;
            if (i2 >= 0) mk |= 1u << i2;
            mask[qt] = mk;
        }
        float mrun[2] = {-1e30f, -1e30f}, lrun[2] = {0.f, 0.f};
        f32x4 oacc[2][8];
#pragma unroll
        for (int qt = 0; qt < 2; ++qt)
#pragma unroll
            for (int dt = 0; dt < 8; ++dt) oacc[qt][dt] = (f32x4){0.f, 0.f, 0.f, 0.f};
        auto compute = [&](int tt, int bi) {
            const int kb = tt >> 2, kt64 = tt & 3;
            const bool own = (kb == qb);
            bool actq[2];
#pragma unroll
            for (int qt = 0; qt < 2; ++qt) actq[qt] = own ? true : (((mask[qt] >> kb) & 1u) != 0u);
            const bool doit = own ? (kt64 * 64 <= wid * 32 + 31) : (__any((int)(actq[0] || actq[1])) != 0);
            const bool elem = own && (kt64 * 64 + 63 > wid * 32);
            if (doit) {
                f32x4 sacc[2][4];
#pragma unroll
                for (int qt = 0; qt < 2; ++qt)
#pragma unroll
                    for (int kt = 0; kt < 4; ++kt) sacc[qt][kt] = (f32x4){0.f, 0.f, 0.f, 0.f};
#pragma unroll
                for (int dc = 0; dc < 4; ++dc)
#pragma unroll
                    for (int kt = 0; kt < 4; ++kt) {
                        const bf16x8 kf = *(const bf16x8*)(KBUFP(bi) + (kt * 16 + fr) * KB_STRIDE + dc * 64 + fq * 16);
#pragma unroll
                        for (int qt = 0; qt < 2; ++qt) sacc[qt][kt] = __builtin_amdgcn_mfma_f32_16x16x32_bf16(kf, qf[qt][dc], sacc[qt][kt], 0, 0, 0);
                    }
                bf16x8 pf[2][2];
#pragma unroll
                for (int qt = 0; qt < 2; ++qt) {
                    const int lim = own ? (qloc0 + qt * 16 - kt64 * 64 - fq * 4) : (actq[qt] ? 1000 : -1000);
                    float mx = -1e30f;
                    if (elem) {
#pragma unroll
                        for (int kt = 0; kt < 4; ++kt)
#pragma unroll
                            for (int r = 0; r < 4; ++r) {
                                const float sv = (kt * 16 + r <= lim) ? sacc[qt][kt][r] : -__builtin_inff();
                                sacc[qt][kt][r] = sv; mx = fmaxf(mx, sv);
                            }
                    } else {
#pragma unroll
                        for (int kt = 0; kt < 4; ++kt)
#pragma unroll
                            for (int r = 0; r < 4; ++r) mx = fmaxf(mx, sacc[qt][kt][r]);
                        mx = actq[qt] ? mx : -__builtin_inff();
                    }
                    mx = xmax_fq(mx);
                    if (__any((int)(mx > mrun[qt] + THR_RAW))) {
                        const float mnew = fmaxf(mrun[qt], mx);
                        const float alpha = __builtin_amdgcn_exp2f((mrun[qt] - mnew) * QC);
                        mrun[qt] = mnew;
                        lrun[qt] *= alpha;
#pragma unroll
                        for (int dt = 0; dt < 8; ++dt) oacc[qt][dt] *= alpha;
                    }
                    const float mneg = (elem || actq[qt]) ? -mrun[qt] * QC : -__builtin_inff();
                    float ps = 0.f;
#pragma unroll
                    for (int kt = 0; kt < 4; ++kt)
#pragma unroll
                        for (int r = 0; r < 4; ++r) { const float pe = __builtin_amdgcn_exp2f(__builtin_fmaf(sacc[qt][kt][r], QC, mneg)); sacc[qt][kt][r] = pe; ps += pe; }
                    lrun[qt] += ps;
#pragma unroll
                    for (int ks = 0; ks < 2; ++ks) {
                        u32x4 w = {pk_bf16(sacc[qt][2 * ks][0], sacc[qt][2 * ks][1]), pk_bf16(sacc[qt][2 * ks][2], sacc[qt][2 * ks][3]),
                                   pk_bf16(sacc[qt][2 * ks + 1][0], sacc[qt][2 * ks + 1][1]), pk_bf16(sacc[qt][2 * ks + 1][2], sacc[qt][2 * ks + 1][3])};
                        pf[qt][ks] = __builtin_bit_cast(bf16x8, w);
                    }
                }
#pragma unroll
                for (int ks = 0; ks < 2; ++ks)
#pragma unroll
                    for (int dt = 0; dt < 8; ++dt) {
                        const bf16x8 vf = *(const bf16x8*)(VBUFP(bi) + (dt * 16 + fr) * VB_STRIDE + ks * 64 + fq * 16);
#pragma unroll
                        for (int qt = 0; qt < 2; ++qt) oacc[qt][dt] = __builtin_amdgcn_mfma_f32_16x16x32_bf16(vf, pf[qt][ks], oacc[qt][dt], 0, 0, 0);
                    }
            }
        };
        lstore(0, kreg0, vreg0);
        __syncthreads();
        for (int tt = 0; tt < ntile; tt += 2) {
            if (tt + 1 < ntile) gload(tt + 1, kreg0, vreg0);
            compute(tt, 0);
            if (tt + 1 < ntile) lstore(1, kreg0, vreg0);
            lds_barrier();
            if (tt + 1 < ntile) {
                if (tt + 2 < ntile) gload(tt + 2, kreg0, vreg0);
                compute(tt + 1, 1);
                if (tt + 2 < ntile) lstore(0, kreg0, vreg0);
                lds_barrier();
            }
        }
        __syncthreads();
#pragma unroll
        for (int qt = 0; qt < 2; ++qt) {
            const float lt = xsum_fq(lrun[qt]);
            const float inv = 1.f / lt;
            bf16_t* orow = O + (tok0 + qb * 256 + qloc0 + qt * 16) * D + h * 128 + fq * 4;
#pragma unroll
            for (int dt = 0; dt < 8; ++dt) {
                const f32x4 o = oacc[qt][dt] * inv;
                u32x2 w = {pk_bf16(o[0], o[1]), pk_bf16(o[2], o[3])};
                *(u32x2*)(orow + dt * 16) = w;
            }
        }
    }
#undef KBUFP
#undef VBUFP
}

DI void rwkv_mix_phase(int tid_, int bid_, const float* x, const float* mu, bf16_t* slots) {
    const int c = (tid_ & 255) * 8, rsel = tid_ >> 8;
    f32x4 m[6][2];
#pragma unroll
    for (int k = 0; k < 6; ++k) { m[k][0] = *(const f32x4*)(mu + k * D + c); m[k][1] = *(const f32x4*)(mu + k * D + c + 4); }
    constexpr int U = 4;
    for (int pb = bid_; pb < T / 2; pb += gridDim.x * U) {
        f32x4 xv[U][2], xp[U][2];
#pragma unroll
        for (int u = 0; u < U; ++u) {
            const int pair = pb + u * gridDim.x, row = pair * 2 + rsel, s_ = row & (SEQ - 1);
            const bool ok = pair < T / 2;
            const float* xr = x + (size_t)row * D + c;
#pragma unroll
            for (int q = 0; q < 2; ++q) {
                xv[u][q] = ok ? *(const f32x4*)(xr + q * 4) : (f32x4){0.f, 0.f, 0.f, 0.f};
                xp[u][q] = (ok && s_ > 0) ? *(const f32x4*)(xr - D + q * 4) : (f32x4){0.f, 0.f, 0.f, 0.f};
            }
        }
#pragma unroll
        for (int u = 0; u < U; ++u) {
            const int pair = pb + u * gridDim.x, row = pair * 2 + rsel;
            if (pair >= T / 2) break;
            const f32x4 xx0 = xp[u][0] - xv[u][0], xx1 = xp[u][1] - xv[u][1];
#pragma unroll
            for (int k = 0; k < 6; ++k) {
                const f32x4 o0 = xv[u][0] + xx0 * m[k][0], o1 = xv[u][1] + xx1 * m[k][1];
                u32x4 w = {pk_bf16(o0[0], o0[1]), pk_bf16(o0[2], o0[3]), pk_bf16(o1[0], o1[1]), pk_bf16(o1[2], o1[3])};
                *(u32x4*)((unsigned char*)slots + k * SLOT + ((size_t)row * D + c) * 2) = w;
            }
        }
    }
}
DI float softplusf_(float y) { return fmaxf(y, 0.f) + __logf(1.f + __expf(-fabsf(y))); }
DI void rwkv_prep_phase(int tid_, int bid_, const Params& p, unsigned char* sl, float* scal) {
    bf16_t* R = (bf16_t*)(sl + 6 * SLOT); bf16_t* Kk = (bf16_t*)(sl + 7 * SLOT);
    const bf16_t* WP = (const bf16_t*)(sl + 0 * SLOT); bf16_t* AP = (bf16_t*)(sl + 1 * SLOT);
    bf16_t* KX = (bf16_t*)(sl + 3 * SLOT); float* WD = (float*)(sl + 4 * SLOT);
    const float* w0 = p.in[18]; const float* a0 = p.in[21]; const float* k_k = p.in[26]; const float* k_a = p.in[27]; const float* r_k = p.in[28];
    float* BR = scal; float* KR = scal + (size_t)T * 32; float* BO = scal + (size_t)2 * T * 32;
    const int lane = tid_ & 63, wid = tid_ >> 6, hq = lane >> 4, k4 = (lane & 15) * 4;
    constexpr int U = 4;
    for (int grp = bid_ * 8 + wid; grp < T * 2; grp += gridDim.x * 8) {
        const size_t t = (size_t)(grp >> 1); const int q0 = (grp & 1) * 4;
        const size_t o0 = t * D + (size_t)(q0 * 4 + hq) * 64 + k4;
        u32x2 rr[U], kr_[U], wpr[U], apr[U];
#pragma unroll
        for (int u = 0; u < U; ++u) { rr[u] = *(const u32x2*)(R + o0 + u * 256); kr_[u] = *(const u32x2*)(Kk + o0 + u * 256); wpr[u] = *(const u32x2*)(WP + o0 + u * 256); apr[u] = *(const u32x2*)(AP + o0 + u * 256); }
#pragma unroll
        for (int u = 0; u < U; ++u) {
            const int h = (q0 + u) * 4 + hq, c = h * 64 + k4; const size_t o = o0 + u * 256;
            const f32x4 w0v = *(const f32x4*)(w0 + c), a0v = *(const f32x4*)(a0 + c), kkv = *(const f32x4*)(k_k + c), kav = *(const f32x4*)(k_a + c), rkv = *(const f32x4*)(r_k + c);
            const float r[4] = {bflo(rr[u][0]), bfhi(rr[u][0]), bflo(rr[u][1]), bfhi(rr[u][1])}, k[4] = {bflo(kr_[u][0]), bfhi(kr_[u][0]), bflo(kr_[u][1]), bfhi(kr_[u][1])};
            const float wp[4] = {bflo(wpr[u][0]), bfhi(wpr[u][0]), bflo(wpr[u][1]), bfhi(wpr[u][1])}, ap[4] = {bflo(apr[u][0]), bfhi(apr[u][0]), bflo(apr[u][1]), bfhi(apr[u][1])};
            float dec[4], a[4], kk[4], kx[4]; float ss = 0.f;
#pragma unroll
            for (int e = 0; e < 4; ++e) {
                const float wlog = -softplusf_(-(w0v[e] + wp[e])) - 0.5f;
                dec[e] = __expf(-__expf(wlog));
                a[e] = __builtin_amdgcn_rcpf(1.f + __expf(-(a0v[e] + ap[e])));
                kk[e] = k[e] * kkv[e]; ss += kk[e] * kk[e];
                kx[e] = k[e] * (1.f + (a[e] - 1.f) * kav[e]);
            }
            const float rn = fminf(__builtin_amdgcn_rsqf(row_sum16(ss)), 1e12f);
            float bb[4], s1 = 0.f, s2 = 0.f, s3 = 0.f;
#pragma unroll
            for (int e = 0; e < 4; ++e) { kk[e] *= rn; bb[e] = kk[e] * a[e]; s1 += bb[e] * r[e]; s2 += kx[e] * r[e]; s3 += r[e] * kx[e] * rkv[e]; }
            const float br = row_sum16(s1), kr = row_sum16(s2), bo = row_sum16(s3);
            { u32x2 w = {pk_bf16(dec[0] * r[0], dec[1] * r[1]), pk_bf16(dec[2] * r[2], dec[3] * r[3])}; *(u32x2*)(R + o) = w; }
            { u32x2 w = {pk_bf16(-kk[0], -kk[1]), pk_bf16(-kk[2], -kk[3])}; *(u32x2*)(Kk + o) = w; }
            { u32x2 w = {pk_bf16(bb[0], bb[1]), pk_bf16(bb[2], bb[3])}; *(u32x2*)(AP + o) = w; }
            { u32x2 w = {pk_bf16(kx[0], kx[1]), pk_bf16(kx[2], kx[3])}; *(u32x2*)(KX + o) = w; }
            { f32x4 dv = {dec[0], dec[1], dec[2], dec[3]}; *(f32x4*)(WD + o) = dv; }
            if ((lane & 15) == 0) { const size_t it = t * 32 + h; BR[it] = br; KR[it] = kr; BO[it] = bo; }
        }
    }
}
DI float dpp_sum8(float v) {
    v += __int_as_float(__builtin_amdgcn_update_dpp(0, __float_as_int(v), 0xB1, 0xF, 0xF, false));
    v += __int_as_float(__builtin_amdgcn_update_dpp(0, __float_as_int(v), 0x4E, 0xF, 0xF, false));
    v += __int_as_float(__builtin_amdgcn_update_dpp(0, __float_as_int(v), 0x141, 0xF, 0xF, false));
    return v;
}
DI void rwkv_scan_phase(int tid_, int bid_, unsigned char* sl, const float* scal, unsigned char* smem) {
    constexpr int TC = 32;
    constexpr int OFF_BB = TC * 128, OFF_KX = OFF_BB + TC * 64, OFF_W = OFF_KX + TC * 64, OFF_V = OFF_W + TC * 64, OFF_SC = OFF_V + TC * 32, BUF_F = OFF_SC + TC * 2;
    constexpr int NCH = SEQ / TC;
#define SBUF(i) ((float*)smem + (i) * BUF_F)
    const bf16_t* NKK = (const bf16_t*)(sl + 7 * SLOT); const bf16_t* WR = (const bf16_t*)(sl + 6 * SLOT);
    const bf16_t* BB = (const bf16_t*)(sl + 1 * SLOT); const bf16_t* KX = (const bf16_t*)(sl + 3 * SLOT);
    const float* WD = (const float*)(sl + 4 * SLOT); const bf16_t* V = (const bf16_t*)(sl + 8 * SLOT);
    bf16_t* Y = (bf16_t*)(sl + 0 * SLOT);
    const float* BR = scal; const float* KR = scal + (size_t)T * 32;
    const int tid = tid_, wid = tid >> 6, lane = tid & 63;
    for (int item = bid_; item < 256; item += gridDim.x) {
        const int half = item & 1, h = (item >> 1) & 31, b = item >> 6;
        const size_t tok0 = (size_t)b * SEQ;
        if (wid >= 4) {
            const int lt = tid - 256, lt_t = lt >> 3, lt_c = lt & 7;
            u32x4 r_nk, r_wr, r_bb, r_kx, r_v = {0u, 0u, 0u, 0u}; f32x4 r_w0, r_w1; float r_s = 0.f;
            auto gload = [&](int c) {
                const size_t tb = tok0 + (size_t)c * TC;
                const size_t o = (tb + lt_t) * D + h * 64 + lt_c * 8;
                r_nk = *(const u32x4*)(NKK + o); r_wr = *(const u32x4*)(WR + o); r_bb = *(const u32x4*)(BB + o); r_kx = *(const u32x4*)(KX + o);
                r_w0 = *(const f32x4*)(WD + (tb + (lt >> 4)) * D + h * 64 + (lt & 15) * 4);
                r_w1 = *(const f32x4*)(WD + (tb + 16 + (lt >> 4)) * D + h * 64 + (lt & 15) * 4);
                if (lt < 128) r_v = *(const u32x4*)(V + (tb + (lt >> 2)) * D + h * 64 + half * 32 + (lt & 3) * 8);
                else if (lt < 192) { const int i = lt - 128; r_s = ((i & 1) ? KR : BR)[(tb + (i >> 1)) * 32 + h]; }
            };
            auto lstore = [&](float* F) {
                float* pp = F + lt_t * 128 + lt_c * 16;
#pragma unroll
                for (int j = 0; j < 4; ++j) { f32x4 q = {bflo(r_nk[j]), bflo(r_wr[j]), bfhi(r_nk[j]), bfhi(r_wr[j])}; *(f32x4*)(pp + j * 4) = q; }
                { float* d = F + OFF_BB + lt_t * 64 + lt_c * 8;
                  f32x4 lo = {bflo(r_bb[0]), bfhi(r_bb[0]), bflo(r_bb[1]), bfhi(r_bb[1])}, hi = {bflo(r_bb[2]), bfhi(r_bb[2]), bflo(r_bb[3]), bfhi(r_bb[3])};
                  *(f32x4*)d = lo; *(f32x4*)(d + 4) = hi; }
                { float* d = F + OFF_KX + lt_t * 64 + lt_c * 8;
                  f32x4 lo = {bflo(r_kx[0]), bfhi(r_kx[0]), bflo(r_kx[1]), bfhi(r_kx[1])}, hi = {bflo(r_kx[2]), bfhi(r_kx[2]), bflo(r_kx[3]), bfhi(r_kx[3])};
                  *(f32x4*)d = lo; *(f32x4*)(d + 4) = hi; }
                *(f32x4*)(F + OFF_W + (lt >> 4) * 64 + (lt & 15) * 4) = r_w0;
                *(f32x4*)(F + OFF_W + (16 + (lt >> 4)) * 64 + (lt & 15) * 4) = r_w1;
                if (lt < 128) { float* d = F + OFF_V + (lt >> 2) * 32 + (lt & 3) * 8;
                  f32x4 lo = {bflo(r_v[0]), bfhi(r_v[0]), bflo(r_v[1]), bfhi(r_v[1])}, hi = {bflo(r_v[2]), bfhi(r_v[2]), bflo(r_v[3]), bfhi(r_v[3])};
                  *(f32x4*)d = lo; *(f32x4*)(d + 4) = hi; }
                else if (lt < 192) F[OFF_SC + (lt - 128)] = r_s;
            };
            gload(0); lstore(SBUF(0)); gload(1);
            __syncthreads();
            for (int c = 0; c < NCH; ++c) {
                if (c + 1 < NCH) lstore(SBUF((c + 1) & 1));
                if (c + 2 < NCH) gload(c + 2);
                lds_barrier();
            }
        } else {
            const int kq = lane & 7, rl = wid * 8 + (lane >> 3);
            f32x2 st[4];
#pragma unroll
            for (int j = 0; j < 4; ++j) st[j] = (f32x2){0.f, 0.f};
            bf16_t* yp = Y + (tok0 + kq) * D + h * 64 + half * 32 + rl;
            __syncthreads();
            struct Ops { f32x4 pq[4], b0, b1, k0, k1, w0, w1; float vv; f32x2 sc; };
            for (int c = 0; c < NCH; ++c) {
                const float* F = SBUF(c & 1);
                const float* fp = F + kq * 16;
                const float* fb = F + OFF_BB + kq * 8;
                auto ld = [&](Ops& o, int t) {
#pragma unroll
                    for (int j = 0; j < 4; ++j) o.pq[j] = *(const f32x4*)(fp + t * 128 + j * 4);
                    o.b0 = *(const f32x4*)(fb + t * 64); o.b1 = *(const f32x4*)(fb + t * 64 + 4);
                    o.k0 = *(const f32x4*)(fb + (OFF_KX - OFF_BB) + t * 64); o.k1 = *(const f32x4*)(fb + (OFF_KX - OFF_BB) + t * 64 + 4);
                    o.w0 = *(const f32x4*)(fb + (OFF_W - OFF_BB) + t * 64); o.w1 = *(const f32x4*)(fb + (OFF_W - OFF_BB) + t * 64 + 4);
                    o.vv = F[OFF_V + t * 32 + rl]; o.sc = *(const f32x2*)(F + OFF_SC + t * 2);
                };
                auto dots = [&](const Ops& o) -> f32x2 {
                    f32x2 acc = {0.f, 0.f}, acc2 = {0.f, 0.f};
#pragma unroll
                    for (int j = 0; j < 4; ++j) {
                        acc += st[j][0] * (f32x2){o.pq[j][0], o.pq[j][1]};
                        acc2 += st[j][1] * (f32x2){o.pq[j][2], o.pq[j][3]};
                    }
                    return acc + acc2;
                };
                auto update = [&](const Ops& o, f32x2 acc) -> float {
                    const float d1 = dpp_sum8(acc[0]), d2 = dpp_sum8(acc[1]);
                    st[0] = st[0] * (f32x2){o.w0[0], o.w0[1]} + d1 * (f32x2){o.b0[0], o.b0[1]} + o.vv * (f32x2){o.k0[0], o.k0[1]};
                    st[1] = st[1] * (f32x2){o.w0[2], o.w0[3]} + d1 * (f32x2){o.b0[2], o.b0[3]} + o.vv * (f32x2){o.k0[2], o.k0[3]};
                    st[2] = st[2] * (f32x2){o.w1[0], o.w1[1]} + d1 * (f32x2){o.b1[0], o.b1[1]} + o.vv * (f32x2){o.k1[0], o.k1[1]};
                    st[3] = st[3] * (f32x2){o.w1[2], o.w1[3]} + d1 * (f32x2){o.b1[2], o.b1[3]} + o.vv * (f32x2){o.k1[2], o.k1[3]};
                    return d2 + d1 * o.sc[0] + o.vv * o.sc[1];
                };
                Ops os[3];
                ld(os[0], 0); ld(os[1], 1);
                float yv = 0.f;
#pragma unroll
                for (int t = 0; t < TC; ++t) {
                    const f32x2 da = dots(os[t % 3]);
                    __builtin_amdgcn_sched_barrier(0);
                    if (t + 2 < TC) ld(os[(t + 2) % 3], t + 2);
                    __builtin_amdgcn_sched_barrier(0);
                    const float ya = update(os[t % 3], da);
                    yv = (kq == (t & 7)) ? ya : yv;
                    if ((t & 7) == 7) yp[(size_t)(c * TC + (t & ~7)) * D] = f2bf(yv);
                }
                lds_barrier();
            }
        }
        __syncthreads();
    }
#undef SBUF
}
DI void rwkv_post_phase(int tid_, int bid_, const Params& p, unsigned char* sl, const float* scal) {
    const bf16_t* Y = (const bf16_t*)(sl + 0 * SLOT); const bf16_t* V = (const bf16_t*)(sl + 8 * SLOT); const bf16_t* G = (const bf16_t*)(sl + 2 * SLOT);
    bf16_t* OUT = (bf16_t*)(sl + 3 * SLOT);
    const float* lg = p.in[29]; const float* lb = p.in[30]; const float* BO = scal + (size_t)2 * T * 32;
    const int lane = tid_ & 63, wid = tid_ >> 6, hq = lane >> 4, k4 = (lane & 15) * 4;
    constexpr int U = 4;
    for (int grp = bid_ * 8 + wid; grp < T * 2; grp += gridDim.x * 8) {
        const size_t t = (size_t)(grp >> 1); const int q0 = (grp & 1) * 4;
        const size_t o0 = t * D + (size_t)(q0 * 4 + hq) * 64 + k4;
        u32x2 yr[U], vr[U], gr[U]; float bor[U];
#pragma unroll
        for (int u = 0; u < U; ++u) { yr[u] = *(const u32x2*)(Y + o0 + u * 256); vr[u] = *(const u32x2*)(V + o0 + u * 256); gr[u] = *(const u32x2*)(G + o0 + u * 256); bor[u] = BO[t * 32 + (q0 + u) * 4 + hq]; }
#pragma unroll
        for (int u = 0; u < U; ++u) {
            const int c = ((q0 + u) * 4 + hq) * 64 + k4;
            const f32x4 lgv = *(const f32x4*)(lg + c), lbv = *(const f32x4*)(lb + c);
            const float y[4] = {bflo(yr[u][0]), bfhi(yr[u][0]), bflo(yr[u][1]), bfhi(yr[u][1])};
            const float vv[4] = {bflo(vr[u][0]), bfhi(vr[u][0]), bflo(vr[u][1]), bfhi(vr[u][1])};
            const float gg[4] = {bflo(gr[u][0]), bfhi(gr[u][0]), bflo(gr[u][1]), bfhi(gr[u][1])};
            const float mean = row_sum16(y[0] + y[1] + y[2] + y[3]) * (1.f / 64.f);
            float d[4], q = 0.f;
#pragma unroll
            for (int e = 0; e < 4; ++e) { d[e] = y[e] - mean; q += d[e] * d[e]; }
            const float rs = rsqrtf(row_sum16(q) * (1.f / 64.f) + 64e-5f);
            float r[4];
#pragma unroll
            for (int e = 0; e < 4; ++e) r[e] = (d[e] * rs * lgv[e] + lbv[e] + bor[u] * vv[e]) * gg[e];
            u32x2 w = {pk_bf16(r[0], r[1]), pk_bf16(r[2], r[3])};
            *(u32x2*)(OUT + o0 + u * 256) = w;
        }
    }
}

DI void pool_phase(int tid_, int bid_, const float* x, bf16_t* outp) {
    constexpr int CH = 32;
    const int tid = tid_, c = tid * 4, w = 2 << (c >> 9);
    for (int item = bid_; item < T / CH; item += gridDim.x) {
        const int t0 = item * CH, s0 = t0 & (SEQ - 1);
        f32x4 sum = {0.f, 0.f, 0.f, 0.f};
#pragma unroll
        for (int j = 1; j <= 16; ++j) if (j <= w && s0 - j >= 0) sum += *(const f32x4*)(x + (size_t)(t0 - j) * D + c);
#pragma unroll 16
        for (int tt = 0; tt < CH; ++tt) {
            const int t = t0 + tt, s = s0 + tt;
            const f32x4 xv = *(const f32x4*)(x + (size_t)t * D + c);
            sum += xv;
            if (s - w >= 0) sum -= *(const f32x4*)(x + (size_t)(t - w) * D + c);
            const float rc = __builtin_amdgcn_rcpf((float)((s + 1 < w) ? (s + 1) : w));
            const f32x4 o = sum * rc - xv;
            u32x2 wv = {pk_bf16(o[0], o[1]), pk_bf16(o[2], o[3])};
            *(u32x2*)(outp + (size_t)t * D + c) = wv;
        }
    }
}

#define XB_TMO      128
#define XB_XCNT(j)  (256  + 64 * (j))
#define XB_XSUB(j)  (1280 + 64 * (j))
#define XB_XGEN(j)  (2304 + 64 * (j))
#define XB_TOP      3328
#define XB_TOPGEN   3392
#define XCD_BAR_WORDS 3456
#define XB_SPIN_CAP (1u << 18)
DI unsigned xb_ld(unsigned* p) { return __hip_atomic_load(p, __ATOMIC_RELAXED, __HIP_MEMORY_SCOPE_AGENT); }
DI unsigned xb_add(unsigned* p, unsigned v) { return __hip_atomic_fetch_add(p, v, __ATOMIC_RELAXED, __HIP_MEMORY_SCOPE_AGENT); }
DI unsigned xb_xcc_id() { return (unsigned)__builtin_amdgcn_s_getreg((3 << 11) | 20) & 0xFu; }
#define XB_SPIN(cond, bar) do { unsigned _sp = 0; while (cond) { __builtin_amdgcn_s_sleep(1); \
    if ((++_sp & 255u) == 0u) { if (xb_ld(&(bar)[XB_TMO])) break; if (_sp > XB_SPIN_CAP) { atomicAdd(&(bar)[XB_TMO], 1u); break; } } } } while (0)
struct XcdBarrier { unsigned* bar; unsigned x; volatile LAS unsigned* st; };
DI XcdBarrier xcd_barrier_post(int tid, unsigned* bar, volatile LAS unsigned* st) {
    XcdBarrier b; b.bar = bar; b.x = xb_xcc_id(); b.st = st;
    if (tid == 0) (void)xb_add(&bar[XB_XCNT(b.x)], 1u);
    return b;
}
DI void xcd_barrier_complete(unsigned* bar, unsigned x, unsigned& nloc, unsigned& nx) {
    const unsigned G = gridDim.x * gridDim.y * gridDim.z;
    unsigned sum, cnt, mine, sp = 0u;
    for (;;) {
        sum = 0u; cnt = 0u; mine = 0u;
#pragma unroll
        for (unsigned j = 0; j < 16; ++j) { const unsigned c = xb_ld(&bar[XB_XCNT(j)]); sum += c; cnt += (c > 0u) ? 1u : 0u; mine = (j == x) ? c : mine; }
        if (sum == G) break;
        __builtin_amdgcn_s_sleep(1);
        if ((++sp & 255u) == 0u) { if (xb_ld(&bar[XB_TMO])) break; if (sp > XB_SPIN_CAP) { atomicAdd(&bar[XB_TMO], 1u); break; } }
    }
    nloc = mine > 0u ? mine : 1u; nx = cnt > 0u ? cnt : 1u;
}
DI void xcd_barrier(int tid, const XcdBarrier& b) {
    asm volatile("s_waitcnt vmcnt(0)" ::: "memory");
    __syncthreads();
    if (tid == 0) {
        unsigned* bar = b.bar;
        __builtin_amdgcn_s_waitcnt(0);
        unsigned nloc = b.st[0], nx = b.st[1];
        if (nloc == 0u) { xcd_barrier_complete(bar, b.x, nloc, nx); b.st[0] = nloc; b.st[1] = nx; }
        const unsigned old = xb_add(&bar[XB_XSUB(b.x)], 1u);
        const unsigned gen = old / nloc;
        if (old + 1u == (gen + 1u) * nloc) {
            __builtin_amdgcn_fence(__ATOMIC_RELEASE, "agent");
            asm volatile("s_waitcnt vmcnt(0)" ::: "memory");
            const unsigned og = xb_add(&bar[XB_TOP], 1u);
            const unsigned tg = og / nx;
            if (og + 1u == (tg + 1u) * nx) xb_add(&bar[XB_TOPGEN], 1u);
            else XB_SPIN(xb_ld(&bar[XB_TOPGEN]) == tg, bar);
            __builtin_amdgcn_fence(__ATOMIC_ACQUIRE, "agent");
            xb_add(&bar[XB_XGEN(b.x)], 1u);
            asm volatile("s_waitcnt vmcnt(0)" ::: "memory");
        } else {
            XB_SPIN(xb_ld(&bar[XB_XGEN(b.x)]) == gen, bar);
            __builtin_amdgcn_fence(__ATOMIC_ACQUIRE, "agent");
            asm volatile("s_waitcnt vmcnt(0)" ::: "memory");
        }
    }
    __syncthreads();
}

enum { K_PREP = 0, K_GACT, K_GRES, K_LN, K_RGCONV, K_RGSCAN0, K_RGSCAN1, K_KMEAN, K_ATTN, K_RMIX, K_RPREP, K_RSCAN, K_RPOST, K_POOL };
constexpr int NSTEPS = 38;
struct Desc {
    int kind;
    pg8::Gemm g;
    bf16_t* C; const float* res; const float* cscale; long sC; int ldc; unsigned acts;
    int lnidx, lnlast;
};
DI bool step_nosync(int st) { return st == 11 || st == 21; }
DI Desc make_desc(int st, const Params& p, unsigned char* ws) {
    unsigned char* sl = ws + O_SLOT;
    auto slot = [&](int i) { return (bf16_t*)(sl + (size_t)i * SLOT); };
    bf16_t* xb = slot(8);
    Desc d; d.kind = K_PREP; d.g = mk_gemm(nullptr, nullptr, 0, 0, 0, 0, 0, 0, 0, 0);
    d.C = nullptr; d.res = nullptr; d.cscale = nullptr; d.sC = 0; d.ldc = D; d.acts = 0u; d.lnidx = 0; d.lnlast = 0;
    int layer = -1, sub = 0;
    if (st >= 7 && st < 11) { layer = 0; sub = st - 7; }
    else if (st >= 16 && st < 20) { layer = 1; sub = st - 16; }
    else if (st >= 28 && st < 32) { layer = 2; sub = st - 28; }
    else if (st >= 34 && st < 38) { layer = 3; sub = st - 34; }
    if (layer >= 0) {
        if (sub == 0) { d.kind = K_LN; d.lnidx = layer * 2; }
        else if (sub == 1) { d.kind = K_GACT; d.C = slot(0); d.ldc = DFF; d.acts = 1u;
            d.g = mk_gemm(xb, (const bf16_t*)(ws + O_W1T + (size_t)layer * DFF * D * 2), 0, 0, D, D, D, T / 256, DFF / 256, 1); }
        else if (sub == 2) { d.kind = K_GRES;
            d.g = mk_gemm(slot(0), (const bf16_t*)(ws + O_W2T + (size_t)layer * DFF * D * 2), 0, 0, DFF, DFF, DFF, T / 256, D / 256, 1); }
        else { d.kind = K_LN; d.lnidx = layer * 2 + 1; d.lnlast = (layer == 3); }
        return d;
    }
    switch (st) {
    case 0: d.kind = K_PREP; break;
    case 1: d.kind = K_GACT; d.C = slot(0); d.ldc = 4096;
            d.g = mk_gemm(xb, (const bf16_t*)(ws + O_WIN), 0, 0, D, D, D, T / 256, 4096 / 256, 1); break;
    case 2: d.kind = K_RGCONV; break;
    case 3: d.kind = K_GACT; d.C = slot(3); d.sC = 512; d.ldc = 4096;
            d.g = mk_gemm(slot(2), (const bf16_t*)(ws + O_GATES), 256, 512 * 256, D, 256, 256, T / 256, 2, 8); break;
    case 4: d.kind = K_RGSCAN0; break;
    case 5: d.kind = K_RGSCAN1; break;
    case 6: d.kind = K_GRES; d.res = p.in[0];
            d.g = mk_gemm(slot(5), (const bf16_t*)(ws + O_RGOUT), 0, 0, D, D, D, T / 256, D / 256, 1); break;
    case 11: d.kind = K_GACT; d.C = slot(0); d.sC = (long)T * D;
             d.g = mk_gemm(xb, (const bf16_t*)(ws + O_QKV), 0, (long)D * D, D, D, D, T / 256, D / 256, 2); break;
    case 12: d.kind = K_GACT; d.C = slot(2); d.ldc = T;
             d.g = mk_gemm((const bf16_t*)(ws + O_QKV + 2 * SZ_DD), xb, 0, 0, D, D, D, D / 256, T / 256, 1); break;
    case 13: d.kind = K_KMEAN; break;
    case 14: d.kind = K_ATTN; break;
    case 15: d.kind = K_GRES;
             d.g = mk_gemm(slot(3), (const bf16_t*)(ws + O_MOUT), 0, 0, D, D, D, T / 256, D / 256, 1); break;
    case 20: d.kind = K_RMIX; break;
    case 21: d.kind = K_GACT; d.C = slot(6); d.sC = (long)T * D;
             d.g = mk_gemm(slot(0), (const bf16_t*)(ws + O_RKV), (long)T * D, (long)D * D, D, D, D, T / 256, D / 256, 3); break;
    case 22: d.kind = K_GACT; d.C = (bf16_t*)(ws + O_L1O); d.sC = (long)T * 256; d.ldc = 256; d.acts = 0x302u;
             d.g = mk_gemm(slot(3), (const bf16_t*)(ws + O_L1), (long)T * D, (long)256 * D, D, D, D, T / 256, 1, 3); break;
    case 23: d.kind = K_GACT; d.C = slot(0); d.sC = (long)T * D;
             d.g = mk_gemm((const bf16_t*)(ws + O_L1O), (const bf16_t*)(ws + O_L2), (long)T * 256, (long)D * 256, 256, 256, 256, T / 256, D / 256, 3); break;
    case 24: d.kind = K_RPREP; break;
    case 25: d.kind = K_RSCAN; break;
    case 26: d.kind = K_RPOST; break;
    case 27: d.kind = K_GRES;
             d.g = mk_gemm(slot(3), (const bf16_t*)(ws + O_ROUT), 0, 0, D, D, D, T / 256, D / 256, 1); break;
    case 32: d.kind = K_POOL; break;
    case 33: d.kind = K_GRES; d.cscale = p.in[33]; d.sC = 512;
             d.g = mk_gemm(slot(0), (const bf16_t*)(ws + O_POOL), 512, 512 * 512, D, 512, 512, T / 256, 2, 4); break;
    default: break;
    }
    return d;
}

__global__ void __launch_bounds__(512, 2) fwd_megakernel(Params p) {
    extern __shared__ __attribute__((aligned(16))) unsigned char smem[];
    cg::grid_group grid = cg::this_grid();
    LAS unsigned char* lds = (LAS unsigned char*)smem;

    const bool multi = (p.hi - p.lo) > 1;
    volatile LAS unsigned* xst = (volatile LAS unsigned*)(lds + 131072);
    if (__builtin_amdgcn_workitem_id_x() == 0) { xst[0] = 0u; xst[1] = 0u; }
    __syncthreads();
    (void)xcd_barrier_post((int)__builtin_amdgcn_workitem_id_x(), (unsigned*)(p.ws + O_BAR), xst);
    for (int st = p.lo; st < p.hi; ++st) {
        int tid_ = (int)__builtin_amdgcn_workitem_id_x(); asm volatile("" : "+v"(tid_));
        int bid_ = (int)__builtin_amdgcn_workgroup_id_x(); asm volatile("" : "+s"(bid_));
        unsigned char* ws = p.ws; asm volatile("" : "+s"(ws));
        float* xcur = p.out; asm volatile("" : "+s"(xcur));
        unsigned char* sl = ws + O_SLOT;
        auto slot = [&](int i) { return (bf16_t*)(sl + (size_t)i * SLOT); };
        const int stu = __builtin_amdgcn_readfirstlane(st);
        const Desc d = make_desc(stu, p, ws);
        switch (__builtin_amdgcn_readfirstlane(d.kind)) {
        case K_PREP: prep_phase(tid_, bid_, p, smem); break;
        case K_GACT: { pg8::EpiAct E; E.C = d.C; E.sC = d.sC; E.ldc = d.ldc; E.acts = d.acts; pg8::gemm_phase(tid_, bid_, lds, d.g, E); } break;
        case K_GRES: { pg8::EpiRes E; E.out = xcur; E.res = d.res ? d.res : xcur; E.cscale = d.cscale; E.alpha = ALPHA; E.sC = d.sC; E.ldc = D; pg8::gemm_phase(tid_, bid_, lds, d.g, E); } break;
        case K_LN: ln_phase(tid_, bid_, xcur, xcur, d.lnlast ? nullptr : slot(8), p.in[1] + (size_t)d.lnidx * D, p.in[2] + (size_t)d.lnidx * D); break;
        case K_RGCONV: rg_conv_phase(tid_, bid_, slot(0), slot(2), p.in[6], p.in[7]); break;
        case K_RGSCAN0: rg_scan_phase<0>(tid_, bid_, p, slot(3), slot(2), slot(0), (float*)(ws + O_AGG), slot(5)); break;
        case K_RGSCAN1: rg_scan_phase<1>(tid_, bid_, p, slot(3), slot(2), slot(0), (float*)(ws + O_AGG), slot(5)); break;
        case K_KMEAN: kmean_phase(tid_, bid_, slot(0), slot(1), (float*)(ws + O_KMEAN), (const float*)(ws + O_ROPE), (const float*)(ws + O_ROPE) + SEQ * 16, smem); break;
        case K_ATTN: attn_phase(tid_, bid_, slot(0), slot(1), slot(2), slot(3), (const float*)(ws + O_KMEAN), smem); break;
        case K_RMIX: rwkv_mix_phase(tid_, bid_, xcur, p.in[16], slot(0)); break;
        case K_RPREP: rwkv_prep_phase(tid_, bid_, p, sl, (float*)(ws + O_SCAL)); break;
        case K_RSCAN: rwkv_scan_phase(tid_, bid_, sl, (const float*)(ws + O_SCAL), smem); break;
        case K_RPOST: rwkv_post_phase(tid_, bid_, p, sl, (const float*)(ws + O_SCAL)); break;
        case K_POOL: pool_phase(tid_, bid_, xcur, slot(0)); break;
        default: break;
        }
        if (multi && !step_nosync(st) && st + 1 < p.hi) { if (st == p.lo) grid.sync(); else { XcdBarrier xb; xb.bar = (unsigned*)(ws + O_BAR); xb.x = xb_xcc_id(); xb.st = (volatile LAS unsigned*)(lds + 131072); xcd_barrier(tid_, xb); } }
    }
}

extern "C" void kernel_launch(void* const* d_in, const int* in_sizes, int n_in, void* d_out, int out_size, void* d_ws, size_t ws_size, hipStream_t stream) {
    static int grid = 0;
    if (grid == 0) {
        if (n_in != 34 || out_size != T * D || ws_size < WS_END) { fprintf(stderr, "kernel_launch: unexpected shapes (n_in %d out %d ws %zu need %zu)\n", n_in, out_size, ws_size, (size_t)WS_END); grid = -1; return; }
        int dev = 0, cus = 0, per_cu = 0;
        hipGetDevice(&dev);
        hipDeviceGetAttribute(&cus, hipDeviceAttributeMultiprocessorCount, dev);
        if (hipFuncSetAttribute((const void*)fwd_megakernel, hipFuncAttributeMaxDynamicSharedMemorySize, LDS_BYTES) != hipSuccess) { fprintf(stderr, "kernel_launch: hipFuncSetAttribute failed\n"); grid = -1; return; }
        hipOccupancyMaxActiveBlocksPerMultiprocessor(&per_cu, (const void*)fwd_megakernel, 512, LDS_BYTES);
        if (per_cu < 1) { fprintf(stderr, "kernel_launch: occupancy query says %d blocks/CU\n", per_cu); per_cu = 1; }
        (void)hipGetLastError();
        grid = cus;
    }
    if (grid < 0) return;
    Params p{};
    for (int i = 0; i < 34; ++i) p.in[i] = (const float*)d_in[i];
    {
        unsigned char* ws = (unsigned char*)d_ws; int nj = 0, t0 = 0;
        auto add = [&](const float* src, size_t dstoff, int Ks, int Ns, int Kd, int Nd) {
            TJob& j = p.tj[nj]; j.src = src; j.dst = (bf16_t*)(ws + dstoff); j.Ks = Ks; j.Ns = Ns; j.Kd = Kd; j.Nd = Nd; j.tile0 = t0; j.pad = 0;
            t0 += (Kd / 128) * (Nd / 128); ++nj; };
        for (int l = 0; l < 4; ++l) add(p.in[3] + (size_t)l * D * DFF, O_W1T + (size_t)l * DFF * D * 2, D, DFF, D, DFF);
        for (int l = 0; l < 4; ++l) add(p.in[4] + (size_t)l * D * DFF, O_W2T + (size_t)l * DFF * D * 2, DFF, D, DFF, D);
        add(p.in[5], O_WIN, D, 4096, D, 4096);
        for (int n = 0; n < 8; ++n) { add(p.in[8] + (size_t)n * 65536, O_GATES + (size_t)n * 512 * 256 * 2, 256, 256, 256, 256);
                                      add(p.in[10] + (size_t)n * 65536, O_GATES + ((size_t)n * 512 + 256) * 256 * 2, 256, 256, 256, 256); }
        add(p.in[13], O_RGOUT, D, D, D, D);
        add(p.in[14], O_QKV, D, 3 * D, D, 3 * D);
        add(p.in[15], O_MOUT, D, D, D, D);
        for (int g = 0; g < 3; ++g) add(p.in[17] + (size_t)g * D * D, O_RKV + g * SZ_DD, D, D, D, D);
        add(p.in[19], O_L1 + 0 * (size_t)256 * D * 2, D, 96, D, 256);
        add(p.in[22], O_L1 + 1 * (size_t)256 * D * 2, D, 96, D, 256);
        add(p.in[24], O_L1 + 2 * (size_t)256 * D * 2, D, 256, D, 256);
        add(p.in[20], O_L2 + 0 * (size_t)D * 256 * 2, 96, D, 256, D);
        add(p.in[23], O_L2 + 1 * (size_t)D * 256 * 2, 96, D, 256, D);
        add(p.in[25], O_L2 + 2 * (size_t)D * 256 * 2, 256, D, 256, D);
        add(p.in[31], O_ROUT, D, D, D, D);
        for (int g = 0; g < 4; ++g) add(p.in[32] + (size_t)g * 512 * 512, O_POOL + (size_t)g * 512 * 512 * 2, 512, 512, 512, 512);
        p.ntiles = t0;
        if (nj != NTJ) fprintf(stderr, "kernel_launch: job table size %d != %d\n", nj, NTJ);
    }
    p.out = (float*)d_out; p.ws = (unsigned char*)d_ws; p.lo = 0; p.hi = NSTEPS;
    if (hipMemsetAsync((unsigned char*)d_ws + O_BAR, 0, BAR_BYTES, stream) != hipSuccess) { fprintf(stderr, "kernel_launch: memset of barrier words failed\n"); return; }
    void* args[] = {&p};
    hipError_t e = hipLaunchCooperativeKernel((const void*)fwd_megakernel, dim3(grid), dim3(512), args, LDS_BYTES, stream);
    if (e != hipSuccess) fprintf(stderr, "cooperative launch failed: %s (grid %d)\n", hipGetErrorString(e), grid);
}
```

```cpp
#include <hip/hip_runtime.h>
#include <hip/hip_cooperative_groups.h>
#include <cstdio>
namespace cg = cooperative_groups;

#define LAS __attribute__((address_space(3)))
typedef unsigned short bf16_t;
typedef short bf16x8 __attribute__((ext_vector_type(8)));
typedef float f32x4 __attribute__((ext_vector_type(4)));
typedef float f32x2 __attribute__((ext_vector_type(2)));
typedef unsigned u32x4 __attribute__((ext_vector_type(4)));
typedef unsigned u32x2 __attribute__((ext_vector_type(2)));
typedef __bf16 bfv2 __attribute__((ext_vector_type(2)));
#define DI __device__ __forceinline__

constexpr int T = 16384, D = 2048, SEQ = 4096, DFF = 8192;
constexpr float ALPHA = 1.6817928305074290f;
constexpr float LN_EPS = 1e-5f;

constexpr size_t SZ_DD = (size_t)D * D * 2;
constexpr size_t O_W1T = 0;
constexpr size_t O_W2T = O_W1T + 4 * (size_t)DFF * D * 2;
constexpr size_t O_WIN = O_W2T + 4 * (size_t)DFF * D * 2;
constexpr size_t O_GATES = O_WIN + (size_t)4096 * D * 2;
constexpr size_t O_RGOUT = O_GATES + (size_t)8 * 512 * 256 * 2;
constexpr size_t O_QKV = O_RGOUT + SZ_DD;
constexpr size_t O_MOUT = O_QKV + 3 * SZ_DD;
constexpr size_t O_RKV = O_MOUT + SZ_DD;
constexpr size_t O_L1 = O_RKV + 3 * SZ_DD;
constexpr size_t O_L2 = O_L1 + (size_t)3 * 256 * D * 2;
constexpr size_t O_ROUT = O_L2 + (size_t)3 * D * 256 * 2;
constexpr size_t O_POOL = O_ROUT + SZ_DD;
constexpr size_t O_SLOT = O_POOL + (size_t)4 * 512 * 512 * 2;
constexpr size_t SLOT = (size_t)T * D * 2;
constexpr size_t O_L1O = O_SLOT + 9 * SLOT;
constexpr size_t O_ROPE = O_L1O + (size_t)3 * T * 256 * 2;
constexpr size_t O_KMEAN = O_ROPE + (size_t)2 * SEQ * 16 * 4;
constexpr size_t O_AGG = O_KMEAN + (size_t)64 * 16 * 128 * 4;
constexpr size_t O_SCAL = O_AGG + (size_t)4 * 128 * D * 2 * 4;
constexpr size_t O_BAR = O_SCAL + (size_t)3 * T * 32 * 4;
constexpr size_t BAR_BYTES = 16384;
constexpr size_t WS_END = O_BAR + BAR_BYTES;

constexpr int LDS_BYTES = 131072 + 16;

struct TJob { const float* src; bf16_t* dst; int Ks, Ns, Kd, Nd, tile0, pad; };
constexpr int NTJ = 42;
struct Params {
    const float* in[34];
    float* out;
    unsigned char* ws;
    int lo, hi, ntiles, pad;
    TJob tj[NTJ];
};

DI unsigned pk_bf16(float a, float b) { f32x2 v = {a, b}; bfv2 r = __builtin_convertvector(v, bfv2); return __builtin_bit_cast(unsigned, r); }
DI bf16_t f2bf(float a) { return (bf16_t)(pk_bf16(a, 0.f) & 0xffffu); }
DI float bf2f(bf16_t b) { return __uint_as_float(((unsigned)b) << 16); }
DI float bflo(unsigned u) { return __uint_as_float(u << 16); }
DI float bfhi(unsigned u) { return __uint_as_float(u & 0xffff0000u); }
DI float wave_sum(float v) {
    v += __int_as_float(__builtin_amdgcn_update_dpp(0, __float_as_int(v), 0xB1, 0xF, 0xF, false));
    v += __int_as_float(__builtin_amdgcn_update_dpp(0, __float_as_int(v), 0x4E, 0xF, 0xF, false));
    v += __int_as_float(__builtin_amdgcn_update_dpp(0, __float_as_int(v), 0x141, 0xF, 0xF, false));
    v += __int_as_float(__builtin_amdgcn_update_dpp(0, __float_as_int(v), 0x140, 0xF, 0xF, false));
    const int iv = __float_as_int(v);
    return __int_as_float(__builtin_amdgcn_readlane(iv, 0)) + __int_as_float(__builtin_amdgcn_readlane(iv, 16)) +
           __int_as_float(__builtin_amdgcn_readlane(iv, 32)) + __int_as_float(__builtin_amdgcn_readlane(iv, 48));
}
DI float xmax_fq(float v) {
    const auto a = __builtin_amdgcn_permlane32_swap(__float_as_uint(v), __float_as_uint(v), false, false);
    v = fmaxf(__uint_as_float(a[0]), __uint_as_float(a[1]));
    const auto b = __builtin_amdgcn_permlane16_swap(__float_as_uint(v), __float_as_uint(v), false, false);
    return fmaxf(__uint_as_float(b[0]), __uint_as_float(b[1]));
}
DI float xsum_fq(float v) {
    const auto a = __builtin_amdgcn_permlane32_swap(__float_as_uint(v), __float_as_uint(v), false, false);
    v = __uint_as_float(a[0]) + __uint_as_float(a[1]);
    const auto b = __builtin_amdgcn_permlane16_swap(__float_as_uint(v), __float_as_uint(v), false, false);
    return __uint_as_float(b[0]) + __uint_as_float(b[1]);
}
DI float row_sum16(float v) {
    v += __int_as_float(__builtin_amdgcn_update_dpp(0, __float_as_int(v), 0xB1, 0xF, 0xF, false));
    v += __int_as_float(__builtin_amdgcn_update_dpp(0, __float_as_int(v), 0x4E, 0xF, 0xF, false));
    v += __int_as_float(__builtin_amdgcn_update_dpp(0, __float_as_int(v), 0x141, 0xF, 0xF, false));
    v += __int_as_float(__builtin_amdgcn_update_dpp(0, __float_as_int(v), 0x140, 0xF, 0xF, false));
    return v;
}
DI float half_sum(float v) {
    v += __int_as_float(__builtin_amdgcn_update_dpp(0, __float_as_int(v), 0xB1, 0xF, 0xF, false));
    v += __int_as_float(__builtin_amdgcn_update_dpp(0, __float_as_int(v), 0x4E, 0xF, 0xF, false));
    v += __int_as_float(__builtin_amdgcn_update_dpp(0, __float_as_int(v), 0x141, 0xF, 0xF, false));
    v += __int_as_float(__builtin_amdgcn_update_dpp(0, __float_as_int(v), 0x140, 0xF, 0xF, false));
    const auto b = __builtin_amdgcn_permlane16_swap(__float_as_uint(v), __float_as_uint(v), false, false);
    return __uint_as_float(b[0]) + __uint_as_float(b[1]);
}
DI void lds_barrier() { asm volatile("s_waitcnt lgkmcnt(0)" ::: "memory"); __builtin_amdgcn_s_barrier(); asm volatile("" ::: "memory"); }
DI float sigmoidf_(float x) { return __builtin_amdgcn_rcpf(1.f + __expf(-x)); }
DI float tanhf_(float x) { return 1.f - 2.f * __builtin_amdgcn_rcpf(1.f + __expf(2.f * x)); }
DI float gelu_tanh(float x) { const float u = 0.7978845608028654f * (x + 0.044715f * x * x * x); return 0.5f * x * (1.f + tanhf_(u)); }

namespace pg8 {
constexpr int BM = 256, BK = 64, HALF = 128, HTB = HALF * BK * 2, NXCD = 8, WGM = 4;
DI int lds_byte(int r, int c) { const int st = (r >> 4) * 2 + (c >> 5), rr = r & 15, cc = c & 31, ob = rr * 64 + cc * 2; return st * 1024 + (ob ^ (((ob >> 9) & 1) << 5)); }
DI void stage_rc(int b, int& R, int& C) { const int st = b / 1024, sb = b % 1024, swz = sb ^ (((sb >> 9) & 1) << 5); R = (st >> 1) * 16 + swz / 64; C = (st & 1) * 32 + (swz % 64) / 2; }
DI int perm32(int rho) { const int n = rho >> 4, i = rho & 15; return 8 * (i >> 2) + 4 * n + (i & 3); }

struct Unit { int g, pm, pn; };
struct Gemm { const bf16_t* A; const bf16_t* Bt; long sA, sB; int lda, ldb, K, nM, nN, G; };

struct Order {
    int nM, nN, nwg, tot, Gd, c;
    DI void init(const Gemm& g, int Gd_, int c_) { nM = g.nM; nN = g.nN; nwg = nM * nN; tot = nwg * g.G; Gd = Gd_; c = c_; }
    DI bool next(int i, Unit& u) const {
        const long L = (long)i * Gd + c; if (L >= tot) return false;
        const int grp = (int)(L / nwg); int wgid = (int)(L - (long)grp * nwg);
        { const int q = nwg / NXCD, r = nwg % NXCD, xcd = wgid % NXCD, off = wgid / NXCD; wgid = (xcd < r ? xcd * (q + 1) : r * (q + 1) + (xcd - r) * q) + off; }
        const int nig = WGM * nN, gid = wgid / nig, fm = gid * WGM, gsz = (nM - fm) < WGM ? (nM - fm) : WGM;
        u.g = grp; u.pm = fm + ((wgid % nig) % gsz); u.pn = (wgid % nig) / gsz; return true;
    }
};

struct EpiAct {
    static constexpr bool PERM = true;
    bf16_t* C; long sC; int ldc; unsigned acts;
    DI void operator()(const f32x4 (&acc)[2][2][4][2], const Unit& u, int wr, int wc, int fr, int fq) const {
        bf16_t* base = C + (size_t)u.g * sC;
        const int act = (int)((acts >> (4 * u.g)) & 15u);
        const int row0 = u.pm * BM + wr * 64 + fr, col0 = u.pn * BM + wc * 32 + 8 * fq;
#pragma unroll
        for (int ai = 0; ai < 2; ++ai)
#pragma unroll
            for (int m = 0; m < 4; ++m) {
                bf16_t* rowp = base + (size_t)(row0 + ai * HALF + m * 16) * ldc + col0;
#pragma unroll
                for (int bj = 0; bj < 2; ++bj) {
                    float v[8];
#pragma unroll
                    for (int e = 0; e < 4; ++e) { v[e] = acc[ai][bj][m][0][e]; v[4 + e] = acc[ai][bj][m][1][e]; }
                    if (act == 1) {
#pragma unroll
                        for (int e = 0; e < 8; ++e) { const float t = fmaxf(v[e], 0.f); v[e] = t * t; }
                    } else if (act == 2) {
#pragma unroll
                        for (int e = 0; e < 8; ++e) v[e] = tanhf_(v[e]);
                    } else if (act == 3) {
#pragma unroll
                        for (int e = 0; e < 8; ++e) v[e] = sigmoidf_(v[e]);
                    }
                    u32x4 o = {pk_bf16(v[0], v[1]), pk_bf16(v[2], v[3]), pk_bf16(v[4], v[5]), pk_bf16(v[6], v[7])};
                    *(u32x4*)(rowp + bj * HALF) = o;
                }
            }
    }
};
struct EpiRes {
    static constexpr bool PERM = false;
    float* out; const float* res; const float* cscale; float alpha; long sC; int ldc;
    DI void operator()(const f32x4 (&acc)[2][2][4][2], const Unit& u, int wr, int wc, int fr, int fq) const {
        const int row0 = u.pm * BM + wr * 64 + fr, col0 = (int)(u.g * sC) + u.pn * BM + wc * 32 + 4 * fq;
        f32x4 r[2][2][2][2];
        auto ldq = [&](int q, int buf) {
            const int ai = q >> 1, m0 = (q & 1) * 2;
#pragma unroll
            for (int mm = 0; mm < 2; ++mm) {
                const size_t ro = (size_t)(row0 + ai * HALF + (m0 + mm) * 16) * ldc + col0;
#pragma unroll
                for (int bj = 0; bj < 2; ++bj)
#pragma unroll
                    for (int n = 0; n < 2; ++n) r[buf][mm][bj][n] = *(const f32x4*)(res + ro + bj * HALF + n * 16);
            }
        };
        auto stq = [&](int q, int buf) {
            const int ai = q >> 1, m0 = (q & 1) * 2;
#pragma unroll
            for (int mm = 0; mm < 2; ++mm) {
                const size_t ro = (size_t)(row0 + ai * HALF + (m0 + mm) * 16) * ldc + col0;
#pragma unroll
                for (int bj = 0; bj < 2; ++bj)
#pragma unroll
                    for (int n = 0; n < 2; ++n) {
                        f32x4 a = acc[ai][bj][m0 + mm][n];
                        if (cscale) a *= *(const f32x4*)(cscale + col0 + bj * HALF + n * 16);
                        *(f32x4*)(out + ro + bj * HALF + n * 16) = alpha * r[buf][mm][bj][n] + a;
                    }
            }
        };
        ldq(0, 0); ldq(1, 1);
        __builtin_amdgcn_sched_barrier(0);
        stq(0, 0); ldq(2, 0);
        __builtin_amdgcn_sched_barrier(0);
        stq(1, 1); ldq(3, 1);
        __builtin_amdgcn_sched_barrier(0);
        stq(2, 0); stq(3, 1);
    }
};
template <class Epi>
DI void gemm_phase(int tid_, int bid_, LAS unsigned char* lds, const Gemm g, const Epi& E) {
    const int tid = tid_, wid = __builtin_amdgcn_readfirstlane(tid >> 6), lane = tid & 63, wr = wid >> 2, wc = wid & 3, fr = lane & 15, fq = lane >> 4;
    const int K = g.K, nt = K / BK;
    Order S; S.init(g, (int)gridDim.x, (int)bid_);
    unsigned voffA[2], voffB[2];
#pragma unroll
    for (int i = 0; i < 2; ++i) { int R, C; stage_rc(tid * 16 + i * 8192, R, C); const int Rb = Epi::PERM ? ((R & ~31) + perm32(R & 31)) : R;
        voffA[i] = (unsigned)(R * g.lda + C) * 2u; voffB[i] = (unsigned)(Rb * g.ldb + C) * 2u; }
    const size_t kstep = (size_t)(BK * 2);
    const size_t hA = (size_t)HALF * g.lda * 2, hB = (size_t)HALF * g.ldb * 2;
    const unsigned ldsw = (unsigned)wid * 1024u;
    const int aoff = lds_byte(wr * 64 + fr, fq * 8), boff = lds_byte(wc * 32 + fr, fq * 8);
#define PG8_SA(b, h) (((b) * 2 + (h)) * HTB)
#define PG8_SB(b, h) ((4 + (b) * 2 + (h)) * HTB)
#define PG8_STAGE(bufoff, gbase, voff) do { _Pragma("unroll") for (int _i = 0; _i < 2; ++_i) \
        __builtin_amdgcn_global_load_lds((const unsigned*)((const char*)(gbase) + (voff)[_i]), (LAS unsigned*)(lds + (bufoff) + ldsw + _i * 8192), 16, 0, 0); } while (0)
#define PG8_LDA(dst, b, h) do { _Pragma("unroll") for (int m = 0; m < 4; ++m) _Pragma("unroll") for (int k = 0; k < 2; ++k) dst[m][k] = *(const LAS bf16x8*)(lds + PG8_SA(b, h) + aoff + m * 2048 + k * 1024); } while (0)
#define PG8_LDB(dst, b, h) do { _Pragma("unroll") for (int n = 0; n < 2; ++n) _Pragma("unroll") for (int k = 0; k < 2; ++k) dst[n][k] = *(const LAS bf16x8*)(lds + PG8_SB(b, h) + boff + n * 2048 + k * 1024); } while (0)
#define PG8_MMA(ai, bj, At, Bt) do { __builtin_amdgcn_s_setprio(1); _Pragma("unroll") for (int m = 0; m < 4; ++m) _Pragma("unroll") for (int n = 0; n < 2; ++n) _Pragma("unroll") for (int k = 0; k < 2; ++k) \
        acc[ai][bj][m][n] = __builtin_amdgcn_mfma_f32_16x16x32_bf16(Bt[n][k], At[m][k], acc[ai][bj][m][n], 0, 0, 0); __builtin_amdgcn_s_setprio(0); } while (0)
#define PG8_WAIT_V(n) asm volatile("s_waitcnt vmcnt(" #n ")" ::: "memory")
#define PG8_WAIT_L(n) asm volatile("s_waitcnt lgkmcnt(" #n ")" ::: "memory")
#define PG8_BAR __builtin_amdgcn_s_barrier()
#define PG8_SCHED __builtin_amdgcn_sched_barrier(0)
    Unit cur, nxt; int ui = 0;
    if (!S.next(0, cur)) return;
    f32x4 acc[2][2][4][2];
#pragma unroll
    for (int a = 0; a < 2; ++a)
#pragma unroll
        for (int b = 0; b < 2; ++b)
#pragma unroll
            for (int m = 0; m < 4; ++m)
#pragma unroll
                for (int n = 0; n < 2; ++n) acc[a][b][m][n] = (f32x4){0.f, 0.f, 0.f, 0.f};
    bf16x8 At[4][2], B0[2][2], B1[2][2];
    const char* cA = (const char*)g.A + ((size_t)cur.g * g.sA + (size_t)cur.pm * BM * g.lda) * 2;
    const char* cB = (const char*)g.Bt + ((size_t)cur.g * g.sB + (size_t)cur.pn * BM * g.ldb) * 2;
    PG8_STAGE(PG8_SB(0, 0), cB, voffB); PG8_STAGE(PG8_SA(0, 0), cA, voffA); PG8_STAGE(PG8_SB(0, 1), cB + hB, voffB); PG8_STAGE(PG8_SA(0, 1), cA + hA, voffA);
    if (wr == 1) PG8_BAR;
    PG8_WAIT_V(4); PG8_BAR;
    PG8_STAGE(PG8_SB(1, 0), cB + kstep, voffB); PG8_STAGE(PG8_SA(1, 0), cA + kstep, voffA); PG8_STAGE(PG8_SB(1, 1), cB + hB + kstep, voffB);
    PG8_WAIT_V(6); PG8_BAR;
    for (;;) {
        const bool has_next = S.next(ui + 1, nxt);
        const char* nA = has_next ? (const char*)g.A + ((size_t)nxt.g * g.sA + (size_t)nxt.pm * BM * g.lda) * 2 : cA;
        const char* nB = has_next ? (const char*)g.Bt + ((size_t)nxt.g * g.sB + (size_t)nxt.pn * BM * g.ldb) * 2 : cB;
        for (int t = 0; t < nt; t += 2) {
            const bool last = (t == nt - 2);
            const char* a1 = cA + (size_t)(t + 1) * kstep;
            const char* a2 = last ? nA : cA + (size_t)(t + 2) * kstep; const char* b2 = last ? nB : cB + (size_t)(t + 2) * kstep;
            const char* a3 = a2 + kstep; const char* b3 = b2 + kstep;
            PG8_LDB(B0, 0, 0); PG8_SCHED; PG8_LDA(At, 0, 0); PG8_STAGE(PG8_SA(1, 1), a1 + hA, voffA);
            PG8_WAIT_L(8); PG8_BAR; PG8_WAIT_L(0); PG8_MMA(0, 0, At, B0); PG8_BAR; PG8_SCHED;
            PG8_LDB(B1, 0, 1); PG8_STAGE(PG8_SB(0, 0), b2, voffB);
            PG8_BAR; PG8_WAIT_L(0); PG8_MMA(0, 1, At, B1); PG8_BAR;
            PG8_LDA(At, 0, 1); PG8_STAGE(PG8_SA(0, 0), a2, voffA);
            PG8_BAR; PG8_WAIT_L(0); PG8_MMA(1, 0, At, B0); PG8_BAR; PG8_SCHED;
            PG8_STAGE(PG8_SB(0, 1), b2 + hB, voffB);
            PG8_WAIT_V(6); PG8_BAR; PG8_MMA(1, 1, At, B1); PG8_BAR;
            PG8_LDB(B0, 1, 0); PG8_SCHED; PG8_LDA(At, 1, 0); PG8_STAGE(PG8_SA(0, 1), a2 + hA, voffA);
            PG8_WAIT_L(8); PG8_BAR; PG8_WAIT_L(0); PG8_MMA(0, 0, At, B0); PG8_BAR; PG8_SCHED;
            PG8_LDB(B1, 1, 1); PG8_STAGE(PG8_SB(1, 0), b3, voffB);
            PG8_BAR; PG8_WAIT_L(0); PG8_MMA(0, 1, At, B1); PG8_BAR;
            PG8_LDA(At, 1, 1); PG8_STAGE(PG8_SA(1, 0), a3, voffA);
            PG8_BAR; PG8_WAIT_L(0); PG8_MMA(1, 0, At, B0); PG8_BAR; PG8_SCHED;
            PG8_STAGE(PG8_SB(1, 1), b3 + hB, voffB);
            PG8_WAIT_V(6); PG8_BAR; PG8_MMA(1, 1, At, B1); PG8_BAR;
        }
        E(acc, cur, wr, wc, fr, fq);
        if (!has_next) break;
#pragma unroll
        for (int a = 0; a < 2; ++a)
#pragma unroll
            for (int b = 0; b < 2; ++b)
#pragma unroll
                for (int m = 0; m < 4; ++m)
#pragma unroll
                    for (int n = 0; n < 2; ++n) acc[a][b][m][n] = (f32x4){0.f, 0.f, 0.f, 0.f};
        cur = nxt; cA = nA; cB = nB; ++ui;
    }
    PG8_WAIT_V(0);
    if (wr == 0) PG8_BAR;
    PG8_BAR;
#undef PG8_SA
#undef PG8_SB
#undef PG8_STAGE
#undef PG8_LDA
#undef PG8_LDB
#undef PG8_MMA
#undef PG8_WAIT_V
#undef PG8_WAIT_L
#undef PG8_BAR
#undef PG8_SCHED
}
}

DI pg8::Gemm mk_gemm(const bf16_t* A, const bf16_t* Bt, long sA, long sB, int lda, int ldb, int K, int nM, int nN, int G) {
    pg8::Gemm g; g.A = A; g.Bt = Bt; g.sA = sA; g.sB = sB; g.lda = lda; g.ldb = ldb; g.K = K; g.nM = nM; g.nN = nN; g.G = G; return g;
}

DI void prep_phase(int tid_, int bid_, const Params& p, unsigned char* smem) {
    TJob* jobs = (TJob*)smem;
    float* tile = (float*)(smem + 4096);
    const int tid = tid_;
    if (tid < NTJ) jobs[tid] = p.tj[tid];
    __syncthreads();
    const int ntiles = p.ntiles;
    for (int tix = bid_; tix < ntiles; tix += gridDim.x) {
        int j = 0;
        for (int q = 1; q < NTJ; ++q) if (jobs[q].tile0 <= tix) j = q;
        const TJob jb = jobs[j];
        const int lt = tix - jb.tile0, ntk = jb.Kd / 128, k0 = (lt % ntk) * 128, n0 = (lt / ntk) * 128;
        f32x4 v[8];
#pragma unroll
        for (int i = 0; i < 8; ++i) {
            const int idx = tid + i * 512, kk = idx >> 5, n4 = idx & 31;
            const int k = k0 + kk, n = n0 + n4 * 4;
            v[i] = (k < jb.Ks && n < jb.Ns) ? *(const f32x4*)(jb.src + (size_t)k * jb.Ns + n) : (f32x4){0.f, 0.f, 0.f, 0.f};
        }
#pragma unroll
        for (int i = 0; i < 8; ++i) {
            const int idx = tid + i * 512, kk = idx >> 5, n4 = idx & 31;
#pragma unroll
            for (int e = 0; e < 4; ++e) tile[kk * 129 + n4 * 4 + e] = v[i][e];
        }
        __syncthreads();
#pragma unroll
        for (int i = 0; i < 4; ++i) {
            const int idx = tid + i * 512, n = idx >> 4, kc = idx & 15;
            float f[8];
#pragma unroll
            for (int e = 0; e < 8; ++e) f[e] = tile[(kc * 8 + e) * 129 + n];
            u32x4 o = {pk_bf16(f[0], f[1]), pk_bf16(f[2], f[3]), pk_bf16(f[4], f[5]), pk_bf16(f[6], f[7])};
            *(u32x4*)(jb.dst + (size_t)(n0 + n) * jb.Kd + k0 + kc * 8) = o;
        }
        __syncthreads();
    }
    {
        const float* x = p.in[0]; bf16_t* xb = (bf16_t*)(p.ws + O_SLOT + 8 * SLOT);
        const size_t n8 = (size_t)T * D / 8;
        for (size_t i = (size_t)bid_ * 512 + tid; i < n8; i += (size_t)gridDim.x * 512) {
            const f32x4 a = *(const f32x4*)(x + i * 8), b = *(const f32x4*)(x + i * 8 + 4);
            u32x4 o = {pk_bf16(a[0], a[1]), pk_bf16(a[2], a[3]), pk_bf16(b[0], b[1]), pk_bf16(b[2], b[3])};
            *(u32x4*)(xb + i * 8) = o;
        }
    }
    {
        float* ct = (float*)(p.ws + O_ROPE); float* st = ct + SEQ * 16;
        for (int i = bid_ * 512 + tid; i < SEQ * 16; i += gridDim.x * 512) {
            const int pos = i >> 4, f = i & 15;
            const float inv = powf(500000.0f, -(float)(2 * f) / 32.0f);
            const float ang = (float)pos * inv;
            ct[i] = cosf(ang); st[i] = sinf(ang);
        }
    }
}

DI void ln_phase(int tid_, int bid_, const float* zin, float* xout, bf16_t* xb, const float* gam, const float* bet) {
    const int lane = tid_ & 63, wid = tid_ >> 6;
    const int rstride = gridDim.x * 8;
    constexpr int NR = 3;
    f32x4 gq[8], bq[8];
#pragma unroll
    for (int i = 0; i < 8; ++i) { gq[i] = *(const f32x4*)(gam + (i * 64 + lane) * 4); bq[i] = *(const f32x4*)(bet + (i * 64 + lane) * 4); }
    for (int row0 = bid_ * 8 + wid; row0 < T; row0 += NR * rstride) {
        f32x4 v[NR][8];
#pragma unroll
        for (int r = 0; r < NR; ++r)
#pragma unroll
            for (int i = 0; i < 8; ++i)
                v[r][i] = (row0 + r * rstride < T) ? *(const f32x4*)(zin + (size_t)(row0 + r * rstride) * D + (i * 64 + lane) * 4) : (f32x4){0.f, 0.f, 0.f, 0.f};
#pragma unroll
        for (int r = 0; r < NR; ++r) {
            const int row = row0 + r * rstride;
            if (row >= T) break;
            float s = 0.f;
#pragma unroll
            for (int i = 0; i < 8; ++i) s += v[r][i][0] + v[r][i][1] + v[r][i][2] + v[r][i][3];
            const float mean = wave_sum(s) * (1.f / D);
            float q = 0.f;
#pragma unroll
            for (int i = 0; i < 8; ++i) { v[r][i] -= mean; q += v[r][i][0] * v[r][i][0] + v[r][i][1] * v[r][i][1] + v[r][i][2] * v[r][i][2] + v[r][i][3] * v[r][i][3]; }
            const float rstd = rsqrtf(wave_sum(q) * (1.f / D) + LN_EPS);
#pragma unroll
            for (int i = 0; i < 8; ++i) {
                const int c = (i * 64 + lane) * 4;
                const f32x4 o = v[r][i] * rstd * gq[i] + bq[i];
                *(f32x4*)(xout + (size_t)row * D + c) = o;
                if (xb) { u32x2 w = {pk_bf16(o[0], o[1]), pk_bf16(o[2], o[3])}; *(u32x2*)(xb + (size_t)row * D + c) = w; }
            }
        }
    }
}

DI void rg_conv_phase(int tid_, int bid_, const bf16_t* gu, bf16_t* uc, const float* cw, const float* cb) {
    const size_t n8 = (size_t)T * D / 8;
    const size_t stride = (size_t)gridDim.x * 512;
    constexpr int U = 4;
    const int cc = (tid_ & 255) * 8;
    f32x4 wq[4][2], bq0, bq1;
#pragma unroll
    for (int j = 0; j < 4; ++j) { wq[j][0] = *(const f32x4*)(cw + j * D + cc); wq[j][1] = *(const f32x4*)(cw + j * D + cc + 4); }
    bq0 = *(const f32x4*)(cb + cc); bq1 = *(const f32x4*)(cb + cc + 4);
    for (size_t ib = (size_t)bid_ * 512 + tid_; ib < n8; ib += stride * U) {
        u32x4 uu[U][4];
#pragma unroll
        for (int u = 0; u < U; ++u) {
            const size_t i = ib + u * stride;
            const int t = (int)(i >> 8), c = (int)(i & 255) * 8, s = t & (SEQ - 1);
#pragma unroll
            for (int j = 0; j < 4; ++j)
                uu[u][j] = (i < n8 && s - 3 + j >= 0) ? *(const u32x4*)(gu + (size_t)(t - 3 + j) * 4096 + 2048 + c) : (u32x4){0u, 0u, 0u, 0u};
        }
#pragma unroll
        for (int u = 0; u < U; ++u) {
            const size_t i = ib + u * stride;
            if (i >= n8) break;
            const int c = (int)(i & 255) * 8;
            float a[8];
#pragma unroll
            for (int e = 0; e < 4; ++e) { a[e] = bq0[e]; a[4 + e] = bq1[e]; }
#pragma unroll
            for (int j = 0; j < 4; ++j) {
                const u32x4 q = uu[u][j];
                const f32x4 w0 = wq[j][0], w1 = wq[j][1];
                a[0] += w0[0] * bflo(q[0]); a[1] += w0[1] * bfhi(q[0]); a[2] += w0[2] * bflo(q[1]); a[3] += w0[3] * bfhi(q[1]);
                a[4] += w1[0] * bflo(q[2]); a[5] += w1[1] * bfhi(q[2]); a[6] += w1[2] * bflo(q[3]); a[7] += w1[3] * bfhi(q[3]);
            }
            u32x4 o = {pk_bf16(a[0], a[1]), pk_bf16(a[2], a[3]), pk_bf16(a[4], a[5]), pk_bf16(a[6], a[7])};
            *(u32x4*)(uc + i * 8) = o;
        }
    }
}
DI void rg_ab(float rpre, float ipre, float u, float ba, float bx, float sp8, float& a, float& b) {
    const float r = sigmoidf_(rpre + ba), ii = sigmoidf_(ipre + bx);
    const float la = -sp8 * r;
    a = __expf(la);
    const float x2 = 2.f * la;
    const float om = (x2 > -0.05f) ? -x2 * (1.f + x2 * (0.5f + x2 * (0.16666667f + x2 * 0.041666668f))) : 1.f - a * a;
    b = u * ii * __builtin_amdgcn_sqrtf(om);
}
template <int MODE>
DI void rg_scan_phase(int tid_, int bid_, const Params& p, const bf16_t* gates, const bf16_t* uc, const bf16_t* gu, float* agg, bf16_t* outg) {
    constexpr int CH = 32;
    const float* gab = p.in[9]; const float* gxb = p.in[11]; const float* lam = p.in[12];
    const int ch = tid_ * 4, n = ch >> 8, v = ch & 255;
    for (int item = bid_; item < 4 * 128; item += gridDim.x) {
        const int chunk = item & 127, b = item >> 7;
        const f32x4 ba = *(const f32x4*)(gab + ch), bx = *(const f32x4*)(gxb + ch), lm = *(const f32x4*)(lam + ch);
        float sp[4], h[4] = {0.f, 0.f, 0.f, 0.f}, P[4] = {1.f, 1.f, 1.f, 1.f};
#pragma unroll
        for (int e = 0; e < 4; ++e) sp[e] = 8.f * log1pf(expf(-lm[e]));
        if (MODE == 1) {
            for (int c0 = 0; c0 < chunk; c0 += 8) {
                f32x4 gv[8][2];
#pragma unroll
                for (int j = 0; j < 8; ++j) {
                    const float* ap = agg + (((size_t)b * 128 + c0 + j) * D + ch) * 2;
                    gv[j][0] = (c0 + j < chunk) ? *(const f32x4*)ap : (f32x4){1.f, 0.f, 1.f, 0.f};
                    gv[j][1] = (c0 + j < chunk) ? *(const f32x4*)(ap + 4) : (f32x4){1.f, 0.f, 1.f, 0.f};
                }
#pragma unroll
                for (int j = 0; j < 8; ++j) { h[0] = gv[j][0][0] * h[0] + gv[j][0][1]; h[1] = gv[j][0][2] * h[1] + gv[j][0][3]; h[2] = gv[j][1][0] * h[2] + gv[j][1][1]; h[3] = gv[j][1][2] * h[3] + gv[j][1][3]; }
            }
        }
        const size_t t0 = (size_t)b * SEQ + (size_t)chunk * CH;
        constexpr int UB = 8;
        for (int tb = 0; tb < CH; tb += UB) {
            u32x2 rpv[UB], ipv[UB], uuv[UB], ggv[UB];
#pragma unroll
            for (int j = 0; j < UB; ++j) {
                const size_t t = t0 + tb + j;
                rpv[j] = *(const u32x2*)(gates + t * 4096 + n * 512 + v);
                ipv[j] = *(const u32x2*)(gates + t * 4096 + n * 512 + 256 + v);
                uuv[j] = *(const u32x2*)(uc + t * D + ch);
                if (MODE == 1) ggv[j] = *(const u32x2*)(gu + t * 4096 + ch);
            }
#pragma unroll
            for (int j = 0; j < UB; ++j) {
                const size_t t = t0 + tb + j;
                const float rp[4] = {bflo(rpv[j][0]), bfhi(rpv[j][0]), bflo(rpv[j][1]), bfhi(rpv[j][1])};
                const float ip[4] = {bflo(ipv[j][0]), bfhi(ipv[j][0]), bflo(ipv[j][1]), bfhi(ipv[j][1])};
                const float uu[4] = {bflo(uuv[j][0]), bfhi(uuv[j][0]), bflo(uuv[j][1]), bfhi(uuv[j][1])};
#pragma unroll
                for (int e = 0; e < 4; ++e) {
                    float a, bb;
                    rg_ab(rp[e], ip[e], uu[e], ba[e], bx[e], sp[e], a, bb);
                    h[e] = a * h[e] + bb;
                    if (MODE == 0) P[e] *= a;
                }
                if (MODE == 1) {
                    const float gg[4] = {bflo(ggv[j][0]), bfhi(ggv[j][0]), bflo(ggv[j][1]), bfhi(ggv[j][1])};
                    u32x2 w = {pk_bf16(gelu_tanh(gg[0]) * h[0], gelu_tanh(gg[1]) * h[1]), pk_bf16(gelu_tanh(gg[2]) * h[2], gelu_tanh(gg[3]) * h[3])};
                    *(u32x2*)(outg + t * D + ch) = w;
                }
            }
        }
        if (MODE == 0) {
            float* ap = agg + (((size_t)b * 128 + chunk) * D + ch) * 2;
            f32x4 o0 = {P[0], h[0], P[1], h[1]}, o1 = {P[2], h[2], P[3], h[3]};
            *(f32x4*)ap = o0; *(f32x4*)(ap + 4) = o1;
        }
    }
}

DI void kmean_phase(int tid_, int bid_, bf16_t* Qx, bf16_t* Kx, float* kmean, const float* ctab, const float* stab, unsigned char* smem) {
    float* redA = (float*)smem;
    float* redB = redA + 1024;
    const int tid = tid_;
    for (int item = bid_; item < 1024; item += gridDim.x) {
        const int blk = item & 15, h = (item >> 4) & 15, b = item >> 8;
        {
            const int i = tid & 15, rg = tid >> 4;
            float s1 = 0.f, s2 = 0.f;
            bf16_t k1v[8], k2v[8], q1v[8], q2v[8]; float cv[8], sv[8];
#pragma unroll
            for (int r = 0; r < 8; ++r) {
                const int pos = blk * 256 + rg * 8 + r;
                const size_t o = ((size_t)b * SEQ + pos) * D + h * 128 + i;
                cv[r] = ctab[pos * 16 + i]; sv[r] = stab[pos * 16 + i];
                k1v[r] = Kx[o]; k2v[r] = Kx[o + 16]; q1v[r] = Qx[o]; q2v[r] = Qx[o + 16];
            }
#pragma unroll
            for (int r = 0; r < 8; ++r) {
                const int pos = blk * 256 + rg * 8 + r;
                const size_t o = ((size_t)b * SEQ + pos) * D + h * 128 + i;
                const float c = cv[r], sn = sv[r];
                const float k1 = bf2f(k1v[r]), k2 = bf2f(k2v[r]);
                const bf16_t k1r = f2bf(k1 * c - k2 * sn), k2r = f2bf(k2 * c + k1 * sn);
                Kx[o] = k1r; Kx[o + 16] = k2r; s1 += bf2f(k1r); s2 += bf2f(k2r);
                const float q1 = bf2f(q1v[r]), q2 = bf2f(q2v[r]);
                Qx[o] = f2bf(q1 * c - q2 * sn); Qx[o + 16] = f2bf(q2 * c + q1 * sn);
            }
            redA[rg * 32 + i] = s1; redA[rg * 32 + 16 + i] = s2;
        }
        {
            const int dp = tid & 63, rg = tid >> 6;
            if (dp >= 16) {
                const bf16_t* base = Kx + ((size_t)b * SEQ + blk * 256 + rg * 32) * D + h * 128 + dp * 2;
                float s0 = 0.f, s1 = 0.f;
                unsigned uv[32];
#pragma unroll
                for (int r = 0; r < 32; ++r) uv[r] = *(const unsigned*)(base + (size_t)r * D);
#pragma unroll
                for (int r = 0; r < 32; ++r) { s0 += bflo(uv[r]); s1 += bfhi(uv[r]); }
                redB[rg * 128 + dp * 2] = s0; redB[rg * 128 + dp * 2 + 1] = s1;
            }
        }
        __syncthreads();
        if (tid < 128) {
            float s = 0.f;
            if (tid < 32) { for (int r = 0; r < 32; ++r) s += redA[r * 32 + tid]; }
            else { for (int r = 0; r < 8; ++r) s += redB[r * 128 + tid]; }
            kmean[(size_t)item * 128 + tid] = s * (1.f / 256.f);
        }
        __syncthreads();
    }
}

DI void attn_phase(int tid_, int bid_, const bf16_t* Q, const bf16_t* Kx, const bf16_t* VT, bf16_t* O, const float* kmean, unsigned char* smem) {
    constexpr int KB_STRIDE = 288, VB_STRIDE = 160;
    constexpr int KBUF = 64 * KB_STRIDE, VBUF = 128 * VB_STRIDE;
    constexpr float QC = 0.08838834764831845f * 1.4426950408889634f;
    constexpr float THR_RAW = 8.0f / 0.08838834764831845f;
#define KBUFP(bi) (smem + (bi) * KBUF)
#define VBUFP(bi) (smem + 2 * KBUF + (bi) * VBUF)
    float* km = (float*)(smem + 2 * KBUF + 2 * VBUF);
    const int tid = tid_, wid = tid >> 6, lane = tid & 63, fr = lane & 15, fq = lane >> 4;
    for (int idx = bid_; idx < 1024; idx += gridDim.x) {
        const int bh = idx & 63, jj = idx >> 6, sub = jj & 3, r2 = jj >> 2;
        const int qb = (r2 == 0) ? sub : (r2 == 1) ? (7 - sub) : (r2 == 2) ? (8 + sub) : (15 - sub);
        const int b = bh >> 4, h = bh & 15;
        const size_t tok0 = (size_t)b * SEQ;
        const int qloc0 = wid * 32 + fr;
        { const f32x4 kv = *(const f32x4*)(kmean + (size_t)bh * 2048 + tid * 4); *(f32x4*)(km + tid * 4) = kv; }
        bf16x8 qf[2][4];
#pragma unroll
        for (int qt = 0; qt < 2; ++qt)
#pragma unroll
            for (int dc = 0; dc < 4; ++dc) qf[qt][dc] = *(const bf16x8*)(Q + (tok0 + qb * 256 + qloc0 + qt * 16) * D + h * 128 + dc * 32 + fq * 8);
        __syncthreads();
        const int ntile = (qb + 1) * 4;
        const int kr0 = tid >> 4, kc0 = tid & 15;
        const int vr0 = tid >> 3, vc0 = tid & 7;
        u32x4 kreg0[2], vreg0[2];
        auto gload = [&](int tt, u32x4 (&kreg)[2], u32x4 (&vreg)[2]) {
            const int key0 = tt * 64;
#pragma unroll
            for (int i = 0; i < 2; ++i) {
                kreg[i] = *(const u32x4*)(Kx + (tok0 + key0 + kr0 + i * 32) * D + h * 128 + kc0 * 8);
                vreg[i] = *(const u32x4*)(VT + (size_t)(h * 128 + vr0 + i * 64) * T + tok0 + key0 + vc0 * 8);
            }
        };
        auto lstore = [&](int bi, const u32x4 (&kreg)[2], const u32x4 (&vreg)[2]) {
#pragma unroll
            for (int i = 0; i < 2; ++i) {
                *(u32x4*)(KBUFP(bi) + (kr0 + i * 32) * KB_STRIDE + kc0 * 16) = kreg[i];
                {
                    unsigned char* vrow = VBUFP(bi) + (vr0 + i * 64) * VB_STRIDE + (vc0 >> 2) * 64;
                    const int c = vc0 & 3, p0 = ((c & 1) * 2) * 16 + (c >> 1) * 8;
                    u32x2 lo = {vreg[i][0], vreg[i][1]}, hi = {vreg[i][2], vreg[i][3]};
                    *(u32x2*)(vrow + p0) = lo; *(u32x2*)(vrow + p0 + 16) = hi;
                }
            }
        };
        gload(0, kreg0, vreg0);
        unsigned mask[2];
#pragma unroll
        for (int qt = 0; qt < 2; ++qt) {
            float v0 = -3e38f, v1 = -3e38f, v2 = -3e38f; int i0 = -1, i1 = -1, i2 = -1;
            for (int j = 0; j < qb; ++j) {
                float g = 0.f;
#pragma unroll
                for (int dc = 0; dc < 4; ++dc) {
                    const f32x4 ka = *(const f32x4*)(km + j * 128 + dc * 32 + fq * 8), kb2 = *(const f32x4*)(km + j * 128 + dc * 32 + fq * 8 + 4);
#pragma unroll
                    for (int e = 0; e < 4; ++e) { g += bf2f((bf16_t)qf[qt][dc][e]) * ka[e]; g += bf2f((bf16_t)qf[qt][dc][4 + e]) * kb2[e]; }
                }
                g = xsum_fq(g);
                if (g > v0) { v2 = v1; i2 = i1; v1 = v0; i1 = i0; v0 = g; i0 = j; }
                else if (g > v1) { v2 = v1; i2 = i1; v1 = g; i1 = j; }
                else if (g > v2) { v2 = g; i2 = j; }
            }
            unsigned mk = 0u;
            if (i0 >= 0) mk |= 1u << i0;
            if (i1 >= 0) mk |= 1u << i1;
            if (i2 >= 0) mk |= 1u << i2;
            mask[qt] = mk;
        }
        float mrun[2] = {-1e30f, -1e30f}, lrun[2] = {0.f, 0.f};
        f32x4 oacc[2][8];
#pragma unroll
        for (int qt = 0; qt < 2; ++qt)
#pragma unroll
            for (int dt = 0; dt < 8; ++dt) oacc[qt][dt] = (f32x4){0.f, 0.f, 0.f, 0.f};
        auto compute = [&](int tt, int bi) {
            const int kb = tt >> 2, kt64 = tt & 3;
            const bool own = (kb == qb);
            bool actq[2];
#pragma unroll
            for (int qt = 0; qt < 2; ++qt) actq[qt] = own ? true : (((mask[qt] >> kb) & 1u) != 0u);
            const bool doit = own ? (kt64 * 64 <= wid * 32 + 31) : (__any((int)(actq[0] || actq[1])) != 0);
            const bool elem = own && (kt64 * 64 + 63 > wid * 32);
            if (doit) {
                f32x4 sacc[2][4];
#pragma unroll
                for (int qt = 0; qt < 2; ++qt)
#pragma unroll
                    for (int kt = 0; kt < 4; ++kt) sacc[qt][kt] = (f32x4){0.f, 0.f, 0.f, 0.f};
#pragma unroll
                for (int dc = 0; dc < 4; ++dc)
#pragma unroll
                    for (int kt = 0; kt < 4; ++kt) {
                        const bf16x8 kf = *(const bf16x8*)(KBUFP(bi) + (kt * 16 + fr) * KB_STRIDE + dc * 64 + fq * 16);
#pragma unroll
                        for (int qt = 0; qt < 2; ++qt) sacc[qt][kt] = __builtin_amdgcn_mfma_f32_16x16x32_bf16(kf, qf[qt][dc], sacc[qt][kt], 0, 0, 0);
                    }
                bf16x8 pf[2][2];
#pragma unroll
                for (int qt = 0; qt < 2; ++qt) {
                    const int lim = own ? (qloc0 + qt * 16 - kt64 * 64 - fq * 4) : (actq[qt] ? 1000 : -1000);
                    float mx = -1e30f;
                    if (elem) {
#pragma unroll
                        for (int kt = 0; kt < 4; ++kt)
#pragma unroll
                            for (int r = 0; r < 4; ++r) {
                                const float sv = (kt * 16 + r <= lim) ? sacc[qt][kt][r] : -__builtin_inff();
                                sacc[qt][kt][r] = sv; mx = fmaxf(mx, sv);
                            }
                    } else {
#pragma unroll
                        for (int kt = 0; kt < 4; ++kt)
#pragma unroll
                            for (int r = 0; r < 4; ++r) mx = fmaxf(mx, sacc[qt][kt][r]);
                        mx = actq[qt] ? mx : -__builtin_inff();
                    }
                    mx = xmax_fq(mx);
                    if (__any((int)(mx > mrun[qt] + THR_RAW))) {
                        const float mnew = fmaxf(mrun[qt], mx);
                        const float alpha = __builtin_amdgcn_exp2f((mrun[qt] - mnew) * QC);
                        mrun[qt] = mnew;
                        lrun[qt] *= alpha;
#pragma unroll
                        for (int dt = 0; dt < 8; ++dt) oacc[qt][dt] *= alpha;
                    }
                    const float mneg = (elem || actq[qt]) ? -mrun[qt] * QC : -__builtin_inff();
                    float ps = 0.f;
#pragma unroll
                    for (int kt = 0; kt < 4; ++kt)
#pragma unroll
                        for (int r = 0; r < 4; ++r) { const float pe = __builtin_amdgcn_exp2f(__builtin_fmaf(sacc[qt][kt][r], QC, mneg)); sacc[qt][kt][r] = pe; ps += pe; }
                    lrun[qt] += ps;
#pragma unroll
                    for (int ks = 0; ks < 2; ++ks) {
                        u32x4 w = {pk_bf16(sacc[qt][2 * ks][0], sacc[qt][2 * ks][1]), pk_bf16(sacc[qt][2 * ks][2], sacc[qt][2 * ks][3]),
                                   pk_bf16(sacc[qt][2 * ks + 1][0], sacc[qt][2 * ks + 1][1]), pk_bf16(sacc[qt][2 * ks + 1][2], sacc[qt][2 * ks + 1][3])};
                        pf[qt][ks] = __builtin_bit_cast(bf16x8, w);
                    }
                }
#pragma unroll
                for (int ks = 0; ks < 2; ++ks)
#pragma unroll
                    for (int dt = 0; dt < 8; ++dt) {
                        const bf16x8 vf = *(const bf16x8*)(VBUFP(bi) + (dt * 16 + fr) * VB_STRIDE + ks * 64 + fq * 16);
#pragma unroll
                        for (int qt = 0; qt < 2; ++qt) oacc[qt][dt] = __builtin_amdgcn_mfma_f32_16x16x32_bf16(vf, pf[qt][ks], oacc[qt][dt], 0, 0, 0);
                    }
            }
        };
        lstore(0, kreg0, vreg0);
        __syncthreads();
        for (int tt = 0; tt < ntile; tt += 2) {
            if (tt + 1 < ntile) gload(tt + 1, kreg0, vreg0);
            compute(tt, 0);
            if (tt + 1 < ntile) lstore(1, kreg0, vreg0);
            lds_barrier();
            if (tt + 1 < ntile) {
                if (tt + 2 < ntile) gload(tt + 2, kreg0, vreg0);
                compute(tt + 1, 1);
                if (tt + 2 < ntile) lstore(0, kreg0, vreg0);
                lds_barrier();
            }
        }
        __syncthreads();
#pragma unroll
        for (int qt = 0; qt < 2; ++qt) {
            const float lt = xsum_fq(lrun[qt]);
            const float inv = 1.f / lt;
            bf16_t* orow = O + (tok0 + qb * 256 + qloc0 + qt * 16) * D + h * 128 + fq * 4;
#pragma unroll
            for (int dt = 0; dt < 8; ++dt) {
                const f32x4 o = oacc[qt][dt] * inv;
                u32x2 w = {pk_bf16(o[0], o[1]), pk_bf16(o[2], o[3])};
                *(u32x2*)(orow + dt * 16) = w;
            }
        }
    }
#undef KBUFP
#undef VBUFP
}

DI void rwkv_mix_phase(int tid_, int bid_, const float* x, const float* mu, bf16_t* slots) {
    const int c = (tid_ & 255) * 8, rsel = tid_ >> 8;
    f32x4 m[6][2];
#pragma unroll
    for (int k = 0; k < 6; ++k) { m[k][0] = *(const f32x4*)(mu + k * D + c); m[k][1] = *(const f32x4*)(mu + k * D + c + 4); }
    constexpr int U = 4;
    for (int pb = bid_; pb < T / 2; pb += gridDim.x * U) {
        f32x4 xv[U][2], xp[U][2];
#pragma unroll
        for (int u = 0; u < U; ++u) {
            const int pair = pb + u * gridDim.x, row = pair * 2 + rsel, s_ = row & (SEQ - 1);
            const bool ok = pair < T / 2;
            const float* xr = x + (size_t)row * D + c;
#pragma unroll
            for (int q = 0; q < 2; ++q) {
                xv[u][q] = ok ? *(const f32x4*)(xr + q * 4) : (f32x4){0.f, 0.f, 0.f, 0.f};
                xp[u][q] = (ok && s_ > 0) ? *(const f32x4*)(xr - D + q * 4) : (f32x4){0.f, 0.f, 0.f, 0.f};
            }
        }
#pragma unroll
        for (int u = 0; u < U; ++u) {
            const int pair = pb + u * gridDim.x, row = pair * 2 + rsel;
            if (pair >= T / 2) break;
            const f32x4 xx0 = xp[u][0] - xv[u][0], xx1 = xp[u][1] - xv[u][1];
#pragma unroll
            for (int k = 0; k < 6; ++k) {
                const f32x4 o0 = xv[u][0] + xx0 * m[k][0], o1 = xv[u][1] + xx1 * m[k][1];
                u32x4 w = {pk_bf16(o0[0], o0[1]), pk_bf16(o0[2], o0[3]), pk_bf16(o1[0], o1[1]), pk_bf16(o1[2], o1[3])};
                *(u32x4*)((unsigned char*)slots + k * SLOT + ((size_t)row * D + c) * 2) = w;
            }
        }
    }
}
DI float softplusf_(float y) { return fmaxf(y, 0.f) + __logf(1.f + __expf(-fabsf(y))); }
DI void rwkv_prep_phase(int tid_, int bid_, const Params& p, unsigned char* sl, float* scal) {
    bf16_t* R = (bf16_t*)(sl + 6 * SLOT); bf16_t* Kk = (bf16_t*)(sl + 7 * SLOT);
    const bf16_t* WP = (const bf16_t*)(sl + 0 * SLOT); bf16_t* AP = (bf16_t*)(sl + 1 * SLOT);
    bf16_t* KX = (bf16_t*)(sl + 3 * SLOT); float* WD = (float*)(sl + 4 * SLOT);
    const float* w0 = p.in[18]; const float* a0 = p.in[21]; const float* k_k = p.in[26]; const float* k_a = p.in[27]; const float* r_k = p.in[28];
    float* BR = scal; float* KR = scal + (size_t)T * 32; float* BO = scal + (size_t)2 * T * 32;
    const int lane = tid_ & 63, wid = tid_ >> 6, hq = lane >> 4, k4 = (lane & 15) * 4;
    constexpr int U = 4;
    const int gw = bid_ * 8 + wid, nw = gridDim.x * 8, quad = gw & 7, h = quad * 4 + hq, c = h * 64 + k4;
    const f32x4 w0v = *(const f32x4*)(w0 + c), a0v = *(const f32x4*)(a0 + c), kkv = *(const f32x4*)(k_k + c), kav = *(const f32x4*)(k_a + c), rkv = *(const f32x4*)(r_k + c);
    for (int tb = gw >> 3; tb < T; tb += (nw >> 3) * U) {
        u32x2 rr[U], kr_[U], wpr[U], apr[U];
#pragma unroll
        for (int u = 0; u < U; ++u) {
            const int tt = tb + u * (nw >> 3); const size_t o = (size_t)(tt < T ? tt : tb) * D + c;
            rr[u] = *(const u32x2*)(R + o); kr_[u] = *(const u32x2*)(Kk + o); wpr[u] = *(const u32x2*)(WP + o); apr[u] = *(const u32x2*)(AP + o);
        }
#pragma unroll
        for (int u = 0; u < U; ++u) {
            const int tt = tb + u * (nw >> 3);
            if (tt >= T) break;
            const size_t t = (size_t)tt, o = t * D + c;
            const float r[4] = {bflo(rr[u][0]), bfhi(rr[u][0]), bflo(rr[u][1]), bfhi(rr[u][1])}, k[4] = {bflo(kr_[u][0]), bfhi(kr_[u][0]), bflo(kr_[u][1]), bfhi(kr_[u][1])};
            const float wp[4] = {bflo(wpr[u][0]), bfhi(wpr[u][0]), bflo(wpr[u][1]), bfhi(wpr[u][1])}, ap[4] = {bflo(apr[u][0]), bfhi(apr[u][0]), bflo(apr[u][1]), bfhi(apr[u][1])};
            float dec[4], a[4], kk[4], kx[4]; float ss = 0.f;
#pragma unroll
            for (int e = 0; e < 4; ++e) {
                const float wlog = -softplusf_(-(w0v[e] + wp[e])) - 0.5f;
                dec[e] = __expf(-__expf(wlog));
                a[e] = __builtin_amdgcn_rcpf(1.f + __expf(-(a0v[e] + ap[e])));
                kk[e] = k[e] * kkv[e]; ss += kk[e] * kk[e];
                kx[e] = k[e] * (1.f + (a[e] - 1.f) * kav[e]);
            }
            const float rn = fminf(__builtin_amdgcn_rsqf(row_sum16(ss)), 1e12f);
            float bb[4], s1 = 0.f, s2 = 0.f, s3 = 0.f;
#pragma unroll
            for (int e = 0; e < 4; ++e) { kk[e] *= rn; bb[e] = kk[e] * a[e]; s1 += bb[e] * r[e]; s2 += kx[e] * r[e]; s3 += r[e] * kx[e] * rkv[e]; }
            const float br = row_sum16(s1), kr = row_sum16(s2), bo = row_sum16(s3);
            { u32x2 w = {pk_bf16(dec[0] * r[0], dec[1] * r[1]), pk_bf16(dec[2] * r[2], dec[3] * r[3])}; *(u32x2*)(R + o) = w; }
            { u32x2 w = {pk_bf16(-kk[0], -kk[1]), pk_bf16(-kk[2], -kk[3])}; *(u32x2*)(Kk + o) = w; }
            { u32x2 w = {pk_bf16(bb[0], bb[1]), pk_bf16(bb[2], bb[3])}; *(u32x2*)(AP + o) = w; }
            { u32x2 w = {pk_bf16(kx[0], kx[1]), pk_bf16(kx[2], kx[3])}; *(u32x2*)(KX + o) = w; }
            { f32x4 dv = {dec[0], dec[1], dec[2], dec[3]}; *(f32x4*)(WD + o) = dv; }
            if ((lane & 15) == 0) { const size_t it = t * 32 + h; BR[it] = br; KR[it] = kr; BO[it] = bo; }
        }
    }
}
DI float dpp_sum8(float v) {
    v += __int_as_float(__builtin_amdgcn_update_dpp(0, __float_as_int(v), 0xB1, 0xF, 0xF, false));
    v += __int_as_float(__builtin_amdgcn_update_dpp(0, __float_as_int(v), 0x4E, 0xF, 0xF, false));
    v += __int_as_float(__builtin_amdgcn_update_dpp(0, __float_as_int(v), 0x141, 0xF, 0xF, false));
    return v;
}
DI void rwkv_scan_phase(int tid_, int bid_, unsigned char* sl, const float* scal, unsigned char* smem) {
    constexpr int TC = 32;
    constexpr int OFF_BB = TC * 128, OFF_KX = OFF_BB + TC * 64, OFF_W = OFF_KX + TC * 64, OFF_V = OFF_W + TC * 64, OFF_SC = OFF_V + TC * 32, BUF_F = OFF_SC + TC * 2;
    constexpr int NCH = SEQ / TC;
#define SBUF(i) ((float*)smem + (i) * BUF_F)
    const bf16_t* NKK = (const bf16_t*)(sl + 7 * SLOT); const bf16_t* WR = (const bf16_t*)(sl + 6 * SLOT);
    const bf16_t* BB = (const bf16_t*)(sl + 1 * SLOT); const bf16_t* KX = (const bf16_t*)(sl + 3 * SLOT);
    const float* WD = (const float*)(sl + 4 * SLOT); const bf16_t* V = (const bf16_t*)(sl + 8 * SLOT);
    bf16_t* Y = (bf16_t*)(sl + 0 * SLOT);
    const float* BR = scal; const float* KR = scal + (size_t)T * 32;
    const int tid = tid_, wid = tid >> 6, lane = tid & 63;
    for (int item = bid_; item < 256; item += gridDim.x) {
        const int half = item & 1, h = (item >> 1) & 31, b = item >> 6;
        const size_t tok0 = (size_t)b * SEQ;
        if (wid >= 4) {
            const int lt = tid - 256, lt_t = lt >> 3, lt_c = lt & 7;
            u32x4 r_nk, r_wr, r_bb, r_kx, r_v = {0u, 0u, 0u, 0u}; f32x4 r_w0, r_w1; float r_s = 0.f;
            auto gload = [&](int c) {
                const size_t tb = tok0 + (size_t)c * TC;
                const size_t o = (tb + lt_t) * D + h * 64 + lt_c * 8;
                r_nk = *(const u32x4*)(NKK + o); r_wr = *(const u32x4*)(WR + o); r_bb = *(const u32x4*)(BB + o); r_kx = *(const u32x4*)(KX + o);
                r_w0 = *(const f32x4*)(WD + (tb + (lt >> 4)) * D + h * 64 + (lt & 15) * 4);
                r_w1 = *(const f32x4*)(WD + (tb + 16 + (lt >> 4)) * D + h * 64 + (lt & 15) * 4);
                if (lt < 128) r_v = *(const u32x4*)(V + (tb + (lt >> 2)) * D + h * 64 + half * 32 + (lt & 3) * 8);
                else if (lt < 192) { const int i = lt - 128; r_s = ((i & 1) ? KR : BR)[(tb + (i >> 1)) * 32 + h]; }
            };
            auto lstore = [&](float* F) {
                float* pp = F + lt_t * 128 + lt_c * 16;
#pragma unroll
                for (int j = 0; j < 4; ++j) { f32x4 q = {bflo(r_nk[j]), bflo(r_wr[j]), bfhi(r_nk[j]), bfhi(r_wr[j])}; *(f32x4*)(pp + j * 4) = q; }
                { float* d = F + OFF_BB + lt_t * 64 + lt_c * 8;
                  f32x4 lo = {bflo(r_bb[0]), bfhi(r_bb[0]), bflo(r_bb[1]), bfhi(r_bb[1])}, hi = {bflo(r_bb[2]), bfhi(r_bb[2]), bflo(r_bb[3]), bfhi(r_bb[3])};
                  *(f32x4*)d = lo; *(f32x4*)(d + 4) = hi; }
                { float* d = F + OFF_KX + lt_t * 64 + lt_c * 8;
                  f32x4 lo = {bflo(r_kx[0]), bfhi(r_kx[0]), bflo(r_kx[1]), bfhi(r_kx[1])}, hi = {bflo(r_kx[2]), bfhi(r_kx[2]), bflo(r_kx[3]), bfhi(r_kx[3])};
                  *(f32x4*)d = lo; *(f32x4*)(d + 4) = hi; }
                *(f32x4*)(F + OFF_W + (lt >> 4) * 64 + (lt & 15) * 4) = r_w0;
                *(f32x4*)(F + OFF_W + (16 + (lt >> 4)) * 64 + (lt & 15) * 4) = r_w1;
                if (lt < 128) { float* d = F + OFF_V + (lt >> 2) * 32 + (lt & 3) * 8;
                  f32x4 lo = {bflo(r_v[0]), bfhi(r_v[0]), bflo(r_v[1]), bfhi(r_v[1])}, hi = {bflo(r_v[2]), bfhi(r_v[2]), bflo(r_v[3]), bfhi(r_v[3])};
                  *(f32x4*)d = lo; *(f32x4*)(d + 4) = hi; }
                else if (lt < 192) F[OFF_SC + (lt - 128)] = r_s;
            };
            gload(0); lstore(SBUF(0)); gload(1);
            __syncthreads();
            for (int c = 0; c < NCH; ++c) {
                if (c + 1 < NCH) lstore(SBUF((c + 1) & 1));
                if (c + 2 < NCH) gload(c + 2);
                lds_barrier();
            }
        } else {
            const int kq = lane & 7, rl = wid * 8 + (lane >> 3);
            f32x2 st[4];
#pragma unroll
            for (int j = 0; j < 4; ++j) st[j] = (f32x2){0.f, 0.f};
            bf16_t* yp = Y + (tok0 + kq) * D + h * 64 + half * 32 + rl;
            __syncthreads();
            struct Ops { f32x4 pq[4], b0, b1, k0, k1, w0, w1; float vv; f32x2 sc; };
            for (int c = 0; c < NCH; ++c) {
                const float* F = SBUF(c & 1);
                const float* fp = F + kq * 16;
                const float* fb = F + OFF_BB + kq * 8;
                auto ld = [&](Ops& o, int t) {
#pragma unroll
                    for (int j = 0; j < 4; ++j) o.pq[j] = *(const f32x4*)(fp + t * 128 + j * 4);
                    o.b0 = *(const f32x4*)(fb + t * 64); o.b1 = *(const f32x4*)(fb + t * 64 + 4);
                    o.k0 = *(const f32x4*)(fb + (OFF_KX - OFF_BB) + t * 64); o.k1 = *(const f32x4*)(fb + (OFF_KX - OFF_BB) + t * 64 + 4);
                    o.w0 = *(const f32x4*)(fb + (OFF_W - OFF_BB) + t * 64); o.w1 = *(const f32x4*)(fb + (OFF_W - OFF_BB) + t * 64 + 4);
                    o.vv = F[OFF_V + t * 32 + rl]; o.sc = *(const f32x2*)(F + OFF_SC + t * 2);
                };
                auto dots = [&](const Ops& o) -> f32x2 {
                    f32x2 acc = {0.f, 0.f}, acc2 = {0.f, 0.f};
#pragma unroll
                    for (int j = 0; j < 4; ++j) {
                        acc += st[j][0] * (f32x2){o.pq[j][0], o.pq[j][1]};
                        acc2 += st[j][1] * (f32x2){o.pq[j][2], o.pq[j][3]};
                    }
                    return acc + acc2;
                };
                auto update = [&](const Ops& o, f32x2 acc) -> float {
                    const float d1 = dpp_sum8(acc[0]), d2 = dpp_sum8(acc[1]);
                    st[0] = st[0] * (f32x2){o.w0[0], o.w0[1]} + d1 * (f32x2){o.b0[0], o.b0[1]} + o.vv * (f32x2){o.k0[0], o.k0[1]};
                    st[1] = st[1] * (f32x2){o.w0[2], o.w0[3]} + d1 * (f32x2){o.b0[2], o.b0[3]} + o.vv * (f32x2){o.k0[2], o.k0[3]};
                    st[2] = st[2] * (f32x2){o.w1[0], o.w1[1]} + d1 * (f32x2){o.b1[0], o.b1[1]} + o.vv * (f32x2){o.k1[0], o.k1[1]};
                    st[3] = st[3] * (f32x2){o.w1[2], o.w1[3]} + d1 * (f32x2){o.b1[2], o.b1[3]} + o.vv * (f32x2){o.k1[2], o.k1[3]};
                    return d2 + d1 * o.sc[0] + o.vv * o.sc[1];
                };
                Ops os[3];
                ld(os[0], 0); ld(os[1], 1);
                float yv = 0.f;
#pragma unroll
                for (int t = 0; t < TC; ++t) {
                    const f32x2 da = dots(os[t % 3]);
                    __builtin_amdgcn_sched_barrier(0);
                    if (t + 2 < TC) ld(os[(t + 2) % 3], t + 2);
                    __builtin_amdgcn_sched_barrier(0);
                    const float ya = update(os[t % 3], da);
                    yv = (kq == (t & 7)) ? ya : yv;
                    if ((t & 7) == 7) yp[(size_t)(c * TC + (t & ~7)) * D] = f2bf(yv);
                }
                lds_barrier();
            }
        }
        __syncthreads();
    }
#undef SBUF
}
DI void rwkv_post_phase(int tid_, int bid_, const Params& p, unsigned char* sl, const float* scal) {
    const bf16_t* Y = (const bf16_t*)(sl + 0 * SLOT); const bf16_t* V = (const bf16_t*)(sl + 8 * SLOT); const bf16_t* G = (const bf16_t*)(sl + 2 * SLOT);
    bf16_t* OUT = (bf16_t*)(sl + 3 * SLOT);
    const float* lg = p.in[29]; const float* lb = p.in[30]; const float* BO = scal + (size_t)2 * T * 32;
    const int lane = tid_ & 63, wid = tid_ >> 6, hq = lane >> 4, k4 = (lane & 15) * 4;
    constexpr int U = 4;
    const int gw = bid_ * 8 + wid, nw = gridDim.x * 8, quad = gw & 7, h = quad * 4 + hq, c = h * 64 + k4;
    const f32x4 lgv = *(const f32x4*)(lg + c), lbv = *(const f32x4*)(lb + c);
    for (int tb = gw >> 3; tb < T; tb += (nw >> 3) * U) {
        u32x2 yr[U], vr[U], gr[U]; float bor[U];
#pragma unroll
        for (int u = 0; u < U; ++u) {
            const int tt = tb + u * (nw >> 3); const size_t t = (size_t)(tt < T ? tt : tb), o = t * D + c;
            yr[u] = *(const u32x2*)(Y + o); vr[u] = *(const u32x2*)(V + o); gr[u] = *(const u32x2*)(G + o); bor[u] = BO[t * 32 + h];
        }
#pragma unroll
        for (int u = 0; u < U; ++u) {
            const int tt = tb + u * (nw >> 3);
            if (tt >= T) break;
            const size_t o0 = (size_t)tt * D + c;
            const float y[4] = {bflo(yr[u][0]), bfhi(yr[u][0]), bflo(yr[u][1]), bfhi(yr[u][1])};
            const float vv[4] = {bflo(vr[u][0]), bfhi(vr[u][0]), bflo(vr[u][1]), bfhi(vr[u][1])};
            const float gg[4] = {bflo(gr[u][0]), bfhi(gr[u][0]), bflo(gr[u][1]), bfhi(gr[u][1])};
            const float mean = row_sum16(y[0] + y[1] + y[2] + y[3]) * (1.f / 64.f);
            float d[4], q = 0.f;
#pragma unroll
            for (int e = 0; e < 4; ++e) { d[e] = y[e] - mean; q += d[e] * d[e]; }
            const float rs = rsqrtf(row_sum16(q) * (1.f / 64.f) + 64e-5f);
            float r[4];
#pragma unroll
            for (int e = 0; e < 4; ++e) r[e] = (d[e] * rs * lgv[e] + lbv[e] + bor[u] * vv[e]) * gg[e];
            u32x2 w = {pk_bf16(r[0], r[1]), pk_bf16(r[2], r[3])};
            *(u32x2*)(OUT + o0) = w;
        }
    }
}

DI void pool_phase(int tid_, int bid_, const float* x, bf16_t* outp) {
    constexpr int CH = 32;
    const int tid = tid_, c = tid * 4, w = 2 << (c >> 9);
    for (int item = bid_; item < T / CH; item += gridDim.x) {
        const int t0 = item * CH, s0 = t0 & (SEQ - 1);
        f32x4 sum = {0.f, 0.f, 0.f, 0.f};
#pragma unroll
        for (int j = 1; j <= 16; ++j) if (j <= w && s0 - j >= 0) sum += *(const f32x4*)(x + (size_t)(t0 - j) * D + c);
#pragma unroll 16
        for (int tt = 0; tt < CH; ++tt) {
            const int t = t0 + tt, s = s0 + tt;
            const f32x4 xv = *(const f32x4*)(x + (size_t)t * D + c);
            sum += xv;
            if (s - w >= 0) sum -= *(const f32x4*)(x + (size_t)(t - w) * D + c);
            const float rc = __builtin_amdgcn_rcpf((float)((s + 1 < w) ? (s + 1) : w));
            const f32x4 o = sum * rc - xv;
            u32x2 wv = {pk_bf16(o[0], o[1]), pk_bf16(o[2], o[3])};
            *(u32x2*)(outp + (size_t)t * D + c) = wv;
        }
    }
}

#define XB_TMO      128
#define XB_XCNT(j)  (256  + 64 * (j))
#define XB_XSUB(j)  (1280 + 64 * (j))
#define XB_XGEN(j)  (2304 + 64 * (j))
#define XB_TOP      3328
#define XB_TOPGEN   3392
#define XCD_BAR_WORDS 3456
#define XB_SPIN_CAP (1u << 18)
DI unsigned xb_ld(unsigned* p) { return __hip_atomic_load(p, __ATOMIC_RELAXED, __HIP_MEMORY_SCOPE_AGENT); }
DI unsigned xb_add(unsigned* p, unsigned v) { return __hip_atomic_fetch_add(p, v, __ATOMIC_RELAXED, __HIP_MEMORY_SCOPE_AGENT); }
DI unsigned xb_xcc_id() { return (unsigned)__builtin_amdgcn_s_getreg((3 << 11) | 20) & 0xFu; }
#define XB_SPIN(cond, bar) do { unsigned _sp = 0; while (cond) { __builtin_amdgcn_s_sleep(1); \
    if ((++_sp & 255u) == 0u) { if (xb_ld(&(bar)[XB_TMO])) break; if (_sp > XB_SPIN_CAP) { atomicAdd(&(bar)[XB_TMO], 1u); break; } } } } while (0)
struct XcdBarrier { unsigned* bar; unsigned x; volatile LAS unsigned* st; };
DI XcdBarrier xcd_barrier_post(int tid, unsigned* bar, volatile LAS unsigned* st) {
    XcdBarrier b; b.bar = bar; b.x = xb_xcc_id(); b.st = st;
    if (tid == 0) (void)xb_add(&bar[XB_XCNT(b.x)], 1u);
    return b;
}
DI void xcd_barrier_complete(unsigned* bar, unsigned x, unsigned& nloc, unsigned& nx) {
    const unsigned G = gridDim.x * gridDim.y * gridDim.z;
    unsigned sum, cnt, mine, sp = 0u;
    for (;;) {
        sum = 0u; cnt = 0u; mine = 0u;
#pragma unroll
        for (unsigned j = 0; j < 16; ++j) { const unsigned c = xb_ld(&bar[XB_XCNT(j)]); sum += c; cnt += (c > 0u) ? 1u : 0u; mine = (j == x) ? c : mine; }
        if (sum == G) break;
        __builtin_amdgcn_s_sleep(1);
        if ((++sp & 255u) == 0u) { if (xb_ld(&bar[XB_TMO])) break; if (sp > XB_SPIN_CAP) { atomicAdd(&bar[XB_TMO], 1u); break; } }
    }
    nloc = mine > 0u ? mine : 1u; nx = cnt > 0u ? cnt : 1u;
}
DI void xcd_barrier(int tid, const XcdBarrier& b) {
    asm volatile("s_waitcnt vmcnt(0)" ::: "memory");
    __syncthreads();
    if (tid == 0) {
        unsigned* bar = b.bar;
        __builtin_amdgcn_s_waitcnt(0);
        unsigned nloc = b.st[0], nx = b.st[1];
        if (nloc == 0u) { xcd_barrier_complete(bar, b.x, nloc, nx); b.st[0] = nloc; b.st[1] = nx; }
        const unsigned old = xb_add(&bar[XB_XSUB(b.x)], 1u);
        const unsigned gen = old / nloc;
        if (old + 1u == (gen + 1u) * nloc) {
            __builtin_amdgcn_fence(__ATOMIC_RELEASE, "agent");
            asm volatile("s_waitcnt vmcnt(0)" ::: "memory");
            const unsigned og = xb_add(&bar[XB_TOP], 1u);
            const unsigned tg = og / nx;
            if (og + 1u == (tg + 1u) * nx) xb_add(&bar[XB_TOPGEN], 1u);
            else XB_SPIN(xb_ld(&bar[XB_TOPGEN]) == tg, bar);
            __builtin_amdgcn_fence(__ATOMIC_ACQUIRE, "agent");
            xb_add(&bar[XB_XGEN(b.x)], 1u);
            asm volatile("s_waitcnt vmcnt(0)" ::: "memory");
        } else {
            XB_SPIN(xb_ld(&bar[XB_XGEN(b.x)]) == gen, bar);
            __builtin_amdgcn_fence(__ATOMIC_ACQUIRE, "agent");
            asm volatile("s_waitcnt vmcnt(0)" ::: "memory");
        }
    }
    __syncthreads();
}

enum { K_PREP = 0, K_GACT, K_GRES, K_LN, K_RGCONV, K_RGSCAN0, K_RGSCAN1, K_KMEAN, K_ATTN, K_RMIX, K_RPREP, K_RSCAN, K_RPOST, K_POOL };
constexpr int NSTEPS = 38;
struct Desc {
    int kind;
    pg8::Gemm g;
    bf16_t* C; const float* res; const float* cscale; long sC; int ldc; unsigned acts;
    int lnidx, lnlast;
};
DI bool step_nosync(int st) { return st == 11 || st == 21; }
DI Desc make_desc(int st, const Params& p, unsigned char* ws) {
    unsigned char* sl = ws + O_SLOT;
    auto slot = [&](int i) { return (bf16_t*)(sl + (size_t)i * SLOT); };
    bf16_t* xb = slot(8);
    Desc d; d.kind = K_PREP; d.g = mk_gemm(nullptr, nullptr, 0, 0, 0, 0, 0, 0, 0, 0);
    d.C = nullptr; d.res = nullptr; d.cscale = nullptr; d.sC = 0; d.ldc = D; d.acts = 0u; d.lnidx = 0; d.lnlast = 0;
    int layer = -1, sub = 0;
    if (st >= 7 && st < 11) { layer = 0; sub = st - 7; }
    else if (st >= 16 && st < 20) { layer = 1; sub = st - 16; }
    else if (st >= 28 && st < 32) { layer = 2; sub = st - 28; }
    else if (st >= 34 && st < 38) { layer = 3; sub = st - 34; }
    if (layer >= 0) {
        if (sub == 0) { d.kind = K_LN; d.lnidx = layer * 2; }
        else if (sub == 1) { d.kind = K_GACT; d.C = slot(0); d.ldc = DFF; d.acts = 1u;
            d.g = mk_gemm(xb, (const bf16_t*)(ws + O_W1T + (size_t)layer * DFF * D * 2), 0, 0, D, D, D, T / 256, DFF / 256, 1); }
        else if (sub == 2) { d.kind = K_GRES;
            d.g = mk_gemm(slot(0), (const bf16_t*)(ws + O_W2T + (size_t)layer * DFF * D * 2), 0, 0, DFF, DFF, DFF, T / 256, D / 256, 1); }
        else { d.kind = K_LN; d.lnidx = layer * 2 + 1; d.lnlast = (layer == 3); }
        return d;
    }
    switch (st) {
    case 0: d.kind = K_PREP; break;
    case 1: d.kind = K_GACT; d.C = slot(0); d.ldc = 4096;
            d.g = mk_gemm(xb, (const bf16_t*)(ws + O_WIN), 0, 0, D, D, D, T / 256, 4096 / 256, 1); break;
    case 2: d.kind = K_RGCONV; break;
    case 3: d.kind = K_GACT; d.C = slot(3); d.sC = 512; d.ldc = 4096;
            d.g = mk_gemm(slot(2), (const bf16_t*)(ws + O_GATES), 256, 512 * 256, D, 256, 256, T / 256, 2, 8); break;
    case 4: d.kind = K_RGSCAN0; break;
    case 5: d.kind = K_RGSCAN1; break;
    case 6: d.kind = K_GRES; d.res = p.in[0];
            d.g = mk_gemm(slot(5), (const bf16_t*)(ws + O_RGOUT), 0, 0, D, D, D, T / 256, D / 256, 1); break;
    case 11: d.kind = K_GACT; d.C = slot(0); d.sC = (long)T * D;
             d.g = mk_gemm(xb, (const bf16_t*)(ws + O_QKV), 0, (long)D * D, D, D, D, T / 256, D / 256, 2); break;
    case 12: d.kind = K_GACT; d.C = slot(2); d.ldc = T;
             d.g = mk_gemm((const bf16_t*)(ws + O_QKV + 2 * SZ_DD), xb, 0, 0, D, D, D, D / 256, T / 256, 1); break;
    case 13: d.kind = K_KMEAN; break;
    case 14: d.kind = K_ATTN; break;
    case 15: d.kind = K_GRES;
             d.g = mk_gemm(slot(3), (const bf16_t*)(ws + O_MOUT), 0, 0, D, D, D, T / 256, D / 256, 1); break;
    case 20: d.kind = K_RMIX; break;
    case 21: d.kind = K_GACT; d.C = slot(6); d.sC = (long)T * D;
             d.g = mk_gemm(slot(0), (const bf16_t*)(ws + O_RKV), (long)T * D, (long)D * D, D, D, D, T / 256, D / 256, 3); break;
    case 22: d.kind = K_GACT; d.C = (bf16_t*)(ws + O_L1O); d.sC = (long)T * 256; d.ldc = 256; d.acts = 0x302u;
             d.g = mk_gemm(slot(3), (const bf16_t*)(ws + O_L1), (long)T * D, (long)256 * D, D, D, D, T / 256, 1, 3); break;
    case 23: d.kind = K_GACT; d.C = slot(0); d.sC = (long)T * D;
             d.g = mk_gemm((const bf16_t*)(ws + O_L1O), (const bf16_t*)(ws + O_L2), (long)T * 256, (long)D * 256, 256, 256, 256, T / 256, D / 256, 3); break;
    case 24: d.kind = K_RPREP; break;
    case 25: d.kind = K_RSCAN; break;
    case 26: d.kind = K_RPOST; break;
    case 27: d.kind = K_GRES;
             d.g = mk_gemm(slot(3), (const bf16_t*)(ws + O_ROUT), 0, 0, D, D, D, T / 256, D / 256, 1); break;
    case 32: d.kind = K_POOL; break;
    case 33: d.kind = K_GRES; d.cscale = p.in[33]; d.sC = 512;
             d.g = mk_gemm(slot(0), (const bf16_t*)(ws + O_POOL), 512, 512 * 512, D, 512, 512, T / 256, 2, 4); break;
    default: break;
    }
    return d;
}

__global__ void __launch_bounds__(512, 2) fwd_megakernel(Params p) {
    extern __shared__ __attribute__((aligned(16))) unsigned char smem[];
    cg::grid_group grid = cg::this_grid();
    LAS unsigned char* lds = (LAS unsigned char*)smem;

    const bool multi = (p.hi - p.lo) > 1;
    volatile LAS unsigned* xst = (volatile LAS unsigned*)(lds + 131072);
    if (__builtin_amdgcn_workitem_id_x() == 0) { xst[0] = 0u; xst[1] = 0u; }
    __syncthreads();
    (void)xcd_barrier_post((int)__builtin_amdgcn_workitem_id_x(), (unsigned*)(p.ws + O_BAR), xst);
    for (int st = p.lo; st < p.hi; ++st) {
        int tid_ = (int)__builtin_amdgcn_workitem_id_x(); asm volatile("" : "+v"(tid_));
        int bid_ = (int)__builtin_amdgcn_workgroup_id_x(); asm volatile("" : "+s"(bid_));
        unsigned char* ws = p.ws; asm volatile("" : "+s"(ws));
        float* xcur = p.out; asm volatile("" : "+s"(xcur));
        unsigned char* sl = ws + O_SLOT;
        auto slot = [&](int i) { return (bf16_t*)(sl + (size_t)i * SLOT); };
        const int stu = __builtin_amdgcn_readfirstlane(st);
        const Desc d = make_desc(stu, p, ws);
        switch (__builtin_amdgcn_readfirstlane(d.kind)) {
        case K_PREP: prep_phase(tid_, bid_, p, smem); break;
        case K_GACT: { pg8::EpiAct E; E.C = d.C; E.sC = d.sC; E.ldc = d.ldc; E.acts = d.acts; pg8::gemm_phase(tid_, bid_, lds, d.g, E); } break;
        case K_GRES: { pg8::EpiRes E; E.out = xcur; E.res = d.res ? d.res : xcur; E.cscale = d.cscale; E.alpha = ALPHA; E.sC = d.sC; E.ldc = D; pg8::gemm_phase(tid_, bid_, lds, d.g, E); } break;
        case K_LN: ln_phase(tid_, bid_, xcur, xcur, d.lnlast ? nullptr : slot(8), p.in[1] + (size_t)d.lnidx * D, p.in[2] + (size_t)d.lnidx * D); break;
        case K_RGCONV: rg_conv_phase(tid_, bid_, slot(0), slot(2), p.in[6], p.in[7]); break;
        case K_RGSCAN0: rg_scan_phase<0>(tid_, bid_, p, slot(3), slot(2), slot(0), (float*)(ws + O_AGG), slot(5)); break;
        case K_RGSCAN1: rg_scan_phase<1>(tid_, bid_, p, slot(3), slot(2), slot(0), (float*)(ws + O_AGG), slot(5)); break;
        case K_KMEAN: kmean_phase(tid_, bid_, slot(0), slot(1), (float*)(ws + O_KMEAN), (const float*)(ws + O_ROPE), (const float*)(ws + O_ROPE) + SEQ * 16, smem); break;
        case K_ATTN: attn_phase(tid_, bid_, slot(0), slot(1), slot(2), slot(3), (const float*)(ws + O_KMEAN), smem); break;
        case K_RMIX: rwkv_mix_phase(tid_, bid_, xcur, p.in[16], slot(0)); break;
        case K_RPREP: rwkv_prep_phase(tid_, bid_, p, sl, (float*)(ws + O_SCAL)); break;
        case K_RSCAN: rwkv_scan_phase(tid_, bid_, sl, (const float*)(ws + O_SCAL), smem); break;
        case K_RPOST: rwkv_post_phase(tid_, bid_, p, sl, (const float*)(ws + O_SCAL)); break;
        case K_POOL: pool_phase(tid_, bid_, xcur, slot(0)); break;
        default: break;
        }
        if (multi && !step_nosync(st) && st + 1 < p.hi) { if (st == p.lo) grid.sync(); else { XcdBarrier xb; xb.bar = (unsigned*)(ws + O_BAR); xb.x = xb_xcc_id(); xb.st = (volatile LAS unsigned*)(lds + 131072); xcd_barrier(tid_, xb); } }
    }
}

extern "C" void kernel_launch(void* const* d_in, const int* in_sizes, int n_in, void* d_out, int out_size, void* d_ws, size_t ws_size, hipStream_t stream) {
    static int grid = 0;
    if (grid == 0) {
        if (n_in != 34 || out_size != T * D || ws_size < WS_END) { fprintf(stderr, "kernel_launch: unexpected shapes (n_in %d out %d ws %zu need %zu)\n", n_in, out_size, ws_size, (size_t)WS_END); grid = -1; return; }
        int dev = 0, cus = 0, per_cu = 0;
        hipGetDevice(&dev);
        hipDeviceGetAttribute(&cus, hipDeviceAttributeMultiprocessorCount, dev);
        if (hipFuncSetAttribute((const void*)fwd_megakernel, hipFuncAttributeMaxDynamicSharedMemorySize, LDS_BYTES) != hipSuccess) { fprintf(stderr, "kernel_launch: hipFuncSetAttribute failed\n"); grid = -1; return; }
        hipOccupancyMaxActiveBlocksPerMultiprocessor(&per_cu, (const void*)fwd_megakernel, 512, LDS_BYTES);
        if (per_cu < 1) { fprintf(stderr, "kernel_launch: occupancy query says %d blocks/CU\n", per_cu); per_cu = 1; }
        (void)hipGetLastError();
        grid = cus;
    }
    if (grid < 0) return;
    Params p{};
    for (int i = 0; i < 34; ++i) p.in[i] = (const float*)d_in[i];
    {
        unsigned char* ws = (unsigned char*)d_ws; int nj = 0, t0 = 0;
        auto add = [&](const float* src, size_t dstoff, int Ks, int Ns, int Kd, int Nd) {
            TJob& j = p.tj[nj]; j.src = src; j.dst = (bf16_t*)(ws + dstoff); j.Ks = Ks; j.Ns = Ns; j.Kd = Kd; j.Nd = Nd; j.tile0 = t0; j.pad = 0;
            t0 += (Kd / 128) * (Nd / 128); ++nj; };
        for (int l = 0; l < 4; ++l) add(p.in[3] + (size_t)l * D * DFF, O_W1T + (size_t)l * DFF * D * 2, D, DFF, D, DFF);
        for (int l = 0; l < 4; ++l) add(p.in[4] + (size_t)l * D * DFF, O_W2T + (size_t)l * DFF * D * 2, DFF, D, DFF, D);
        add(p.in[5], O_WIN, D, 4096, D, 4096);
        for (int n = 0; n < 8; ++n) { add(p.in[8] + (size_t)n * 65536, O_GATES + (size_t)n * 512 * 256 * 2, 256, 256, 256, 256);
                                      add(p.in[10] + (size_t)n * 65536, O_GATES + ((size_t)n * 512 + 256) * 256 * 2, 256, 256, 256, 256); }
        add(p.in[13], O_RGOUT, D, D, D, D);
        add(p.in[14], O_QKV, D, 3 * D, D, 3 * D);
        add(p.in[15], O_MOUT, D, D, D, D);
        for (int g = 0; g < 3; ++g) add(p.in[17] + (size_t)g * D * D, O_RKV + g * SZ_DD, D, D, D, D);
        add(p.in[19], O_L1 + 0 * (size_t)256 * D * 2, D, 96, D, 256);
        add(p.in[22], O_L1 + 1 * (size_t)256 * D * 2, D, 96, D, 256);
        add(p.in[24], O_L1 + 2 * (size_t)256 * D * 2, D, 256, D, 256);
        add(p.in[20], O_L2 + 0 * (size_t)D * 256 * 2, 96, D, 256, D);
        add(p.in[23], O_L2 + 1 * (size_t)D * 256 * 2, 96, D, 256, D);
        add(p.in[25], O_L2 + 2 * (size_t)D * 256 * 2, 256, D, 256, D);
        add(p.in[31], O_ROUT, D, D, D, D);
        for (int g = 0; g < 4; ++g) add(p.in[32] + (size_t)g * 512 * 512, O_POOL + (size_t)g * 512 * 512 * 2, 512, 512, 512, 512);
        p.ntiles = t0;
        if (nj != NTJ) fprintf(stderr, "kernel_launch: job table size %d != %d\n", nj, NTJ);
    }
    p.out = (float*)d_out; p.ws = (unsigned char*)d_ws; p.lo = 0; p.hi = NSTEPS;
    if (hipMemsetAsync((unsigned char*)d_ws + O_BAR, 0, BAR_BYTES, stream) != hipSuccess) { fprintf(stderr, "kernel_launch: memset of barrier words failed\n"); return; }
    void* args[] = {&p};
    hipError_t e = hipLaunchCooperativeKernel((const void*)fwd_megakernel, dim3(grid), dim3(512), args, LDS_BYTES, stream);
    if (e != hipSuccess) fprintf(stderr, "cooperative launch failed: %s (grid %d)\n", hipGetErrorString(e), grid);
}
```
